# Optimizing an MI355X kernel written in HIP

```python
import math
import jax, jax.numpy as jnp
from jax import lax
import numpy as np

D_MODEL = 1024
BATCH = 16
SEQ = 2048
DEPTH = 2

N_MIXERS = 2
N_DIFF = (DEPTH + 1) // 2
N_RET = DEPTH // 2

DA_HEADS = 8
DA_HEAD_DIM = 64
DA_V_DIM = 2 * DA_HEAD_DIM
Q_BLOCK = 128
RET_HEADS = 4
RET_DK = 256
RET_DV = 512
RET_CHUNK = 128
N_EXPERTS = 64
TOP_K = 8
N_GROUPS = 8
TOPK_GROUPS = 4
EXPERT_FF = 256
SHARED_FF = 256
ROUTED_SCALE = 2.5
DISPATCH_BLOCK = 128
EPS = 1e-6

kernel_name = "hybrid_diffattn_retnet_moe_adaln"


def rmsnorm(x, g):
    xf = x.astype(jnp.float32)
    y = xf * lax.rsqrt(jnp.mean(xf * xf, axis=-1, keepdims=True) + EPS)
    return (y * g.astype(jnp.float32)).astype(x.dtype)


def alibi_slopes(n_heads):
    return 2.0 ** (-8.0 * jnp.arange(1, n_heads + 1, dtype=jnp.float32) / n_heads)


def diff_attention(xn, w_in, w_out, lq1, lk1, lq2, lk2, subln_g, layer_idx):
    B, S, _ = xn.shape
    H, dh, dv = DA_HEADS, DA_HEAD_DIM, DA_V_DIM
    proj = xn @ w_in
    q, k, v = jnp.split(proj, [2 * H * dh, 4 * H * dh], axis=-1)
    q = q.reshape(B, S, 2 * H, dh).transpose(0, 2, 1, 3) * (dh ** -0.5)
    k = k.reshape(B, S, 2 * H, dh).transpose(0, 2, 1, 3)
    v = v.reshape(B, S, H, dv).transpose(0, 2, 1, 3)
    lam_init = 0.8 - 0.6 * math.exp(-0.3 * layer_idx)
    lam = (jnp.exp(jnp.sum(lq1.astype(jnp.float32) * lk1.astype(jnp.float32)))
           - jnp.exp(jnp.sum(lq2.astype(jnp.float32) * lk2.astype(jnp.float32))) + lam_init)
    slopes2 = jnp.repeat(alibi_slopes(H), 2)
    n_blk = S // Q_BLOCK
    q_blocks = q.reshape(B, 2 * H, n_blk, Q_BLOCK, dh).transpose(2, 0, 1, 3, 4)
    kpos = jnp.arange(S)

    def one_block(args):
        qb, b_idx = args
        qpos = b_idx * Q_BLOCK + jnp.arange(Q_BLOCK)
        dist = (qpos[:, None] - kpos[None, :]).astype(jnp.float32)
        s = jnp.einsum('bhqd,bhkd->bhqk', qb, k).astype(jnp.float32) - slopes2[:, None, None] * dist
        s = jnp.where(dist >= 0, s, -jnp.inf)
        p = jax.nn.softmax(s, axis=-1).reshape(B, H, 2, Q_BLOCK, S)
        a = p[:, :, 0] - lam * p[:, :, 1]
        return jnp.einsum('bhqk,bhkv->bhqv', a.astype(v.dtype), v)

    o = lax.map(one_block, (q_blocks, jnp.arange(n_blk)))
    o = o.transpose(1, 0, 3, 2, 4).reshape(B, S, H, dv)
    o = rmsnorm(o, subln_g) * (1.0 - lam_init)
    return o.reshape(B, S, H * dv) @ w_out


def retention(xn, w_in, w_out, gn_g):
    B, S, _ = xn.shape
    H, dk, dv, C = RET_HEADS, RET_DK, RET_DV, RET_CHUNK
    n_c = S // C
    proj = (xn @ w_in).astype(jnp.float32)
    q, k, v, g = jnp.split(proj, [H * dk, 2 * H * dk, 2 * H * dk + H * dv], axis=-1)
    q = q.reshape(B, n_c, C, H, dk).transpose(1, 0, 3, 2, 4)
    k = k.reshape(B, n_c, C, H, dk).transpose(1, 0, 3, 2, 4) * (dk ** -0.5)
    v = v.reshape(B, n_c, C, H, dv).transpose(1, 0, 3, 2, 4)
    log_g = jnp.log1p(-(2.0 ** (-5.0 - jnp.arange(H, dtype=jnp.float32))))
    idx = jnp.arange(C, dtype=jnp.float32)
    diff = idx[:, None] - idx[None, :]
    decay = jnp.where(diff >= 0, jnp.exp(log_g[:, None, None] * jnp.maximum(diff, 0.0)), 0.0)
    zeta = jnp.exp(log_g[:, None] * (C - 1 - idx))
    xi = jnp.exp(log_g[:, None] * (idx + 1))
    g_c = jnp.exp(log_g * C)

    def step(R, inp):
        qc, kc, vc = inp
        inner = jnp.einsum('bhid,bhjd->bhij', qc, kc) * decay
        o = (jnp.einsum('bhij,bhjv->bhiv', inner, vc)
             + jnp.einsum('bhid,bhdv->bhiv', qc, R) * xi[:, :, None])
        R = g_c[:, None, None] * R + jnp.einsum('bhjd,bhjv->bhdv', kc * zeta[:, :, None], vc)
        return R, o

    R0 = jnp.zeros((B, H, dk, dv), jnp.float32)
    _, o = lax.scan(step, R0, (q, k, v))
    o = o.transpose(1, 0, 3, 2, 4).reshape(B, S, H, dv)
    o = rmsnorm(o, gn_g.reshape(H, dv))
    y = jax.nn.silu(g) * o.reshape(B, S, H * dv)
    return y.astype(xn.dtype) @ w_out


def moe(xm, router_w, router_b, w1, w3, w2, s_w1, s_w3, s_w2):
    B, S, D = xm.shape
    T = B * S
    E, K, BLK = N_EXPERTS, TOP_K, DISPATCH_BLOCK
    xt = xm.reshape(T, D)
    scores = jax.nn.sigmoid((xt @ router_w).astype(jnp.float32))
    choice = scores + router_b.astype(jnp.float32)
    grp = choice.reshape(T, N_GROUPS, E // N_GROUPS)
    grp_score = lax.top_k(grp, 2)[0].sum(-1)
    _, grp_idx = lax.top_k(grp_score, TOPK_GROUPS)
    grp_mask = jax.nn.one_hot(grp_idx, N_GROUPS, dtype=jnp.float32).sum(1) > 0
    choice = jnp.where(jnp.repeat(grp_mask, E // N_GROUPS, axis=1), choice, -jnp.inf)
    _, top_idx = lax.top_k(choice, K)
    top_w = jnp.take_along_axis(scores, top_idx, axis=1)
    top_w = top_w / jnp.sum(top_w, axis=-1, keepdims=True) * ROUTED_SCALE

    A = T * K
    flat_e = top_idx.reshape(A).astype(jnp.int32)
    flat_tok = jnp.arange(A, dtype=jnp.int32) // K
    flat_w = top_w.reshape(A)
    order = jnp.argsort(flat_e)
    e_s, tok_s, w_s = flat_e[order], flat_tok[order], flat_w[order]
    counts = jnp.bincount(flat_e, length=E).astype(jnp.int32)
    starts = jnp.cumsum(counts) - counts
    pad_counts = (counts + BLK - 1) // BLK * BLK
    pad_ends = jnp.cumsum(pad_counts)
    pad_starts = pad_ends - pad_counts
    dest = pad_starts[e_s] + jnp.arange(A, dtype=jnp.int32) - starts[e_s]
    n_blocks = -(-A // BLK) + E
    P = n_blocks * BLK
    buf_tok = jnp.full((P,), T, jnp.int32).at[dest].set(tok_s)
    buf_w = jnp.zeros((P,), jnp.float32).at[dest].set(w_s)
    blk_e = jnp.minimum(jnp.searchsorted(pad_ends, jnp.arange(n_blocks, dtype=jnp.int32) * BLK,
                                         side='right'), E - 1)
    x_pad = jnp.concatenate([xt, jnp.zeros((1, D), xt.dtype)], axis=0)

    def blk_step(acc, inp):
        tok, wgt, e = inp
        xb = x_pad[tok]
        h = jax.nn.silu(xb @ w1[e]) * (xb @ w3[e])
        yb = (h @ w2[e]) * wgt[:, None].astype(xb.dtype)
        return acc.at[tok].add(yb), None

    acc0 = jnp.zeros((T + 1, D), xt.dtype)
    acc, _ = lax.scan(blk_step, acc0,
                      (buf_tok.reshape(n_blocks, BLK), buf_w.reshape(n_blocks, BLK), blk_e))
    shared = (jax.nn.silu(xt @ s_w1) * (xt @ s_w3)) @ s_w2
    return (acc[:T] + shared).reshape(B, S, D)


def setup_inputs(seed: int = 0) -> dict:
    key = jax.random.key(seed)
    ks = jax.random.split(key, 25)
    D, F, SF, E = D_MODEL, EXPERT_FF, SHARED_FF, N_EXPERTS
    nrm = lambda k, shape, s: jax.random.normal(k, shape, jnp.float32) * s
    gain = lambda k, shape: 1.0 + 0.02 * jax.random.normal(k, shape, jnp.float32)
    ret_in = 2 * RET_HEADS * RET_DK + 2 * RET_HEADS * RET_DV
    return {
        "x": nrm(ks[0], (BATCH, SEQ, D), 1.0),
        "c": nrm(ks[1], (BATCH, D), 1.0),
        "norm_mix": gain(ks[2], (DEPTH, D)),
        "norm_ffn": gain(ks[3], (DEPTH, D)),
        "ada_w": nrm(ks[4], (DEPTH, D, 6 * D), 0.5 * D ** -0.5),
        "ada_b": nrm(ks[5], (DEPTH, 6 * D), 0.02),
        "da_w_in": nrm(ks[6], (N_DIFF, D, 6 * DA_HEADS * DA_HEAD_DIM), D ** -0.5),
        "da_w_out": nrm(ks[7], (N_DIFF, DA_HEADS * DA_V_DIM, D), (DA_HEADS * DA_V_DIM) ** -0.5),
        "da_lq1": nrm(ks[8], (N_DIFF, DA_HEAD_DIM), 0.1),
        "da_lk1": nrm(ks[9], (N_DIFF, DA_HEAD_DIM), 0.1),
        "da_lq2": nrm(ks[10], (N_DIFF, DA_HEAD_DIM), 0.1),
        "da_lk2": nrm(ks[11], (N_DIFF, DA_HEAD_DIM), 0.1),
        "da_subln": gain(ks[12], (N_DIFF, DA_V_DIM)),
        "ret_w_in": nrm(ks[13], (N_RET, D, ret_in), D ** -0.5),
        "ret_w_out": nrm(ks[14], (N_RET, RET_HEADS * RET_DV, D), (RET_HEADS * RET_DV) ** -0.5),
        "ret_gn": gain(ks[15], (N_RET, RET_HEADS * RET_DV)),
        "router_w": nrm(ks[16], (DEPTH, D, E), D ** -0.5),
        "router_b": nrm(ks[17], (DEPTH, E), 0.01),
        "exp_w1": nrm(ks[18], (DEPTH, E, D, F), D ** -0.5),
        "exp_w3": nrm(ks[19], (DEPTH, E, D, F), D ** -0.5),
        "exp_w2": nrm(ks[20], (DEPTH, E, F, D), F ** -0.5),
        "sh_w1": nrm(ks[21], (DEPTH, D, SF), D ** -0.5),
        "sh_w3": nrm(ks[22], (DEPTH, D, SF), D ** -0.5),
        "sh_w2": nrm(ks[23], (DEPTH, SF, D), SF ** -0.5),
        "final_norm": gain(ks[24], (D,)),
    }


def reference(x, c, norm_mix, norm_ffn, ada_w, ada_b, da_w_in, da_w_out, da_lq1, da_lk1,
              da_lq2, da_lk2, da_subln, ret_w_in, ret_w_out, ret_gn, router_w, router_b,
              exp_w1, exp_w3, exp_w2, sh_w1, sh_w3, sh_w2, final_norm):
    for i in range(DEPTH):
        mod = jax.nn.silu(c) @ ada_w[i] + ada_b[i]
        sh_a, sc_a, g_a, sh_f, sc_f, g_f = jnp.split(mod[:, None, :], 6, axis=-1)
        h = rmsnorm(x, norm_mix[i]) * (1.0 + sc_a) + sh_a
        j = i // N_MIXERS
        if i % N_MIXERS == 0:
            y = diff_attention(h, da_w_in[j], da_w_out[j], da_lq1[j], da_lk1[j],
                               da_lq2[j], da_lk2[j], da_subln[j], i)
        else:
            y = retention(h, ret_w_in[j], ret_w_out[j], ret_gn[j])
        x = x + g_a * y
        h = rmsnorm(x, norm_ffn[i]) * (1.0 + sc_f) + sh_f
        x = x + g_f * moe(h, router_w[i], router_b[i], exp_w1[i], exp_w3[i], exp_w2[i],
                          sh_w1[i], sh_w3[i], sh_w2[i])
    return rmsnorm(x, final_norm)
```

```cpp
#include <hip/hip_runtime.h>
#include <cstdio>
#include <cstdint>
#include <type_traits>

typedef unsigned short bf16_t;
typedef short bf16x8 __attribute__((ext_vector_type(8)));
typedef short bf16x4 __attribute__((ext_vector_type(4)));
typedef float f32x4 __attribute__((ext_vector_type(4)));
typedef float f32x2 __attribute__((ext_vector_type(2)));
typedef unsigned u32x4 __attribute__((ext_vector_type(4)));
typedef unsigned u32x2 __attribute__((ext_vector_type(2)));
#define LAS __attribute__((address_space(3)))
typedef LAS unsigned char* ldsp;

constexpr int T = 32768, D = 1024, NB = 16, SEQ = 2048;
constexpr int NTHR = 512, NWAVE = 8, GRID = 256;
constexpr int CH_TOK = 8192, NCHUNK = 4;
constexpr int SLOT_CAP = 81920;
constexpr float LOG2E = 1.4426950408889634f;

constexpr size_t MiB = 1u << 20;
constexpr size_t WS_BAR = 0, WS_CNT = 16384, WS_MOD = 1 * MiB;
constexpr size_t WS_WQKV = 2 * MiB, WS_WO = 8 * MiB, WS_WRI = 10 * MiB, WS_WRO = 22 * MiB;
constexpr size_t WS_W13 = 26 * MiB, WS_W2 = 90 * MiB, WS_WS13 = 122 * MiB, WS_WS2 = 123 * MiB;
constexpr size_t WS_H = 124 * MiB, WS_P = WS_H;
constexpr size_t WS_BIG = 188 * MiB;
constexpr size_t WS_QKV = WS_BIG, WS_AO = WS_BIG + 192 * MiB;
constexpr size_t WS_RP = WS_BIG;
constexpr size_t WS_SELE = WS_BIG, WS_SELW = WS_BIG + 1 * MiB, WS_SELP = WS_BIG + 2 * MiB, WS_TOKL = WS_BIG + 4 * MiB;
constexpr size_t WS_ACT = WS_BIG + 12 * MiB, WS_YS = WS_BIG + 52 * MiB;
constexpr size_t WS_END = WS_BIG + 384 * MiB;
constexpr int LDS_BYTES = 152 * 1024, LDS_MISC = 144 * 1024;

#define XB_TMO      128
#define XB_XCNT(j)  (256  + 64 * (j))
#define XB_XSUB(j)  (1280 + 64 * (j))
#define XB_XGEN(j)  (2304 + 64 * (j))
#define XB_TOP      3328
#define XB_TOPGEN   3392
#define XCD_BAR_WORDS 3456
#define XB_SPIN_CAP (1u << 20)
__device__ __forceinline__ unsigned xb_ld(unsigned* p)              { return __hip_atomic_load(p, __ATOMIC_RELAXED, __HIP_MEMORY_SCOPE_AGENT); }
__device__ __forceinline__ unsigned xb_add(unsigned* p, unsigned v) { return __hip_atomic_fetch_add(p, v, __ATOMIC_RELAXED, __HIP_MEMORY_SCOPE_AGENT); }
__device__ __forceinline__ unsigned xb_xcc_id() { return (unsigned)__builtin_amdgcn_s_getreg((3 << 11) | 20) & 0xFu; }
#define XB_SPIN(cond, bar) do { unsigned _sp = 0; while (cond) { __builtin_amdgcn_s_sleep(1); \
    if ((++_sp & 255u) == 0u) { if (xb_ld(&(bar)[XB_TMO])) break; if (_sp > XB_SPIN_CAP) { atomicAdd(&(bar)[XB_TMO], 1u); break; } } } } while (0)
struct XcdBarrier { unsigned* bar; unsigned x; volatile LAS unsigned* st; };
__device__ __forceinline__ XcdBarrier xcd_barrier_post(unsigned* bar, volatile LAS unsigned* st) {
    XcdBarrier b; b.bar = bar; b.x = xb_xcc_id(); b.st = st;
    if (threadIdx.x == 0) (void)xb_add(&bar[XB_XCNT(b.x)], 1u);
    return b;
}
__device__ __forceinline__ void xcd_barrier_complete(unsigned* bar, unsigned x, unsigned& nloc, unsigned& nx) {
    const unsigned G = gridDim.x * gridDim.y * gridDim.z;
    unsigned sum, cnt, mine, sp = 0u;
    for (;;) {
        sum = 0u; cnt = 0u; mine = 0u;
#pragma unroll
        for (unsigned j = 0; j < 16; ++j) { const unsigned c = xb_ld(&bar[XB_XCNT(j)]); sum += c; cnt += (c > 0u) ? 1u : 0u; mine = (j == x) ? c : mine; }
        if (sum == G) break;
        __builtin_amdgcn_s_sleep(1);
        if ((++sp & 255u) == 0u) { if (xb_ld(&bar[XB_TMO])) break; if (sp > XB_SPIN_CAP) { atomicAdd(&bar[XB_TMO], 1u); break; } }
    }
    nloc = mine > 0u ? mine : 1u; nx = cnt > 0u ? cnt : 1u;
}
__device__ __forceinline__ void xcd_barrier(const XcdBarrier& b) {
    asm volatile("s_waitcnt vmcnt(0)" ::: "memory");
    __syncthreads();
    if (threadIdx.x == 0) {
        unsigned* bar = b.bar; unsigned bx = b.x;
        asm volatile("" : "+s"(bar), "+s"(bx));
        __builtin_amdgcn_s_waitcnt(0);
        unsigned nloc = b.st[0], nx = b.st[1];
        if (nloc == 0u) { xcd_barrier_complete(bar, bx, nloc, nx); b.st[0] = nloc; b.st[1] = nx; }
        const unsigned old = xb_add(&bar[XB_XSUB(bx)], 1u);
        const unsigned gen = old / nloc;
        if (old + 1u == (gen + 1u) * nloc) {
            __builtin_amdgcn_fence(__ATOMIC_RELEASE, "agent");
            asm volatile("s_waitcnt vmcnt(0)" ::: "memory");
            const unsigned og = xb_add(&bar[XB_TOP], 1u);
            const unsigned tg = og / nx;
            if (og + 1u == (tg + 1u) * nx) xb_add(&bar[XB_TOPGEN], 1u);
            else XB_SPIN(xb_ld(&bar[XB_TOPGEN]) == tg, bar);
            __builtin_amdgcn_fence(__ATOMIC_ACQUIRE, "agent");
            xb_add(&bar[XB_XGEN(bx)], 1u);
            asm volatile("s_waitcnt vmcnt(0)" ::: "memory");
        } else {
            XB_SPIN(xb_ld(&bar[XB_XGEN(bx)]) == gen, bar);
            __builtin_amdgcn_fence(__ATOMIC_ACQUIRE, "agent");
            asm volatile("s_waitcnt vmcnt(0)" ::: "memory");
        }
    }
    __syncthreads();
}

template <int N> __device__ __forceinline__ void wait_vm() { asm volatile("s_waitcnt vmcnt(%0)" :: "n"(N) : "memory"); }
#define BAR() __builtin_amdgcn_s_barrier()
#define LDS_WAIT() asm volatile("s_waitcnt lgkmcnt(0)" ::: "memory")
__device__ __forceinline__ unsigned pk2(float a, float b) {
    typedef __bf16 bf2 __attribute__((ext_vector_type(2)));
    f32x2 v = {a, b}; bf2 r = __builtin_convertvector(v, bf2); return __builtin_bit_cast(unsigned, r);
}
__device__ __forceinline__ float bf_lo(unsigned u) { return __uint_as_float(u << 16); }
__device__ __forceinline__ float bf_hi(unsigned u) { return __uint_as_float(u & 0xffff0000u); }
__device__ __forceinline__ float wave_sum(float v) {
#pragma unroll
    for (int o = 1; o < 64; o <<= 1) v += __shfl_xor(v, o);
    return v;
}
__device__ __forceinline__ float fast_exp2(float x) { return __builtin_amdgcn_exp2f(x); }
__device__ __forceinline__ float silu_f(float v) { return v / (1.f + __expf(-v)); }
__device__ __forceinline__ void glds16(const void* src, ldsp dst) {
    unsigned keep; const unsigned d = (unsigned)(__SIZE_TYPE__)dst;
    asm volatile("s_mov_b32 %0, m0\n\ts_mov_b32 m0, %2\n\ts_nop 0\n\tglobal_load_lds_dwordx4 %1, off\n\ts_mov_b32 m0, %0" : "=&s"(keep) : "v"(src), "s"(d) : "memory");
}
__device__ __forceinline__ bf16x8 tr2(ldsp a0, ldsp a1) {
    const bf16x4 t0 = __builtin_amdgcn_ds_read_tr16_b64_v4i16((LAS bf16x4*)a0);
    const bf16x4 t1 = __builtin_amdgcn_ds_read_tr16_b64_v4i16((LAS bf16x4*)a1);
    return __builtin_shufflevector(t0, t1, 0, 1, 2, 3, 4, 5, 6, 7);
}
__device__ __forceinline__ bf16x8 rd2x64(ldsp a0, ldsp a1) {
    const bf16x4 t0 = *(LAS bf16x4*)a0; const bf16x4 t1 = *(LAS bf16x4*)a1;
    return __builtin_shufflevector(t0, t1, 0, 1, 2, 3, 4, 5, 6, 7);
}
__device__ __forceinline__ int fresh_tid() { int t = threadIdx.x; asm volatile("" : "+v"(t)); return t; }
__device__ __forceinline__ int vcu_of_block() { const int bx = blockIdx.x; return (bx & 7) * (GRID / 8) + (bx >> 3); }

struct Args {
    const float* in[25];
    float* out; unsigned char* ws;
};
enum { I_X = 0, I_C, I_NMIX, I_NFFN, I_ADAW, I_ADAB, I_DAWIN, I_DAWOUT, I_LQ1, I_LK1, I_LQ2, I_LK2, I_SUBLN, I_RWIN, I_RWOUT, I_RGN,
       I_ROUTW, I_ROUTB, I_EW1, I_EW3, I_EW2, I_SW1, I_SW3, I_SW2, I_FNORM };

template <int WM, int WN, int MT, int NT, class RowFn, class Epi>
__device__ __forceinline__ void gemm_tile(ldsp lds, const bf16_t* A, size_t lda, const RowFn& rowfn, const bf16_t* Bt, size_t ldb, int n0, int K, const Epi& epi) {
    constexpr int BM = WM * MT * 16, BN = WN * NT * 16, STAGE = (BM + BN) * 128, LA = BM / 64, LB = BN / 64, L = LA + LB;
    static_assert(WM * WN == NWAVE, "8 waves");
    const int tid = fresh_tid(), lane = tid & 63, wid = __builtin_amdgcn_readfirstlane(tid >> 6);
    const int wr = wid / WN, wc = wid % WN, fr = lane & 15, fq = lane >> 4;
    const char* srcA[LA]; const char* srcB[LB];
#pragma unroll
    for (int j = 0; j < LA; ++j) { const int i = wid + 8 * j, row = 8 * i + (lane >> 3), ch = (lane & 7) ^ ((row >> 1) & 7); srcA[j] = (const char*)(A + (size_t)rowfn(row) * lda) + ch * 16; }
#pragma unroll
    for (int j = 0; j < LB; ++j) { const int i = wid + 8 * j, row = 8 * i + (lane >> 3), ch = (lane & 7) ^ ((row >> 1) & 7); srcB[j] = (const char*)(Bt + (size_t)(n0 + row) * ldb) + ch * 16; }
    f32x4 acc[MT][NT];
#pragma unroll
    for (int m = 0; m < MT; ++m)
#pragma unroll
        for (int n = 0; n < NT; ++n) acc[m][n] = (f32x4){0.f, 0.f, 0.f, 0.f};
    const int swz = fr >> 1;
    const int aoff = (wr * MT * 16 + fr) * 128, boff = BM * 128 + (wc * NT * 16 + fr) * 128;
    const int ok0 = ((fq ^ swz) << 4), ok1 = (((4 + fq) ^ swz) << 4);
    auto issue = [&](int s, int t) {
        ldsp st = lds + s * STAGE;
#pragma unroll
        for (int j = 0; j < LA; ++j) glds16(srcA[j] + (size_t)t * 128, st + (wid + 8 * j) * 1024);
#pragma unroll
        for (int j = 0; j < LB; ++j) glds16(srcB[j] + (size_t)t * 128, st + BM * 128 + (wid + 8 * j) * 1024);
    };
    const int nt = K / 64;
    BAR();
    issue(0, 0); if (nt > 1) issue(1, 1);
    int s = 0;
    for (int t = 0; t < nt; ++t) {
        if (t + 1 < nt) wait_vm<L>(); else wait_vm<0>();
        BAR();
        if (t + 2 < nt) { int s2 = s + 2; if (s2 >= 3) s2 -= 3; issue(s2, t + 2); }
        ldsp st = lds + s * STAGE;
#pragma unroll
        for (int kk = 0; kk < 2; ++kk) {
            bf16x8 a[MT], b[NT];
            const int ok = kk ? ok1 : ok0;
#pragma unroll
            for (int m = 0; m < MT; ++m) a[m] = *(LAS bf16x8*)(st + aoff + m * 2048 + ok);
#pragma unroll
            for (int n = 0; n < NT; ++n) b[n] = *(LAS bf16x8*)(st + boff + n * 2048 + ok);
#pragma unroll
            for (int m = 0; m < MT; ++m)
#pragma unroll
                for (int n = 0; n < NT; ++n) acc[m][n] = __builtin_amdgcn_mfma_f32_16x16x32_bf16(b[n], a[m], acc[m][n], 0, 0, 0);
        }
        s = (s == 2) ? 0 : s + 1;
    }
    epi(acc, wr * MT * 16, n0 + wc * NT * 16, fr, fq);
}
struct RowId { int m0; __device__ __forceinline__ int operator()(int r) const { return m0 + r; } };

template <int WM, int WN, int MT, int NT, class EpiMaker>
__device__ __forceinline__ void gemm_dense_phase(ldsp lds, const bf16_t* A, size_t lda, const bf16_t* Bt, size_t ldb, int M, int N, int K, const EpiMaker& mk) {
    constexpr int BM = WM * MT * 16, BN = WN * NT * 16, GM = 4;
    const int nM = M / BM, nN = N / BN, per_x = nM / 8, vcu = vcu_of_block(), xcd = vcu >> 5, local = vcu & 31;
    const int tiles_x = per_x * nN;
    for (int q = local; q < tiles_x; q += 32) {
        const int grp = q / (GM * nN), r = q % (GM * nN), m = xcd * per_x + grp * GM + (r % GM), n = r / GM;
        RowId rf{m * BM};
        gemm_tile<WM, WN, MT, NT>(lds, A, lda, rf, Bt, ldb, n * BN, K, mk(m * BM));
    }
}

struct EpiStoreBf16 {
    bf16_t* O; size_t ldc; int m0;
    template <int MT, int NT> __device__ __forceinline__ void operator()(const f32x4 (&acc)[MT][NT], int rb, int cb, int fr, int fq) const {
#pragma unroll
        for (int m = 0; m < MT; ++m) { bf16_t* rp = O + (size_t)(m0 + rb + m * 16 + fr) * ldc + cb + 4 * fq;
#pragma unroll
            for (int n = 0; n < NT; ++n) { u32x2 w; w.x = pk2(acc[m][n][0], acc[m][n][1]); w.y = pk2(acc[m][n][2], acc[m][n][3]); *(u32x2*)(rp + n * 16) = w; } }
    }
};
struct EpiResidual {
    const float* Xin; float* Xout; const float* gate; int m0;
    template <int MT, int NT> __device__ __forceinline__ void operator()(const f32x4 (&acc)[MT][NT], int rb, int cb, int fr, int fq) const {
#pragma unroll
        for (int m = 0; m < MT; ++m) { const int row = m0 + rb + m * 16 + fr; const float* g = gate + (size_t)(row >> 11) * 6144;
#pragma unroll
            for (int n = 0; n < NT; ++n) { const int col = cb + n * 16 + 4 * fq; const f32x4 xv = *(const f32x4*)(Xin + (size_t)row * D + col); const f32x4 gv = *(const f32x4*)(g + col);
                *(f32x4*)(Xout + (size_t)row * D + col) = xv + gv * acc[m][n]; } }
    }
};
struct EpiRetProj {
    bf16_t* O; int m0;
    template <int MT, int NT> __device__ __forceinline__ void operator()(const f32x4 (&acc)[MT][NT], int rb, int cb, int fr, int fq) const {
        float l2g = 0.f, pre = 1.f;
        if (cb < 2048) { const int h = (cb & 1023) >> 8; l2g = __log2f(1.f - exp2f(-5.f - (float)h)); if (cb >= 1024) { l2g = -l2g; pre = 0.0625f; } }
#pragma unroll
        for (int m = 0; m < MT; ++m) { const int row = m0 + rb + m * 16 + fr; const float sc = pre * exp2f(l2g * (float)(row & 127)); bf16_t* rp = O + (size_t)row * 6144 + cb + 4 * fq;
#pragma unroll
            for (int n = 0; n < NT; ++n) { u32x2 w; w.x = pk2(acc[m][n][0] * sc, acc[m][n][1] * sc); w.y = pk2(acc[m][n][2] * sc, acc[m][n][3] * sc); *(u32x2*)(rp + n * 16) = w; } }
    }
};
struct EpiCausalP {
    bf16_t* O;
    template <int MT, int NT> __device__ __forceinline__ void operator()(const f32x4 (&acc)[MT][NT], int rb, int cb, int fr, int fq) const {
#pragma unroll
        for (int m = 0; m < MT; ++m) { const int i = rb + m * 16 + fr; bf16_t* rp = O + (size_t)i * 128 + cb + 4 * fq;
#pragma unroll
            for (int n = 0; n < NT; ++n) { const int j = cb + n * 16 + 4 * fq; f32x4 v = acc[m][n];
                v[0] = (i >= j) ? v[0] : 0.f; v[1] = (i >= j + 1) ? v[1] : 0.f; v[2] = (i >= j + 2) ? v[2] : 0.f; v[3] = (i >= j + 3) ? v[3] : 0.f;
                u32x2 w; w.x = pk2(v[0], v[1]); w.y = pk2(v[2], v[3]); *(u32x2*)(rp + n * 16) = w; } }
    }
};
struct EpiSwiGLU {
    bf16_t* O; int slot0;
    template <int MT, int NT> __device__ __forceinline__ void operator()(const f32x4 (&acc)[MT][NT], int rb, int cb, int fr, int fq) const {
        static_assert(NT == 4, "NT");
#pragma unroll
        for (int m = 0; m < MT; ++m) { bf16_t* rp = O + (size_t)(slot0 + rb + m * 16 + fr) * 256 + (cb >> 1) + 4 * fq;
#pragma unroll
            for (int p = 0; p < 2; ++p) { const f32x4 a = acc[m][2 * p], b = acc[m][2 * p + 1]; u32x2 w;
                w.x = pk2(silu_f(a[0]) * b[0], silu_f(a[1]) * b[1]); w.y = pk2(silu_f(a[2]) * b[2], silu_f(a[3]) * b[3]); *(u32x2*)(rp + p * 16) = w; } }
    }
};

__device__ __forceinline__ void transpose_item(const float* W, int K, int N, bf16_t* WT, int mode, LAS float* scr, int item, int lane) {
    const int nblk = N / 32, kb = item / nblk, nb = item % nblk, k0 = 64 * kb, n0 = 32 * nb;
#pragma unroll 8
    for (int i = 0; i < 32; ++i) { const int kk = 2 * i + (lane >> 5); scr[kk * 33 + (lane & 31)] = W[(size_t)(k0 + kk) * N + n0 + (lane & 31)]; }
    LDS_WAIT();
    const int c = lane & 7;
#pragma unroll
    for (int j = 0; j < 4; ++j) { const int n = (lane >> 3) + 8 * j; const LAS float* s = scr + (8 * c) * 33 + n;
        u32x4 o; o.x = pk2(s[0 * 33], s[1 * 33]); o.y = pk2(s[2 * 33], s[3 * 33]); o.z = pk2(s[4 * 33], s[5 * 33]); o.w = pk2(s[6 * 33], s[7 * 33]);
        const int nn = n0 + n; const int row = mode == 0 ? nn : ((nn >> 4) * 32 + (mode == 2 ? 16 : 0) + (nn & 15));
        *(u32x4*)(WT + (size_t)row * K + k0 + 8 * c) = o; }
    LDS_WAIT();
}
__device__ __forceinline__ void convert_expert_weights(const Args& a, int layer, ldsp lds, int gw, int ngw, int wave, int lane) {
    LAS float* scr = (LAS float*)(lds + wave * 16384);
    unsigned char* ws = a.ws;
    constexpr int I13 = (D / 64) * (256 / 32), I2 = (256 / 64) * (D / 32);
    constexpr int NE = 64 * I13;
    constexpr int TOTAL = 3 * NE + 3 * 128;
    for (int it = gw; it < TOTAL; it += ngw) {
        int r = it;
        if (r < NE) { const int e = r / I13; transpose_item(a.in[I_EW1] + ((size_t)layer * 64 + e) * D * 256, D, 256, (bf16_t*)(ws + WS_W13) + (size_t)e * 512 * D, 1, scr, r % I13, lane); continue; } r -= NE;
        if (r < NE) { const int e = r / I13; transpose_item(a.in[I_EW3] + ((size_t)layer * 64 + e) * D * 256, D, 256, (bf16_t*)(ws + WS_W13) + (size_t)e * 512 * D, 2, scr, r % I13, lane); continue; } r -= NE;
        if (r < NE) { const int e = r / I2; transpose_item(a.in[I_EW2] + ((size_t)layer * 64 + e) * 256 * D, 256, D, (bf16_t*)(ws + WS_W2) + (size_t)e * D * 256, 0, scr, r % I2, lane); continue; } r -= NE;
        if (r < 128) { transpose_item(a.in[I_SW1] + (size_t)layer * D * 256, D, 256, (bf16_t*)(ws + WS_WS13), 1, scr, r, lane); continue; } r -= 128;
        if (r < 128) { transpose_item(a.in[I_SW3] + (size_t)layer * D * 256, D, 256, (bf16_t*)(ws + WS_WS13), 2, scr, r, lane); continue; } r -= 128;
        transpose_item(a.in[I_SW2] + (size_t)layer * 256 * D, 256, D, (bf16_t*)(ws + WS_WS2), 0, scr, r, lane);
    }
}
__device__ __forceinline__ void convert_dense_weights(const Args& a, ldsp lds, int gw, int ngw, int wave, int lane) {
    LAS float* scr = (LAS float*)(lds + wave * 16384);
    unsigned char* ws = a.ws;
    constexpr int IQ = 16 * 96, IO = 16 * 32, IRI = 16 * 192, IRO = 32 * 32;
    for (int it = gw; it < IQ + IO + IRI + IRO; it += ngw) {
        int r = it;
        if (r < IQ) { transpose_item(a.in[I_DAWIN], D, 3072, (bf16_t*)(ws + WS_WQKV), 0, scr, r, lane); continue; } r -= IQ;
        if (r < IO) { transpose_item(a.in[I_DAWOUT], D, D, (bf16_t*)(ws + WS_WO), 0, scr, r, lane); continue; } r -= IO;
        if (r < IRI) { transpose_item(a.in[I_RWIN], D, 6144, (bf16_t*)(ws + WS_WRI), 0, scr, r, lane); continue; } r -= IRI;
        transpose_item(a.in[I_RWOUT], 2048, D, (bf16_t*)(ws + WS_WRO), 0, scr, r, lane);
    }
}
__device__ __forceinline__ void mod_items(const Args& a, ldsp lds) {
    const int tid = threadIdx.x;
    if ((int)blockIdx.x >= 192) return;
    LAS float* sl = (LAS float*)lds;
    LAS float* red = (LAS float*)(lds + 65536);
    const float* c = a.in[I_C];
    for (int i = tid; i < 16 * 1024; i += NTHR) sl[i] = silu_f(c[i]);
    __syncthreads();
    float* mod = (float*)(a.ws + WS_MOD);
    for (int item = blockIdx.x; item < 192; item += GRID) {
        const int layer = item / 96, j0 = (item % 96) * 64, kq = tid >> 6, col = tid & 63;
        const float* w = a.in[I_ADAW] + (size_t)layer * D * 6144 + j0 + col;
        float acc[16];
#pragma unroll
        for (int b = 0; b < 16; ++b) acc[b] = 0.f;
        for (int k = kq * 128; k < kq * 128 + 128; ++k) { const float wv = w[(size_t)k * 6144];
#pragma unroll
            for (int b = 0; b < 16; ++b) acc[b] += sl[b * 1024 + k] * wv; }
#pragma unroll
        for (int b = 0; b < 16; ++b) red[(kq * 16 + b) * 64 + col] = acc[b];
        __syncthreads();
        for (int o = tid; o < 1024; o += NTHR) { const int b = o >> 6, cc = o & 63; float s = a.in[I_ADAB][(size_t)layer * 6144 + j0 + cc];
#pragma unroll
            for (int q = 0; q < 8; ++q) s += red[(q * 16 + b) * 64 + cc];
            mod[((size_t)layer * 16 + b) * 6144 + j0 + cc] = s; }
        __syncthreads();
    }
}

__device__ __forceinline__ void adaln_store(const f32x4 (&v)[4], float rstd, const float* gain, const float* sh, const float* sc, bf16_t* hrow, int lane) {
#pragma unroll
    for (int j = 0; j < 4; ++j) { const int col = 4 * lane + 256 * j; const f32x4 g = *(const f32x4*)(gain + col), s1 = *(const f32x4*)(sc + col), s0 = *(const f32x4*)(sh + col);
        const f32x4 h = v[j] * rstd * g * (s1 + 1.f) + s0; u32x2 w; w.x = pk2(h[0], h[1]); w.y = pk2(h[2], h[3]); *(u32x2*)(hrow + col) = w; }
}
__device__ __forceinline__ void adaln_phase(const float* X, const float* gain, const float* mod_sh  , const float* mod_sc, bf16_t* H, int gw, int ngw, int lane) {
    for (int row = gw; row < T; row += ngw) {
        const float* xr = X + (size_t)row * D; f32x4 v[4]; float ss = 0.f;
#pragma unroll
        for (int j = 0; j < 4; ++j) { v[j] = *(const f32x4*)(xr + 4 * lane + 256 * j); ss += v[j][0] * v[j][0] + v[j][1] * v[j][1] + v[j][2] * v[j][2] + v[j][3] * v[j][3]; }
        const float rstd = rsqrtf(wave_sum(ss) * (1.f / D) + 1e-6f); const int b = row >> 11;
        adaln_store(v, rstd, gain, mod_sh + (size_t)b * 6144, mod_sc + (size_t)b * 6144, H + (size_t)row * D, lane);
    }
}

__device__ __forceinline__ void attn_phase(ldsp lds, const bf16_t* qkv, bf16_t* ao, float lam, const float* subln_g) {
    const int tid = fresh_tid(), lane = tid & 63, wid = __builtin_amdgcn_readfirstlane(tid >> 6), map = wid & 1, qg = wid >> 1, fr = lane & 15, fq = lane >> 4;
    constexpr int STAGE = 32768;
    const float cs = 0.125f * LOG2E;
    const int kswz = fr >> 1, kok0 = ((fq ^ kswz) << 4), kok1 = (((4 + fq) ^ kswz) << 4), koff = map * 8192 + fr * 128;
    const int vq = fr >> 2, vp = fr & 3, vrow = 4 * fq + vq, vsw = ((vrow & 7) << 1);
    int voff[8];
#pragma unroll
    for (int dt = 0; dt < 8; ++dt) voff[dt] = 16384 + vrow * 256 + ((((2 * dt + (vp >> 1)) ^ vsw) & 15) << 4) + (vp & 1) * 8;
    for (int round = 0; round < 8; ++round) {
        const int i = blockIdx.x, jgrp = i >> 7, bh = i & 127;
        const int qb = (round & 1) ? (14 - 2 * round + jgrp) : (15 - 2 * round - jgrp);
        const int b = bh >> 3, h = bh & 7;
        const size_t tok0 = (size_t)b * SEQ;
        const float slope2 = exp2f(-(float)(h + 1)) * LOG2E;
        bf16x8 qf[2][2];
#pragma unroll
        for (int qt = 0; qt < 2; ++qt)
#pragma unroll
            for (int kk = 0; kk < 2; ++kk) qf[qt][kk] = *(const bf16x8*)(qkv + (tok0 + qb * 128 + qg * 32 + qt * 16 + fr) * 3072 + (2 * h + map) * 64 + kk * 32 + fq * 8);
        asm volatile("" :: "v"(qf[0][0]), "v"(qf[0][1]), "v"(qf[1][0]), "v"(qf[1][1]));
        const char* srcK0; const char* srcV0;
        { const int row = 8 * wid + (lane >> 3), ch = (lane & 7) ^ ((row >> 1) & 7);
          srcK0 = (const char*)(qkv + (tok0 + row) * 3072 + 1024 + (2 * h) * 64) + ch * 16; }
        { const int row = 4 * wid + (lane >> 4), ch = (lane & 15) ^ ((row & 7) << 1); srcV0 = (const char*)(qkv + (tok0 + row) * 3072 + 2048 + h * 128) + ch * 16; }
        auto issue = [&](int s, int t) {
            ldsp st = lds + s * STAGE; const size_t adv = (size_t)t * 64 * 3072 * 2;
            glds16(srcK0 + adv, st + wid * 1024); glds16(srcK0 + adv + 128, st + 8192 + wid * 1024);
            glds16(srcV0 + adv, st + 16384 + wid * 1024); glds16(srcV0 + adv + (size_t)32 * 6144, st + 16384 + (wid + 8) * 1024);
        };
        f32x4 o[8][2];
#pragma unroll
        for (int dt = 0; dt < 8; ++dt) { o[dt][0] = (f32x4){0.f, 0.f, 0.f, 0.f}; o[dt][1] = (f32x4){0.f, 0.f, 0.f, 0.f}; }
        float mrow[2] = {-__builtin_inff(), -__builtin_inff()}, lrow[2] = {0.f, 0.f};
        const int ntile = 2 * qb + 2;
        const int qlast = qb * 128 + qg * 32 + 31, qfirst = qb * 128 + qg * 32;
        BAR();
        issue(0, 0); issue(1, 1);
        int s = 0;
        for (int t = 0; t < ntile; ++t) {
            if (t + 1 < ntile) wait_vm<4>(); else wait_vm<0>();
            BAR();
            if (t + 2 < ntile) { int s2 = s + 2; if (s2 >= 3) s2 -= 3; issue(s2, t + 2); }
            ldsp st = lds + s * STAGE;
            const int key0 = 64 * t;
            if (key0 <= qlast) {
                f32x4 sc[4][2];
#pragma unroll
                for (int kt = 0; kt < 4; ++kt) { sc[kt][0] = (f32x4){0.f, 0.f, 0.f, 0.f}; sc[kt][1] = (f32x4){0.f, 0.f, 0.f, 0.f}; }
#pragma unroll
                for (int kk = 0; kk < 2; ++kk) {
                    const int ok = kk ? kok1 : kok0;
#pragma unroll
                    for (int kt = 0; kt < 4; ++kt) { const bf16x8 kf = *(LAS bf16x8*)(st + koff + kt * 2048 + ok);
                        sc[kt][0] = __builtin_amdgcn_mfma_f32_16x16x32_bf16(kf, qf[0][kk], sc[kt][0], 0, 0, 0);
                        sc[kt][1] = __builtin_amdgcn_mfma_f32_16x16x32_bf16(kf, qf[1][kk], sc[kt][1], 0, 0, 0); }
                }
                __builtin_amdgcn_sched_barrier(0);
                const bool need_mask = (key0 + 63 > qfirst);
                const float kb0 = slope2 * (float)(key0 + 4 * fq);
                bf16x8 pf[2][2];
#pragma unroll
                for (int qt = 0; qt < 2; ++qt) {
                    const int qrow = qb * 128 + qg * 32 + qt * 16 + fr;
                    float mx = -__builtin_inff();
#pragma unroll
                    for (int kt = 0; kt < 4; ++kt)
#pragma unroll
                        for (int r = 0; r < 4; ++r) { float v = sc[kt][qt][r] * cs + (kb0 + slope2 * (float)(16 * kt + r));
                            if (need_mask && (key0 + 16 * kt + 4 * fq + r > qrow)) v = -__builtin_inff();
                            sc[kt][qt][r] = v; mx = fmaxf(mx, v); }
                    mx = fmaxf(mx, __shfl_xor(mx, 16)); mx = fmaxf(mx, __shfl_xor(mx, 32));
                    const float mnew = fmaxf(mrow[qt], mx), alpha = fast_exp2(mrow[qt] - mnew);
                    mrow[qt] = mnew;
                    float ps = 0.f;
#pragma unroll
                    for (int kt = 0; kt < 4; ++kt)
#pragma unroll
                        for (int r = 0; r < 4; ++r) { const float p = fast_exp2(sc[kt][qt][r] - mnew); sc[kt][qt][r] = p; ps += p; }
                    lrow[qt] = lrow[qt] * alpha + ps;
#pragma unroll
                    for (int dt = 0; dt < 8; ++dt) o[dt][qt] = o[dt][qt] * alpha;
#pragma unroll
                    for (int s2 = 0; s2 < 2; ++s2) { u32x4 w; w.x = pk2(sc[2 * s2][qt][0], sc[2 * s2][qt][1]); w.y = pk2(sc[2 * s2][qt][2], sc[2 * s2][qt][3]);
                        w.z = pk2(sc[2 * s2 + 1][qt][0], sc[2 * s2 + 1][qt][1]); w.w = pk2(sc[2 * s2 + 1][qt][2], sc[2 * s2 + 1][qt][3]); pf[qt][s2] = __builtin_bit_cast(bf16x8, w); }
                }
#pragma unroll
                for (int s2 = 0; s2 < 2; ++s2)
#pragma unroll
                    for (int dt = 0; dt < 8; ++dt) { const bf16x8 vf = tr2(st + voff[dt] + s2 * 8192, st + voff[dt] + s2 * 8192 + 4096);
                        o[dt][0] = __builtin_amdgcn_mfma_f32_16x16x32_bf16(vf, pf[0][s2], o[dt][0], 0, 0, 0);
                        o[dt][1] = __builtin_amdgcn_mfma_f32_16x16x32_bf16(vf, pf[1][s2], o[dt][1], 0, 0, 0);
                        if ((dt & 3) == 3) __builtin_amdgcn_sched_barrier(0); }
            }
            s = (s == 2) ? 0 : s + 1;
        }
#pragma unroll
        for (int qt = 0; qt < 2; ++qt) { float l = lrow[qt]; l += __shfl_xor(l, 16); l += __shfl_xor(l, 32); const float inv = 1.f / l;
#pragma unroll
            for (int dt = 0; dt < 8; ++dt) o[dt][qt] = o[dt][qt] * inv; }
        BAR();
        LAS float* xb = (LAS float*)lds + qg * 4096;
        if (map == 1) {
#pragma unroll
            for (int dt = 0; dt < 8; ++dt)
#pragma unroll
                for (int qt = 0; qt < 2; ++qt)
#pragma unroll
                    for (int r = 0; r < 4; ++r) xb[((dt * 2 + qt) * 4 + r) * 64 + lane] = o[dt][qt][r];
        }
        LDS_WAIT(); BAR();
        if (map == 0) {
            const float* sg = subln_g; asm volatile("" : "+s"(sg));
#pragma unroll
            for (int qt = 0; qt < 2; ++qt) {
                float ss = 0.f;
#pragma unroll
                for (int dt = 0; dt < 8; ++dt)
#pragma unroll
                    for (int r = 0; r < 4; ++r) { const float v = o[dt][qt][r] - lam * xb[((dt * 2 + qt) * 4 + r) * 64 + lane]; o[dt][qt][r] = v; ss += v * v; }
                ss += __shfl_xor(ss, 16); ss += __shfl_xor(ss, 32);
                const float rstd = rsqrtf(ss * (1.f / 128.f) + 1e-6f) * 0.8f;
                bf16_t* orow = ao + (tok0 + qb * 128 + qg * 32 + qt * 16 + fr) * D + h * 128 + 4 * fq;
#pragma unroll
                for (int dt = 0; dt < 8; ++dt) { const f32x4 g = *(const f32x4*)(sg + dt * 16 + 4 * fq); const f32x4 v = o[dt][qt] * rstd * g;
                    u32x2 w; w.x = pk2(v[0], v[1]); w.y = pk2(v[2], v[3]); *(u32x2*)(orow + dt * 16) = w; }
            }
        }
        LDS_WAIT(); BAR();
    }
}

__device__ __forceinline__ void chain_phase(ldsp lds, bf16_t* rp, const bf16_t* P) {
    const int tid = fresh_tid(), lane = tid & 63, wid = __builtin_amdgcn_readfirstlane(tid >> 6), fr = lane & 15, fq = lane >> 4;
    constexpr int STAGE = 32768, NSTG = 4;
    const int chain = blockIdx.x, b = chain >> 4, h = (chain >> 2) & 3, sl = chain & 3;
    const size_t tok0 = (size_t)b * SEQ;
    const float lg = __log2f(1.f - exp2f(-5.f - (float)h));
    const float gamma = exp2f(lg), g127 = exp2f(lg * 127.f), g128 = exp2f(lg * 128.f);
    const bf16_t* vbase = rp + tok0 * 6144 + 2048 + h * 512 + sl * 128;
    const bf16_t* qbase = rp + tok0 * 6144 + h * 256;
    const bf16_t* kbase = rp + tok0 * 6144 + 1024 + h * 256;
    const bf16_t* pbase = P + (size_t)((b * 4 + h) * 16) * 16384;
    unsigned vsrc0, psrc0, qsrc0, ksrc0;
    { const int row = 4 * wid + (lane >> 4); vsrc0 = (unsigned)(row * 6144 * 2 + (((lane & 15) ^ ((row & 7) << 1)) << 4)); psrc0 = (unsigned)(row * 256 + (((lane & 15) ^ (row & 15)) << 4)); }
    { const int row = 8 * wid + (lane >> 3); qsrc0 = (unsigned)(row * 6144 * 2 + (((lane & 7) ^ ((row >> 1) & 7)) << 4)); ksrc0 = (unsigned)(row * 6144 * 2 + (((lane & 7) ^ (((row >> 1) & 3) << 1)) << 4)); }
    auto issue = [&](int s, int g) {
        ldsp st = lds + s * STAGE; const int c = g / 6, kind = g - c * 6; const size_t coff = (size_t)c * 128 * 6144 * 2;
        if (kind == 0) {
            const char* bp = (const char*)vbase + coff;
#pragma unroll
            for (int jj = 0; jj < 4; ++jj) glds16(bp + (size_t)jj * 32 * 12288 + vsrc0, st + (wid + 8 * jj) * 1024);
        } else if (kind == 5) {
            const char* bp = (const char*)pbase + (size_t)c * 32768;
#pragma unroll
            for (int jj = 0; jj < 4; ++jj) glds16(bp + (size_t)jj * 32 * 256 + psrc0, st + (wid + 8 * jj) * 1024);
        } else { const int p = kind - 1;
            const char* bq = (const char*)qbase + coff + p * 128; const char* bk = (const char*)kbase + coff + p * 128;
#pragma unroll
            for (int jj = 0; jj < 2; ++jj) glds16(bq + (size_t)jj * 64 * 12288 + qsrc0, st + (wid + 8 * jj) * 1024);
#pragma unroll
            for (int jj = 0; jj < 2; ++jj) glds16(bk + (size_t)jj * 64 * 12288 + ksrc0, st + 16384 + (wid + 8 * jj) * 1024);
        }
    };
    const int tq = fr >> 2, tp = fr & 3;
    const int vrow = 4 * fq + tq;
    const int vfo = vrow * 256 + ((((2 * wid + (tp >> 1)) ^ ((vrow & 7) << 1)) & 15) << 4) + (tp & 1) * 8;
    const int ksw = ((vrow >> 1) & 3) << 1;
    int kfo[4];
#pragma unroll
    for (int dkt = 0; dkt < 4; ++dkt) kfo[dkt] = 16384 + vrow * 128 + ((((2 * dkt + (tp >> 1)) ^ ksw) & 7) << 4) + (tp & 1) * 8;
    const int qsw = fr >> 1;
    int qfo[2][2];
#pragma unroll
    for (int s2 = 0; s2 < 2; ++s2)
#pragma unroll
        for (int hf = 0; hf < 2; ++hf) qfo[s2][hf] = fr * 128 + ((((4 * s2 + 2 * hf + (fq >> 1)) ^ qsw) & 7) << 4) + (fq & 1) * 8;
    int pfo[4][2];
#pragma unroll
    for (int s4 = 0; s4 < 4; ++s4)
#pragma unroll
        for (int hf = 0; hf < 2; ++hf) pfo[s4][hf] = fr * 256 + ((((4 * s4 + 2 * hf + (fq >> 1)) ^ fr) & 15) << 4) + (fq & 1) * 8;

    f32x4 R[16];
#pragma unroll
    for (int i = 0; i < 16; ++i) R[i] = (f32x4){0.f, 0.f, 0.f, 0.f};
    f32x4 o[8];
#pragma unroll
    for (int it = 0; it < 8; ++it) o[it] = (f32x4){0.f, 0.f, 0.f, 0.f};
    bf16x8 vf[4];
#pragma unroll
    for (int s4 = 0; s4 < 4; ++s4) vf[s4] = (bf16x8){0, 0, 0, 0, 0, 0, 0, 0};
    constexpr int NG = 16 * 6;
    BAR();
    issue(0, 0); issue(1, 1); issue(2, 2);
    for (int c = 0; c < 16; ++c) {
        auto step = [&](auto KC) {
            constexpr int kind = decltype(KC)::value;
            const int g = c * 6 + kind;
            if (g + 2 < NG) wait_vm<8>(); else if (g + 1 < NG) wait_vm<4>(); else wait_vm<0>();
            BAR();
            if (g + 3 < NG) issue((g + 3) & 3, g + 3);
            ldsp st = lds + (g & 3) * STAGE;
            if constexpr (kind == 0) {
#pragma unroll
                for (int s4 = 0; s4 < 4; ++s4) vf[s4] = tr2(st + vfo + s4 * 8192, st + vfo + s4 * 8192 + 4096);
#pragma unroll
                for (int it = 0; it < 8; ++it) o[it] = (f32x4){0.f, 0.f, 0.f, 0.f};
            } else if constexpr (kind == 5) {
#pragma unroll
                for (int it = 0; it < 8; ++it) o[it] = o[it] * gamma;
#pragma unroll
                for (int s4 = 0; s4 < 4; ++s4) {
#pragma unroll
                    for (int it = 0; it < 8; ++it) { const bf16x8 pf = rd2x64(st + pfo[s4][0] + it * 4096, st + pfo[s4][1] + it * 4096);
                        o[it] = __builtin_amdgcn_mfma_f32_16x16x32_bf16(vf[s4], pf, o[it], 0, 0, 0); if (it == 3) __builtin_amdgcn_sched_barrier(0); }
                    __builtin_amdgcn_sched_barrier(0);
                }
                bf16_t* ob = rp + (tok0 + (size_t)c * 128) * 6144 + 2048 + h * 512 + sl * 128 + 16 * wid + 4 * fq;
#pragma unroll
                for (int it = 0; it < 8; ++it) { u32x2 w; w.x = pk2(o[it][0], o[it][1]); w.y = pk2(o[it][2], o[it][3]); *(u32x2*)(ob + (size_t)(16 * it + fr) * 6144) = w; }
            } else {
                constexpr int p = kind - 1;
#pragma unroll
                for (int s2 = 0; s2 < 2; ++s2) {
                    u32x4 w; const f32x4 r0 = R[4 * p + 2 * s2], r1 = R[4 * p + 2 * s2 + 1];
                    w.x = pk2(r0[0], r0[1]); w.y = pk2(r0[2], r0[3]); w.z = pk2(r1[0], r1[1]); w.w = pk2(r1[2], r1[3]);
                    const bf16x8 rf = __builtin_bit_cast(bf16x8, w);
#pragma unroll
                    for (int it = 0; it < 8; ++it) { const bf16x8 qf = rd2x64(st + qfo[s2][0] + it * 2048, st + qfo[s2][1] + it * 2048);
                        o[it] = __builtin_amdgcn_mfma_f32_16x16x32_bf16(rf, qf, o[it], 0, 0, 0); if (it == 3) __builtin_amdgcn_sched_barrier(0); }
                    __builtin_amdgcn_sched_barrier(0);
                }
#pragma unroll
                for (int dkt = 0; dkt < 4; ++dkt) {
                    f32x4 acc = (f32x4){0.f, 0.f, 0.f, 0.f};
#pragma unroll
                    for (int s4 = 0; s4 < 4; ++s4) { const bf16x8 kf = tr2(st + kfo[dkt] + s4 * 4096, st + kfo[dkt] + s4 * 4096 + 2048);
                        acc = __builtin_amdgcn_mfma_f32_16x16x32_bf16(kf, vf[s4], acc, 0, 0, 0); }
                    R[4 * p + dkt] = R[4 * p + dkt] * g128 + acc * g127;
                }
                __builtin_amdgcn_sched_barrier(0);
            }
        };
        step(std::integral_constant<int, 0>{}); step(std::integral_constant<int, 1>{}); step(std::integral_constant<int, 2>{});
        step(std::integral_constant<int, 3>{}); step(std::integral_constant<int, 4>{}); step(std::integral_constant<int, 5>{});
    }
}

__device__ __forceinline__ void gnorm_phase(bf16_t* rp, const float* gn, int gw, int ngw, int lane) {
    for (int row = gw; row < T; row += ngw) {
        bf16_t* orow = rp + (size_t)row * 6144 + 2048; const bf16_t* grow = rp + (size_t)row * 6144 + 4096;
#pragma unroll
        for (int hh = 0; hh < 4; ++hh) {
            const u32x4 ov = *(const u32x4*)(orow + hh * 512 + 8 * lane), gv = *(const u32x4*)(grow + hh * 512 + 8 * lane);
            float of[8] = {bf_lo(ov.x), bf_hi(ov.x), bf_lo(ov.y), bf_hi(ov.y), bf_lo(ov.z), bf_hi(ov.z), bf_lo(ov.w), bf_hi(ov.w)};
            float gf[8] = {bf_lo(gv.x), bf_hi(gv.x), bf_lo(gv.y), bf_hi(gv.y), bf_lo(gv.z), bf_hi(gv.z), bf_lo(gv.w), bf_hi(gv.w)};
            float ss = 0.f;
#pragma unroll
            for (int e = 0; e < 8; ++e) ss += of[e] * of[e];
            const float rstd = rsqrtf(wave_sum(ss) * (1.f / 512.f) + 1e-6f);
            const f32x4 w0 = *(const f32x4*)(gn + hh * 512 + 8 * lane), w1 = *(const f32x4*)(gn + hh * 512 + 8 * lane + 4);
            float y[8];
#pragma unroll
            for (int e = 0; e < 8; ++e) y[e] = silu_f(gf[e]) * of[e] * rstd * (e < 4 ? w0[e] : w1[e - 4]);
            u32x4 w; w.x = pk2(y[0], y[1]); w.y = pk2(y[2], y[3]); w.z = pk2(y[4], y[5]); w.w = pk2(y[6], y[7]);
            *(u32x4*)(orow + hh * 512 + 8 * lane) = w;
        }
    }
}

__device__ __forceinline__ void router_phase(ldsp lds, const float* XR, const float* gain, const float* mod_sh, const float* mod_sc, const float* rw, const float* rbias,
                                             bf16_t* H, int* sel_e, float* sel_w, int* sel_p, int* tokl, unsigned* cnt, int gw, int ngw, int wave, int lane) {
    LAS float* hb = (LAS float*)(lds + wave * 16384);
    const float rb = rbias[lane];
    for (int t0 = gw * 4; t0 < T; t0 += ngw * 4) {
#pragma unroll
        for (int tt = 0; tt < 4; ++tt) {
            const int row = t0 + tt; const float* xr = XR + (size_t)row * D; f32x4 v[4]; float ss = 0.f;
#pragma unroll
            for (int j = 0; j < 4; ++j) { v[j] = *(const f32x4*)(xr + 4 * lane + 256 * j); ss += v[j][0] * v[j][0] + v[j][1] * v[j][1] + v[j][2] * v[j][2] + v[j][3] * v[j][3]; }
            const float rstd = rsqrtf(wave_sum(ss) * (1.f / D) + 1e-6f); const int b = row >> 11;
            const float* sh = mod_sh + (size_t)b * 6144; const float* sc = mod_sc + (size_t)b * 6144; bf16_t* hrow = H + (size_t)row * D;
#pragma unroll
            for (int j = 0; j < 4; ++j) { const int col = 4 * lane + 256 * j; const f32x4 g = *(const f32x4*)(gain + col), s1 = *(const f32x4*)(sc + col), s0 = *(const f32x4*)(sh + col);
                const f32x4 hv = v[j] * rstd * g * (s1 + 1.f) + s0; u32x2 w; w.x = pk2(hv[0], hv[1]); w.y = pk2(hv[2], hv[3]); *(u32x2*)(hrow + col) = w;
#pragma unroll
                for (int e = 0; e < 4; ++e) hb[(col + e) * 4 + tt] = hv[e]; }
        }
        LDS_WAIT();
        f32x4 acc = (f32x4){0.f, 0.f, 0.f, 0.f};
#pragma unroll 8
        for (int k = 0; k < 1024; ++k) { const f32x4 hv = *(LAS f32x4*)(hb + k * 4); const float w = rw[k * 64 + lane]; acc = acc + hv * w; }
        LDS_WAIT();
#pragma unroll
        for (int tt = 0; tt < 4; ++tt) {
            const int tok = t0 + tt;
            const float score = 1.f / (1.f + __expf(-acc[tt])), choice = score + rb;
            int rk = 0;
#pragma unroll
            for (int d = 1; d < 8; ++d) { const int oi = (lane + d) & 7; const float other = __shfl(choice, (lane & ~7) | oi); rk += (other > choice || (other == choice && oi < (lane & 7))) ? 1 : 0; }
            float gs = rk < 2 ? choice : 0.f;
            gs += __shfl_xor(gs, 1); gs += __shfl_xor(gs, 2); gs += __shfl_xor(gs, 4);
            int rg = 0;
#pragma unroll
            for (int j = 0; j < 8; ++j) { const float gj = __int_as_float(__builtin_amdgcn_readlane(__float_as_int(gs), 8 * j)); rg += (gj > gs || (gj == gs && j < (lane >> 3))) ? 1 : 0; }
            const float c2 = rg < 4 ? choice : -__builtin_inff();
            int r8 = 0;
#pragma unroll
            for (int j = 0; j < 64; ++j) { const float cj = __int_as_float(__builtin_amdgcn_readlane(__float_as_int(c2), j)); r8 += (cj > c2 || (cj == c2 && j < lane)) ? 1 : 0; }
            const bool chosen = r8 < 8;
            const float wsum = wave_sum(chosen ? score : 0.f);
            if (chosen) {
                const int chunk = tok / CH_TOK;
                const unsigned pos = atomicAdd(&cnt[chunk * 64 + lane], 1u);
                sel_e[tok * 8 + r8] = lane; sel_w[tok * 8 + r8] = score / wsum * 2.5f; sel_p[tok * 8 + r8] = (int)pos;
                tokl[(size_t)(chunk * 64 + lane) * CH_TOK + pos] = tok;
            }
        }
    }
}

__device__ __forceinline__ void build_tstart(const unsigned* cnt, int c, LAS int* ts) {
    if (threadIdx.x == 0) { int run = 0; for (int e = 0; e < 64; ++e) { ts[e] = run; run += ((int)cnt[c * 64 + e] + 127) >> 7; } ts[64] = run; ts[65] = run + CH_TOK / 128; }
}
struct RowGather { const int* list; int cnt, r0, dummy; __device__ __forceinline__ int operator()(int r) const { const int g = r0 + r; return g < cnt ? list[g] : dummy; } };

__device__ __forceinline__ void moe_up_phase(ldsp lds, const unsigned char* ws, const unsigned* cnt, int c, const LAS int* ts) {
    const bf16_t* H = (const bf16_t*)(ws + WS_H); bf16_t* act = (bf16_t*)(ws + WS_ACT); const int* tokl = (const int*)(ws + WS_TOKL);
    const int total = ts[65] * 2, vcu = vcu_of_block();
    for (int Lt = vcu; Lt < total; Lt += GRID) {
        const int mt = Lt >> 1, nt = Lt & 1;
        int e = 0;
#pragma unroll
        for (int stp = 64; stp >= 1; stp >>= 1) if (e + stp <= 64 && ts[e + stp] <= mt) e += stp;
        const int ml = mt - ts[e];
        EpiSwiGLU epi{act, mt * 128};
        if (e < 64) { RowGather rf{tokl + (size_t)(c * 64 + e) * CH_TOK, (int)cnt[c * 64 + e], ml * 128, c * CH_TOK};
            gemm_tile<2, 4, 4, 4>(lds, H, D, rf, (const bf16_t*)(ws + WS_W13) + (size_t)e * 512 * D, D, nt * 256, D, epi); }
        else { RowId rf{c * CH_TOK + ml * 128};
            gemm_tile<2, 4, 4, 4>(lds, H, D, rf, (const bf16_t*)(ws + WS_WS13), D, nt * 256, D, epi); }
    }
}
__device__ __forceinline__ void moe_down_phase(ldsp lds, const unsigned char* ws, const LAS int* ts) {
    const bf16_t* act = (const bf16_t*)(ws + WS_ACT); bf16_t* ys = (bf16_t*)(ws + WS_YS);
    const int total = ts[65] * 4, vcu = vcu_of_block();
    for (int Lt = vcu; Lt < total; Lt += GRID) {
        const int mt = Lt >> 2, nt = Lt & 3;
        int e = 0;
#pragma unroll
        for (int stp = 64; stp >= 1; stp >>= 1) if (e + stp <= 64 && ts[e + stp] <= mt) e += stp;
        RowId rf{mt * 128}; EpiStoreBf16 epi{ys, (size_t)D, mt * 128};
        const bf16_t* w2 = e < 64 ? (const bf16_t*)(ws + WS_W2) + (size_t)e * D * 256 : (const bf16_t*)(ws + WS_WS2);
        gemm_tile<2, 4, 4, 4>(lds, act, 256, rf, w2, 256, nt * 256, 256, epi);
    }
}
__device__ __forceinline__ void moe_combine_phase(const unsigned char* ws, float* XR, int c, const LAS int* ts, const float* gate_f  , bool last_layer,
                                                  const float* gain_next, const float* mod_sh_next, const float* mod_sc_next, bf16_t* H, const float* fnorm, int gw, int ngw, int lane) {
    const bf16_t* ys = (const bf16_t*)(ws + WS_YS); const int* sel_e = (const int*)(ws + WS_SELE); const float* sel_w = (const float*)(ws + WS_SELW); const int* sel_p = (const int*)(ws + WS_SELP);
    for (int tl = gw; tl < CH_TOK; tl += ngw) {
        const int tok = c * CH_TOK + tl; const int b = tok >> 11;
        float acc[16];
#pragma unroll
        for (int i = 0; i < 16; ++i) acc[i] = 0.f;
#pragma unroll
        for (int k = 0; k < 9; ++k) {
            int slot; float w;
            if (k < 8) { const int e = sel_e[tok * 8 + k]; slot = ts[e] * 128 + sel_p[tok * 8 + k]; w = sel_w[tok * 8 + k]; } else { slot = ts[64] * 128 + tl; w = 1.f; }
            const bf16_t* yr = ys + (size_t)slot * D;
#pragma unroll
            for (int j = 0; j < 2; ++j) { const u32x4 v = *(const u32x4*)(yr + 8 * lane + 512 * j);
                acc[8 * j + 0] += w * bf_lo(v.x); acc[8 * j + 1] += w * bf_hi(v.x); acc[8 * j + 2] += w * bf_lo(v.y); acc[8 * j + 3] += w * bf_hi(v.y);
                acc[8 * j + 4] += w * bf_lo(v.z); acc[8 * j + 5] += w * bf_hi(v.z); acc[8 * j + 6] += w * bf_lo(v.w); acc[8 * j + 7] += w * bf_hi(v.w); }
        }
        float* xr = XR + (size_t)tok * D; const float* gf = gate_f + (size_t)b * 6144; float ss = 0.f; float xn[16];
#pragma unroll
        for (int j = 0; j < 2; ++j)
#pragma unroll
            for (int q = 0; q < 2; ++q) { const int col = 8 * lane + 512 * j + 4 * q; const f32x4 xv = *(const f32x4*)(xr + col), gv = *(const f32x4*)(gf + col);
#pragma unroll
                for (int e = 0; e < 4; ++e) { const float v = xv[e] + gv[e] * acc[8 * j + 4 * q + e]; xn[8 * j + 4 * q + e] = v; ss += v * v; } }
        const float rstd = rsqrtf(wave_sum(ss) * (1.f / D) + 1e-6f);
        if (last_layer) {
#pragma unroll
            for (int j = 0; j < 2; ++j)
#pragma unroll
                for (int q = 0; q < 2; ++q) { const int col = 8 * lane + 512 * j + 4 * q; const f32x4 g = *(const f32x4*)(fnorm + col); f32x4 ov;
#pragma unroll
                    for (int e = 0; e < 4; ++e) ov[e] = xn[8 * j + 4 * q + e] * rstd * g[e];
                    *(f32x4*)(xr + col) = ov; }
        } else {
            const float* sh = mod_sh_next + (size_t)b * 6144; const float* sc = mod_sc_next + (size_t)b * 6144; bf16_t* hrow = H + (size_t)tok * D;
#pragma unroll
            for (int j = 0; j < 2; ++j) { u32x4 hw;
#pragma unroll
                for (int q = 0; q < 2; ++q) { const int col = 8 * lane + 512 * j + 4 * q; const f32x4 g = *(const f32x4*)(gain_next + col), s1 = *(const f32x4*)(sc + col), s0 = *(const f32x4*)(sh + col); f32x4 xv, hv;
#pragma unroll
                    for (int e = 0; e < 4; ++e) { xv[e] = xn[8 * j + 4 * q + e]; hv[e] = xv[e] * rstd * g[e] * (s1[e] + 1.f) + s0[e]; }
                    *(f32x4*)(xr + col) = xv;
                    if (q == 0) { hw.x = pk2(hv[0], hv[1]); hw.y = pk2(hv[2], hv[3]); } else { hw.z = pk2(hv[0], hv[1]); hw.w = pk2(hv[2], hv[3]); } }
                *(u32x4*)(hrow + 8 * lane + 512 * j) = hw; }
        }
    }
}

#define FRESH_IDS() const int t_ = fresh_tid(); const int lane = t_ & 63, wave = __builtin_amdgcn_readfirstlane(t_ >> 6); const int gw = blockIdx.x * NWAVE + wave, ngw = GRID * NWAVE; (void)lane; (void)gw; (void)ngw
__device__ __forceinline__ void moe_layer(const Args& a, ldsp lds, const XcdBarrier& bar, int layer) {
    unsigned char* ws = a.ws;
    float* mod = (float*)(ws + WS_MOD); float* XR = a.out; bf16_t* H = (bf16_t*)(ws + WS_H);
    const float* modl = mod + (size_t)layer * 16 * 6144;
    const float* modn = mod + (size_t)16 * 6144;
    unsigned* cl = (unsigned*)(ws + WS_CNT) + layer * 256;
    LAS int* ts0 = (LAS int*)(lds + LDS_MISC); LAS int* ts1 = ts0 + 80;
    { FRESH_IDS();
      router_phase(lds, XR, a.in[I_NFFN] + (size_t)layer * D, modl + 3072, modl + 4096, a.in[I_ROUTW] + (size_t)layer * D * 64, a.in[I_ROUTB] + layer * 64,
                   H, (int*)(ws + WS_SELE), (float*)(ws + WS_SELW), (int*)(ws + WS_SELP), (int*)(ws + WS_TOKL), cl, gw, ngw, wave, lane); }
    xcd_barrier(bar);
    for (int c = 0; c <= NCHUNK; ++c) {
        __syncthreads();
        if (c < NCHUNK) build_tstart(cl, c, ts0);
        if (c > 0) build_tstart(cl, c - 1, ts1);
        __syncthreads();
        if (c < NCHUNK) moe_up_phase(lds, ws, cl, c, ts0);
        if (c > 0) { FRESH_IDS(); moe_combine_phase(ws, XR, c - 1, ts1, modl + 5120, layer == 1, a.in[I_NMIX] + D, modn, modn + 1024, H, a.in[I_FNORM], gw, ngw, lane); }
        if (c == NCHUNK) break;
        xcd_barrier(bar);
        moe_down_phase(lds, ws, ts0);
        xcd_barrier(bar);
    }
}
__global__ void __launch_bounds__(NTHR, 2) fwd_kernel(Args a) {
    extern __shared__ __attribute__((aligned(16))) unsigned char lds_raw[];
    ldsp lds = (ldsp)lds_raw;
    unsigned char* ws = a.ws;
    volatile LAS unsigned* st = (volatile LAS unsigned*)(lds + LDS_BYTES - 16);
    if (threadIdx.x < 4) st[threadIdx.x] = 0u;
    __syncthreads();
    XcdBarrier bar = xcd_barrier_post((unsigned*)(ws + WS_BAR), st);
    float* mod = (float*)(ws + WS_MOD);
    float* XR = a.out;
    bf16_t* H = (bf16_t*)(ws + WS_H);

    mod_items(a, lds);
    __syncthreads();
    { FRESH_IDS(); convert_dense_weights(a, lds, gw, ngw, wave, lane); convert_expert_weights(a, 0, lds, gw, ngw, wave, lane); }
    xcd_barrier(bar);

    { FRESH_IDS(); adaln_phase(a.in[I_X], a.in[I_NMIX], mod, mod + 1024, H, gw, ngw, lane); }
    xcd_barrier(bar);
    { bf16_t* qkv = (bf16_t*)(ws + WS_QKV);
      auto mk = [&](int m0) { return EpiStoreBf16{qkv, (size_t)3072, m0}; };
      gemm_dense_phase<4, 2, 4, 4>(lds, H, D, (const bf16_t*)(ws + WS_WQKV), D, T, 3072, D, mk); }
    xcd_barrier(bar);
    { float d1 = 0.f, d2 = 0.f;
      for (int i = 0; i < 64; ++i) { d1 += a.in[I_LQ1][i] * a.in[I_LK1][i]; d2 += a.in[I_LQ2][i] * a.in[I_LK2][i]; }
      const float lam = __expf(d1) - __expf(d2) + 0.2f;
      attn_phase(lds, (const bf16_t*)(ws + WS_QKV), (bf16_t*)(ws + WS_AO), lam, a.in[I_SUBLN]); }
    xcd_barrier(bar);
    { auto mk = [&](int m0) { return EpiResidual{a.in[I_X], XR, mod + 2048, m0}; };
      gemm_dense_phase<4, 2, 4, 4>(lds, (const bf16_t*)(ws + WS_AO), D, (const bf16_t*)(ws + WS_WO), D, T, D, D, mk); }
    xcd_barrier(bar);
    moe_layer(a, lds, bar, 0);
    xcd_barrier(bar);

    const float* mod1 = mod + (size_t)16 * 6144;
    { bf16_t* rp = (bf16_t*)(ws + WS_RP);
      auto mk = [&](int m0) { return EpiRetProj{rp, m0}; };
      gemm_dense_phase<4, 2, 4, 4>(lds, H, D, (const bf16_t*)(ws + WS_WRI), D, T, 6144, D, mk); }
    xcd_barrier(bar);
    { const bf16_t* rp = (const bf16_t*)(ws + WS_RP); bf16_t* P = (bf16_t*)(ws + WS_P);
      for (int u = blockIdx.x; u < 1024; u += GRID) { const int bh = u >> 4, c = u & 15, b = bh >> 2, h = bh & 3;
          const bf16_t* qa = rp + ((size_t)b * SEQ + c * 128) * 6144 + h * 256; RowId rf{0}; EpiCausalP epi{P + (size_t)u * 16384};
          gemm_tile<2, 4, 4, 2>(lds, qa, 6144, rf, qa + 1024, 6144, 0, 256, epi); }
      __syncthreads();
      { FRESH_IDS(); convert_expert_weights(a, 1, lds, gw, ngw, wave, lane); } }
    xcd_barrier(bar);
    chain_phase(lds, (bf16_t*)(ws + WS_RP), (const bf16_t*)(ws + WS_P));
    xcd_barrier(bar);
    { FRESH_IDS(); gnorm_phase((bf16_t*)(ws + WS_RP), a.in[I_RGN], gw, ngw, lane); }
    xcd_barrier(bar);
    { auto mk = [&](int m0) { return EpiResidual{XR, XR, mod1 + 2048, m0}; };
      gemm_dense_phase<4, 2, 4, 4>(lds, (const bf16_t*)(ws + WS_RP) + 2048, 6144, (const bf16_t*)(ws + WS_WRO), 2048, T, D, 2048, mk); }
    xcd_barrier(bar);
    moe_layer(a, lds, bar, 1);
}

extern "C" void kernel_launch(void* const* d_in, const int* in_sizes, int n_in, void* d_out, int out_size, void* d_ws, size_t ws_size, hipStream_t stream) {
    static int ready = 0;
    if (ready == 0) {
        if (n_in != 25 || out_size != T * D || ws_size < WS_END) { fprintf(stderr, "kernel_launch: unexpected shapes (n_in %d out %d ws %zu need %zu)\n", n_in, out_size, ws_size, (size_t)WS_END); ready = -1; return; }
        (void)hipFuncSetAttribute((const void*)fwd_kernel, hipFuncAttributeMaxDynamicSharedMemorySize, LDS_BYTES);
        ready = 1;
    }
    if (ready < 0) return;
    (void)hipMemsetAsync(d_ws, 0, 65536, stream);
    Args a{};
    for (int i = 0; i < 25; ++i) a.in[i] = (const float*)d_in[i];
    a.out = (float*)d_out; a.ws = (unsigned char*)d_ws;
    hipLaunchKernelGGL(fwd_kernel, dim3(GRID), dim3(NTHR), LDS_BYTES, stream, a);
}
```

```cpp
#include <hip/hip_runtime.h>
#include <cstdio>
#include <cstdint>
#include <type_traits>

typedef unsigned short bf16_t;
typedef short bf16x8 __attribute__((ext_vector_type(8)));
typedef short bf16x4 __attribute__((ext_vector_type(4)));
typedef float f32x4 __attribute__((ext_vector_type(4)));
typedef float f32x2 __attribute__((ext_vector_type(2)));
typedef unsigned u32x4 __attribute__((ext_vector_type(4)));
typedef unsigned u32x2 __attribute__((ext_vector_type(2)));
#define LAS __attribute__((address_space(3)))
typedef LAS unsigned char* ldsp;

constexpr int T = 32768, D = 1024, NB = 16, SEQ = 2048;
constexpr int NTHR = 512, NWAVE = 8, GRID = 256;
constexpr int CH_TOK = 8192, NCHUNK = 4;
constexpr int SLOT_CAP = 81920;
constexpr float LOG2E = 1.4426950408889634f;
#define REP_GEMM 1
#define REP_ATTN 1
#define REP_MOE 1
#define REP_P0 1
#define REP_ROUTER 1
#define REP_CHAIN 1


constexpr size_t MiB = 1u << 20;
constexpr size_t WS_BAR = 0, WS_CNT = 16384, WS_RWT = 256 * 1024  , WS_MOD = 1 * MiB;
constexpr size_t WS_WQKV = 2 * MiB, WS_WO = 8 * MiB, WS_WRI = 10 * MiB, WS_WRO = 22 * MiB;
constexpr size_t WS_W13 = 26 * MiB, WS_W2 = 90 * MiB, WS_WS13 = 122 * MiB, WS_WS2 = 123 * MiB;
constexpr size_t WS_H = 124 * MiB, WS_P = WS_H;
constexpr size_t WS_BIG = 188 * MiB;
constexpr size_t WS_QKV = WS_BIG, WS_AO = WS_BIG + 192 * MiB;
constexpr size_t WS_RP = WS_BIG;
constexpr size_t WS_SELE = WS_BIG, WS_SELW = WS_BIG + 1 * MiB, WS_SELP = WS_BIG + 2 * MiB, WS_TOKL = WS_BIG + 4 * MiB;
constexpr size_t WS_ACT = WS_BIG + 12 * MiB, WS_YS = WS_BIG + 52 * MiB;
constexpr size_t WS_END = WS_BIG + 384 * MiB;
constexpr int LDS_BYTES = 152 * 1024, LDS_MISC = 144 * 1024;

#define XB_TMO      128
#define XB_XCNT(j)  (256  + 64 * (j))
#define XB_XSUB(j)  (1280 + 64 * (j))
#define XB_XGEN(j)  (2304 + 64 * (j))
#define XB_TOP      3328
#define XB_TOPGEN   3392
#define XCD_BAR_WORDS 3456
#define XB_SPIN_CAP (1u << 20)
__device__ __forceinline__ unsigned xb_ld(unsigned* p)              { return __hip_atomic_load(p, __ATOMIC_RELAXED, __HIP_MEMORY_SCOPE_AGENT); }
__device__ __forceinline__ unsigned xb_add(unsigned* p, unsigned v) { return __hip_atomic_fetch_add(p, v, __ATOMIC_RELAXED, __HIP_MEMORY_SCOPE_AGENT); }
__device__ __forceinline__ unsigned xb_xcc_id() { return (unsigned)__builtin_amdgcn_s_getreg((3 << 11) | 20) & 0xFu; }
#define XB_SPIN(cond, bar) do { unsigned _sp = 0; while (cond) { __builtin_amdgcn_s_sleep(1); \
    if ((++_sp & 255u) == 0u) { if (xb_ld(&(bar)[XB_TMO])) break; if (_sp > XB_SPIN_CAP) { atomicAdd(&(bar)[XB_TMO], 1u); break; } } } } while (0)
struct XcdBarrier { unsigned* bar; unsigned x; volatile LAS unsigned* st; };
__device__ __forceinline__ XcdBarrier xcd_barrier_post(unsigned* bar, volatile LAS unsigned* st) {
    XcdBarrier b; b.bar = bar; b.x = xb_xcc_id(); b.st = st;
    if (threadIdx.x == 0) (void)xb_add(&bar[XB_XCNT(b.x)], 1u);
    return b;
}
__device__ __forceinline__ void xcd_barrier_complete(unsigned* bar, unsigned x, unsigned& nloc, unsigned& nx) {
    const unsigned G = gridDim.x * gridDim.y * gridDim.z;
    unsigned sum, cnt, mine, sp = 0u;
    for (;;) {
        sum = 0u; cnt = 0u; mine = 0u;
#pragma unroll
        for (unsigned j = 0; j < 16; ++j) { const unsigned c = xb_ld(&bar[XB_XCNT(j)]); sum += c; cnt += (c > 0u) ? 1u : 0u; mine = (j == x) ? c : mine; }
        if (sum == G) break;
        __builtin_amdgcn_s_sleep(1);
        if ((++sp & 255u) == 0u) { if (xb_ld(&bar[XB_TMO])) break; if (sp > XB_SPIN_CAP) { atomicAdd(&bar[XB_TMO], 1u); break; } }
    }
    nloc = mine > 0u ? mine : 1u; nx = cnt > 0u ? cnt : 1u;
}
__device__ __forceinline__ void xcd_barrier(const XcdBarrier& b) {
    asm volatile("s_waitcnt vmcnt(0)" ::: "memory");
    __syncthreads();
    if (threadIdx.x == 0) {
        unsigned* bar = b.bar; unsigned bx = b.x;
        asm volatile("" : "+s"(bar), "+s"(bx));
        __builtin_amdgcn_s_waitcnt(0);
        unsigned nloc = b.st[0], nx = b.st[1];
        if (nloc == 0u) { xcd_barrier_complete(bar, bx, nloc, nx); b.st[0] = nloc; b.st[1] = nx; }
        const unsigned old = xb_add(&bar[XB_XSUB(bx)], 1u);
        const unsigned gen = old / nloc;
        if (old + 1u == (gen + 1u) * nloc) {
            __builtin_amdgcn_fence(__ATOMIC_RELEASE, "agent");
            asm volatile("s_waitcnt vmcnt(0)" ::: "memory");
            const unsigned og = xb_add(&bar[XB_TOP], 1u);
            const unsigned tg = og / nx;
            if (og + 1u == (tg + 1u) * nx) xb_add(&bar[XB_TOPGEN], 1u);
            else XB_SPIN(xb_ld(&bar[XB_TOPGEN]) == tg, bar);
            __builtin_amdgcn_fence(__ATOMIC_ACQUIRE, "agent");
            xb_add(&bar[XB_XGEN(bx)], 1u);
            asm volatile("s_waitcnt vmcnt(0)" ::: "memory");
        } else {
            XB_SPIN(xb_ld(&bar[XB_XGEN(bx)]) == gen, bar);
            __builtin_amdgcn_fence(__ATOMIC_ACQUIRE, "agent");
            asm volatile("s_waitcnt vmcnt(0)" ::: "memory");
        }
    }
    __syncthreads();
}

template <int N> __device__ __forceinline__ void wait_vm() { asm volatile("s_waitcnt vmcnt(%0)" :: "n"(N) : "memory"); }
#define BAR() __builtin_amdgcn_s_barrier()
#define LDS_WAIT() asm volatile("s_waitcnt lgkmcnt(0)" ::: "memory")
__device__ __forceinline__ unsigned pk2(float a, float b) {
    typedef __bf16 bf2 __attribute__((ext_vector_type(2)));
    f32x2 v = {a, b}; bf2 r = __builtin_convertvector(v, bf2); return __builtin_bit_cast(unsigned, r);
}
__device__ __forceinline__ float bf_lo(unsigned u) { return __uint_as_float(u << 16); }
__device__ __forceinline__ float bf_hi(unsigned u) { return __uint_as_float(u & 0xffff0000u); }
__device__ __forceinline__ float wave_sum(float v) {
#pragma unroll
    for (int o = 1; o < 64; o <<= 1) v += __shfl_xor(v, o);
    return v;
}
__device__ __forceinline__ float fast_exp2(float x) { return __builtin_amdgcn_exp2f(x); }
__device__ __forceinline__ float silu_f(float v) { return v / (1.f + __expf(-v)); }
__device__ __forceinline__ void glds16(const void* src, ldsp dst) {
    unsigned keep; const unsigned d = (unsigned)(__SIZE_TYPE__)dst;
    asm volatile("s_mov_b32 %0, m0\n\ts_mov_b32 m0, %2\n\ts_nop 0\n\tglobal_load_lds_dwordx4 %1, off\n\ts_mov_b32 m0, %0" : "=&s"(keep) : "v"(src), "s"(d) : "memory");
}
__device__ __forceinline__ bf16x8 tr2(ldsp a0, ldsp a1) {
    const bf16x4 t0 = __builtin_amdgcn_ds_read_tr16_b64_v4i16((LAS bf16x4*)a0);
    const bf16x4 t1 = __builtin_amdgcn_ds_read_tr16_b64_v4i16((LAS bf16x4*)a1);
    return __builtin_shufflevector(t0, t1, 0, 1, 2, 3, 4, 5, 6, 7);
}
__device__ __forceinline__ bf16x8 rd2x64(ldsp a0, ldsp a1) {
    const bf16x4 t0 = *(LAS bf16x4*)a0; const bf16x4 t1 = *(LAS bf16x4*)a1;
    return __builtin_shufflevector(t0, t1, 0, 1, 2, 3, 4, 5, 6, 7);
}
__device__ __forceinline__ int fresh_tid() { int t = threadIdx.x; asm volatile("" : "+v"(t)); return t; }
__device__ __forceinline__ int vcu_of_block() { const int bx = blockIdx.x; return (bx & 7) * (GRID / 8) + (bx >> 3); }

struct Args {
    const float* in[25];
    float* out; unsigned char* ws;
};
enum { I_X = 0, I_C, I_NMIX, I_NFFN, I_ADAW, I_ADAB, I_DAWIN, I_DAWOUT, I_LQ1, I_LK1, I_LQ2, I_LK2, I_SUBLN, I_RWIN, I_RWOUT, I_RGN,
       I_ROUTW, I_ROUTB, I_EW1, I_EW3, I_EW2, I_SW1, I_SW3, I_SW2, I_FNORM };

template <int WM, int WN, int MT, int NT, class RowFn, class Epi>
__device__ __forceinline__ void gemm_tile(ldsp lds, const bf16_t* A, size_t lda, const RowFn& rowfn, const bf16_t* Bt, size_t ldb, int n0, int K, const Epi& epi) {
    constexpr int BM = WM * MT * 16, BN = WN * NT * 16, STAGE = (BM + BN) * 128, LA = BM / 64, LB = BN / 64, L = LA + LB;
    static_assert(WM * WN == NWAVE, "8 waves");
    const int tid = fresh_tid(), lane = tid & 63, wid = __builtin_amdgcn_readfirstlane(tid >> 6);
    const int wr = wid / WN, wc = wid % WN, fr = lane & 15, fq = lane >> 4;
    const char* srcA[LA]; const char* srcB[LB];
#pragma unroll
    for (int j = 0; j < LA; ++j) { const int i = wid + 8 * j, row = 8 * i + (lane >> 3), ch = (lane & 7) ^ ((row >> 1) & 7); srcA[j] = (const char*)(A + (size_t)rowfn(row) * lda) + ch * 16; }
#pragma unroll
    for (int j = 0; j < LB; ++j) { const int i = wid + 8 * j, row = 8 * i + (lane >> 3), ch = (lane & 7) ^ ((row >> 1) & 7); srcB[j] = (const char*)(Bt + (size_t)(n0 + row) * ldb) + ch * 16; }
    f32x4 acc[MT][NT];
#pragma unroll
    for (int m = 0; m < MT; ++m)
#pragma unroll
        for (int n = 0; n < NT; ++n) acc[m][n] = (f32x4){0.f, 0.f, 0.f, 0.f};
    const int swz = fr >> 1;
    const int aoff = (wr * MT * 16 + fr) * 128, boff = BM * 128 + (wc * NT * 16 + fr) * 128;
    const int ok0 = ((fq ^ swz) << 4), ok1 = (((4 + fq) ^ swz) << 4);
    auto issue = [&](int s, int t) {
        ldsp st = lds + s * STAGE;
#pragma unroll
        for (int j = 0; j < LA; ++j) glds16(srcA[j] + (size_t)t * 128, st + (wid + 8 * j) * 1024);
#pragma unroll
        for (int j = 0; j < LB; ++j) glds16(srcB[j] + (size_t)t * 128, st + BM * 128 + (wid + 8 * j) * 1024);
    };
    const int nt = K / 64;
    BAR();
    issue(0, 0); if (nt > 1) issue(1, 1);
    int s = 0;
    for (int t = 0; t < nt; ++t) {
        if (t + 1 < nt) wait_vm<L>(); else wait_vm<0>();
        BAR();
        if (t + 2 < nt) { int s2 = s + 2; if (s2 >= 3) s2 -= 3; issue(s2, t + 2); }
        ldsp st = lds + s * STAGE;
#pragma unroll
        for (int kk = 0; kk < 2; ++kk) {
            bf16x8 a[MT], b[NT];
            const int ok = kk ? ok1 : ok0;
#pragma unroll
            for (int m = 0; m < MT; ++m) a[m] = *(LAS bf16x8*)(st + aoff + m * 2048 + ok);
#pragma unroll
            for (int n = 0; n < NT; ++n) b[n] = *(LAS bf16x8*)(st + boff + n * 2048 + ok);
#pragma unroll
            for (int m = 0; m < MT; ++m)
#pragma unroll
                for (int n = 0; n < NT; ++n) acc[m][n] = __builtin_amdgcn_mfma_f32_16x16x32_bf16(b[n], a[m], acc[m][n], 0, 0, 0);
        }
        s = (s == 2) ? 0 : s + 1;
    }
    epi(acc, wr * MT * 16, n0 + wc * NT * 16, fr, fq);
}
struct RowId { int m0; __device__ __forceinline__ int operator()(int r) const { return m0 + r; } };

template <int WM, int WN, int MT, int NT, class EpiMaker>
__device__ __forceinline__ void gemm_dense_phase(ldsp lds, const bf16_t* A, size_t lda, const bf16_t* Bt, size_t ldb, int M, int N, int K, const EpiMaker& mk) {
    constexpr int BM = WM * MT * 16, BN = WN * NT * 16, GM = 4;
    const int nM = M / BM, nN = N / BN, per_x = nM / 8, vcu = vcu_of_block(), xcd = vcu >> 5, local = vcu & 31;
    const int tiles_x = per_x * nN;
    for (int q = local; q < tiles_x; q += 32) {
        const int grp = q / (GM * nN), r = q % (GM * nN), m = xcd * per_x + grp * GM + (r % GM), n = r / GM;
        RowId rf{m * BM};
        gemm_tile<WM, WN, MT, NT>(lds, A, lda, rf, Bt, ldb, n * BN, K, mk(m * BM));
    }
}

struct EpiStoreBf16 {
    bf16_t* O; size_t ldc; int m0;
    template <int MT, int NT> __device__ __forceinline__ void operator()(const f32x4 (&acc)[MT][NT], int rb, int cb, int fr, int fq) const {
#pragma unroll
        for (int m = 0; m < MT; ++m) { bf16_t* rp = O + (size_t)(m0 + rb + m * 16 + fr) * ldc + cb + 4 * fq;
#pragma unroll
            for (int n = 0; n < NT; ++n) { u32x2 w; w.x = pk2(acc[m][n][0], acc[m][n][1]); w.y = pk2(acc[m][n][2], acc[m][n][3]); *(u32x2*)(rp + n * 16) = w; } }
    }
};
struct EpiResidual {
    const float* Xin; float* Xout; const float* gate; int m0;
    template <int MT, int NT> __device__ __forceinline__ void operator()(const f32x4 (&acc)[MT][NT], int rb, int cb, int fr, int fq) const {
#pragma unroll
        for (int m = 0; m < MT; ++m) { const int row = m0 + rb + m * 16 + fr; const float* g = gate + (size_t)(row >> 11) * 6144;
#pragma unroll
            for (int n = 0; n < NT; ++n) { const int col = cb + n * 16 + 4 * fq; const f32x4 xv = *(const f32x4*)(Xin + (size_t)row * D + col); const f32x4 gv = *(const f32x4*)(g + col);
                *(f32x4*)(Xout + (size_t)row * D + col) = xv + gv * acc[m][n]; } }
    }
};
struct EpiRetProj {
    bf16_t* O; int m0;
    template <int MT, int NT> __device__ __forceinline__ void operator()(const f32x4 (&acc)[MT][NT], int rb, int cb, int fr, int fq) const {
        float l2g = 0.f, pre = 1.f;
        if (cb < 2048) { const int h = (cb & 1023) >> 8; l2g = __log2f(1.f - exp2f(-5.f - (float)h)); if (cb >= 1024) { l2g = -l2g; pre = 0.0625f; } }
#pragma unroll
        for (int m = 0; m < MT; ++m) { const int row = m0 + rb + m * 16 + fr; const float sc = pre * exp2f(l2g * (float)(row & 127)); bf16_t* rp = O + (size_t)row * 6144 + cb + 4 * fq;
#pragma unroll
            for (int n = 0; n < NT; ++n) { u32x2 w; w.x = pk2(acc[m][n][0] * sc, acc[m][n][1] * sc); w.y = pk2(acc[m][n][2] * sc, acc[m][n][3] * sc); *(u32x2*)(rp + n * 16) = w; } }
    }
};
struct EpiCausalP {
    bf16_t* O;
    template <int MT, int NT> __device__ __forceinline__ void operator()(const f32x4 (&acc)[MT][NT], int rb, int cb, int fr, int fq) const {
#pragma unroll
        for (int m = 0; m < MT; ++m) { const int i = rb + m * 16 + fr; bf16_t* rp = O + (size_t)i * 128 + cb + 4 * fq;
#pragma unroll
            for (int n = 0; n < NT; ++n) { const int j = cb + n * 16 + 4 * fq; f32x4 v = acc[m][n];
                v[0] = (i >= j) ? v[0] : 0.f; v[1] = (i >= j + 1) ? v[1] : 0.f; v[2] = (i >= j + 2) ? v[2] : 0.f; v[3] = (i >= j + 3) ? v[3] : 0.f;
                u32x2 w; w.x = pk2(v[0], v[1]); w.y = pk2(v[2], v[3]); *(u32x2*)(rp + n * 16) = w; } }
    }
};
struct EpiSwiGLU {
    bf16_t* O; int slot0;
    template <int MT, int NT> __device__ __forceinline__ void operator()(const f32x4 (&acc)[MT][NT], int rb, int cb, int fr, int fq) const {
        static_assert(NT == 4, "NT");
#pragma unroll
        for (int m = 0; m < MT; ++m) { bf16_t* rp = O + (size_t)(slot0 + rb + m * 16 + fr) * 256 + (cb >> 1) + 4 * fq;
#pragma unroll
            for (int p = 0; p < 2; ++p) { const f32x4 a = acc[m][2 * p], b = acc[m][2 * p + 1]; u32x2 w;
                w.x = pk2(silu_f(a[0]) * b[0], silu_f(a[1]) * b[1]); w.y = pk2(silu_f(a[2]) * b[2], silu_f(a[3]) * b[3]); *(u32x2*)(rp + p * 16) = w; } }
    }
};

__device__ __forceinline__ void transpose_item(const float* W, int K, int N, bf16_t* WT, int mode, LAS float* scr, int item, int lane) {
    const int nblk = N / 32, kb = item / nblk, nb = item % nblk, k0 = 64 * kb, n0 = 32 * nb;
#pragma unroll 8
    for (int i = 0; i < 32; ++i) { const int kk = 2 * i + (lane >> 5); scr[kk * 33 + (lane & 31)] = W[(size_t)(k0 + kk) * N + n0 + (lane & 31)]; }
    LDS_WAIT();
    const int c = lane & 7;
#pragma unroll
    for (int j = 0; j < 4; ++j) { const int n = (lane >> 3) + 8 * j; const LAS float* s = scr + (8 * c) * 33 + n;
        u32x4 o; o.x = pk2(s[0 * 33], s[1 * 33]); o.y = pk2(s[2 * 33], s[3 * 33]); o.z = pk2(s[4 * 33], s[5 * 33]); o.w = pk2(s[6 * 33], s[7 * 33]);
        const int nn = n0 + n; const int row = mode == 0 ? nn : ((nn >> 4) * 32 + (mode == 2 ? 16 : 0) + (nn & 15));
        *(u32x4*)(WT + (size_t)row * K + k0 + 8 * c) = o; }
    LDS_WAIT();
}
__device__ __forceinline__ void convert_expert_weights(const Args& a, int layer, ldsp lds, int gw, int ngw, int wave, int lane) {
    LAS float* scr = (LAS float*)(lds + wave * 16384);
    unsigned char* ws = a.ws;
    constexpr int I13 = (D / 64) * (256 / 32), I2 = (256 / 64) * (D / 32);
    constexpr int NE = 64 * I13;
    constexpr int TOTAL = 3 * NE + 3 * 128;
    for (int it = gw; it < TOTAL; it += ngw) {
        int r = it;
        if (r < NE) { const int e = r / I13; transpose_item(a.in[I_EW1] + ((size_t)layer * 64 + e) * D * 256, D, 256, (bf16_t*)(ws + WS_W13) + (size_t)e * 512 * D, 1, scr, r % I13, lane); continue; } r -= NE;
        if (r < NE) { const int e = r / I13; transpose_item(a.in[I_EW3] + ((size_t)layer * 64 + e) * D * 256, D, 256, (bf16_t*)(ws + WS_W13) + (size_t)e * 512 * D, 2, scr, r % I13, lane); continue; } r -= NE;
        if (r < NE) { const int e = r / I2; transpose_item(a.in[I_EW2] + ((size_t)layer * 64 + e) * 256 * D, 256, D, (bf16_t*)(ws + WS_W2) + (size_t)e * D * 256, 0, scr, r % I2, lane); continue; } r -= NE;
        if (r < 128) { transpose_item(a.in[I_SW1] + (size_t)layer * D * 256, D, 256, (bf16_t*)(ws + WS_WS13), 1, scr, r, lane); continue; } r -= 128;
        if (r < 128) { transpose_item(a.in[I_SW3] + (size_t)layer * D * 256, D, 256, (bf16_t*)(ws + WS_WS13), 2, scr, r, lane); continue; } r -= 128;
        transpose_item(a.in[I_SW2] + (size_t)layer * 256 * D, 256, D, (bf16_t*)(ws + WS_WS2), 0, scr, r, lane);
    }
}
__device__ __forceinline__ void convert_dense_weights(const Args& a, ldsp lds, int gw, int ngw, int wave, int lane) {
    LAS float* scr = (LAS float*)(lds + wave * 16384);
    unsigned char* ws = a.ws;
    constexpr int IQ = 16 * 96, IO = 16 * 32, IRI = 16 * 192, IRO = 32 * 32;
    for (int it = gw; it < IQ + IO + IRI + IRO; it += ngw) {
        int r = it;
        if (r < IQ) { transpose_item(a.in[I_DAWIN], D, 3072, (bf16_t*)(ws + WS_WQKV), 0, scr, r, lane); continue; } r -= IQ;
        if (r < IO) { transpose_item(a.in[I_DAWOUT], D, D, (bf16_t*)(ws + WS_WO), 0, scr, r, lane); continue; } r -= IO;
        if (r < IRI) { transpose_item(a.in[I_RWIN], D, 6144, (bf16_t*)(ws + WS_WRI), 0, scr, r, lane); continue; } r -= IRI;
        transpose_item(a.in[I_RWOUT], 2048, D, (bf16_t*)(ws + WS_WRO), 0, scr, r, lane);
    }
}
__device__ __forceinline__ void mod_items(const Args& a, ldsp lds) {
    const int tid = threadIdx.x;
    if ((int)blockIdx.x >= 192) return;
    LAS float* sl = (LAS float*)lds;
    LAS float* red = (LAS float*)(lds + 65536);
    const float* c = a.in[I_C];
    for (int i = tid; i < 16 * 1024; i += NTHR) sl[i] = silu_f(c[i]);
    __syncthreads();
    float* mod = (float*)(a.ws + WS_MOD);
    for (int item = blockIdx.x; item < 192; item += GRID) {
        const int layer = item / 96, j0 = (item % 96) * 64, kq = tid >> 6, col = tid & 63;
        const float* w = a.in[I_ADAW] + (size_t)layer * D * 6144 + j0 + col;
        float acc[16];
#pragma unroll
        for (int b = 0; b < 16; ++b) acc[b] = 0.f;
        for (int k = kq * 128; k < kq * 128 + 128; ++k) { const float wv = w[(size_t)k * 6144];
#pragma unroll
            for (int b = 0; b < 16; ++b) acc[b] += sl[b * 1024 + k] * wv; }
#pragma unroll
        for (int b = 0; b < 16; ++b) red[(kq * 16 + b) * 64 + col] = acc[b];
        __syncthreads();
        for (int o = tid; o < 1024; o += NTHR) { const int b = o >> 6, cc = o & 63; float s = a.in[I_ADAB][(size_t)layer * 6144 + j0 + cc];
#pragma unroll
            for (int q = 0; q < 8; ++q) s += red[(q * 16 + b) * 64 + cc];
            const int j = j0 + cc;
            if (j >= 1024 && j < 2048) s = a.in[I_NMIX][layer * D + j - 1024] * (1.f + s);
            if (j >= 4096 && j < 5120) s = a.in[I_NFFN][layer * D + j - 4096] * (1.f + s);
            mod[((size_t)layer * 16 + b) * 6144 + j] = s; }
        __syncthreads();
    }
}

__device__ __forceinline__ void adaln_store(const f32x4 (&v)[4], float rstd, const float* G, const float* sh, bf16_t* hrow, int lane) {
#pragma unroll
    for (int j = 0; j < 4; ++j) { const int col = 4 * lane + 256 * j; const f32x4 g = *(const f32x4*)(G + col), s0 = *(const f32x4*)(sh + col);
        const f32x4 h = v[j] * rstd * g + s0; u32x2 w; w.x = pk2(h[0], h[1]); w.y = pk2(h[2], h[3]); *(u32x2*)(hrow + col) = w; }
}
__device__ __forceinline__ void adaln_phase(const float* X, const float* mod_sh  , const float* mod_G, bf16_t* H, int gw, int ngw, int lane) {
    for (int row0 = gw * 2; row0 < T; row0 += ngw * 2) {
        f32x4 v[2][4]; float ss[2] = {0.f, 0.f};
#pragma unroll
        for (int r = 0; r < 2; ++r)
#pragma unroll
            for (int j = 0; j < 4; ++j) v[r][j] = *(const f32x4*)(X + (size_t)(row0 + r) * D + 4 * lane + 256 * j);
#pragma unroll
        for (int r = 0; r < 2; ++r) {
#pragma unroll
            for (int j = 0; j < 4; ++j) ss[r] += v[r][j][0] * v[r][j][0] + v[r][j][1] * v[r][j][1] + v[r][j][2] * v[r][j][2] + v[r][j][3] * v[r][j][3];
            const float rstd = rsqrtf(wave_sum(ss[r]) * (1.f / D) + 1e-6f); const int b = (row0 + r) >> 11;
            adaln_store(v[r], rstd, mod_G + (size_t)b * 6144, mod_sh + (size_t)b * 6144, H + (size_t)(row0 + r) * D, lane); }
    }
}

__device__ __forceinline__ void attn_phase(ldsp lds, const bf16_t* qkv, bf16_t* ao, float lam, const float* subln_g) {
    const int tid = fresh_tid(), lane = tid & 63, wid = __builtin_amdgcn_readfirstlane(tid >> 6), map = wid & 1, qg = wid >> 1, fr = lane & 15, fq = lane >> 4;
    constexpr int STAGE = 32768;
    const float cs = 0.125f * LOG2E;
    const int kswz = fr >> 1, kok0 = ((fq ^ kswz) << 4), kok1 = (((4 + fq) ^ kswz) << 4), koff = map * 8192 + fr * 128;
    const int vq = fr >> 2, vp = fr & 3, vrow = 4 * fq + vq, vsw = ((vrow & 7) << 1);
    const int vbase0 = 16384 + vrow * 256 + ((((vp >> 1) ^ vsw) & 15) << 4) + (vp & 1) * 8;
    for (int round = 0; round < 8; ++round) {
        const int i = blockIdx.x, jgrp = i >> 7, bh = i & 127;
        const int qb = (round & 1) ? (14 - 2 * round + jgrp) : (15 - 2 * round - jgrp);
        const int b = bh >> 3, h = bh & 7;
        const size_t tok0 = (size_t)b * SEQ;
        const float slope2 = exp2f(-(float)(h + 1)) * LOG2E;
        bf16x8 qf[2][2];
#pragma unroll
        for (int qt = 0; qt < 2; ++qt)
#pragma unroll
            for (int kk = 0; kk < 2; ++kk) qf[qt][kk] = *(const bf16x8*)(qkv + (tok0 + qb * 128 + qg * 32 + qt * 16 + fr) * 3072 + (2 * h + map) * 64 + kk * 32 + fq * 8);
        asm volatile("" :: "v"(qf[0][0]), "v"(qf[0][1]), "v"(qf[1][0]), "v"(qf[1][1]));
        const char* srcK0; const char* srcV0;
        { const int row = 8 * wid + (lane >> 3), ch = (lane & 7) ^ ((row >> 1) & 7);
          srcK0 = (const char*)(qkv + (tok0 + row) * 3072 + 1024 + (2 * h) * 64) + ch * 16; }
        { const int row = 4 * wid + (lane >> 4), ch = (lane & 15) ^ ((row & 7) << 1); srcV0 = (const char*)(qkv + (tok0 + row) * 3072 + 2048 + h * 128) + ch * 16; }
        auto issue = [&](int s, int t) {
            ldsp st = lds + s * STAGE; const size_t adv = (size_t)t * 64 * 3072 * 2;
            glds16(srcK0 + adv, st + wid * 1024); glds16(srcK0 + adv + 128, st + 8192 + wid * 1024);
            glds16(srcV0 + adv, st + 16384 + wid * 1024); glds16(srcV0 + adv + (size_t)32 * 6144, st + 16384 + (wid + 8) * 1024);
        };
        f32x4 o[8][2];
#pragma unroll
        for (int dt = 0; dt < 8; ++dt) { o[dt][0] = (f32x4){0.f, 0.f, 0.f, 0.f}; o[dt][1] = (f32x4){0.f, 0.f, 0.f, 0.f}; }
        float mrow[2] = {-__builtin_inff(), -__builtin_inff()}, lrow[2] = {0.f, 0.f};
        const int ntile = 2 * qb + 2;
        const int qlast = qb * 128 + qg * 32 + 31, qfirst = qb * 128 + qg * 32;
        BAR();
        issue(0, 0); issue(1, 1);
        int s = 0;
        for (int t = 0; t < ntile; ++t) {
            if (t + 1 < ntile) wait_vm<4>(); else wait_vm<0>();
            BAR();
            if (t + 2 < ntile) { int s2 = s + 2; if (s2 >= 3) s2 -= 3; issue(s2, t + 2); }
            ldsp st = lds + s * STAGE;
            const int key0 = 64 * t;
            if (key0 <= qlast) {
                f32x4 sc[4][2];
#pragma unroll
                for (int kt = 0; kt < 4; ++kt) { sc[kt][0] = (f32x4){0.f, 0.f, 0.f, 0.f}; sc[kt][1] = (f32x4){0.f, 0.f, 0.f, 0.f}; }
#pragma unroll
                for (int kk = 0; kk < 2; ++kk) {
                    const int ok = kk ? kok1 : kok0;
#pragma unroll
                    for (int kt = 0; kt < 4; ++kt) { const bf16x8 kf = *(LAS bf16x8*)(st + koff + kt * 2048 + ok);
                        sc[kt][0] = __builtin_amdgcn_mfma_f32_16x16x32_bf16(kf, qf[0][kk], sc[kt][0], 0, 0, 0);
                        sc[kt][1] = __builtin_amdgcn_mfma_f32_16x16x32_bf16(kf, qf[1][kk], sc[kt][1], 0, 0, 0); }
                }
                __builtin_amdgcn_sched_barrier(0);
                const bool need_mask = (key0 + 63 > qfirst);
                const float kb0 = slope2 * (float)(key0 + 4 * fq);
                bf16x8 pf[2][2];
#pragma unroll
                for (int qt = 0; qt < 2; ++qt) {
                    const int qrow = qb * 128 + qg * 32 + qt * 16 + fr;
                    float mx = -__builtin_inff();
#pragma unroll
                    for (int kt = 0; kt < 4; ++kt)
#pragma unroll
                        for (int r = 0; r < 4; ++r) { float v = sc[kt][qt][r] * cs + (kb0 + slope2 * (float)(16 * kt + r));
                            if (need_mask && (key0 + 16 * kt + 4 * fq + r > qrow)) v = -__builtin_inff();
                            sc[kt][qt][r] = v; mx = fmaxf(mx, v); }
                    mx = fmaxf(mx, __shfl_xor(mx, 16)); mx = fmaxf(mx, __shfl_xor(mx, 32));
                    const float mnew = fmaxf(mrow[qt], mx), alpha = fast_exp2(mrow[qt] - mnew);
                    mrow[qt] = mnew;
                    float ps = 0.f;
#pragma unroll
                    for (int kt = 0; kt < 4; ++kt)
#pragma unroll
                        for (int r = 0; r < 4; ++r) { const float p = fast_exp2(sc[kt][qt][r] - mnew); sc[kt][qt][r] = p; ps += p; }
                    lrow[qt] = lrow[qt] * alpha + ps;
#pragma unroll
                    for (int dt = 0; dt < 8; ++dt) o[dt][qt] = o[dt][qt] * alpha;
#pragma unroll
                    for (int s2 = 0; s2 < 2; ++s2) { u32x4 w; w.x = pk2(sc[2 * s2][qt][0], sc[2 * s2][qt][1]); w.y = pk2(sc[2 * s2][qt][2], sc[2 * s2][qt][3]);
                        w.z = pk2(sc[2 * s2 + 1][qt][0], sc[2 * s2 + 1][qt][1]); w.w = pk2(sc[2 * s2 + 1][qt][2], sc[2 * s2 + 1][qt][3]); pf[qt][s2] = __builtin_bit_cast(bf16x8, w); }
                }
#pragma unroll
                for (int s2 = 0; s2 < 2; ++s2) {
                    int vb = vbase0; asm volatile("" : "+v"(vb));
#pragma unroll
                    for (int dt = 0; dt < 8; ++dt) { const int vo = vb ^ (dt << 5); const bf16x8 vf = tr2(st + vo + s2 * 8192, st + vo + s2 * 8192 + 4096);
                        o[dt][0] = __builtin_amdgcn_mfma_f32_16x16x32_bf16(vf, pf[0][s2], o[dt][0], 0, 0, 0);
                        o[dt][1] = __builtin_amdgcn_mfma_f32_16x16x32_bf16(vf, pf[1][s2], o[dt][1], 0, 0, 0);
                        if ((dt & 3) == 3) __builtin_amdgcn_sched_barrier(0); }
                }
            }
            s = (s == 2) ? 0 : s + 1;
        }
#pragma unroll
        for (int qt = 0; qt < 2; ++qt) { float l = lrow[qt]; l += __shfl_xor(l, 16); l += __shfl_xor(l, 32); const float inv = 1.f / l;
#pragma unroll
            for (int dt = 0; dt < 8; ++dt) o[dt][qt] = o[dt][qt] * inv; }
        BAR();
        LAS float* xb = (LAS float*)lds + qg * 4096;
        if (map == 1) {
#pragma unroll
            for (int dt = 0; dt < 8; ++dt)
#pragma unroll
                for (int qt = 0; qt < 2; ++qt)
#pragma unroll
                    for (int r = 0; r < 4; ++r) xb[((dt * 2 + qt) * 4 + r) * 64 + lane] = o[dt][qt][r];
        }
        LDS_WAIT(); BAR();
        if (map == 0) {
            const float* sg = subln_g; asm volatile("" : "+s"(sg));
#pragma unroll
            for (int qt = 0; qt < 2; ++qt) {
                float ss = 0.f;
#pragma unroll
                for (int dt = 0; dt < 8; ++dt)
#pragma unroll
                    for (int r = 0; r < 4; ++r) { const float v = o[dt][qt][r] - lam * xb[((dt * 2 + qt) * 4 + r) * 64 + lane]; o[dt][qt][r] = v; ss += v * v; }
                ss += __shfl_xor(ss, 16); ss += __shfl_xor(ss, 32);
                const float rstd = rsqrtf(ss * (1.f / 128.f) + 1e-6f) * 0.8f;
                bf16_t* orow = ao + (tok0 + qb * 128 + qg * 32 + qt * 16 + fr) * D + h * 128 + 4 * fq;
#pragma unroll
                for (int dt = 0; dt < 8; ++dt) { const f32x4 g = *(const f32x4*)(sg + dt * 16 + 4 * fq); const f32x4 v = o[dt][qt] * rstd * g;
                    u32x2 w; w.x = pk2(v[0], v[1]); w.y = pk2(v[2], v[3]); *(u32x2*)(orow + dt * 16) = w; }
            }
        }
        LDS_WAIT(); BAR();
    }
}

__device__ __forceinline__ void chain_phase(ldsp lds, bf16_t* rp, const bf16_t* P, bool dry) {
    const int tid = fresh_tid(), lane = tid & 63, wid = __builtin_amdgcn_readfirstlane(tid >> 6), fr = lane & 15, fq = lane >> 4;
    constexpr int STAGE = 32768, NSTG = 4;
    const int chain = blockIdx.x, b = chain >> 4, h = (chain >> 2) & 3, sl = chain & 3;
    const size_t tok0 = (size_t)b * SEQ;
    const float lg = __log2f(1.f - exp2f(-5.f - (float)h));
    const float gamma = exp2f(lg), g127 = exp2f(lg * 127.f), g128 = exp2f(lg * 128.f);
    const bf16_t* vbase = rp + tok0 * 6144 + 2048 + h * 512 + sl * 128;
    const bf16_t* qbase = rp + tok0 * 6144 + h * 256;
    const bf16_t* kbase = rp + tok0 * 6144 + 1024 + h * 256;
    const bf16_t* pbase = P + (size_t)((b * 4 + h) * 16) * 16384;
    unsigned vsrc0, psrc0, qsrc0, ksrc0;
    { const int row = 4 * wid + (lane >> 4); vsrc0 = (unsigned)(row * 6144 * 2 + (((lane & 15) ^ ((row & 7) << 1)) << 4)); psrc0 = (unsigned)(row * 256 + (((lane & 15) ^ (row & 15)) << 4)); }
    { const int row = 8 * wid + (lane >> 3); qsrc0 = (unsigned)(row * 6144 * 2 + (((lane & 7) ^ ((row >> 1) & 7)) << 4)); ksrc0 = (unsigned)(row * 6144 * 2 + (((lane & 7) ^ (((row >> 1) & 3) << 1)) << 4)); }
    auto issue = [&](int s, int g) {
        ldsp st = lds + s * STAGE; const int c = g / 6, kind = g - c * 6; const size_t coff = (size_t)c * 128 * 6144 * 2;
        if (kind == 0) {
            const char* bp = (const char*)vbase + coff;
#pragma unroll
            for (int jj = 0; jj < 4; ++jj) glds16(bp + (size_t)jj * 32 * 12288 + vsrc0, st + (wid + 8 * jj) * 1024);
        } else if (kind == 5) {
            const char* bp = (const char*)pbase + (size_t)c * 32768;
#pragma unroll
            for (int jj = 0; jj < 4; ++jj) glds16(bp + (size_t)jj * 32 * 256 + psrc0, st + (wid + 8 * jj) * 1024);
        } else { const int p = kind - 1;
            const char* bq = (const char*)qbase + coff + p * 128; const char* bk = (const char*)kbase + coff + p * 128;
#pragma unroll
            for (int jj = 0; jj < 2; ++jj) glds16(bq + (size_t)jj * 64 * 12288 + qsrc0, st + (wid + 8 * jj) * 1024);
#pragma unroll
            for (int jj = 0; jj < 2; ++jj) glds16(bk + (size_t)jj * 64 * 12288 + ksrc0, st + 16384 + (wid + 8 * jj) * 1024);
        }
    };
    const int tq = fr >> 2, tp = fr & 3;
    const int vrow = 4 * fq + tq;
    const int vfo = vrow * 256 + ((((2 * wid + (tp >> 1)) ^ ((vrow & 7) << 1)) & 15) << 4) + (tp & 1) * 8;
    const int ksw = ((vrow >> 1) & 3) << 1;
    const int kfo0 = 16384 + vrow * 128 + ((((tp >> 1) ^ ksw) & 7) << 4) + (tp & 1) * 8;
    const int qsw = fr >> 1;
    const int qfo0 = fr * 128 + ((((fq >> 1) ^ qsw) & 7) << 4) + (fq & 1) * 8;
    const int pfo0 = fr * 256 + ((((fq >> 1) ^ fr) & 15) << 4) + (fq & 1) * 8;

    f32x4 R[16];
#pragma unroll
    for (int i = 0; i < 16; ++i) R[i] = (f32x4){0.f, 0.f, 0.f, 0.f};
    f32x4 o[8];
#pragma unroll
    for (int it = 0; it < 8; ++it) o[it] = (f32x4){0.f, 0.f, 0.f, 0.f};
    bf16x8 vf[4];
#pragma unroll
    for (int s4 = 0; s4 < 4; ++s4) vf[s4] = (bf16x8){0, 0, 0, 0, 0, 0, 0, 0};
    constexpr int NG = 16 * 6;
    BAR();
    issue(0, 0); issue(1, 1); issue(2, 2);
    for (int c = 0; c < 16; ++c) {
        auto step = [&](auto KC) {
            constexpr int kind = decltype(KC)::value;
            const int g = c * 6 + kind;
            if (g + 2 < NG) wait_vm<8>(); else if (g + 1 < NG) wait_vm<4>(); else wait_vm<0>();
            BAR();
            if (g + 3 < NG) issue((g + 3) & 3, g + 3);
            ldsp st = lds + (g & 3) * STAGE;
            if constexpr (kind == 0) {
#pragma unroll
                for (int s4 = 0; s4 < 4; ++s4) vf[s4] = tr2(st + vfo + s4 * 8192, st + vfo + s4 * 8192 + 4096);
#pragma unroll
                for (int it = 0; it < 8; ++it) o[it] = (f32x4){0.f, 0.f, 0.f, 0.f};
            } else if constexpr (kind == 5) {
#pragma unroll
                for (int it = 0; it < 8; ++it) o[it] = o[it] * gamma;
#pragma unroll
                for (int s4 = 0; s4 < 4; ++s4) {
                    int pb = pfo0; asm volatile("" : "+v"(pb)); const int p0 = pb ^ ((4 * s4) << 4), p1 = pb ^ ((4 * s4 + 2) << 4);
#pragma unroll
                    for (int it = 0; it < 8; ++it) { const bf16x8 pf = rd2x64(st + p0 + it * 4096, st + p1 + it * 4096);
                        o[it] = __builtin_amdgcn_mfma_f32_16x16x32_bf16(vf[s4], pf, o[it], 0, 0, 0); if (it == 3) __builtin_amdgcn_sched_barrier(0); }
                    __builtin_amdgcn_sched_barrier(0);
                }
                bf16_t* ob = rp + (tok0 + (size_t)c * 128) * 6144 + 2048 + h * 512 + sl * 128 + 16 * wid + 4 * fq;
#pragma unroll
                for (int it = 0; it < 8; ++it) { u32x2 w; w.x = pk2(o[it][0], o[it][1]); w.y = pk2(o[it][2], o[it][3]); if (!dry) *(u32x2*)(ob + (size_t)(16 * it + fr) * 6144) = w; else asm volatile("" :: "v"(w)); }
            } else {
                constexpr int p = kind - 1;
#pragma unroll
                for (int s2 = 0; s2 < 2; ++s2) {
                    u32x4 w; const f32x4 r0 = R[4 * p + 2 * s2], r1 = R[4 * p + 2 * s2 + 1];
                    w.x = pk2(r0[0], r0[1]); w.y = pk2(r0[2], r0[3]); w.z = pk2(r1[0], r1[1]); w.w = pk2(r1[2], r1[3]);
                    const bf16x8 rf = __builtin_bit_cast(bf16x8, w);
                    int qb = qfo0; asm volatile("" : "+v"(qb)); const int q0 = qb ^ ((4 * s2) << 4), q1 = qb ^ ((4 * s2 + 2) << 4);
#pragma unroll
                    for (int it = 0; it < 8; ++it) { const bf16x8 qf = rd2x64(st + q0 + it * 2048, st + q1 + it * 2048);
                        o[it] = __builtin_amdgcn_mfma_f32_16x16x32_bf16(rf, qf, o[it], 0, 0, 0); if (it == 3) __builtin_amdgcn_sched_barrier(0); }
                    __builtin_amdgcn_sched_barrier(0);
                }
#pragma unroll
                for (int dkt = 0; dkt < 4; ++dkt) {
                    f32x4 acc = (f32x4){0.f, 0.f, 0.f, 0.f};
                    int kb = kfo0; asm volatile("" : "+v"(kb)); const int ko = kb ^ (dkt << 5);
#pragma unroll
                    for (int s4 = 0; s4 < 4; ++s4) { const bf16x8 kf = tr2(st + ko + s4 * 4096, st + ko + s4 * 4096 + 2048);
                        acc = __builtin_amdgcn_mfma_f32_16x16x32_bf16(kf, vf[s4], acc, 0, 0, 0); }
                    R[4 * p + dkt] = R[4 * p + dkt] * g128 + acc * g127;
                }
                __builtin_amdgcn_sched_barrier(0);
            }
        };
        step(std::integral_constant<int, 0>{}); step(std::integral_constant<int, 1>{}); step(std::integral_constant<int, 2>{});
        step(std::integral_constant<int, 3>{}); step(std::integral_constant<int, 4>{}); step(std::integral_constant<int, 5>{});
    }
}

__device__ __forceinline__ void gnorm_phase(bf16_t* rp, const float* gn, int gw, int ngw, int lane) {
    for (int row = gw; row < T; row += ngw) {
        bf16_t* orow = rp + (size_t)row * 6144 + 2048; const bf16_t* grow = rp + (size_t)row * 6144 + 4096;
#pragma unroll
        for (int hh = 0; hh < 4; ++hh) {
            const u32x4 ov = *(const u32x4*)(orow + hh * 512 + 8 * lane), gv = *(const u32x4*)(grow + hh * 512 + 8 * lane);
            float of[8] = {bf_lo(ov.x), bf_hi(ov.x), bf_lo(ov.y), bf_hi(ov.y), bf_lo(ov.z), bf_hi(ov.z), bf_lo(ov.w), bf_hi(ov.w)};
            float gf[8] = {bf_lo(gv.x), bf_hi(gv.x), bf_lo(gv.y), bf_hi(gv.y), bf_lo(gv.z), bf_hi(gv.z), bf_lo(gv.w), bf_hi(gv.w)};
            float ss = 0.f;
#pragma unroll
            for (int e = 0; e < 8; ++e) ss += of[e] * of[e];
            const float rstd = rsqrtf(wave_sum(ss) * (1.f / 512.f) + 1e-6f);
            const f32x4 w0 = *(const f32x4*)(gn + hh * 512 + 8 * lane), w1 = *(const f32x4*)(gn + hh * 512 + 8 * lane + 4);
            float y[8];
#pragma unroll
            for (int e = 0; e < 8; ++e) y[e] = silu_f(gf[e]) * of[e] * rstd * (e < 4 ? w0[e] : w1[e - 4]);
            u32x4 w; w.x = pk2(y[0], y[1]); w.y = pk2(y[2], y[3]); w.z = pk2(y[4], y[5]); w.w = pk2(y[6], y[7]);
            *(u32x4*)(orow + hh * 512 + 8 * lane) = w;
        }
    }
}

__device__ __forceinline__ void router_phase(ldsp lds, const float* XR, const float* mod_sh, const float* mod_G, const bf16_t* rwt  , const float* rbias,
                                             bf16_t* H, int* sel_e, float* sel_w, int* sel_p, int* tokl, unsigned* cnt, int gw, int ngw, int wave, int lane, bool dry) {
    LAS float* lg = (LAS float*)(lds + wave * 4096);
    const float rb = rbias[lane];
    const int fr = lane & 15, fq = lane >> 4;
    for (int tile = gw; tile < T / 16; tile += ngw) {
        const int row = tile * 16 + fr, b = row >> 11;
        const float* xr = XR + (size_t)row * D + 8 * fq;
        float ss = 0.f;
#pragma unroll 8
        for (int s = 0; s < 32; ++s) { const f32x4 x0 = *(const f32x4*)(xr + 32 * s), x1 = *(const f32x4*)(xr + 32 * s + 4);
            ss += x0[0] * x0[0] + x0[1] * x0[1] + x0[2] * x0[2] + x0[3] * x0[3] + x1[0] * x1[0] + x1[1] * x1[1] + x1[2] * x1[2] + x1[3] * x1[3]; }
        ss += __shfl_xor(ss, 16); ss += __shfl_xor(ss, 32);
        const float rstd = rsqrtf(ss * (1.f / D) + 1e-6f);
        const float* G = mod_G + (size_t)b * 6144 + 8 * fq; const float* SH = mod_sh + (size_t)b * 6144 + 8 * fq;
        bf16_t* hrow = H + (size_t)row * D + 8 * fq;
        const bf16_t* whi = rwt + (size_t)fr * 1024 + 8 * fq; const bf16_t* wlo = whi + 64 * 1024;
        f32x4 acc[4];
#pragma unroll
        for (int et = 0; et < 4; ++et) acc[et] = (f32x4){0.f, 0.f, 0.f, 0.f};
#pragma unroll 2
        for (int s = 0; s < 32; ++s) {
            const f32x4 x0 = *(const f32x4*)(xr + 32 * s), x1 = *(const f32x4*)(xr + 32 * s + 4);
            const f32x4 g0 = *(const f32x4*)(G + 32 * s), g1 = *(const f32x4*)(G + 32 * s + 4), s0 = *(const f32x4*)(SH + 32 * s), s1 = *(const f32x4*)(SH + 32 * s + 4);
            const f32x4 h0 = x0 * rstd * g0 + s0, h1 = x1 * rstd * g1 + s1;
            u32x4 hi; hi.x = pk2(h0[0], h0[1]); hi.y = pk2(h0[2], h0[3]); hi.z = pk2(h1[0], h1[1]); hi.w = pk2(h1[2], h1[3]);
            *(u32x4*)(hrow + 32 * s) = hi;
            u32x4 lo; lo.x = pk2(h0[0] - bf_lo(hi.x), h0[1] - bf_hi(hi.x)); lo.y = pk2(h0[2] - bf_lo(hi.y), h0[3] - bf_hi(hi.y));
            lo.z = pk2(h1[0] - bf_lo(hi.z), h1[1] - bf_hi(hi.z)); lo.w = pk2(h1[2] - bf_lo(hi.w), h1[3] - bf_hi(hi.w));
            const bf16x8 ahi = __builtin_bit_cast(bf16x8, hi), alo = __builtin_bit_cast(bf16x8, lo);
#pragma unroll
            for (int et = 0; et < 4; ++et) { const bf16x8 bh = *(const bf16x8*)(whi + (size_t)et * 16 * 1024 + 32 * s), bl = *(const bf16x8*)(wlo + (size_t)et * 16 * 1024 + 32 * s);
                acc[et] = __builtin_amdgcn_mfma_f32_16x16x32_bf16(ahi, bh, acc[et], 0, 0, 0);
                acc[et] = __builtin_amdgcn_mfma_f32_16x16x32_bf16(ahi, bl, acc[et], 0, 0, 0);
                acc[et] = __builtin_amdgcn_mfma_f32_16x16x32_bf16(alo, bh, acc[et], 0, 0, 0); }
        }
#pragma unroll
        for (int et = 0; et < 4; ++et)
#pragma unroll
            for (int r = 0; r < 4; ++r) lg[(4 * fq + r) * 64 + 16 * et + fr] = acc[et][r];
        LDS_WAIT();
        for (int tt = 0; tt < 16; ++tt) {
            const int tok = tile * 16 + tt;
            const float logit = lg[tt * 64 + lane];
            const float score = 1.f / (1.f + __expf(-logit)), choice = score + rb;
            int rk = 0;
#pragma unroll
            for (int d = 1; d < 8; ++d) { const int oi = (lane + d) & 7; const float other = __shfl(choice, (lane & ~7) | oi); rk += (other > choice || (other == choice && oi < (lane & 7))) ? 1 : 0; }
            float gs = rk < 2 ? choice : 0.f;
            gs += __shfl_xor(gs, 1); gs += __shfl_xor(gs, 2); gs += __shfl_xor(gs, 4);
            int rg = 0;
#pragma unroll
            for (int j = 0; j < 8; ++j) { const float gj = __int_as_float(__builtin_amdgcn_readlane(__float_as_int(gs), 8 * j)); rg += (gj > gs || (gj == gs && j < (lane >> 3))) ? 1 : 0; }
            const float c2 = rg < 4 ? choice : -__builtin_inff();
            int r8 = 0;
#pragma unroll
            for (int j = 0; j < 64; ++j) { const float cj = __int_as_float(__builtin_amdgcn_readlane(__float_as_int(c2), j)); r8 += (cj > c2 || (cj == c2 && j < lane)) ? 1 : 0; }
            const bool chosen = r8 < 8;
            const float wsum = wave_sum(chosen ? score : 0.f);
            if (dry) { asm volatile("" :: "v"(wsum), "v"(r8)); }
            else if (chosen) {
                const int chunk = tok / CH_TOK;
                const unsigned pos = atomicAdd(&cnt[chunk * 64 + lane], 1u);
                sel_e[tok * 8 + r8] = lane; sel_w[tok * 8 + r8] = score / wsum * 2.5f; sel_p[tok * 8 + r8] = (int)pos;
                tokl[(size_t)(chunk * 64 + lane) * CH_TOK + pos] = tok;
            }
        }
        LDS_WAIT();
    }
}

__device__ __forceinline__ void build_tstart(const unsigned* cnt, int c, LAS int* ts) {
    if (threadIdx.x < 64) {
        const int l = threadIdx.x; const int n = ((int)cnt[c * 64 + l] + 127) >> 7; int incl = n;
#pragma unroll
        for (int o = 1; o < 64; o <<= 1) { const int v = __shfl_up(incl, o); if (l >= o) incl += v; }
        ts[l] = incl - n; if (l == 63) { ts[64] = incl; ts[65] = incl + CH_TOK / 128; }
    }
}
struct RowGather { const int* list; int cnt, r0, dummy; __device__ __forceinline__ int operator()(int r) const { const int g = r0 + r; return g < cnt ? list[g] : dummy; } };

__device__ __forceinline__ void moe_up_phase(ldsp lds, const unsigned char* ws, const unsigned* cnt, int c, const LAS int* ts) {
    const bf16_t* H = (const bf16_t*)(ws + WS_H); bf16_t* act = (bf16_t*)(ws + WS_ACT); const int* tokl = (const int*)(ws + WS_TOKL);
    const int total = ts[65] * 2, vcu = vcu_of_block();
    for (int Lt = vcu; Lt < total; Lt += GRID) {
        const int mt = Lt >> 1, nt = Lt & 1;
        int e = 0;
#pragma unroll
        for (int stp = 64; stp >= 1; stp >>= 1) if (e + stp <= 64 && ts[e + stp] <= mt) e += stp;
        const int ml = mt - ts[e];
        EpiSwiGLU epi{act, mt * 128};
        if (e < 64) { RowGather rf{tokl + (size_t)(c * 64 + e) * CH_TOK, (int)cnt[c * 64 + e], ml * 128, c * CH_TOK};
            gemm_tile<2, 4, 4, 4>(lds, H, D, rf, (const bf16_t*)(ws + WS_W13) + (size_t)e * 512 * D, D, nt * 256, D, epi); }
        else { RowId rf{c * CH_TOK + ml * 128};
            gemm_tile<2, 4, 4, 4>(lds, H, D, rf, (const bf16_t*)(ws + WS_WS13), D, nt * 256, D, epi); }
    }
}
__device__ __forceinline__ void moe_down_phase(ldsp lds, const unsigned char* ws, const LAS int* ts) {
    const bf16_t* act = (const bf16_t*)(ws + WS_ACT); bf16_t* ys = (bf16_t*)(ws + WS_YS);
    const int total = ts[65] * 4, vcu = vcu_of_block();
    for (int Lt = vcu; Lt < total; Lt += GRID) {
        const int mt = Lt >> 2, nt = Lt & 3;
        int e = 0;
#pragma unroll
        for (int stp = 64; stp >= 1; stp >>= 1) if (e + stp <= 64 && ts[e + stp] <= mt) e += stp;
        RowId rf{mt * 128}; EpiStoreBf16 epi{ys, (size_t)D, mt * 128};
        const bf16_t* w2 = e < 64 ? (const bf16_t*)(ws + WS_W2) + (size_t)e * D * 256 : (const bf16_t*)(ws + WS_WS2);
        gemm_tile<2, 4, 4, 4>(lds, act, 256, rf, w2, 256, nt * 256, 256, epi);
    }
}
__device__ __forceinline__ void moe_combine_phase(const unsigned char* ws, float* XR, int c, const LAS int* ts, const float* gate_f  , bool last_layer,
                                                  const float* mod_sh_next, const float* mod_G_next, bf16_t* H, const float* fnorm, int gw, int ngw, int lane) {
    const bf16_t* ys = (const bf16_t*)(ws + WS_YS); const int* sel_e = (const int*)(ws + WS_SELE); const float* sel_w = (const float*)(ws + WS_SELW); const int* sel_p = (const int*)(ws + WS_SELP);
    for (int tl = gw; tl < CH_TOK; tl += ngw) {
        const int tok = c * CH_TOK + tl; const int b = tok >> 11;
        float acc[16];
#pragma unroll
        for (int i = 0; i < 16; ++i) acc[i] = 0.f;
#pragma unroll
        for (int k = 0; k < 9; ++k) {
            int slot; float w;
            if (k < 8) { const int e = sel_e[tok * 8 + k]; slot = ts[e] * 128 + sel_p[tok * 8 + k]; w = sel_w[tok * 8 + k]; } else { slot = ts[64] * 128 + tl; w = 1.f; }
            const bf16_t* yr = ys + (size_t)slot * D;
#pragma unroll
            for (int j = 0; j < 2; ++j) { const u32x4 v = *(const u32x4*)(yr + 8 * lane + 512 * j);
                acc[8 * j + 0] += w * bf_lo(v.x); acc[8 * j + 1] += w * bf_hi(v.x); acc[8 * j + 2] += w * bf_lo(v.y); acc[8 * j + 3] += w * bf_hi(v.y);
                acc[8 * j + 4] += w * bf_lo(v.z); acc[8 * j + 5] += w * bf_hi(v.z); acc[8 * j + 6] += w * bf_lo(v.w); acc[8 * j + 7] += w * bf_hi(v.w); }
        }
        float* xr = XR + (size_t)tok * D; const float* gf = gate_f + (size_t)b * 6144; float ss = 0.f; float xn[16];
#pragma unroll
        for (int j = 0; j < 2; ++j)
#pragma unroll
            for (int q = 0; q < 2; ++q) { const int col = 8 * lane + 512 * j + 4 * q; const f32x4 xv = *(const f32x4*)(xr + col), gv = *(const f32x4*)(gf + col);
#pragma unroll
                for (int e = 0; e < 4; ++e) { const float v = xv[e] + gv[e] * acc[8 * j + 4 * q + e]; xn[8 * j + 4 * q + e] = v; ss += v * v; } }
        const float rstd = rsqrtf(wave_sum(ss) * (1.f / D) + 1e-6f);
        if (last_layer) {
#pragma unroll
            for (int j = 0; j < 2; ++j)
#pragma unroll
                for (int q = 0; q < 2; ++q) { const int col = 8 * lane + 512 * j + 4 * q; const f32x4 g = *(const f32x4*)(fnorm + col); f32x4 ov;
#pragma unroll
                    for (int e = 0; e < 4; ++e) ov[e] = xn[8 * j + 4 * q + e] * rstd * g[e];
                    *(f32x4*)(xr + col) = ov; }
        } else {
            const float* sh = mod_sh_next + (size_t)b * 6144; const float* Gn = mod_G_next + (size_t)b * 6144; bf16_t* hrow = H + (size_t)tok * D;
#pragma unroll
            for (int j = 0; j < 2; ++j) { u32x4 hw;
#pragma unroll
                for (int q = 0; q < 2; ++q) { const int col = 8 * lane + 512 * j + 4 * q; const f32x4 g = *(const f32x4*)(Gn + col), s0 = *(const f32x4*)(sh + col); f32x4 xv, hv;
#pragma unroll
                    for (int e = 0; e < 4; ++e) { xv[e] = xn[8 * j + 4 * q + e]; hv[e] = xv[e] * rstd * g[e] + s0[e]; }
                    *(f32x4*)(xr + col) = xv;
                    if (q == 0) { hw.x = pk2(hv[0], hv[1]); hw.y = pk2(hv[2], hv[3]); } else { hw.z = pk2(hv[0], hv[1]); hw.w = pk2(hv[2], hv[3]); } }
                *(u32x4*)(hrow + 8 * lane + 512 * j) = hw; }
        }
    }
}

#define FRESH_IDS() const int t_ = fresh_tid(); const int lane = t_ & 63, wave = __builtin_amdgcn_readfirstlane(t_ >> 6); const int gw = blockIdx.x * NWAVE + wave, ngw = GRID * NWAVE; (void)lane; (void)gw; (void)ngw
__device__ __forceinline__ void moe_layer(const Args& a, ldsp lds, const XcdBarrier& bar, int layer) {
    unsigned char* ws = a.ws;
    float* mod = (float*)(ws + WS_MOD); float* XR = a.out; bf16_t* H = (bf16_t*)(ws + WS_H);
    const float* modl = mod + (size_t)layer * 16 * 6144;
    const float* modn = mod + (size_t)16 * 6144;
    unsigned* cl = (unsigned*)(ws + WS_CNT) + layer * 256;
    LAS int* ts0 = (LAS int*)(lds + LDS_MISC); LAS int* ts1 = ts0 + 80;
    for (int rep = 0; rep < REP_ROUTER; ++rep) { FRESH_IDS();
      router_phase(lds, XR, modl + 3072, modl + 4096, (const bf16_t*)(ws + WS_RWT) + (size_t)layer * 2 * 64 * 1024, a.in[I_ROUTB] + layer * 64,
                   H, (int*)(ws + WS_SELE), (float*)(ws + WS_SELW), (int*)(ws + WS_SELP), (int*)(ws + WS_TOKL), cl, gw, ngw, wave, lane, rep + 1 < REP_ROUTER); }
    xcd_barrier(bar);
    for (int c = 0; c <= NCHUNK; ++c) {
        __syncthreads();
        if (c < NCHUNK) build_tstart(cl, c, ts0);
        if (c > 0) build_tstart(cl, c - 1, ts1);
        __syncthreads();
        if (c < NCHUNK) for (int rep = 0; rep < REP_MOE; ++rep) moe_up_phase(lds, ws, cl, c, ts0);
        if (c > 0) { FRESH_IDS(); moe_combine_phase(ws, XR, c - 1, ts1, modl + 5120, layer == 1, modn, modn + 1024, H, a.in[I_FNORM], gw, ngw, lane); }
        if (c == NCHUNK) break;
        xcd_barrier(bar);
        for (int rep = 0; rep < REP_MOE; ++rep) moe_down_phase(lds, ws, ts0);
        xcd_barrier(bar);
    }
}
__global__ void __launch_bounds__(NTHR, 2) fwd_kernel(Args a) {
    extern __shared__ __attribute__((aligned(16))) unsigned char lds_raw[];
    ldsp lds = (ldsp)lds_raw;
    unsigned char* ws = a.ws;
    volatile LAS unsigned* st = (volatile LAS unsigned*)(lds + LDS_BYTES - 16);
    if (threadIdx.x < 4) st[threadIdx.x] = 0u;
    __syncthreads();
    XcdBarrier bar = xcd_barrier_post((unsigned*)(ws + WS_BAR), st);
    float* mod = (float*)(ws + WS_MOD);
    float* XR = a.out;
    bf16_t* H = (bf16_t*)(ws + WS_H);

    for (int rep = 0; rep < REP_P0; ++rep) {
    mod_items(a, lds);
    __syncthreads();
    { FRESH_IDS(); convert_dense_weights(a, lds, gw, ngw, wave, lane); convert_expert_weights(a, 0, lds, gw, ngw, wave, lane);
      bf16_t* rwt = (bf16_t*)(ws + WS_RWT);
      for (int idx = blockIdx.x * NTHR + t_; idx < 2 * D * 64; idx += GRID * NTHR) { const int l2 = idx >> 16, k = (idx >> 6) & 1023, e = idx & 63;
          const float w = a.in[I_ROUTW][idx]; const unsigned hi = pk2(w, 0.f) & 0xffffu; const unsigned lo = pk2(w - bf_lo(hi), 0.f) & 0xffffu;
          rwt[((size_t)(l2 * 2 + 0) * 64 + e) * 1024 + k] = (bf16_t)hi; rwt[((size_t)(l2 * 2 + 1) * 64 + e) * 1024 + k] = (bf16_t)lo; } }
    xcd_barrier(bar);
    }

    { FRESH_IDS(); adaln_phase(a.in[I_X], mod, mod + 1024, H, gw, ngw, lane); }
    xcd_barrier(bar);
    for (int rep = 0; rep < REP_GEMM; ++rep) {
    { bf16_t* qkv = (bf16_t*)(ws + WS_QKV);
      auto mk = [&](int m0) { return EpiStoreBf16{qkv, (size_t)3072, m0}; };
      gemm_dense_phase<4, 2, 4, 4>(lds, H, D, (const bf16_t*)(ws + WS_WQKV), D, T, 3072, D, mk); }
    xcd_barrier(bar);
    }
    { float d1 = 0.f, d2 = 0.f;
      for (int i = 0; i < 64; ++i) { d1 += a.in[I_LQ1][i] * a.in[I_LK1][i]; d2 += a.in[I_LQ2][i] * a.in[I_LK2][i]; }
      const float lam = __expf(d1) - __expf(d2) + 0.2f;
      for (int rep = 0; rep < REP_ATTN; ++rep) {
      attn_phase(lds, (const bf16_t*)(ws + WS_QKV), (bf16_t*)(ws + WS_AO), lam, a.in[I_SUBLN]);
      xcd_barrier(bar); } }
    for (int rep = 0; rep < REP_GEMM; ++rep) {
    { auto mk = [&](int m0) { return EpiResidual{a.in[I_X], XR, mod + 2048, m0}; };
      gemm_dense_phase<4, 2, 4, 4>(lds, (const bf16_t*)(ws + WS_AO), D, (const bf16_t*)(ws + WS_WO), D, T, D, D, mk); }
    xcd_barrier(bar);
    }
    moe_layer(a, lds, bar, 0);
    xcd_barrier(bar);

    const float* mod1 = mod + (size_t)16 * 6144;
    for (int rep = 0; rep < REP_GEMM; ++rep) {
    { bf16_t* rp = (bf16_t*)(ws + WS_RP);
      auto mk = [&](int m0) { return EpiRetProj{rp, m0}; };
      gemm_dense_phase<4, 2, 4, 4>(lds, H, D, (const bf16_t*)(ws + WS_WRI), D, T, 6144, D, mk); }
    xcd_barrier(bar);
    }
    { const bf16_t* rp = (const bf16_t*)(ws + WS_RP); bf16_t* P = (bf16_t*)(ws + WS_P);
      for (int u = blockIdx.x; u < 1024; u += GRID) { const int bh = u >> 4, c = u & 15, b = bh >> 2, h = bh & 3;
          const bf16_t* qa = rp + ((size_t)b * SEQ + c * 128) * 6144 + h * 256; RowId rf{0}; EpiCausalP epi{P + (size_t)u * 16384};
          gemm_tile<2, 4, 4, 2>(lds, qa, 6144, rf, qa + 1024, 6144, 0, 256, epi); }
      __syncthreads();
      { FRESH_IDS(); convert_expert_weights(a, 1, lds, gw, ngw, wave, lane); } }
    xcd_barrier(bar);
    for (int rep = 0; rep < REP_CHAIN; ++rep) {
    chain_phase(lds, (bf16_t*)(ws + WS_RP), (const bf16_t*)(ws + WS_P), rep + 1 < REP_CHAIN);
    xcd_barrier(bar);
    }
    { FRESH_IDS(); gnorm_phase((bf16_t*)(ws + WS_RP), a.in[I_RGN], gw, ngw, lane); }
    xcd_barrier(bar);
    { auto mk = [&](int m0) { return EpiResidual{XR, XR, mod1 + 2048, m0}; };
      gemm_dense_phase<4, 2, 4, 4>(lds, (const bf16_t*)(ws + WS_RP) + 2048, 6144, (const bf16_t*)(ws + WS_WRO), 2048, T, D, 2048, mk); }
    xcd_barrier(bar);
    moe_layer(a, lds, bar, 1);
}

extern "C" void kernel_launch(void* const* d_in, const int* in_sizes, int n_in, void* d_out, int out_size, void* d_ws, size_t ws_size, hipStream_t stream) {
    static int ready = 0;
    if (ready == 0) {
        if (n_in != 25 || out_size != T * D || ws_size < WS_END) { fprintf(stderr, "kernel_launch: unexpected shapes (n_in %d out %d ws %zu need %zu)\n", n_in, out_size, ws_size, (size_t)WS_END); ready = -1; return; }
        (void)hipFuncSetAttribute((const void*)fwd_kernel, hipFuncAttributeMaxDynamicSharedMemorySize, LDS_BYTES);
        ready = 1;
    }
    if (ready < 0) return;
    (void)hipMemsetAsync(d_ws, 0, 65536, stream);
    Args a{};
    for (int i = 0; i < 25; ++i) a.in[i] = (const float*)d_in[i];
    a.out = (float*)d_out; a.ws = (unsigned char*)d_ws;
    hipLaunchKernelGGL(fwd_kernel, dim3(GRID), dim3(NTHR), LDS_BYTES, stream, a);
}
```

```cpp
#include <hip/hip_runtime.h>
#include <cstdio>
#include <cstdint>
#include <type_traits>

typedef unsigned short bf16_t;
typedef short bf16x8 __attribute__((ext_vector_type(8)));
typedef short bf16x4 __attribute__((ext_vector_type(4)));
typedef float f32x4 __attribute__((ext_vector_type(4)));
typedef float f32x2 __attribute__((ext_vector_type(2)));
typedef unsigned u32x4 __attribute__((ext_vector_type(4)));
typedef unsigned u32x2 __attribute__((ext_vector_type(2)));
#define LAS __attribute__((address_space(3)))
typedef LAS unsigned char* ldsp;

constexpr int T = 32768, D = 1024, NB = 16, SEQ = 2048;
constexpr int NTHR = 512, NWAVE = 8, GRID = 256;
constexpr int CH_TOK = 8192, NCHUNK = 4;
constexpr int SLOT_CAP = 81920;
constexpr float LOG2E = 1.4426950408889634f;
#define REP_GEMM 1
#define REP_ATTN 1
#define REP_MOE 1
#define REP_P0 1
#define REP_ROUTER 1
#define REP_CHAIN 1
#define REP_COMBINE 1
#define REP_ROWS 1
#define REP_PPH 1
#define EXTRA_BARS 0


constexpr size_t MiB = 1u << 20;
constexpr size_t WS_BAR = 0, WS_CNT = 16384, WS_RWT = 256 * 1024  , WS_MOD = 1 * MiB;
constexpr size_t WS_WQKV = 2 * MiB, WS_WO = 8 * MiB, WS_WRI = 10 * MiB, WS_WRO = 22 * MiB;
constexpr size_t WS_W13 = 26 * MiB, WS_W2 = 90 * MiB, WS_WS13 = 122 * MiB, WS_WS2 = 123 * MiB;
constexpr size_t WS_H = 124 * MiB, WS_P = WS_H;
constexpr size_t WS_BIG = 188 * MiB;
constexpr size_t WS_QKV = WS_BIG, WS_AO = WS_BIG + 192 * MiB;
constexpr size_t WS_RP = WS_BIG;
constexpr size_t WS_SELE = WS_BIG, WS_SELW = WS_BIG + 1 * MiB, WS_SELP = WS_BIG + 2 * MiB, WS_TOKL = WS_BIG + 4 * MiB;
constexpr size_t WS_ACT = WS_BIG + 12 * MiB, WS_YS = WS_BIG + 52 * MiB;
constexpr size_t WS_END = WS_BIG + 384 * MiB;
constexpr int LDS_BYTES = 152 * 1024, LDS_MISC = 144 * 1024;

#define XB_TMO      128
#define XB_XCNT(j)  (256  + 64 * (j))
#define XB_XSUB(j)  (1280 + 64 * (j))
#define XB_XGEN(j)  (2304 + 64 * (j))
#define XB_TOP      3328
#define XB_TOPGEN   3392
#define XCD_BAR_WORDS 3456
#define XB_SPIN_CAP (1u << 20)
__device__ __forceinline__ unsigned xb_ld(unsigned* p)              { return __hip_atomic_load(p, __ATOMIC_RELAXED, __HIP_MEMORY_SCOPE_AGENT); }
__device__ __forceinline__ unsigned xb_add(unsigned* p, unsigned v) { return __hip_atomic_fetch_add(p, v, __ATOMIC_RELAXED, __HIP_MEMORY_SCOPE_AGENT); }
__device__ __forceinline__ unsigned xb_xcc_id() { return (unsigned)__builtin_amdgcn_s_getreg((3 << 11) | 20) & 0xFu; }
#define XB_SPIN(cond, bar) do { unsigned _sp = 0; while (cond) { __builtin_amdgcn_s_sleep(1); \
    if ((++_sp & 255u) == 0u) { if (xb_ld(&(bar)[XB_TMO])) break; if (_sp > XB_SPIN_CAP) { atomicAdd(&(bar)[XB_TMO], 1u); break; } } } } while (0)
struct XcdBarrier { unsigned* bar; unsigned x; volatile LAS unsigned* st; };
__device__ __forceinline__ XcdBarrier xcd_barrier_post(unsigned* bar, volatile LAS unsigned* st) {
    XcdBarrier b; b.bar = bar; b.x = xb_xcc_id(); b.st = st;
    if (threadIdx.x == 0) (void)xb_add(&bar[XB_XCNT(b.x)], 1u);
    return b;
}
__device__ __forceinline__ void xcd_barrier_complete(unsigned* bar, unsigned x, unsigned& nloc, unsigned& nx) {
    const unsigned G = gridDim.x * gridDim.y * gridDim.z;
    unsigned sum, cnt, mine, sp = 0u;
    for (;;) {
        sum = 0u; cnt = 0u; mine = 0u;
#pragma unroll
        for (unsigned j = 0; j < 16; ++j) { const unsigned c = xb_ld(&bar[XB_XCNT(j)]); sum += c; cnt += (c > 0u) ? 1u : 0u; mine = (j == x) ? c : mine; }
        if (sum == G) break;
        __builtin_amdgcn_s_sleep(1);
        if ((++sp & 255u) == 0u) { if (xb_ld(&bar[XB_TMO])) break; if (sp > XB_SPIN_CAP) { atomicAdd(&bar[XB_TMO], 1u); break; } }
    }
    nloc = mine > 0u ? mine : 1u; nx = cnt > 0u ? cnt : 1u;
}
__device__ __forceinline__ void xcd_barrier(const XcdBarrier& b) {
    asm volatile("s_waitcnt vmcnt(0)" ::: "memory");
    __syncthreads();
    if (threadIdx.x == 0) {
        unsigned* bar = b.bar; unsigned bx = b.x;
        asm volatile("" : "+s"(bar), "+s"(bx));
        __builtin_amdgcn_s_waitcnt(0);
        unsigned nloc = b.st[0], nx = b.st[1];
        if (nloc == 0u) { xcd_barrier_complete(bar, bx, nloc, nx); b.st[0] = nloc; b.st[1] = nx; }
        const unsigned old = xb_add(&bar[XB_XSUB(bx)], 1u);
        const unsigned gen = old / nloc;
        if (old + 1u == (gen + 1u) * nloc) {
            __builtin_amdgcn_fence(__ATOMIC_RELEASE, "agent");
            asm volatile("s_waitcnt vmcnt(0)" ::: "memory");
            const unsigned og = xb_add(&bar[XB_TOP], 1u);
            const unsigned tg = og / nx;
            if (og + 1u == (tg + 1u) * nx) xb_add(&bar[XB_TOPGEN], 1u);
            else XB_SPIN(xb_ld(&bar[XB_TOPGEN]) == tg, bar);
            __builtin_amdgcn_fence(__ATOMIC_ACQUIRE, "agent");
            xb_add(&bar[XB_XGEN(bx)], 1u);
            asm volatile("s_waitcnt vmcnt(0)" ::: "memory");
        } else {
            XB_SPIN(xb_ld(&bar[XB_XGEN(bx)]) == gen, bar);
            __builtin_amdgcn_fence(__ATOMIC_ACQUIRE, "agent");
            asm volatile("s_waitcnt vmcnt(0)" ::: "memory");
        }
    }
    __syncthreads();
}

template <int N> __device__ __forceinline__ void wait_vm() { asm volatile("s_waitcnt vmcnt(%0)" :: "n"(N) : "memory"); }
#define BAR() __builtin_amdgcn_s_barrier()
#define LDS_WAIT() asm volatile("s_waitcnt lgkmcnt(0)" ::: "memory")
__device__ __forceinline__ unsigned pk2(float a, float b) {
    typedef __bf16 bf2 __attribute__((ext_vector_type(2)));
    f32x2 v = {a, b}; bf2 r = __builtin_convertvector(v, bf2); return __builtin_bit_cast(unsigned, r);
}
__device__ __forceinline__ float bf_lo(unsigned u) { return __uint_as_float(u << 16); }
__device__ __forceinline__ float bf_hi(unsigned u) { return __uint_as_float(u & 0xffff0000u); }
__device__ __forceinline__ float wave_sum(float v) {
#pragma unroll
    for (int o = 1; o < 64; o <<= 1) v += __shfl_xor(v, o);
    return v;
}
__device__ __forceinline__ float fast_exp2(float x) { return __builtin_amdgcn_exp2f(x); }
__device__ __forceinline__ float silu_f(float v) { return v / (1.f + __expf(-v)); }
__device__ __forceinline__ void glds16(const void* src, ldsp dst) {
    unsigned keep; const unsigned d = (unsigned)(__SIZE_TYPE__)dst;
    asm volatile("s_mov_b32 %0, m0\n\ts_mov_b32 m0, %2\n\ts_nop 0\n\tglobal_load_lds_dwordx4 %1, off\n\ts_mov_b32 m0, %0" : "=&s"(keep) : "v"(src), "s"(d) : "memory");
}
__device__ __forceinline__ bf16x8 tr2(ldsp a0, ldsp a1) {
    const bf16x4 t0 = __builtin_amdgcn_ds_read_tr16_b64_v4i16((LAS bf16x4*)a0);
    const bf16x4 t1 = __builtin_amdgcn_ds_read_tr16_b64_v4i16((LAS bf16x4*)a1);
    return __builtin_shufflevector(t0, t1, 0, 1, 2, 3, 4, 5, 6, 7);
}
__device__ __forceinline__ bf16x8 rd2x64(ldsp a0, ldsp a1) {
    const bf16x4 t0 = *(LAS bf16x4*)a0; const bf16x4 t1 = *(LAS bf16x4*)a1;
    return __builtin_shufflevector(t0, t1, 0, 1, 2, 3, 4, 5, 6, 7);
}
__device__ __forceinline__ int fresh_tid() { int t = threadIdx.x; asm volatile("" : "+v"(t)); return t; }
__device__ __forceinline__ int vcu_of_block() { const int bx = blockIdx.x; return (bx & 7) * (GRID / 8) + (bx >> 3); }

struct Args {
    const float* in[25];
    float* out; unsigned char* ws;
};
enum { I_X = 0, I_C, I_NMIX, I_NFFN, I_ADAW, I_ADAB, I_DAWIN, I_DAWOUT, I_LQ1, I_LK1, I_LQ2, I_LK2, I_SUBLN, I_RWIN, I_RWOUT, I_RGN,
       I_ROUTW, I_ROUTB, I_EW1, I_EW3, I_EW2, I_SW1, I_SW3, I_SW2, I_FNORM };

template <int WM, int WN, int MT, int NT, int NSTAGE, class Src>
__device__ __forceinline__ void gemm_stream(ldsp lds, int K, const Src& src) {
    constexpr int BM = WM * MT * 16, BN = WN * NT * 16, STAGE = (BM + BN) * 128, LA = BM / 64, LB = BN / 64, L = LA + LB, PD = NSTAGE - 1;
    static_assert(WM * WN == NWAVE && NSTAGE * STAGE <= LDS_MISC, "8 waves; ring fits");
    const int tid = fresh_tid(), lane = tid & 63, wid = __builtin_amdgcn_readfirstlane(tid >> 6);
    const int wr = wid / WN, wc = wid % WN, fr = lane & 15, fq = lane >> 4;
    const char* cbA; const char* cbB; const char* nbA; const char* nbB; unsigned cA[LA], nA[LA], oB[LB];
    typename Src::Epi ce, ne; int cn0 = 0, nn0 = 0;
    if (!src.template setup<LA>(0, cbA, cA, cbB, ce, cn0, wid, lane)) return;
#pragma unroll
    for (int j = 0; j < LB; ++j) { const int row = 8 * (wid + 8 * j) + (lane >> 3); oB[j] = (unsigned)(row * (int)src.ldb * 2 + (((lane & 7) ^ ((row >> 1) & 7)) << 4)); }
    const int swz = fr >> 1;
    const int aoff = (wr * MT * 16 + fr) * 128, boff = BM * 128 + (wc * NT * 16 + fr) * 128;
    const int ok0 = ((fq ^ swz) << 4), ok1 = (((4 + fq) ^ swz) << 4);
    auto issue = [&](int s, const char* bA, const unsigned (&oA)[LA], const char* bB, int t) {
        ldsp st = lds + s * STAGE;
#pragma unroll
        for (int j = 0; j < LA; ++j) glds16(bA + (size_t)t * 128 + oA[j], st + (wid + 8 * j) * 1024);
#pragma unroll
        for (int j = 0; j < LB; ++j) glds16(bB + (size_t)t * 128 + oB[j], st + BM * 128 + (wid + 8 * j) * 1024);
    };
    const int nt = K / 64;
    BAR();
#pragma unroll
    for (int d = 0; d < PD; ++d) issue(d, cbA, cA, cbB, d);
    int s = 0;
    for (int i = 0;; ++i) {
        const bool hasn = src.template setup<LA>(i + 1, nbA, nA, nbB, ne, nn0, wid, lane);
        f32x4 acc[MT][NT];
#pragma unroll
        for (int m = 0; m < MT; ++m)
#pragma unroll
            for (int n = 0; n < NT; ++n) acc[m][n] = (f32x4){0.f, 0.f, 0.f, 0.f};
        for (int t = 0; t < nt; ++t) {
            if (PD >= 2 && (hasn || t + 1 < nt)) wait_vm<(PD - 1) * L>(); else wait_vm<0>();
            BAR();
            { int s2 = s + PD; if (s2 >= NSTAGE) s2 -= NSTAGE;
              if (t + PD < nt) issue(s2, cbA, cA, cbB, t + PD); else if (hasn) issue(s2, nbA, nA, nbB, t + PD - nt); }
            ldsp st = lds + s * STAGE;
#pragma unroll
            for (int kk = 0; kk < 2; ++kk) {
                bf16x8 a[MT], b[NT];
                const int ok = kk ? ok1 : ok0;
#pragma unroll
                for (int n = 0; n < NT; ++n) b[n] = *(LAS bf16x8*)(st + boff + n * 2048 + ok);
#pragma unroll
                for (int m = 0; m < MT; ++m) a[m] = *(LAS bf16x8*)(st + aoff + m * 2048 + ok);
                __builtin_amdgcn_s_setprio(1);
#pragma unroll
                for (int m = 0; m < MT; ++m)
#pragma unroll
                    for (int n = 0; n < NT; ++n) acc[m][n] = __builtin_amdgcn_mfma_f32_16x16x32_bf16(b[n], a[m], acc[m][n], 0, 0, 0);
                __builtin_amdgcn_s_setprio(0);
            }
            s = (s == NSTAGE - 1) ? 0 : s + 1;
        }
        ce(acc, wr * MT * 16, cn0 + wc * NT * 16, fr, fq);
        if (!hasn) break;
#pragma unroll
        for (int j = 0; j < LA; ++j) cA[j] = nA[j];
        cbA = nbA; cbB = nbB; ce = ne; cn0 = nn0;
    }
}
__device__ __forceinline__ int stage_row(int wid, int j, int lane) { return 8 * (wid + 8 * j) + (lane >> 3); }
__device__ __forceinline__ int stage_chunk(int row, int lane) { return ((lane & 7) ^ ((row >> 1) & 7)) * 16; }
__device__ __forceinline__ const char* uniform_ptr(const void* p) { unsigned long long v = (unsigned long long)p; const unsigned lo = __builtin_amdgcn_readfirstlane((unsigned)v), hi = __builtin_amdgcn_readfirstlane((unsigned)(v >> 32)); return (const char*)(((unsigned long long)hi << 32) | lo); }

template <int BM, int BN, class Mk> struct DenseSrc {
    using Epi = decltype(((Mk*)nullptr)->operator()(0));
    const bf16_t* A; size_t lda; const bf16_t* Bt; size_t ldb; int nN, per_x, xcd, local; const Mk& mk;
    __device__ __forceinline__ DenseSrc(const bf16_t* A_, size_t lda_, const bf16_t* Bt_, size_t ldb_, int M, int N, const Mk& mk_) : A(A_), lda(lda_), Bt(Bt_), ldb(ldb_), mk(mk_) {
        const int vcu = vcu_of_block(); nN = N / BN; per_x = (M / BM) / 8; xcd = vcu >> 5; local = vcu & 31; }
    template <int LA> __device__ __forceinline__ bool setup(int i, const char*& bA, unsigned (&oA)[LA], const char*& bB, Epi& e, int& n0, int wid, int lane) const {
        constexpr int GM = 4;
        const int q = local + 32 * i; if (q >= per_x * nN) return false;
        const int grp = q / (GM * nN), r = q % (GM * nN), m = xcd * per_x + grp * GM + (r % GM), n = r / GM;
#pragma unroll
        for (int j = 0; j < LA; ++j) { const int row = stage_row(wid, j, lane); oA[j] = (unsigned)(row * (int)lda * 2 + stage_chunk(row, lane)); }
        bA = (const char*)(A + (size_t)(m * BM) * lda); bB = (const char*)(Bt + (size_t)(n * BN) * ldb);
        e = mk(m * BM); n0 = n * BN; return true;
    }
};
template <int WM, int WN, int MT, int NT, int NSTAGE, class Mk>
__device__ __forceinline__ void gemm_dense_phase(ldsp lds, const bf16_t* A, size_t lda, const bf16_t* Bt, size_t ldb, int M, int N, int K, const Mk& mk) {
    DenseSrc<WM * MT * 16, WN * NT * 16, Mk> src(A, lda, Bt, ldb, M, N, mk);
    gemm_stream<WM, WN, MT, NT, NSTAGE>(lds, K, src);
}

struct EpiStoreBf16 {
    bf16_t* O; size_t ldc; int m0;
    template <int MT, int NT> __device__ __forceinline__ void operator()(const f32x4 (&acc)[MT][NT], int rb, int cb, int fr, int fq) const {
#pragma unroll
        for (int m = 0; m < MT; ++m) { bf16_t* rp = O + (size_t)(m0 + rb + m * 16 + fr) * ldc + cb + 4 * fq;
#pragma unroll
            for (int n = 0; n < NT; ++n) { u32x2 w; w.x = pk2(acc[m][n][0], acc[m][n][1]); w.y = pk2(acc[m][n][2], acc[m][n][3]); *(u32x2*)(rp + n * 16) = w; } }
    }
};
struct EpiResidual {
    const float* Xin; float* Xout; const float* gate; int m0;
    template <int MT, int NT> __device__ __forceinline__ void operator()(const f32x4 (&acc)[MT][NT], int rb, int cb, int fr, int fq) const {
#pragma unroll
        for (int m = 0; m < MT; ++m) { const int row = m0 + rb + m * 16 + fr; const float* g = gate + (size_t)(row >> 11) * 6144;
#pragma unroll
            for (int n = 0; n < NT; ++n) { const int col = cb + n * 16 + 4 * fq; const f32x4 xv = *(const f32x4*)(Xin + (size_t)row * D + col); const f32x4 gv = *(const f32x4*)(g + col);
                *(f32x4*)(Xout + (size_t)row * D + col) = xv + gv * acc[m][n]; } }
    }
};
struct EpiRetProj {
    bf16_t* O; int m0;
    template <int MT, int NT> __device__ __forceinline__ void operator()(const f32x4 (&acc)[MT][NT], int rb, int cb, int fr, int fq) const {
        float l2g = 0.f, pre = 1.f;
        if (cb < 2048) { const int h = (cb & 1023) >> 8; l2g = __log2f(1.f - exp2f(-5.f - (float)h)); if (cb >= 1024) { l2g = -l2g; pre = 0.0625f; } }
#pragma unroll
        for (int m = 0; m < MT; ++m) { const int row = m0 + rb + m * 16 + fr; const float sc = pre * exp2f(l2g * (float)(row & 127)); bf16_t* rp = O + (size_t)row * 6144 + cb + 4 * fq;
#pragma unroll
            for (int n = 0; n < NT; ++n) { u32x2 w; w.x = pk2(acc[m][n][0] * sc, acc[m][n][1] * sc); w.y = pk2(acc[m][n][2] * sc, acc[m][n][3] * sc); *(u32x2*)(rp + n * 16) = w; } }
    }
};
struct EpiCausalP {
    bf16_t* O;
    template <int MT, int NT> __device__ __forceinline__ void operator()(const f32x4 (&acc)[MT][NT], int rb, int cb, int fr, int fq) const {
#pragma unroll
        for (int m = 0; m < MT; ++m) { const int i = rb + m * 16 + fr; bf16_t* rp = O + (size_t)i * 128 + cb + 4 * fq;
#pragma unroll
            for (int n = 0; n < NT; ++n) { const int j = cb + n * 16 + 4 * fq; f32x4 v = acc[m][n];
                v[0] = (i >= j) ? v[0] : 0.f; v[1] = (i >= j + 1) ? v[1] : 0.f; v[2] = (i >= j + 2) ? v[2] : 0.f; v[3] = (i >= j + 3) ? v[3] : 0.f;
                u32x2 w; w.x = pk2(v[0], v[1]); w.y = pk2(v[2], v[3]); *(u32x2*)(rp + n * 16) = w; } }
    }
};
struct EpiSwiGLU {
    bf16_t* O; int slot0;
    template <int MT, int NT> __device__ __forceinline__ void operator()(const f32x4 (&acc)[MT][NT], int rb, int cb, int fr, int fq) const {
        static_assert(NT == 4, "NT");
#pragma unroll
        for (int m = 0; m < MT; ++m) { bf16_t* rp = O + (size_t)(slot0 + rb + m * 16 + fr) * 256 + (cb >> 1) + 4 * fq;
#pragma unroll
            for (int p = 0; p < 2; ++p) { const f32x4 a = acc[m][2 * p], b = acc[m][2 * p + 1]; u32x2 w;
                w.x = pk2(silu_f(a[0]) * b[0], silu_f(a[1]) * b[1]); w.y = pk2(silu_f(a[2]) * b[2], silu_f(a[3]) * b[3]); *(u32x2*)(rp + p * 16) = w; } }
    }
};

__device__ __forceinline__ void transpose_item(const float* W, int K, int N, bf16_t* WT, int mode, LAS float* scr, int item, int lane) {
    const int nblk = N / 32, kb = item / nblk, nb = item % nblk, k0 = 64 * kb, n0 = 32 * nb;
#pragma unroll 8
    for (int i = 0; i < 32; ++i) { const int kk = 2 * i + (lane >> 5); scr[kk * 33 + (lane & 31)] = W[(size_t)(k0 + kk) * N + n0 + (lane & 31)]; }
    LDS_WAIT();
    const int c = lane & 7;
#pragma unroll
    for (int j = 0; j < 4; ++j) { const int n = (lane >> 3) + 8 * j; const LAS float* s = scr + (8 * c) * 33 + n;
        u32x4 o; o.x = pk2(s[0 * 33], s[1 * 33]); o.y = pk2(s[2 * 33], s[3 * 33]); o.z = pk2(s[4 * 33], s[5 * 33]); o.w = pk2(s[6 * 33], s[7 * 33]);
        const int nn = n0 + n; const int row = mode == 0 ? nn : ((nn >> 4) * 32 + (mode == 2 ? 16 : 0) + (nn & 15));
        *(u32x4*)(WT + (size_t)row * K + k0 + 8 * c) = o; }
    LDS_WAIT();
}
__device__ __forceinline__ void convert_expert_weights(const Args& a, int layer, ldsp lds, int gw, int ngw, int wave, int lane) {
    LAS float* scr = (LAS float*)(lds + wave * 16384);
    unsigned char* ws = a.ws;
    constexpr int I13 = (D / 64) * (256 / 32), I2 = (256 / 64) * (D / 32);
    constexpr int NE = 64 * I13;
    constexpr int TOTAL = 3 * NE + 3 * 128;
    for (int it = gw; it < TOTAL; it += ngw) {
        int r = it;
        if (r < NE) { const int e = r / I13; transpose_item(a.in[I_EW1] + ((size_t)layer * 64 + e) * D * 256, D, 256, (bf16_t*)(ws + WS_W13) + (size_t)e * 512 * D, 1, scr, r % I13, lane); continue; } r -= NE;
        if (r < NE) { const int e = r / I13; transpose_item(a.in[I_EW3] + ((size_t)layer * 64 + e) * D * 256, D, 256, (bf16_t*)(ws + WS_W13) + (size_t)e * 512 * D, 2, scr, r % I13, lane); continue; } r -= NE;
        if (r < NE) { const int e = r / I2; transpose_item(a.in[I_EW2] + ((size_t)layer * 64 + e) * 256 * D, 256, D, (bf16_t*)(ws + WS_W2) + (size_t)e * D * 256, 0, scr, r % I2, lane); continue; } r -= NE;
        if (r < 128) { transpose_item(a.in[I_SW1] + (size_t)layer * D * 256, D, 256, (bf16_t*)(ws + WS_WS13), 1, scr, r, lane); continue; } r -= 128;
        if (r < 128) { transpose_item(a.in[I_SW3] + (size_t)layer * D * 256, D, 256, (bf16_t*)(ws + WS_WS13), 2, scr, r, lane); continue; } r -= 128;
        transpose_item(a.in[I_SW2] + (size_t)layer * 256 * D, 256, D, (bf16_t*)(ws + WS_WS2), 0, scr, r, lane);
    }
}
__device__ __forceinline__ void convert_dense_weights(const Args& a, ldsp lds, int gw, int ngw, int wave, int lane) {
    LAS float* scr = (LAS float*)(lds + wave * 16384);
    unsigned char* ws = a.ws;
    constexpr int IQ = 16 * 96, IO = 16 * 32, IRI = 16 * 192, IRO = 32 * 32;
    for (int it = gw; it < IQ + IO + IRI + IRO; it += ngw) {
        int r = it;
        if (r < IQ) { transpose_item(a.in[I_DAWIN], D, 3072, (bf16_t*)(ws + WS_WQKV), 0, scr, r, lane); continue; } r -= IQ;
        if (r < IO) { transpose_item(a.in[I_DAWOUT], D, D, (bf16_t*)(ws + WS_WO), 0, scr, r, lane); continue; } r -= IO;
        if (r < IRI) { transpose_item(a.in[I_RWIN], D, 6144, (bf16_t*)(ws + WS_WRI), 0, scr, r, lane); continue; } r -= IRI;
        transpose_item(a.in[I_RWOUT], 2048, D, (bf16_t*)(ws + WS_WRO), 0, scr, r, lane);
    }
}
__device__ __forceinline__ void mod_items(const Args& a, ldsp lds) {
    const int tid = threadIdx.x;
    if ((int)blockIdx.x >= 192) return;
    LAS float* sl = (LAS float*)lds;
    LAS float* red = (LAS float*)(lds + 65536);
    const float* c = a.in[I_C];
    for (int i = tid; i < 16 * 1024; i += NTHR) sl[i] = silu_f(c[i]);
    __syncthreads();
    float* mod = (float*)(a.ws + WS_MOD);
    for (int item = blockIdx.x; item < 192; item += GRID) {
        const int layer = item / 96, j0 = (item % 96) * 64, kq = tid >> 6, col = tid & 63;
        const float* w = a.in[I_ADAW] + (size_t)layer * D * 6144 + j0 + col;
        float acc[16];
#pragma unroll
        for (int b = 0; b < 16; ++b) acc[b] = 0.f;
        for (int k = kq * 128; k < kq * 128 + 128; ++k) { const float wv = w[(size_t)k * 6144];
#pragma unroll
            for (int b = 0; b < 16; ++b) acc[b] += sl[b * 1024 + k] * wv; }
#pragma unroll
        for (int b = 0; b < 16; ++b) red[(kq * 16 + b) * 64 + col] = acc[b];
        __syncthreads();
        for (int o = tid; o < 1024; o += NTHR) { const int b = o >> 6, cc = o & 63; float s = a.in[I_ADAB][(size_t)layer * 6144 + j0 + cc];
#pragma unroll
            for (int q = 0; q < 8; ++q) s += red[(q * 16 + b) * 64 + cc];
            const int j = j0 + cc;
            if (j >= 1024 && j < 2048) s = a.in[I_NMIX][layer * D + j - 1024] * (1.f + s);
            if (j >= 4096 && j < 5120) s = a.in[I_NFFN][layer * D + j - 4096] * (1.f + s);
            mod[((size_t)layer * 16 + b) * 6144 + j] = s; }
        __syncthreads();
    }
}

__device__ __forceinline__ void adaln_store(const f32x4 (&v)[4], float rstd, const float* G, const float* sh, bf16_t* hrow, int lane) {
#pragma unroll
    for (int j = 0; j < 4; ++j) { const int col = 4 * lane + 256 * j; const f32x4 g = *(const f32x4*)(G + col), s0 = *(const f32x4*)(sh + col);
        const f32x4 h = v[j] * rstd * g + s0; u32x2 w; w.x = pk2(h[0], h[1]); w.y = pk2(h[2], h[3]); *(u32x2*)(hrow + col) = w; }
}
__device__ __forceinline__ void adaln_phase(const float* X, const float* mod_sh  , const float* mod_G, bf16_t* H, int gw, int ngw, int lane) {
    for (int row0 = gw * 2; row0 < T; row0 += ngw * 2) {
        f32x4 v[2][4]; float ss[2] = {0.f, 0.f};
#pragma unroll
        for (int r = 0; r < 2; ++r)
#pragma unroll
            for (int j = 0; j < 4; ++j) v[r][j] = *(const f32x4*)(X + (size_t)(row0 + r) * D + 4 * lane + 256 * j);
#pragma unroll
        for (int r = 0; r < 2; ++r) {
#pragma unroll
            for (int j = 0; j < 4; ++j) ss[r] += v[r][j][0] * v[r][j][0] + v[r][j][1] * v[r][j][1] + v[r][j][2] * v[r][j][2] + v[r][j][3] * v[r][j][3];
            const float rstd = rsqrtf(wave_sum(ss[r]) * (1.f / D) + 1e-6f); const int b = (row0 + r) >> 11;
            adaln_store(v[r], rstd, mod_G + (size_t)b * 6144, mod_sh + (size_t)b * 6144, H + (size_t)(row0 + r) * D, lane); }
    }
}

__device__ __forceinline__ void attn_phase(ldsp lds, const bf16_t* qkv, bf16_t* ao, float lam, const float* subln_g) {
    const int tid = fresh_tid(), lane = tid & 63, wid = __builtin_amdgcn_readfirstlane(tid >> 6), map = wid & 1, qg = wid >> 1, fr = lane & 15, fq = lane >> 4;
    constexpr int STAGE = 32768;
    const float cs = 0.125f * LOG2E;
    const int kswz = fr >> 1, kok0 = ((fq ^ kswz) << 4), kok1 = (((4 + fq) ^ kswz) << 4), koff = map * 8192 + fr * 128;
    const int vq = fr >> 2, vp = fr & 3, vrow = 4 * fq + vq, vsw = ((vrow & 7) << 1);
    const int vbase0 = 16384 + vrow * 256 + ((((vp >> 1) ^ vsw) & 15) << 4) + (vp & 1) * 8;
    for (int round = 0; round < 8; ++round) {
        const int i = blockIdx.x, jgrp = i >> 7, bh = i & 127;
        const int qb = (round & 1) ? (14 - 2 * round + jgrp) : (15 - 2 * round - jgrp);
        const int b = bh >> 3, h = bh & 7;
        const size_t tok0 = (size_t)b * SEQ;
        const float slope2 = exp2f(-(float)(h + 1)) * LOG2E;
        bf16x8 qf[2][2];
#pragma unroll
        for (int qt = 0; qt < 2; ++qt)
#pragma unroll
            for (int kk = 0; kk < 2; ++kk) qf[qt][kk] = *(const bf16x8*)(qkv + (tok0 + qb * 128 + qg * 32 + qt * 16 + fr) * 3072 + (2 * h + map) * 64 + kk * 32 + fq * 8);
        asm volatile("" :: "v"(qf[0][0]), "v"(qf[0][1]), "v"(qf[1][0]), "v"(qf[1][1]));
        const char* srcK0; const char* srcV0;
        { const int row = 8 * wid + (lane >> 3), ch = (lane & 7) ^ ((row >> 1) & 7);
          srcK0 = (const char*)(qkv + (tok0 + row) * 3072 + 1024 + (2 * h) * 64) + ch * 16; }
        { const int row = 4 * wid + (lane >> 4), ch = (lane & 15) ^ ((row & 7) << 1); srcV0 = (const char*)(qkv + (tok0 + row) * 3072 + 2048 + h * 128) + ch * 16; }
        auto issue = [&](int s, int t) {
            ldsp st = lds + s * STAGE; const size_t adv = (size_t)t * 64 * 3072 * 2;
            glds16(srcK0 + adv, st + wid * 1024); glds16(srcK0 + adv + 128, st + 8192 + wid * 1024);
            glds16(srcV0 + adv, st + 16384 + wid * 1024); glds16(srcV0 + adv + (size_t)32 * 6144, st + 16384 + (wid + 8) * 1024);
        };
        f32x4 o[8][2];
#pragma unroll
        for (int dt = 0; dt < 8; ++dt) { o[dt][0] = (f32x4){0.f, 0.f, 0.f, 0.f}; o[dt][1] = (f32x4){0.f, 0.f, 0.f, 0.f}; }
        float mrow[2] = {-__builtin_inff(), -__builtin_inff()}, lrow[2] = {0.f, 0.f};
        const int ntile = 2 * qb + 2;
        const int qlast = qb * 128 + qg * 32 + 31, qfirst = qb * 128 + qg * 32;
        BAR();
        issue(0, 0); issue(1, 1);
        int s = 0;
        for (int t = 0; t < ntile; ++t) {
            if (t + 1 < ntile) wait_vm<4>(); else wait_vm<0>();
            BAR();
            if (t + 2 < ntile) { int s2 = s + 2; if (s2 >= 3) s2 -= 3; issue(s2, t + 2); }
            ldsp st = lds + s * STAGE;
            const int key0 = 64 * t;
            if (key0 <= qlast) {
                f32x4 sc[4][2];
#pragma unroll
                for (int kt = 0; kt < 4; ++kt) { sc[kt][0] = (f32x4){0.f, 0.f, 0.f, 0.f}; sc[kt][1] = (f32x4){0.f, 0.f, 0.f, 0.f}; }
#pragma unroll
                for (int kk = 0; kk < 2; ++kk) {
                    const int ok = kk ? kok1 : kok0;
#pragma unroll
                    for (int kt = 0; kt < 4; ++kt) { const bf16x8 kf = *(LAS bf16x8*)(st + koff + kt * 2048 + ok);
                        sc[kt][0] = __builtin_amdgcn_mfma_f32_16x16x32_bf16(kf, qf[0][kk], sc[kt][0], 0, 0, 0);
                        sc[kt][1] = __builtin_amdgcn_mfma_f32_16x16x32_bf16(kf, qf[1][kk], sc[kt][1], 0, 0, 0); }
                }
                __builtin_amdgcn_sched_barrier(0);
                const bool need_mask = (key0 + 63 > qfirst);
                const float kb0 = slope2 * (float)(key0 + 4 * fq);
                bf16x8 pf[2][2];
#pragma unroll
                for (int qt = 0; qt < 2; ++qt) {
                    const int qrow = qb * 128 + qg * 32 + qt * 16 + fr;
                    float mx = -__builtin_inff();
#pragma unroll
                    for (int kt = 0; kt < 4; ++kt)
#pragma unroll
                        for (int r = 0; r < 4; ++r) { float v = sc[kt][qt][r] * cs + (kb0 + slope2 * (float)(16 * kt + r));
                            if (need_mask && (key0 + 16 * kt + 4 * fq + r > qrow)) v = -__builtin_inff();
                            sc[kt][qt][r] = v; mx = fmaxf(mx, v); }
                    mx = fmaxf(mx, __shfl_xor(mx, 16)); mx = fmaxf(mx, __shfl_xor(mx, 32));
                    const float mnew = fmaxf(mrow[qt], mx), alpha = fast_exp2(mrow[qt] - mnew);
                    mrow[qt] = mnew;
                    float ps = 0.f;
#pragma unroll
                    for (int kt = 0; kt < 4; ++kt)
#pragma unroll
                        for (int r = 0; r < 4; ++r) { const float p = fast_exp2(sc[kt][qt][r] - mnew); sc[kt][qt][r] = p; ps += p; }
                    lrow[qt] = lrow[qt] * alpha + ps;
#pragma unroll
                    for (int dt = 0; dt < 8; ++dt) o[dt][qt] = o[dt][qt] * alpha;
#pragma unroll
                    for (int s2 = 0; s2 < 2; ++s2) { u32x4 w; w.x = pk2(sc[2 * s2][qt][0], sc[2 * s2][qt][1]); w.y = pk2(sc[2 * s2][qt][2], sc[2 * s2][qt][3]);
                        w.z = pk2(sc[2 * s2 + 1][qt][0], sc[2 * s2 + 1][qt][1]); w.w = pk2(sc[2 * s2 + 1][qt][2], sc[2 * s2 + 1][qt][3]); pf[qt][s2] = __builtin_bit_cast(bf16x8, w); }
                }
#pragma unroll
                for (int s2 = 0; s2 < 2; ++s2) {
                    int vb = vbase0; asm volatile("" : "+v"(vb));
#pragma unroll
                    for (int dt = 0; dt < 8; ++dt) { const int vo = vb ^ (dt << 5); const bf16x8 vf = tr2(st + vo + s2 * 8192, st + vo + s2 * 8192 + 4096);
                        o[dt][0] = __builtin_amdgcn_mfma_f32_16x16x32_bf16(vf, pf[0][s2], o[dt][0], 0, 0, 0);
                        o[dt][1] = __builtin_amdgcn_mfma_f32_16x16x32_bf16(vf, pf[1][s2], o[dt][1], 0, 0, 0);
                        if ((dt & 3) == 3) __builtin_amdgcn_sched_barrier(0); }
                }
            }
            s = (s == 2) ? 0 : s + 1;
        }
#pragma unroll
        for (int qt = 0; qt < 2; ++qt) { float l = lrow[qt]; l += __shfl_xor(l, 16); l += __shfl_xor(l, 32); const float inv = 1.f / l;
#pragma unroll
            for (int dt = 0; dt < 8; ++dt) o[dt][qt] = o[dt][qt] * inv; }
        BAR();
        LAS float* xb = (LAS float*)lds + qg * 4096;
        if (map == 1) {
#pragma unroll
            for (int dt = 0; dt < 8; ++dt)
#pragma unroll
                for (int qt = 0; qt < 2; ++qt)
#pragma unroll
                    for (int r = 0; r < 4; ++r) xb[((dt * 2 + qt) * 4 + r) * 64 + lane] = o[dt][qt][r];
        }
        LDS_WAIT(); BAR();
        if (map == 0) {
            const float* sg = subln_g; asm volatile("" : "+s"(sg));
#pragma unroll
            for (int qt = 0; qt < 2; ++qt) {
                float ss = 0.f;
#pragma unroll
                for (int dt = 0; dt < 8; ++dt)
#pragma unroll
                    for (int r = 0; r < 4; ++r) { const float v = o[dt][qt][r] - lam * xb[((dt * 2 + qt) * 4 + r) * 64 + lane]; o[dt][qt][r] = v; ss += v * v; }
                ss += __shfl_xor(ss, 16); ss += __shfl_xor(ss, 32);
                const float rstd = rsqrtf(ss * (1.f / 128.f) + 1e-6f) * 0.8f;
                bf16_t* orow = ao + (tok0 + qb * 128 + qg * 32 + qt * 16 + fr) * D + h * 128 + 4 * fq;
#pragma unroll
                for (int dt = 0; dt < 8; ++dt) { const f32x4 g = *(const f32x4*)(sg + dt * 16 + 4 * fq); const f32x4 v = o[dt][qt] * rstd * g;
                    u32x2 w; w.x = pk2(v[0], v[1]); w.y = pk2(v[2], v[3]); *(u32x2*)(orow + dt * 16) = w; }
            }
        }
        LDS_WAIT(); BAR();
    }
}

__device__ __forceinline__ void chain_phase(ldsp lds, bf16_t* rp, const bf16_t* P, bool dry) {
    const int tid = fresh_tid(), lane = tid & 63, wid = __builtin_amdgcn_readfirstlane(tid >> 6), fr = lane & 15, fq = lane >> 4;
    constexpr int STAGE = 32768, NSTG = 4;
    const int chain = blockIdx.x, b = chain >> 4, h = (chain >> 2) & 3, sl = chain & 3;
    const size_t tok0 = (size_t)b * SEQ;
    const float lg = __log2f(1.f - exp2f(-5.f - (float)h));
    const float gamma = exp2f(lg), g127 = exp2f(lg * 127.f), g128 = exp2f(lg * 128.f);
    const bf16_t* vbase = rp + tok0 * 6144 + 2048 + h * 512 + sl * 128;
    const bf16_t* qbase = rp + tok0 * 6144 + h * 256;
    const bf16_t* kbase = rp + tok0 * 6144 + 1024 + h * 256;
    const bf16_t* pbase = P + (size_t)((b * 4 + h) * 16) * 16384;
    unsigned vsrc0, psrc0, qsrc0, ksrc0;
    { const int row = 4 * wid + (lane >> 4); vsrc0 = (unsigned)(row * 6144 * 2 + (((lane & 15) ^ ((row & 7) << 1)) << 4)); psrc0 = (unsigned)(row * 256 + (((lane & 15) ^ (row & 15)) << 4)); }
    { const int row = 8 * wid + (lane >> 3); qsrc0 = (unsigned)(row * 6144 * 2 + (((lane & 7) ^ ((row >> 1) & 7)) << 4)); ksrc0 = (unsigned)(row * 6144 * 2 + (((lane & 7) ^ (((row >> 1) & 3) << 1)) << 4)); }
    auto issue = [&](int s, int g) {
        ldsp st = lds + s * STAGE; const int c = g / 6, kind = g - c * 6; const size_t coff = (size_t)c * 128 * 6144 * 2;
        if (kind == 0) {
            const char* bp = (const char*)vbase + coff;
#pragma unroll
            for (int jj = 0; jj < 4; ++jj) glds16(bp + (size_t)jj * 32 * 12288 + vsrc0, st + (wid + 8 * jj) * 1024);
        } else if (kind == 5) {
            const char* bp = (const char*)pbase + (size_t)c * 32768;
#pragma unroll
            for (int jj = 0; jj < 4; ++jj) glds16(bp + (size_t)jj * 32 * 256 + psrc0, st + (wid + 8 * jj) * 1024);
        } else { const int p = kind - 1;
            const char* bq = (const char*)qbase + coff + p * 128; const char* bk = (const char*)kbase + coff + p * 128;
#pragma unroll
            for (int jj = 0; jj < 2; ++jj) glds16(bq + (size_t)jj * 64 * 12288 + qsrc0, st + (wid + 8 * jj) * 1024);
#pragma unroll
            for (int jj = 0; jj < 2; ++jj) glds16(bk + (size_t)jj * 64 * 12288 + ksrc0, st + 16384 + (wid + 8 * jj) * 1024);
        }
    };
    const int tq = fr >> 2, tp = fr & 3;
    const int vrow = 4 * fq + tq;
    const int vfo = vrow * 256 + ((((2 * wid + (tp >> 1)) ^ ((vrow & 7) << 1)) & 15) << 4) + (tp & 1) * 8;
    const int ksw = ((vrow >> 1) & 3) << 1;
    const int kfo0 = 16384 + vrow * 128 + ((((tp >> 1) ^ ksw) & 7) << 4) + (tp & 1) * 8;
    const int qsw = fr >> 1;
    const int qfo0 = fr * 128 + ((((fq >> 1) ^ qsw) & 7) << 4) + (fq & 1) * 8;
    const int pfo0 = fr * 256 + ((((fq >> 1) ^ fr) & 15) << 4) + (fq & 1) * 8;

    f32x4 R[16];
#pragma unroll
    for (int i = 0; i < 16; ++i) R[i] = (f32x4){0.f, 0.f, 0.f, 0.f};
    f32x4 o[8];
#pragma unroll
    for (int it = 0; it < 8; ++it) o[it] = (f32x4){0.f, 0.f, 0.f, 0.f};
    bf16x8 vf[4];
#pragma unroll
    for (int s4 = 0; s4 < 4; ++s4) vf[s4] = (bf16x8){0, 0, 0, 0, 0, 0, 0, 0};
    constexpr int NG = 16 * 6;
    BAR();
    issue(0, 0); issue(1, 1); issue(2, 2);
    for (int c = 0; c < 16; ++c) {
        auto step = [&](auto KC) {
            constexpr int kind = decltype(KC)::value;
            const int g = c * 6 + kind;
            if (g + 2 < NG) wait_vm<8>(); else if (g + 1 < NG) wait_vm<4>(); else wait_vm<0>();
            BAR();
            if (g + 3 < NG) issue((g + 3) & 3, g + 3);
            ldsp st = lds + (g & 3) * STAGE;
            if constexpr (kind == 0) {
#pragma unroll
                for (int s4 = 0; s4 < 4; ++s4) vf[s4] = tr2(st + vfo + s4 * 8192, st + vfo + s4 * 8192 + 4096);
#pragma unroll
                for (int it = 0; it < 8; ++it) o[it] = (f32x4){0.f, 0.f, 0.f, 0.f};
            } else if constexpr (kind == 5) {
#pragma unroll
                for (int it = 0; it < 8; ++it) o[it] = o[it] * gamma;
#pragma unroll
                for (int s4 = 0; s4 < 4; ++s4) {
                    int pb = pfo0; asm volatile("" : "+v"(pb)); const int p0 = pb ^ ((4 * s4) << 4), p1 = pb ^ ((4 * s4 + 2) << 4);
#pragma unroll
                    for (int it = 0; it < 8; ++it) { const bf16x8 pf = rd2x64(st + p0 + it * 4096, st + p1 + it * 4096);
                        o[it] = __builtin_amdgcn_mfma_f32_16x16x32_bf16(vf[s4], pf, o[it], 0, 0, 0); if (it == 3) __builtin_amdgcn_sched_barrier(0); }
                    __builtin_amdgcn_sched_barrier(0);
                }
                bf16_t* ob = rp + (tok0 + (size_t)c * 128) * 6144 + 2048 + h * 512 + sl * 128 + 16 * wid + 4 * fq;
#pragma unroll
                for (int it = 0; it < 8; ++it) { u32x2 w; w.x = pk2(o[it][0], o[it][1]); w.y = pk2(o[it][2], o[it][3]); if (!dry) *(u32x2*)(ob + (size_t)(16 * it + fr) * 6144) = w; else asm volatile("" :: "v"(w)); }
            } else {
                constexpr int p = kind - 1;
#pragma unroll
                for (int s2 = 0; s2 < 2; ++s2) {
                    u32x4 w; const f32x4 r0 = R[4 * p + 2 * s2], r1 = R[4 * p + 2 * s2 + 1];
                    w.x = pk2(r0[0], r0[1]); w.y = pk2(r0[2], r0[3]); w.z = pk2(r1[0], r1[1]); w.w = pk2(r1[2], r1[3]);
                    const bf16x8 rf = __builtin_bit_cast(bf16x8, w);
                    int qb = qfo0; asm volatile("" : "+v"(qb)); const int q0 = qb ^ ((4 * s2) << 4), q1 = qb ^ ((4 * s2 + 2) << 4);
#pragma unroll
                    for (int it = 0; it < 8; ++it) { const bf16x8 qf = rd2x64(st + q0 + it * 2048, st + q1 + it * 2048);
                        o[it] = __builtin_amdgcn_mfma_f32_16x16x32_bf16(rf, qf, o[it], 0, 0, 0); if (it == 3) __builtin_amdgcn_sched_barrier(0); }
                    __builtin_amdgcn_sched_barrier(0);
                }
#pragma unroll
                for (int dkt = 0; dkt < 4; ++dkt) {
                    f32x4 acc = (f32x4){0.f, 0.f, 0.f, 0.f};
                    int kb = kfo0; asm volatile("" : "+v"(kb)); const int ko = kb ^ (dkt << 5);
#pragma unroll
                    for (int s4 = 0; s4 < 4; ++s4) { const bf16x8 kf = tr2(st + ko + s4 * 4096, st + ko + s4 * 4096 + 2048);
                        acc = __builtin_amdgcn_mfma_f32_16x16x32_bf16(kf, vf[s4], acc, 0, 0, 0); }
                    R[4 * p + dkt] = R[4 * p + dkt] * g128 + acc * g127;
                }
                __builtin_amdgcn_sched_barrier(0);
            }
        };
        step(std::integral_constant<int, 0>{}); step(std::integral_constant<int, 1>{}); step(std::integral_constant<int, 2>{});
        step(std::integral_constant<int, 3>{}); step(std::integral_constant<int, 4>{}); step(std::integral_constant<int, 5>{});
    }
}

__device__ __forceinline__ void gnorm_phase(bf16_t* rp, const float* gn, int gw, int ngw, int lane, bool dry) {
    for (int row = gw; row < T; row += ngw) {
        bf16_t* orow = rp + (size_t)row * 6144 + 2048; const bf16_t* grow = rp + (size_t)row * 6144 + 4096;
#pragma unroll
        for (int hh = 0; hh < 4; ++hh) {
            const u32x4 ov = *(const u32x4*)(orow + hh * 512 + 8 * lane), gv = *(const u32x4*)(grow + hh * 512 + 8 * lane);
            float of[8] = {bf_lo(ov.x), bf_hi(ov.x), bf_lo(ov.y), bf_hi(ov.y), bf_lo(ov.z), bf_hi(ov.z), bf_lo(ov.w), bf_hi(ov.w)};
            float gf[8] = {bf_lo(gv.x), bf_hi(gv.x), bf_lo(gv.y), bf_hi(gv.y), bf_lo(gv.z), bf_hi(gv.z), bf_lo(gv.w), bf_hi(gv.w)};
            float ss = 0.f;
#pragma unroll
            for (int e = 0; e < 8; ++e) ss += of[e] * of[e];
            const float rstd = rsqrtf(wave_sum(ss) * (1.f / 512.f) + 1e-6f);
            const f32x4 w0 = *(const f32x4*)(gn + hh * 512 + 8 * lane), w1 = *(const f32x4*)(gn + hh * 512 + 8 * lane + 4);
            float y[8];
#pragma unroll
            for (int e = 0; e < 8; ++e) y[e] = silu_f(gf[e]) * of[e] * rstd * (e < 4 ? w0[e] : w1[e - 4]);
            u32x4 w; w.x = pk2(y[0], y[1]); w.y = pk2(y[2], y[3]); w.z = pk2(y[4], y[5]); w.w = pk2(y[6], y[7]);
            if (!dry) *(u32x4*)(orow + hh * 512 + 8 * lane) = w; else asm volatile("" :: "v"(w));
        }
    }
}

__device__ __forceinline__ void router_phase(ldsp lds, const float* XR, const float* mod_sh, const float* mod_G, const bf16_t* rwt  , const float* rbias,
                                             bf16_t* H, int* sel_e, float* sel_w, int* sel_p, int* tokl, unsigned* cnt, int gw, int ngw, int wave, int lane, bool dry) {
    LAS float* lg = (LAS float*)(lds + wave * 4096);
    const float rb = rbias[lane];
    const int fr = lane & 15, fq = lane >> 4;
    for (int tile = gw; tile < T / 16; tile += ngw) {
        const int row = tile * 16 + fr, b = row >> 11;
        const float* xr = XR + (size_t)row * D + 8 * fq;
        float ss = 0.f;
#pragma unroll 8
        for (int s = 0; s < 32; ++s) { const f32x4 x0 = *(const f32x4*)(xr + 32 * s), x1 = *(const f32x4*)(xr + 32 * s + 4);
            ss += x0[0] * x0[0] + x0[1] * x0[1] + x0[2] * x0[2] + x0[3] * x0[3] + x1[0] * x1[0] + x1[1] * x1[1] + x1[2] * x1[2] + x1[3] * x1[3]; }
        ss += __shfl_xor(ss, 16); ss += __shfl_xor(ss, 32);
        const float rstd = rsqrtf(ss * (1.f / D) + 1e-6f);
        const float* G = mod_G + (size_t)b * 6144 + 8 * fq; const float* SH = mod_sh + (size_t)b * 6144 + 8 * fq;
        bf16_t* hrow = H + (size_t)row * D + 8 * fq;
        const bf16_t* whi = rwt + (size_t)fr * 1024 + 8 * fq; const bf16_t* wlo = whi + 64 * 1024;
        f32x4 acc[4];
#pragma unroll
        for (int et = 0; et < 4; ++et) acc[et] = (f32x4){0.f, 0.f, 0.f, 0.f};
#pragma unroll 2
        for (int s = 0; s < 32; ++s) {
            const f32x4 x0 = *(const f32x4*)(xr + 32 * s), x1 = *(const f32x4*)(xr + 32 * s + 4);
            const f32x4 g0 = *(const f32x4*)(G + 32 * s), g1 = *(const f32x4*)(G + 32 * s + 4), s0 = *(const f32x4*)(SH + 32 * s), s1 = *(const f32x4*)(SH + 32 * s + 4);
            const f32x4 h0 = x0 * rstd * g0 + s0, h1 = x1 * rstd * g1 + s1;
            u32x4 hi; hi.x = pk2(h0[0], h0[1]); hi.y = pk2(h0[2], h0[3]); hi.z = pk2(h1[0], h1[1]); hi.w = pk2(h1[2], h1[3]);
            *(u32x4*)(hrow + 32 * s) = hi;
            u32x4 lo; lo.x = pk2(h0[0] - bf_lo(hi.x), h0[1] - bf_hi(hi.x)); lo.y = pk2(h0[2] - bf_lo(hi.y), h0[3] - bf_hi(hi.y));
            lo.z = pk2(h1[0] - bf_lo(hi.z), h1[1] - bf_hi(hi.z)); lo.w = pk2(h1[2] - bf_lo(hi.w), h1[3] - bf_hi(hi.w));
            const bf16x8 ahi = __builtin_bit_cast(bf16x8, hi), alo = __builtin_bit_cast(bf16x8, lo);
#pragma unroll
            for (int et = 0; et < 4; ++et) { const bf16x8 bh = *(const bf16x8*)(whi + (size_t)et * 16 * 1024 + 32 * s), bl = *(const bf16x8*)(wlo + (size_t)et * 16 * 1024 + 32 * s);
                acc[et] = __builtin_amdgcn_mfma_f32_16x16x32_bf16(ahi, bh, acc[et], 0, 0, 0);
                acc[et] = __builtin_amdgcn_mfma_f32_16x16x32_bf16(ahi, bl, acc[et], 0, 0, 0);
                acc[et] = __builtin_amdgcn_mfma_f32_16x16x32_bf16(alo, bh, acc[et], 0, 0, 0); }
        }
#pragma unroll
        for (int et = 0; et < 4; ++et)
#pragma unroll
            for (int r = 0; r < 4; ++r) lg[(4 * fq + r) * 64 + 16 * et + fr] = acc[et][r];
        LDS_WAIT();
        for (int tt = 0; tt < 16; ++tt) {
            const int tok = tile * 16 + tt;
            const float logit = lg[tt * 64 + lane];
            const float score = 1.f / (1.f + __expf(-logit)), choice = score + rb;
            int rk = 0;
#pragma unroll
            for (int d = 1; d < 8; ++d) { const int oi = (lane + d) & 7; const float other = __shfl(choice, (lane & ~7) | oi); rk += (other > choice || (other == choice && oi < (lane & 7))) ? 1 : 0; }
            float gs = rk < 2 ? choice : 0.f;
            gs += __shfl_xor(gs, 1); gs += __shfl_xor(gs, 2); gs += __shfl_xor(gs, 4);
            int rg = 0;
#pragma unroll
            for (int j = 0; j < 8; ++j) { const float gj = __int_as_float(__builtin_amdgcn_readlane(__float_as_int(gs), 8 * j)); rg += (gj > gs || (gj == gs && j < (lane >> 3))) ? 1 : 0; }
            const float c2 = rg < 4 ? choice : -__builtin_inff();
            int r8 = 0;
#pragma unroll
            for (int j = 0; j < 64; ++j) { const float cj = __int_as_float(__builtin_amdgcn_readlane(__float_as_int(c2), j)); r8 += (cj > c2 || (cj == c2 && j < lane)) ? 1 : 0; }
            const bool chosen = r8 < 8;
            const float wsum = wave_sum(chosen ? score : 0.f);
            if (dry) { asm volatile("" :: "v"(wsum), "v"(r8)); }
            else if (chosen) {
                const int chunk = tok / CH_TOK;
                const unsigned pos = atomicAdd(&cnt[chunk * 64 + lane], 1u);
                sel_e[tok * 8 + r8] = lane; sel_w[tok * 8 + r8] = score / wsum * 2.5f; sel_p[tok * 8 + r8] = (int)pos;
                tokl[(size_t)(chunk * 64 + lane) * CH_TOK + pos] = tok;
            }
        }
        LDS_WAIT();
    }
}

__device__ __forceinline__ void build_tstart(const unsigned* cnt, int c, LAS int* ts) {
    if (threadIdx.x < 64) {
        const int l = threadIdx.x; const int n = ((int)cnt[c * 64 + l] + 127) >> 7; int incl = n;
#pragma unroll
        for (int o = 1; o < 64; o <<= 1) { const int v = __shfl_up(incl, o); if (l >= o) incl += v; }
        ts[l] = incl - n; if (l == 63) { ts[64] = incl; ts[65] = incl + CH_TOK / 128; }
    }
}
struct MoeUpSrc {
    using Epi = EpiSwiGLU;
    const unsigned char* ws; const unsigned* cnt; int c; const LAS int* ts; int total, vcu;
    template <int LA> __device__ __forceinline__ bool setup(int i, const char*& bA, unsigned (&oA)[LA], const char*& bB, Epi& e, int& n0, int wid, int lane) const {
        const int Lt = vcu + GRID * i; if (Lt >= total) return false;
        const int mt = Lt >> 1, nt = Lt & 1;
        int ex = 0;
#pragma unroll
        for (int stp = 64; stp >= 1; stp >>= 1) if (ex + stp <= 64 && ts[ex + stp] <= mt) ex += stp;
        const int ml = mt - ts[ex];
        const bf16_t* Bt = ex < 64 ? (const bf16_t*)(ws + WS_W13) + (size_t)ex * 512 * D : (const bf16_t*)(ws + WS_WS13);
        const int* list = (const int*)(ws + WS_TOKL) + (size_t)(c * 64 + (ex & 63)) * CH_TOK; const int n = ex < 64 ? (int)cnt[c * 64 + ex] : 0;
#pragma unroll
        for (int j = 0; j < LA; ++j) { const int row = stage_row(wid, j, lane), g = ml * 128 + row;
            const int tok = ex < 64 ? (g < n ? list[g] : c * CH_TOK) : c * CH_TOK + g;
            oA[j] = (unsigned)tok * (unsigned)(D * 2) + (unsigned)stage_chunk(row, lane); }
        bA = (const char*)(ws + WS_H); bB = (const char*)(Bt + (size_t)(nt * 256) * D);
        e = EpiSwiGLU{(bf16_t*)(ws + WS_ACT), mt * 128}; n0 = nt * 256; return true;
    }
    static constexpr size_t ldb = D;
};
__device__ __forceinline__ void moe_up_phase(ldsp lds, const unsigned char* ws, const unsigned* cnt, int c, const LAS int* ts) {
    MoeUpSrc src{ws, cnt, c, ts, ts[65] * 2, vcu_of_block()};
    gemm_stream<2, 4, 4, 4, 3>(lds, D, src);
}
struct MoeDownSrc {
    using Epi = EpiStoreBf16;
    const unsigned char* ws; const LAS int* ts; int total, vcu;
    template <int LA> __device__ __forceinline__ bool setup(int i, const char*& bA, unsigned (&oA)[LA], const char*& bB, Epi& e, int& n0, int wid, int lane) const {
        const int Lt = vcu + GRID * i; if (Lt >= total) return false;
        const int mt = Lt >> 2, nt = Lt & 3;
        int ex = 0;
#pragma unroll
        for (int stp = 64; stp >= 1; stp >>= 1) if (ex + stp <= 64 && ts[ex + stp] <= mt) ex += stp;
        const bf16_t* act = (const bf16_t*)(ws + WS_ACT);
        const bf16_t* w2 = ex < 64 ? (const bf16_t*)(ws + WS_W2) + (size_t)ex * D * 256 : (const bf16_t*)(ws + WS_WS2);
#pragma unroll
        for (int j = 0; j < LA; ++j) { const int row = stage_row(wid, j, lane); oA[j] = (unsigned)(row * 512 + stage_chunk(row, lane)); }
        bA = (const char*)(act + (size_t)(mt * 128) * 256); bB = (const char*)(w2 + (size_t)(nt * 256) * 256);
        e = EpiStoreBf16{(bf16_t*)(ws + WS_YS), (size_t)D, mt * 128}; n0 = nt * 256; return true;
    }
    static constexpr size_t ldb = 256;
};
__device__ __forceinline__ void moe_down_phase(ldsp lds, const unsigned char* ws, const LAS int* ts) {
    MoeDownSrc src{ws, ts, ts[65] * 4, vcu_of_block()};
    gemm_stream<2, 4, 4, 4, 3>(lds, 256, src);
}
__device__ __forceinline__ void moe_combine_phase(const unsigned char* ws, float* XR, int c, const LAS int* ts, const float* gate_f  , bool last_layer,
                                                  const float* mod_sh_next, const float* mod_G_next, bf16_t* H, const float* fnorm, int gw, int ngw, int lane, bool dry) {
    const bf16_t* ys = (const bf16_t*)(ws + WS_YS); const int* sel_e = (const int*)(ws + WS_SELE); const float* sel_w = (const float*)(ws + WS_SELW); const int* sel_p = (const int*)(ws + WS_SELP);
    for (int tl = gw; tl < CH_TOK; tl += ngw) {
        const int tok = c * CH_TOK + tl; const int b = tok >> 11;
        float acc[16];
#pragma unroll
        for (int i = 0; i < 16; ++i) acc[i] = 0.f;
#pragma unroll
        for (int k = 0; k < 9; ++k) {
            int slot; float w;
            if (k < 8) { const int e = sel_e[tok * 8 + k]; slot = ts[e] * 128 + sel_p[tok * 8 + k]; w = sel_w[tok * 8 + k]; } else { slot = ts[64] * 128 + tl; w = 1.f; }
            const bf16_t* yr = ys + (size_t)slot * D;
#pragma unroll
            for (int j = 0; j < 2; ++j) { const u32x4 v = *(const u32x4*)(yr + 8 * lane + 512 * j);
                acc[8 * j + 0] += w * bf_lo(v.x); acc[8 * j + 1] += w * bf_hi(v.x); acc[8 * j + 2] += w * bf_lo(v.y); acc[8 * j + 3] += w * bf_hi(v.y);
                acc[8 * j + 4] += w * bf_lo(v.z); acc[8 * j + 5] += w * bf_hi(v.z); acc[8 * j + 6] += w * bf_lo(v.w); acc[8 * j + 7] += w * bf_hi(v.w); }
        }
        float* xr = XR + (size_t)tok * D; const float* gf = gate_f + (size_t)b * 6144; float ss = 0.f; float xn[16];
#pragma unroll
        for (int j = 0; j < 2; ++j)
#pragma unroll
            for (int q = 0; q < 2; ++q) { const int col = 8 * lane + 512 * j + 4 * q; const f32x4 xv = *(const f32x4*)(xr + col), gv = *(const f32x4*)(gf + col);
#pragma unroll
                for (int e = 0; e < 4; ++e) { const float v = xv[e] + gv[e] * acc[8 * j + 4 * q + e]; xn[8 * j + 4 * q + e] = v; ss += v * v; } }
        const float rstd = rsqrtf(wave_sum(ss) * (1.f / D) + 1e-6f);
        if (last_layer) {
#pragma unroll
            for (int j = 0; j < 2; ++j)
#pragma unroll
                for (int q = 0; q < 2; ++q) { const int col = 8 * lane + 512 * j + 4 * q; const f32x4 g = *(const f32x4*)(fnorm + col); f32x4 ov;
#pragma unroll
                    for (int e = 0; e < 4; ++e) ov[e] = xn[8 * j + 4 * q + e] * rstd * g[e];
                    if (!dry) *(f32x4*)(xr + col) = ov; else asm volatile("" :: "v"(ov)); }
        } else {
            const float* sh = mod_sh_next + (size_t)b * 6144; const float* Gn = mod_G_next + (size_t)b * 6144; bf16_t* hrow = H + (size_t)tok * D;
#pragma unroll
            for (int j = 0; j < 2; ++j) { u32x4 hw;
#pragma unroll
                for (int q = 0; q < 2; ++q) { const int col = 8 * lane + 512 * j + 4 * q; const f32x4 g = *(const f32x4*)(Gn + col), s0 = *(const f32x4*)(sh + col); f32x4 xv, hv;
#pragma unroll
                    for (int e = 0; e < 4; ++e) { xv[e] = xn[8 * j + 4 * q + e]; hv[e] = xv[e] * rstd * g[e] + s0[e]; }
                    if (!dry) *(f32x4*)(xr + col) = xv; else asm volatile("" :: "v"(xv));
                    if (q == 0) { hw.x = pk2(hv[0], hv[1]); hw.y = pk2(hv[2], hv[3]); } else { hw.z = pk2(hv[0], hv[1]); hw.w = pk2(hv[2], hv[3]); } }
                if (!dry) *(u32x4*)(hrow + 8 * lane + 512 * j) = hw; else asm volatile("" :: "v"(hw)); }
        }
    }
}

struct PSrc {
    using Epi = EpiCausalP;
    const bf16_t* rp; bf16_t* P;
    template <int LA> __device__ __forceinline__ bool setup(int i, const char*& bA, unsigned (&oA)[LA], const char*& bB, Epi& e, int& n0, int wid, int lane) const {
        const int u = blockIdx.x + GRID * i; if (u >= 1024) return false;
        const int bh = u >> 4, c = u & 15, b = bh >> 2, h = bh & 3;
        const bf16_t* qa = rp + ((size_t)b * SEQ + c * 128) * 6144 + h * 256;
#pragma unroll
        for (int j = 0; j < LA; ++j) { const int row = stage_row(wid, j, lane); oA[j] = (unsigned)(row * 6144 * 2 + stage_chunk(row, lane)); }
        bA = (const char*)qa; bB = (const char*)(qa + 1024);
        e = EpiCausalP{P + (size_t)u * 16384}; n0 = 0; return true;
    }
    static constexpr size_t ldb = 6144;
};
#define FRESH_IDS() const int t_ = fresh_tid(); const int lane = t_ & 63, wave = __builtin_amdgcn_readfirstlane(t_ >> 6); const int gw = blockIdx.x * NWAVE + wave, ngw = GRID * NWAVE; (void)lane; (void)gw; (void)ngw
__device__ __forceinline__ void moe_layer(const Args& a, ldsp lds, const XcdBarrier& bar, int layer) {
    unsigned char* ws = a.ws;
    float* mod = (float*)(ws + WS_MOD); float* XR = a.out; bf16_t* H = (bf16_t*)(ws + WS_H);
    const float* modl = mod + (size_t)layer * 16 * 6144;
    const float* modn = mod + (size_t)16 * 6144;
    unsigned* cl = (unsigned*)(ws + WS_CNT) + layer * 256;
    LAS int* ts0 = (LAS int*)(lds + LDS_MISC); LAS int* ts1 = ts0 + 80;
    for (int rep = 0; rep < REP_ROUTER; ++rep) { FRESH_IDS();
      router_phase(lds, XR, modl + 3072, modl + 4096, (const bf16_t*)(ws + WS_RWT) + (size_t)layer * 2 * 64 * 1024, a.in[I_ROUTB] + layer * 64,
                   H, (int*)(ws + WS_SELE), (float*)(ws + WS_SELW), (int*)(ws + WS_SELP), (int*)(ws + WS_TOKL), cl, gw, ngw, wave, lane, rep + 1 < REP_ROUTER); }
    xcd_barrier(bar);
    for (int c = 0; c <= NCHUNK; ++c) {
        __syncthreads();
        if (c < NCHUNK) build_tstart(cl, c, ts0);
        if (c > 0) build_tstart(cl, c - 1, ts1);
        __syncthreads();
        if (c < NCHUNK) for (int rep = 0; rep < REP_MOE; ++rep) moe_up_phase(lds, ws, cl, c, ts0);
        if (c > 0) for (int rep = 0; rep < REP_COMBINE; ++rep) { FRESH_IDS(); moe_combine_phase(ws, XR, c - 1, ts1, modl + 5120, layer == 1, modn, modn + 1024, H, a.in[I_FNORM], gw, ngw, lane, rep + 1 < REP_COMBINE); }
        if (c == NCHUNK) break;
        xcd_barrier(bar);
        for (int rep = 0; rep < REP_MOE; ++rep) moe_down_phase(lds, ws, ts0);
        xcd_barrier(bar);
    }
}
__global__ void __launch_bounds__(NTHR, 2) fwd_kernel(Args a) {
    extern __shared__ __attribute__((aligned(16))) unsigned char lds_raw[];
    ldsp lds = (ldsp)lds_raw;
    unsigned char* ws = a.ws;
    volatile LAS unsigned* st = (volatile LAS unsigned*)(lds + LDS_BYTES - 16);
    if (threadIdx.x < 4) st[threadIdx.x] = 0u;
    __syncthreads();
    XcdBarrier bar = xcd_barrier_post((unsigned*)(ws + WS_BAR), st);
    float* mod = (float*)(ws + WS_MOD);
    float* XR = a.out;
    bf16_t* H = (bf16_t*)(ws + WS_H);

    for (int rep = 0; rep < REP_P0; ++rep) {
    mod_items(a, lds);
    __syncthreads();
    { FRESH_IDS(); convert_dense_weights(a, lds, gw, ngw, wave, lane); convert_expert_weights(a, 0, lds, gw, ngw, wave, lane);
      bf16_t* rwt = (bf16_t*)(ws + WS_RWT);
      for (int idx = blockIdx.x * NTHR + t_; idx < 2 * D * 64; idx += GRID * NTHR) { const int l2 = idx >> 16, k = (idx >> 6) & 1023, e = idx & 63;
          const float w = a.in[I_ROUTW][idx]; const unsigned hi = pk2(w, 0.f) & 0xffffu; const unsigned lo = pk2(w - bf_lo(hi), 0.f) & 0xffffu;
          rwt[((size_t)(l2 * 2 + 0) * 64 + e) * 1024 + k] = (bf16_t)hi; rwt[((size_t)(l2 * 2 + 1) * 64 + e) * 1024 + k] = (bf16_t)lo; } }
    xcd_barrier(bar);
    }

    for (int rep = 0; rep < REP_ROWS; ++rep) { FRESH_IDS(); adaln_phase(a.in[I_X], mod, mod + 1024, H, gw, ngw, lane); }
    xcd_barrier(bar);
    for (int rep = 0; rep < REP_GEMM; ++rep) {
    { bf16_t* qkv = (bf16_t*)(ws + WS_QKV);
      auto mk = [&](int m0) { return EpiStoreBf16{qkv, (size_t)3072, m0}; };
      gemm_dense_phase<2, 4, 8, 4, 2>(lds, H, D, (const bf16_t*)(ws + WS_WQKV), D, T, 3072, D, mk); }
    xcd_barrier(bar);
    }
    { float d1 = 0.f, d2 = 0.f;
      for (int i = 0; i < 64; ++i) { d1 += a.in[I_LQ1][i] * a.in[I_LK1][i]; d2 += a.in[I_LQ2][i] * a.in[I_LK2][i]; }
      const float lam = __expf(d1) - __expf(d2) + 0.2f;
      for (int rep = 0; rep < REP_ATTN; ++rep) {
      attn_phase(lds, (const bf16_t*)(ws + WS_QKV), (bf16_t*)(ws + WS_AO), lam, a.in[I_SUBLN]);
      xcd_barrier(bar); } }
    for (int rep = 0; rep < REP_GEMM; ++rep) {
    { auto mk = [&](int m0) { return EpiResidual{a.in[I_X], XR, mod + 2048, m0}; };
      gemm_dense_phase<2, 4, 8, 4, 2>(lds, (const bf16_t*)(ws + WS_AO), D, (const bf16_t*)(ws + WS_WO), D, T, D, D, mk); }
    xcd_barrier(bar);
    }
    moe_layer(a, lds, bar, 0);
    xcd_barrier(bar);

    const float* mod1 = mod + (size_t)16 * 6144;
    for (int rep = 0; rep < REP_GEMM; ++rep) {
    { bf16_t* rp = (bf16_t*)(ws + WS_RP);
      auto mk = [&](int m0) { return EpiRetProj{rp, m0}; };
      gemm_dense_phase<2, 4, 8, 4, 2>(lds, H, D, (const bf16_t*)(ws + WS_WRI), D, T, 6144, D, mk); }
    xcd_barrier(bar);
    }
    for (int i = 0; i < EXTRA_BARS; ++i) xcd_barrier(bar);
    for (int rep = 0; rep < REP_PPH; ++rep)
    { PSrc src{(const bf16_t*)(ws + WS_RP), (bf16_t*)(ws + WS_P)};
      gemm_stream<2, 4, 4, 2, 3>(lds, 256, src);
      __syncthreads();
      { FRESH_IDS(); convert_expert_weights(a, 1, lds, gw, ngw, wave, lane); } }
    xcd_barrier(bar);
    for (int rep = 0; rep < REP_CHAIN; ++rep) {
    chain_phase(lds, (bf16_t*)(ws + WS_RP), (const bf16_t*)(ws + WS_P), rep + 1 < REP_CHAIN);
    xcd_barrier(bar);
    }
    for (int rep = 0; rep < REP_ROWS; ++rep) { FRESH_IDS(); gnorm_phase((bf16_t*)(ws + WS_RP), a.in[I_RGN], gw, ngw, lane, rep + 1 < REP_ROWS); }
    xcd_barrier(bar);
    { auto mk = [&](int m0) { return EpiResidual{XR, XR, mod1 + 2048, m0}; };
      gemm_dense_phase<2, 4, 8, 4, 2>(lds, (const bf16_t*)(ws + WS_RP) + 2048, 6144, (const bf16_t*)(ws + WS_WRO), 2048, T, D, 2048, mk); }
    xcd_barrier(bar);
    moe_layer(a, lds, bar, 1);
}

extern "C" void kernel_launch(void* const* d_in, const int* in_sizes, int n_in, void* d_out, int out_size, void* d_ws, size_t ws_size, hipStream_t stream) {
    static int ready = 0;
    if (ready == 0) {
        if (n_in != 25 || out_size != T * D || ws_size < WS_END) { fprintf(stderr, "kernel_launch: unexpected shapes (n_in %d out %d ws %zu need %zu)\n", n_in, out_size, ws_size, (size_t)WS_END); ready = -1; return; }
        (void)hipFuncSetAttribute((const void*)fwd_kernel, hipFuncAttributeMaxDynamicSharedMemorySize, LDS_BYTES);
        ready = 1;
    }
    if (ready < 0) return;
    (void)hipMemsetAsync(d_ws, 0, 65536, stream);
    Args a{};
    for (int i = 0; i < 25; ++i) a.in[i] = (const float*)d_in[i];
    a.out = (float*)d_out; a.ws = (unsigned char*)d_ws;
    hipLaunchKernelGGL(fwd_kernel, dim3(GRID), dim3(NTHR), LDS_BYTES, stream, a);
}
```

```cpp
#include <hip/hip_runtime.h>
#include <cstdio>
#include <cstdint>
#include <type_traits>

typedef unsigned short bf16_t;
typedef short bf16x8 __attribute__((ext_vector_type(8)));
typedef short bf16x4 __attribute__((ext_vector_type(4)));
typedef float f32x4 __attribute__((ext_vector_type(4)));
typedef float f32x2 __attribute__((ext_vector_type(2)));
typedef unsigned u32x4 __attribute__((ext_vector_type(4)));
typedef unsigned u32x2 __attribute__((ext_vector_type(2)));
#define LAS __attribute__((address_space(3)))
typedef LAS unsigned char* ldsp;

constexpr int T = 32768, D = 1024, NB = 16, SEQ = 2048;
constexpr int NTHR = 512, NWAVE = 8, GRID = 256;
constexpr int CH_TOK = 16384, NCHUNK = 2, MTILE = 256;
constexpr int SLOT_CAP = 163840;
constexpr float LOG2E = 1.4426950408889634f;
constexpr int XRB_LD = 2048, XRB_OFF = 1024;
#define TIME_SEL -1


constexpr size_t MiB = 1u << 20;
constexpr size_t WS_BAR = 0, WS_CNT = 16384, WS_RWT = 256 * 1024  , WS_MOD = 1 * MiB;
constexpr size_t WS_WQKV = 2 * MiB, WS_WO = 8 * MiB, WS_WRI = 10 * MiB, WS_WRO = 22 * MiB;
constexpr size_t WS_W13 = 26 * MiB, WS_W2 = 90 * MiB, WS_WS13 = 122 * MiB, WS_WS2 = 123 * MiB;
constexpr size_t WS_H = 124 * MiB, WS_P = WS_H;
constexpr size_t WS_BIG = 188 * MiB;
constexpr size_t WS_QKV = WS_BIG, WS_AO = WS_BIG + 192 * MiB;
constexpr size_t WS_RP = WS_BIG;
constexpr size_t WS_SELE = WS_BIG, WS_SELW = WS_BIG + 1 * MiB, WS_SELP = WS_BIG + 2 * MiB, WS_TOKL = WS_BIG + 4 * MiB;
constexpr size_t WS_ACT = WS_BIG + 12 * MiB  , WS_YS = WS_BIG + 92 * MiB  ;
constexpr size_t WS_END = WS_BIG + 412 * MiB;
constexpr int LDS_BYTES = 152 * 1024, LDS_MISC = 144 * 1024;

#define XB_TMO      128
#define XB_XCNT(j)  (256  + 64 * (j))
#define XB_XSUB(j)  (1280 + 64 * (j))
#define XB_XGEN(j)  (2304 + 64 * (j))
#define XB_TOP      3328
#define XB_TOPGEN   3392
#define XCD_BAR_WORDS 3456
#define XB_SPIN_CAP (1u << 20)
__device__ __forceinline__ unsigned xb_ld(unsigned* p)              { return __hip_atomic_load(p, __ATOMIC_RELAXED, __HIP_MEMORY_SCOPE_AGENT); }
__device__ __forceinline__ unsigned xb_add(unsigned* p, unsigned v) { return __hip_atomic_fetch_add(p, v, __ATOMIC_RELAXED, __HIP_MEMORY_SCOPE_AGENT); }
__device__ __forceinline__ unsigned xb_xcc_id() { return (unsigned)__builtin_amdgcn_s_getreg((3 << 11) | 20) & 0xFu; }
#define XB_SPIN(cond, bar) do { unsigned _sp = 0; while (cond) { __builtin_amdgcn_s_sleep(1); \
    if ((++_sp & 255u) == 0u) { if (xb_ld(&(bar)[XB_TMO])) break; if (_sp > XB_SPIN_CAP) { atomicAdd(&(bar)[XB_TMO], 1u); break; } } } } while (0)
struct XcdBarrier { unsigned* bar; unsigned x; volatile LAS unsigned* st; };
__device__ __forceinline__ XcdBarrier xcd_barrier_post(unsigned* bar, volatile LAS unsigned* st) {
    XcdBarrier b; b.bar = bar; b.x = xb_xcc_id(); b.st = st;
    if (threadIdx.x == 0) (void)xb_add(&bar[XB_XCNT(b.x)], 1u);
    return b;
}
__device__ __forceinline__ void xcd_barrier_complete(unsigned* bar, unsigned x, unsigned& nloc, unsigned& nx) {
    const unsigned G = gridDim.x * gridDim.y * gridDim.z;
    unsigned sum, cnt, mine, sp = 0u;
    for (;;) {
        sum = 0u; cnt = 0u; mine = 0u;
#pragma unroll
        for (unsigned j = 0; j < 16; ++j) { const unsigned c = xb_ld(&bar[XB_XCNT(j)]); sum += c; cnt += (c > 0u) ? 1u : 0u; mine = (j == x) ? c : mine; }
        if (sum == G) break;
        __builtin_amdgcn_s_sleep(1);
        if ((++sp & 255u) == 0u) { if (xb_ld(&bar[XB_TMO])) break; if (sp > XB_SPIN_CAP) { atomicAdd(&bar[XB_TMO], 1u); break; } }
    }
    nloc = mine > 0u ? mine : 1u; nx = cnt > 0u ? cnt : 1u;
}
__device__ __forceinline__ void xcd_barrier(const XcdBarrier& b) {
    asm volatile("s_waitcnt vmcnt(0)" ::: "memory");
    __syncthreads();
    if (threadIdx.x == 0) {
        unsigned* bar = b.bar; unsigned bx = b.x;
        asm volatile("" : "+s"(bar), "+s"(bx));
        __builtin_amdgcn_s_waitcnt(0);
        unsigned nloc = b.st[0], nx = b.st[1];
        if (nloc == 0u) { xcd_barrier_complete(bar, bx, nloc, nx); b.st[0] = nloc; b.st[1] = nx; }
        const unsigned old = xb_add(&bar[XB_XSUB(bx)], 1u);
        const unsigned gen = old / nloc;
        if (old + 1u == (gen + 1u) * nloc) {
            __builtin_amdgcn_fence(__ATOMIC_RELEASE, "agent");
            asm volatile("s_waitcnt vmcnt(0)" ::: "memory");
            const unsigned og = xb_add(&bar[XB_TOP], 1u);
            const unsigned tg = og / nx;
            if (og + 1u == (tg + 1u) * nx) xb_add(&bar[XB_TOPGEN], 1u);
            else XB_SPIN(xb_ld(&bar[XB_TOPGEN]) == tg, bar);
            __builtin_amdgcn_fence(__ATOMIC_ACQUIRE, "agent");
            xb_add(&bar[XB_XGEN(bx)], 1u);
            asm volatile("s_waitcnt vmcnt(0)" ::: "memory");
        } else {
            XB_SPIN(xb_ld(&bar[XB_XGEN(bx)]) == gen, bar);
            __builtin_amdgcn_fence(__ATOMIC_ACQUIRE, "agent");
            asm volatile("s_waitcnt vmcnt(0)" ::: "memory");
        }
    }
    __syncthreads();
}

template <int N> __device__ __forceinline__ void wait_vm() { asm volatile("s_waitcnt vmcnt(%0)" :: "n"(N) : "memory"); }
#define BAR() __builtin_amdgcn_s_barrier()
#define LDS_WAIT() asm volatile("s_waitcnt lgkmcnt(0)" ::: "memory")
__device__ __forceinline__ unsigned pk2(float a, float b) {
    typedef __bf16 bf2 __attribute__((ext_vector_type(2)));
    f32x2 v = {a, b}; bf2 r = __builtin_convertvector(v, bf2); return __builtin_bit_cast(unsigned, r);
}
__device__ __forceinline__ float bf_lo(unsigned u) { return __uint_as_float(u << 16); }
__device__ __forceinline__ float bf_hi(unsigned u) { return __uint_as_float(u & 0xffff0000u); }
__device__ __forceinline__ float wave_sum(float v) {
#pragma unroll
    for (int o = 1; o < 64; o <<= 1) v += __shfl_xor(v, o);
    return v;
}
__device__ __forceinline__ float fast_exp2(float x) { return __builtin_amdgcn_exp2f(x); }
__device__ __forceinline__ float silu_f(float v) { return v / (1.f + __expf(-v)); }
__device__ __forceinline__ void glds16(const void* src, ldsp dst) {
    unsigned keep; const unsigned d = (unsigned)(__SIZE_TYPE__)dst;
    asm volatile("s_mov_b32 %0, m0\n\ts_mov_b32 m0, %2\n\ts_nop 0\n\tglobal_load_lds_dwordx4 %1, off\n\ts_mov_b32 m0, %0" : "=&s"(keep) : "v"(src), "s"(d) : "memory");
}
__device__ __forceinline__ bf16x8 tr2(ldsp a0, ldsp a1) {
    const bf16x4 t0 = __builtin_amdgcn_ds_read_tr16_b64_v4i16((LAS bf16x4*)a0);
    const bf16x4 t1 = __builtin_amdgcn_ds_read_tr16_b64_v4i16((LAS bf16x4*)a1);
    return __builtin_shufflevector(t0, t1, 0, 1, 2, 3, 4, 5, 6, 7);
}
__device__ __forceinline__ bf16x8 rd2x64(ldsp a0, ldsp a1) {
    const bf16x4 t0 = *(LAS bf16x4*)a0; const bf16x4 t1 = *(LAS bf16x4*)a1;
    return __builtin_shufflevector(t0, t1, 0, 1, 2, 3, 4, 5, 6, 7);
}
__device__ __forceinline__ int fresh_tid() { int t = threadIdx.x; asm volatile("" : "+v"(t)); return t; }
__device__ __forceinline__ int vcu_of_block() { const int bx = blockIdx.x; return (bx & 7) * (GRID / 8) + (bx >> 3); }

struct Args {
    const float* in[25];
    float* out; unsigned char* ws;
};
enum { I_X = 0, I_C, I_NMIX, I_NFFN, I_ADAW, I_ADAB, I_DAWIN, I_DAWOUT, I_LQ1, I_LK1, I_LQ2, I_LK2, I_SUBLN, I_RWIN, I_RWOUT, I_RGN,
       I_ROUTW, I_ROUTB, I_EW1, I_EW3, I_EW2, I_SW1, I_SW3, I_SW2, I_FNORM };

template <int WM, int WN, int MT, int NT, int NSTAGE, class Src>
__device__ __forceinline__ void gemm_stream(ldsp lds, int K, const Src& src) {
    constexpr int BM = WM * MT * 16, BN = WN * NT * 16, STAGE = (BM + BN) * 128, LA = BM / 64, LB = BN / 64, L = LA + LB, PD = NSTAGE - 1;
    static_assert(WM * WN == NWAVE && NSTAGE * STAGE <= LDS_MISC, "8 waves; ring fits");
    const int tid = fresh_tid(), lane = tid & 63, wid = __builtin_amdgcn_readfirstlane(tid >> 6);
    const int wr = wid / WN, wc = wid % WN, fr = lane & 15, fq = lane >> 4;
    const char* cbA; const char* cbB; const char* nbA; const char* nbB; unsigned cA[LA], nA[LA], oB[LB];
    typename Src::Epi ce, ne; int cn0 = 0, nn0 = 0;
    if (!src.template setup<LA>(0, cbA, cA, cbB, ce, cn0, wid, lane)) return;
#pragma unroll
    for (int j = 0; j < LB; ++j) { const int row = 8 * (wid + 8 * j) + (lane >> 3); oB[j] = (unsigned)(row * (int)src.ldb * 2 + (((lane & 7) ^ ((row >> 1) & 7)) << 4)); }
    const int swz = fr >> 1;
    const int aoff = (wr * MT * 16 + fr) * 128, boff = BM * 128 + (wc * NT * 16 + fr) * 128;
    const int ok0 = ((fq ^ swz) << 4), ok1 = (((4 + fq) ^ swz) << 4);
    auto issue = [&](int s, const char* bA, const unsigned (&oA)[LA], const char* bB, int t) {
        ldsp st = lds + s * STAGE;
#pragma unroll
        for (int j = 0; j < LA; ++j) glds16(bA + (size_t)t * 128 + oA[j], st + (wid + 8 * j) * 1024);
#pragma unroll
        for (int j = 0; j < LB; ++j) glds16(bB + (size_t)t * 128 + oB[j], st + BM * 128 + (wid + 8 * j) * 1024);
    };
    const int nt = K / 64;
    BAR();
#pragma unroll
    for (int d = 0; d < PD; ++d) issue(d, cbA, cA, cbB, d);
    int s = 0;
    for (int i = 0;; ++i) {
        const bool hasn = src.template setup<LA>(i + 1, nbA, nA, nbB, ne, nn0, wid, lane);
        f32x4 acc[MT][NT];
#pragma unroll
        for (int m = 0; m < MT; ++m)
#pragma unroll
            for (int n = 0; n < NT; ++n) acc[m][n] = (f32x4){0.f, 0.f, 0.f, 0.f};
        for (int t = 0; t < nt; ++t) {
            if (PD >= 2 && (hasn || t + 1 < nt)) wait_vm<(PD - 1) * L>(); else wait_vm<0>();
            BAR();
            { int s2 = s + PD; if (s2 >= NSTAGE) s2 -= NSTAGE;
              if (t + PD < nt) issue(s2, cbA, cA, cbB, t + PD); else if (hasn) issue(s2, nbA, nA, nbB, t + PD - nt); }
            ldsp st = lds + s * STAGE;
#pragma unroll
            for (int kk = 0; kk < 2; ++kk) {
                bf16x8 b[NT];
                const int ok = kk ? ok1 : ok0;
#pragma unroll
                for (int n = 0; n < NT; ++n) b[n] = *(LAS bf16x8*)(st + boff + n * 2048 + ok);
#pragma unroll
                for (int mh = 0; mh < MT; mh += 4) {
                    bf16x8 a[4];
#pragma unroll
                    for (int m = 0; m < 4; ++m) a[m] = *(LAS bf16x8*)(st + aoff + (mh + m) * 2048 + ok);
                    __builtin_amdgcn_s_setprio(1);
#pragma unroll
                    for (int m = 0; m < 4; ++m)
#pragma unroll
                        for (int n = 0; n < NT; ++n) acc[mh + m][n] = __builtin_amdgcn_mfma_f32_16x16x32_bf16(b[n], a[m], acc[mh + m][n], 0, 0, 0);
                    __builtin_amdgcn_s_setprio(0);
                    if (MT > 4) __builtin_amdgcn_sched_barrier(0);
                }
            }
            s = (s == NSTAGE - 1) ? 0 : s + 1;
        }
        ce(acc, wr * MT * 16, cn0 + wc * NT * 16, fr, fq);
        if (!hasn) break;
#pragma unroll
        for (int j = 0; j < LA; ++j) cA[j] = nA[j];
        cbA = nbA; cbB = nbB; ce = ne; cn0 = nn0;
    }
}
__device__ __forceinline__ int stage_row(int wid, int j, int lane) { return 8 * (wid + 8 * j) + (lane >> 3); }
__device__ __forceinline__ int stage_chunk(int row, int lane) { return ((lane & 7) ^ ((row >> 1) & 7)) * 16; }
__device__ __forceinline__ const char* uniform_ptr(const void* p) { unsigned long long v = (unsigned long long)p; const unsigned lo = __builtin_amdgcn_readfirstlane((unsigned)v), hi = __builtin_amdgcn_readfirstlane((unsigned)(v >> 32)); return (const char*)(((unsigned long long)hi << 32) | lo); }

template <int BM, int BN, class Mk> struct DenseSrc {
    using Epi = decltype(((Mk*)nullptr)->operator()(0));
    const bf16_t* A; size_t lda; const bf16_t* Bt; size_t ldb; int nN, per_x, xcd, local; const Mk& mk;
    __device__ __forceinline__ DenseSrc(const bf16_t* A_, size_t lda_, const bf16_t* Bt_, size_t ldb_, int M, int N, const Mk& mk_) : A(A_), lda(lda_), Bt(Bt_), ldb(ldb_), mk(mk_) {
        const int vcu = vcu_of_block(); nN = N / BN; per_x = (M / BM) / 8; xcd = vcu >> 5; local = vcu & 31; }
    template <int LA> __device__ __forceinline__ bool setup(int i, const char*& bA, unsigned (&oA)[LA], const char*& bB, Epi& e, int& n0, int wid, int lane) const {
        constexpr int GM = 4;
        const int q = local + 32 * i; if (q >= per_x * nN) return false;
        const int grp = q / (GM * nN), r = q % (GM * nN), m = xcd * per_x + grp * GM + (r % GM), n = r / GM;
#pragma unroll
        for (int j = 0; j < LA; ++j) { const int row = stage_row(wid, j, lane); oA[j] = (unsigned)(row * (int)lda * 2 + stage_chunk(row, lane)); }
        bA = (const char*)(A + (size_t)(m * BM) * lda); bB = (const char*)(Bt + (size_t)(n * BN) * ldb);
        e = mk(m * BM); n0 = n * BN; return true;
    }
};
template <int WM, int WN, int MT, int NT, int NSTAGE, class Mk>
__device__ __forceinline__ void gemm_dense_phase(ldsp lds, const bf16_t* A, size_t lda, const bf16_t* Bt, size_t ldb, int M, int N, int K, const Mk& mk) {
    DenseSrc<WM * MT * 16, WN * NT * 16, Mk> src(A, lda, Bt, ldb, M, N, mk);
    gemm_stream<WM, WN, MT, NT, NSTAGE>(lds, K, src);
}

struct EpiStoreBf16 {
    bf16_t* O; size_t ldc; int m0;
    template <int MT, int NT> __device__ __forceinline__ void operator()(const f32x4 (&acc)[MT][NT], int rb, int cb, int fr, int fq) const {
#pragma unroll
        for (int m = 0; m < MT; ++m) { bf16_t* rp = O + (size_t)(m0 + rb + m * 16 + fr) * ldc + cb + 4 * fq;
#pragma unroll
            for (int n = 0; n < NT; ++n) { u32x2 w; w.x = pk2(acc[m][n][0], acc[m][n][1]); w.y = pk2(acc[m][n][2], acc[m][n][3]); *(u32x2*)(rp + n * 16) = w; } }
    }
};
struct EpiResidual {
    const float* Xin; float* Xout; const float* gate; int m0;
    template <int MT, int NT> __device__ __forceinline__ void operator()(const f32x4 (&acc)[MT][NT], int rb, int cb, int fr, int fq) const {
#pragma unroll
        for (int m = 0; m < MT; ++m) { const int row = m0 + rb + m * 16 + fr; const float* g = gate + (size_t)(row >> 11) * 6144;
#pragma unroll
            for (int n = 0; n < NT; ++n) { const int col = cb + n * 16 + 4 * fq; const f32x4 xv = *(const f32x4*)(Xin + (size_t)row * D + col); const f32x4 gv = *(const f32x4*)(g + col);
                *(f32x4*)(Xout + (size_t)row * D + col) = xv + gv * acc[m][n]; } }
    }
};
struct EpiRetProj {
    bf16_t* O; int m0;
    template <int MT, int NT> __device__ __forceinline__ void operator()(const f32x4 (&acc)[MT][NT], int rb, int cb, int fr, int fq) const {
        float l2g = 0.f, pre = 1.f;
        if (cb < 2048) { const int h = (cb & 1023) >> 8; l2g = __log2f(1.f - exp2f(-5.f - (float)h)); if (cb >= 1024) { l2g = -l2g; pre = 0.0625f; } }
#pragma unroll
        for (int m = 0; m < MT; ++m) { const int row = m0 + rb + m * 16 + fr; const float sc = pre * exp2f(l2g * (float)(row & 127)); bf16_t* rp = O + (size_t)row * 6144 + cb + 4 * fq;
#pragma unroll
            for (int n = 0; n < NT; ++n) { u32x2 w; w.x = pk2(acc[m][n][0] * sc, acc[m][n][1] * sc); w.y = pk2(acc[m][n][2] * sc, acc[m][n][3] * sc); *(u32x2*)(rp + n * 16) = w; } }
    }
};
struct EpiCausalP {
    bf16_t* O;
    template <int MT, int NT> __device__ __forceinline__ void operator()(const f32x4 (&acc)[MT][NT], int rb, int cb, int fr, int fq) const {
#pragma unroll
        for (int m = 0; m < MT; ++m) { const int i = rb + m * 16 + fr; bf16_t* rp = O + (size_t)i * 128 + cb + 4 * fq;
#pragma unroll
            for (int n = 0; n < NT; ++n) { const int j = cb + n * 16 + 4 * fq; f32x4 v = acc[m][n];
                v[0] = (i >= j) ? v[0] : 0.f; v[1] = (i >= j + 1) ? v[1] : 0.f; v[2] = (i >= j + 2) ? v[2] : 0.f; v[3] = (i >= j + 3) ? v[3] : 0.f;
                u32x2 w; w.x = pk2(v[0], v[1]); w.y = pk2(v[2], v[3]); *(u32x2*)(rp + n * 16) = w; } }
    }
};
struct EpiSwiGLU {
    bf16_t* O; int slot0;
    template <int MT, int NT> __device__ __forceinline__ void operator()(const f32x4 (&acc)[MT][NT], int rb, int cb, int fr, int fq) const {
        static_assert(NT == 4, "NT");
#pragma unroll
        for (int m = 0; m < MT; ++m) { bf16_t* rp = O + (size_t)(slot0 + rb + m * 16 + fr) * 256 + (cb >> 1) + 4 * fq;
#pragma unroll
            for (int p = 0; p < 2; ++p) { const f32x4 a = acc[m][2 * p], b = acc[m][2 * p + 1]; u32x2 w;
                w.x = pk2(silu_f(a[0]) * b[0], silu_f(a[1]) * b[1]); w.y = pk2(silu_f(a[2]) * b[2], silu_f(a[3]) * b[3]); *(u32x2*)(rp + p * 16) = w; } }
    }
};

namespace pg8 {
constexpr int BM = 256, BK = 64, HALF = 128, HTB = HALF * BK * 2  , STAGE_BYTES = 8 * HTB, NXCD = 8, WGM = 8;
__device__ __forceinline__ int lds_byte(int r, int c) { const int st = (r >> 4) * 2 + (c >> 5), rr = r & 15, cc = c & 31, ob = rr * 64 + cc * 2; return st * 1024 + (ob ^ (((ob >> 9) & 1) << 5)); }
__device__ __forceinline__ void stage_rc(int b, int& R, int& C) { const int st = b / 1024, sb = b % 1024, swz = sb ^ (((sb >> 9) & 1) << 5); R = (st >> 1) * 16 + swz / 64; C = (st & 1) * 32 + (swz % 64) / 2; }
__device__ __forceinline__ int perm32(int rho) { const int n = rho >> 4, i = rho & 15; return 8 * (i >> 2) + 4 * n + (i & 3); }
struct Unit { int pm, pn; };
struct Gemm { const bf16_t* A; const bf16_t* Bt; int M, N, K, lda; };
struct StaticOrder {
    int nM, nN, nwg, G, c;
    __device__ void init(int M, int N, int G_, int c_) { nM = M / BM; nN = N / BM; nwg = nM * nN; G = G_; c = c_; }
    __device__ bool next(int i, Unit& u) const {
        const long L = (long)i * G + c; if (L >= nwg) return false;
        int wgid = (int)L; { const int q = nwg / NXCD, r = nwg % NXCD, xcd = wgid % NXCD, off = wgid / NXCD; wgid = (xcd < r ? xcd * (q + 1) : r * (q + 1) + (xcd - r) * q) + off; }
        const int nig = WGM * nN, gid = wgid / nig, fm = gid * WGM, gsz = (nM - fm) < WGM ? (nM - fm) : WGM;
        u.pm = fm + ((wgid % nig) % gsz); u.pn = (wgid % nig) / gsz; return true;
    }
};
template <class Epi, bool ALIGN_EPI = true>
__device__ __forceinline__ void gemm_phase(ldsp lds, const Gemm g, const StaticOrder& S, const Epi& E) {
    const int tid = fresh_tid(), wid = __builtin_amdgcn_readfirstlane(tid >> 6), lane = tid & 63, wr = wid >> 2, wc = wid & 3, fr = lane & 15, fq = lane >> 4;
    const int K = g.K, nt = K / BK;
    unsigned voffA[2], voffB[2];
#pragma unroll
    for (int i = 0; i < 2; ++i) { int R, C; stage_rc(tid * 16 + i * 8192, R, C); const int Rb = Epi::PERM ? ((R & ~31) + perm32(R & 31)) : R;
        voffA[i] = (unsigned)(R * g.lda + C) * 2u; voffB[i] = (unsigned)(Rb * K + C) * 2u; }
    const size_t kstep = (size_t)(BK * 2);
    const size_t hstepA = (size_t)HALF * g.lda * 2, hstepB = (size_t)HALF * K * 2;
    const size_t tstepA = 2 * hstepA, tstepB = 2 * hstepB;
    const unsigned ldsw = (unsigned)wid * 1024u;
    const int aoff = lds_byte(wr * 64 + fr, fq * 8), boff = lds_byte(wc * 32 + fr, fq * 8);
#define PG8_SA(b, h) (((b) * 2 + (h)) * HTB)
#define PG8_SB(b, h) ((4 + (b) * 2 + (h)) * HTB)
#define PG8_STAGE(bufoff, gbase, voff) do { _Pragma("unroll") for (int _i = 0; _i < 2; ++_i) glds16((const char*)(gbase) + (voff)[_i], lds + (bufoff) + ldsw + _i * 8192); } while (0)
#define PG8_LDA(dst, b, h) do { _Pragma("unroll") for (int m = 0; m < 4; ++m) _Pragma("unroll") for (int k = 0; k < 2; ++k) dst[m][k] = *(const LAS bf16x8*)(lds + PG8_SA(b, h) + aoff + m * 2048 + k * 1024); } while (0)
#define PG8_LDB(dst, b, h) do { _Pragma("unroll") for (int n = 0; n < 2; ++n) _Pragma("unroll") for (int k = 0; k < 2; ++k) dst[n][k] = *(const LAS bf16x8*)(lds + PG8_SB(b, h) + boff + n * 2048 + k * 1024); } while (0)
#define PG8_MMA(ai, bj, At, Bt) do { __builtin_amdgcn_s_setprio(1); _Pragma("unroll") for (int m = 0; m < 4; ++m) _Pragma("unroll") for (int n = 0; n < 2; ++n) _Pragma("unroll") for (int k = 0; k < 2; ++k) \
        acc[ai][bj][m][n] = __builtin_amdgcn_mfma_f32_16x16x32_bf16(Bt[n][k], At[m][k], acc[ai][bj][m][n], 0, 0, 0); __builtin_amdgcn_s_setprio(0); } while (0)
#define PG8_WAIT_V(n) asm volatile("s_waitcnt vmcnt(" #n ")" ::: "memory")
#define PG8_WAIT_L(n) asm volatile("s_waitcnt lgkmcnt(" #n ")" ::: "memory")
#define PG8_BAR __builtin_amdgcn_s_barrier()
#define PG8_SCHED __builtin_amdgcn_sched_barrier(0)
    Unit cur, nxt; int ui = 0;
    PG8_WAIT_V(0); PG8_BAR;
    if (!S.next(0, cur)) return;
    f32x4 acc[2][2][4][2];
#pragma unroll
    for (int a = 0; a < 2; ++a)
#pragma unroll
        for (int b = 0; b < 2; ++b)
#pragma unroll
            for (int m = 0; m < 4; ++m)
#pragma unroll
                for (int n = 0; n < 2; ++n) acc[a][b][m][n] = (f32x4){0.f, 0.f, 0.f, 0.f};
    bf16x8 At[4][2], B0[2][2], B1[2][2];
    const char* cA = (const char*)g.A + (size_t)cur.pm * tstepA; const char* cB = (const char*)g.Bt + (size_t)cur.pn * tstepB;
    PG8_STAGE(PG8_SB(0, 0), cB, voffB); PG8_STAGE(PG8_SB(0, 1), cB + hstepB, voffB); PG8_STAGE(PG8_SA(0, 0), cA, voffA); PG8_STAGE(PG8_SA(0, 1), cA + hstepA, voffA);
    if (wr == 1) PG8_BAR;
    PG8_WAIT_V(2); PG8_BAR;
    PG8_STAGE(PG8_SB(1, 0), cB + kstep, voffB); PG8_STAGE(PG8_SA(1, 0), cA + kstep, voffA); PG8_STAGE(PG8_SB(1, 1), cB + hstepB + kstep, voffB);
    PG8_WAIT_V(6); PG8_BAR;
    for (;;) {
        const bool has_next = S.next(ui + 1, nxt);
        const char* nA = has_next ? (const char*)g.A + (size_t)nxt.pm * tstepA : cA; const char* nB = has_next ? (const char*)g.Bt + (size_t)nxt.pn * tstepB : cB;
        for (int t = 0; t < nt; t += 2) {
            const bool last = (t == nt - 2);
            const char* a1 = cA + (size_t)(t + 1) * kstep;
            const char* a2 = last ? nA : cA + (size_t)(t + 2) * kstep; const char* b2 = last ? nB : cB + (size_t)(t + 2) * kstep;
            const char* a3 = a2 + kstep; const char* b3 = b2 + kstep;
            PG8_LDB(B0, 0, 0); PG8_LDB(B1, 0, 1); PG8_SCHED; PG8_LDA(At, 0, 0); PG8_STAGE(PG8_SA(1, 1), a1 + hstepA, voffA);
            PG8_WAIT_V(8); PG8_WAIT_L(0); PG8_BAR; PG8_MMA(0, 0, At, B0); PG8_MMA(0, 1, At, B1); PG8_BAR; PG8_SCHED;
            PG8_LDA(At, 0, 1); PG8_STAGE(PG8_SB(0, 0), b2, voffB); PG8_STAGE(PG8_SB(0, 1), b2 + hstepB, voffB); PG8_STAGE(PG8_SA(0, 0), a2, voffA);
            PG8_WAIT_V(8); PG8_WAIT_L(0); PG8_BAR; PG8_MMA(1, 0, At, B0); PG8_MMA(1, 1, At, B1); PG8_BAR; PG8_SCHED;
            PG8_LDB(B0, 1, 0); PG8_LDB(B1, 1, 1); PG8_SCHED; PG8_LDA(At, 1, 0); PG8_STAGE(PG8_SA(0, 1), a2 + hstepA, voffA);
            PG8_WAIT_V(8); PG8_WAIT_L(0); PG8_BAR; PG8_MMA(0, 0, At, B0); PG8_MMA(0, 1, At, B1); PG8_BAR; PG8_SCHED;
            PG8_LDA(At, 1, 1); PG8_STAGE(PG8_SB(1, 0), b3, voffB); PG8_STAGE(PG8_SB(1, 1), b3 + hstepB, voffB); PG8_STAGE(PG8_SA(1, 0), a3, voffA);
            PG8_WAIT_V(8); PG8_WAIT_L(0); PG8_BAR; PG8_MMA(1, 0, At, B0); PG8_MMA(1, 1, At, B1); PG8_BAR; PG8_SCHED;
        }
        if constexpr (ALIGN_EPI) { if (wr == 0) PG8_BAR; }
        E(acc, cur, wr, wc, fr, fq);
        if (!has_next) break;
#pragma unroll
        for (int a = 0; a < 2; ++a)
#pragma unroll
            for (int b = 0; b < 2; ++b)
#pragma unroll
                for (int m = 0; m < 4; ++m)
#pragma unroll
                    for (int n = 0; n < 2; ++n) acc[a][b][m][n] = (f32x4){0.f, 0.f, 0.f, 0.f};
        cur = nxt; cA = nA; cB = nB; ++ui;
        if constexpr (ALIGN_EPI) { if (wr == 1) PG8_BAR; }
    }
    PG8_WAIT_V(0);
    if constexpr (!ALIGN_EPI) { if (wr == 0) PG8_BAR; }
    PG8_BAR;
#undef PG8_SA
#undef PG8_SB
#undef PG8_STAGE
#undef PG8_LDA
#undef PG8_LDB
#undef PG8_MMA
#undef PG8_WAIT_V
#undef PG8_WAIT_L
#undef PG8_BAR
#undef PG8_SCHED
}
struct EpiBf16 {
    static constexpr bool PERM = true;
    bf16_t* O; size_t ldc;
    __device__ __forceinline__ void operator()(const f32x4 (&acc)[2][2][4][2], const Unit& u, int wr, int wc, int fr, int fq) const {
        const int row0 = u.pm * BM + wr * 64 + fr, col0 = u.pn * BM + wc * 32 + 8 * fq;
#pragma unroll
        for (int ai = 0; ai < 2; ++ai)
#pragma unroll
            for (int m = 0; m < 4; ++m) { bf16_t* rowp = O + (size_t)(row0 + ai * HALF + m * 16) * ldc + col0;
#pragma unroll
                for (int bj = 0; bj < 2; ++bj) { const f32x4 v0 = acc[ai][bj][m][0], v1 = acc[ai][bj][m][1];
                    u32x4 w; w.x = pk2(v0[0], v0[1]); w.y = pk2(v0[2], v0[3]); w.z = pk2(v1[0], v1[1]); w.w = pk2(v1[2], v1[3]);
                    *(u32x4*)(rowp + bj * HALF) = w; } }
    }
};
struct EpiRet {
    static constexpr bool PERM = true;
    bf16_t* O;
    __device__ __forceinline__ void operator()(const f32x4 (&acc)[2][2][4][2], const Unit& u, int wr, int wc, int fr, int fq) const {
        const int row0 = u.pm * BM + wr * 64 + fr, colt = u.pn * BM, col0 = colt + wc * 32 + 8 * fq;
        float l2g = 0.f, pre = 1.f;
        if (colt < 2048) { const int h = (colt & 1023) >> 8; l2g = __log2f(1.f - exp2f(-5.f - (float)h)); if (colt >= 1024) { l2g = -l2g; pre = 0.0625f; } }
#pragma unroll
        for (int ai = 0; ai < 2; ++ai)
#pragma unroll
            for (int m = 0; m < 4; ++m) { const int row = row0 + ai * HALF + m * 16; const float sc = pre * exp2f(l2g * (float)(row & 127)); bf16_t* rowp = O + (size_t)row * 6144 + col0;
#pragma unroll
                for (int bj = 0; bj < 2; ++bj) { const f32x4 v0 = acc[ai][bj][m][0] * sc, v1 = acc[ai][bj][m][1] * sc;
                    u32x4 w; w.x = pk2(v0[0], v0[1]); w.y = pk2(v0[2], v0[3]); w.z = pk2(v1[0], v1[1]); w.w = pk2(v1[2], v1[3]);
                    *(u32x4*)(rowp + bj * HALF) = w; } }
    }
};
template <bool SRC_F32> struct EpiRes {
    static constexpr bool PERM = true;
    const void* Xin; bf16_t* Xout; const float* gate;
    __device__ __forceinline__ void operator()(const f32x4 (&acc)[2][2][4][2], const Unit& u, int wr, int wc, int fr, int fq) const {
        const int row0 = u.pm * BM + wr * 64 + fr, col0 = u.pn * BM + wc * 32 + 8 * fq;
        const float* g = gate + (size_t)(row0 >> 11) * 6144 + col0;
        f32x4 gv[2][2];
#pragma unroll
        for (int bj = 0; bj < 2; ++bj)
#pragma unroll
            for (int n = 0; n < 2; ++n) gv[bj][n] = *(const f32x4*)(g + bj * HALF + n * 4);
#pragma unroll
        for (int ai = 0; ai < 2; ++ai)
#pragma unroll
            for (int m = 0; m < 4; ++m) { const int row = row0 + ai * HALF + m * 16;
#pragma unroll
                for (int bj = 0; bj < 2; ++bj) { f32x4 x0, x1;
                    if constexpr (SRC_F32) { const float* xp = (const float*)Xin + (size_t)row * D + col0 + bj * HALF; x0 = *(const f32x4*)xp; x1 = *(const f32x4*)(xp + 4); }
                    else { const u32x4 xb = *(const u32x4*)((const bf16_t*)Xin + (size_t)row * XRB_LD + XRB_OFF + col0 + bj * HALF);
                        x0 = (f32x4){bf_lo(xb.x), bf_hi(xb.x), bf_lo(xb.y), bf_hi(xb.y)}; x1 = (f32x4){bf_lo(xb.z), bf_hi(xb.z), bf_lo(xb.w), bf_hi(xb.w)}; }
                    const f32x4 v0 = x0 + gv[bj][0] * acc[ai][bj][m][0], v1 = x1 + gv[bj][1] * acc[ai][bj][m][1];
                    u32x4 w; w.x = pk2(v0[0], v0[1]); w.y = pk2(v0[2], v0[3]); w.z = pk2(v1[0], v1[1]); w.w = pk2(v1[2], v1[3]);
                    *(u32x4*)(Xout + (size_t)row * XRB_LD + XRB_OFF + col0 + bj * HALF) = w; }
                if (m & 1) asm volatile("" ::: "memory"); }
    }
};
template <class Epi>
__device__ __forceinline__ void dense(ldsp lds, const bf16_t* A, int lda, const bf16_t* Bt, int M, int N, int K, const Epi& E) {
    Gemm g{A, Bt, M, N, K, lda}; StaticOrder S; S.init(M, N, GRID, (int)blockIdx.x);
    gemm_phase<Epi, true>(lds, g, S, E);
}
struct UnitX { int pm, pn; const char* aBase; const char* bBase; const int* list; int cnt, r0, dummy; };
template <class Src, class Epi>
__device__ __forceinline__ void gemm_phase_x(ldsp lds, const Src& S, const Epi& E) {
    const int tid = fresh_tid(), wid = __builtin_amdgcn_readfirstlane(tid >> 6), lane = tid & 63, wr = wid >> 2, wc = wid & 3, fr = lane & 15, fq = lane >> 4;
    constexpr int K = Src::K, nt = K / BK, LDA = Src::LDA;
    int RA[2], CA[2]; unsigned voffB[2];
#pragma unroll
    for (int i = 0; i < 2; ++i) { int R, C; stage_rc(tid * 16 + i * 8192, R, C); RA[i] = R; CA[i] = C * 2; const int Rb = Epi::PERM ? ((R & ~31) + perm32(R & 31)) : R; voffB[i] = (unsigned)(Rb * K + C) * 2u; }
    const size_t kstep = (size_t)(BK * 2), hstepB = (size_t)HALF * K * 2;
    const unsigned ldsw = (unsigned)wid * 1024u;
    const int aoff = lds_byte(wr * 64 + fr, fq * 8), boff = lds_byte(wc * 32 + fr, fq * 8);
    auto rows_of = [&](const UnitX& u, unsigned (&v)[2][2]) {
#pragma unroll
        for (int h = 0; h < 2; ++h)
#pragma unroll
            for (int i = 0; i < 2; ++i) { const int r = h * HALF + RA[i];
                if constexpr (Src::GATHER) { const int gidx = u.r0 + r; const int tok = u.list ? (gidx < u.cnt ? u.list[gidx] : u.dummy) : u.dummy + gidx; v[h][i] = (unsigned)tok * (unsigned)(LDA * 2) + (unsigned)CA[i]; }
                else v[h][i] = (unsigned)(r * LDA * 2 + CA[i]); }
    };
#define PGX_SA(b, h) (((b) * 2 + (h)) * HTB)
#define PGX_SB(b, h) ((4 + (b) * 2 + (h)) * HTB)
#define PGX_STAGEB(bufoff, gbase) do { _Pragma("unroll") for (int _i = 0; _i < 2; ++_i) glds16((const char*)(gbase) + voffB[_i], lds + (bufoff) + ldsw + _i * 8192); } while (0)
#define PGX_STAGEA(bufoff, gbase, h, nx) do { _Pragma("unroll") for (int _i = 0; _i < 2; ++_i) glds16((const char*)(gbase) + ((nx) ? nv[h][_i] : cv[h][_i]), lds + (bufoff) + ldsw + _i * 8192); } while (0)
#define PGX_LDA(dst, b, h) do { _Pragma("unroll") for (int m = 0; m < 4; ++m) _Pragma("unroll") for (int k = 0; k < 2; ++k) dst[m][k] = *(const LAS bf16x8*)(lds + PGX_SA(b, h) + aoff + m * 2048 + k * 1024); } while (0)
#define PGX_LDB(dst, b, h) do { _Pragma("unroll") for (int n = 0; n < 2; ++n) _Pragma("unroll") for (int k = 0; k < 2; ++k) dst[n][k] = *(const LAS bf16x8*)(lds + PGX_SB(b, h) + boff + n * 2048 + k * 1024); } while (0)
#define PGX_MMA(ai, bj, At, Bt) do { __builtin_amdgcn_s_setprio(1); _Pragma("unroll") for (int m = 0; m < 4; ++m) _Pragma("unroll") for (int n = 0; n < 2; ++n) _Pragma("unroll") for (int k = 0; k < 2; ++k) \
        acc[ai][bj][m][n] = __builtin_amdgcn_mfma_f32_16x16x32_bf16(Bt[n][k], At[m][k], acc[ai][bj][m][n], 0, 0, 0); __builtin_amdgcn_s_setprio(0); } while (0)
#define PGX_WAIT_V(n) asm volatile("s_waitcnt vmcnt(" #n ")" ::: "memory")
#define PGX_WAIT_L(n) asm volatile("s_waitcnt lgkmcnt(" #n ")" ::: "memory")
#define PGX_BAR __builtin_amdgcn_s_barrier()
#define PGX_SCHED __builtin_amdgcn_sched_barrier(0)
    UnitX cur, nxt; int ui = 0;
    PGX_WAIT_V(0); PGX_BAR;
    if (!S.next(0, cur)) return;
    unsigned cv[2][2], nv[2][2];
    rows_of(cur, cv);
    asm volatile("" :: "v"(cv[0][0]), "v"(cv[0][1]), "v"(cv[1][0]), "v"(cv[1][1]));
    f32x4 acc[2][2][4][2];
#pragma unroll
    for (int a = 0; a < 2; ++a)
#pragma unroll
        for (int b = 0; b < 2; ++b)
#pragma unroll
            for (int m = 0; m < 4; ++m)
#pragma unroll
                for (int n = 0; n < 2; ++n) acc[a][b][m][n] = (f32x4){0.f, 0.f, 0.f, 0.f};
    bf16x8 At[4][2], B0[2][2], B1[2][2];
    const char* cA = cur.aBase; const char* cB = cur.bBase;
    PGX_STAGEB(PGX_SB(0, 0), cB); PGX_STAGEB(PGX_SB(0, 1), cB + hstepB); PGX_STAGEA(PGX_SA(0, 0), cA, 0, false); PGX_STAGEA(PGX_SA(0, 1), cA, 1, false);
    if (wr == 1) PGX_BAR;
    PGX_WAIT_V(2); PGX_BAR;
    PGX_STAGEB(PGX_SB(1, 0), cB + kstep); PGX_STAGEA(PGX_SA(1, 0), cA + kstep, 0, false); PGX_STAGEB(PGX_SB(1, 1), cB + hstepB + kstep);
    PGX_WAIT_V(6); PGX_BAR;
    LAS int* lbuf = (LAS int*)(lds + LDS_MISC + 2048);
    for (;;) {
        const bool has_next = S.next(ui + 1, nxt);
        if constexpr (Src::GATHER) {
            if (has_next && nxt.list && wid == 0) glds16((const char*)(nxt.list + nxt.r0) + lane * 16, (ldsp)(lbuf + ((ui + 1) & 1) * 256));
        } else {
            if (has_next) rows_of(nxt, nv); else {
#pragma unroll
                for (int h = 0; h < 2; ++h)
#pragma unroll
                    for (int i = 0; i < 2; ++i) nv[h][i] = cv[h][i]; }
        }
        const char* nA = has_next ? nxt.aBase : cA; const char* nB = has_next ? nxt.bBase : cB;
#pragma unroll 1
        for (int t = 0; t < nt; t += 2) {
            const bool last = (t == nt - 2);
            if constexpr (Src::GATHER) { if (last) {
#pragma unroll
                for (int h = 0; h < 2; ++h)
#pragma unroll
                    for (int i = 0; i < 2; ++i) { const int r = h * HALF + RA[i], gidx = nxt.r0 + r; unsigned v = cv[h][i];
                        if (has_next) { int tok;
                            if (nxt.list) { const int tl = lbuf[((ui + 1) & 1) * 256 + r]; tok = gidx < nxt.cnt ? tl : nxt.dummy; } else tok = nxt.dummy + gidx;
                            v = (unsigned)tok * (unsigned)(LDA * 2) + (unsigned)CA[i]; }
                        nv[h][i] = v; } } }
            const char* a1 = cA + (size_t)(t + 1) * kstep;
            const char* a2 = last ? nA : cA + (size_t)(t + 2) * kstep; const char* b2 = last ? nB : cB + (size_t)(t + 2) * kstep;
            const char* a3 = a2 + kstep; const char* b3 = b2 + kstep;
            PGX_LDB(B0, 0, 0); PGX_LDB(B1, 0, 1); PGX_SCHED; PGX_LDA(At, 0, 0); PGX_STAGEA(PGX_SA(1, 1), a1, 1, false);
            PGX_WAIT_V(8); PGX_WAIT_L(0); PGX_BAR; PGX_MMA(0, 0, At, B0); PGX_MMA(0, 1, At, B1); PGX_BAR; PGX_SCHED;
            PGX_LDA(At, 0, 1); PGX_STAGEB(PGX_SB(0, 0), b2); PGX_STAGEB(PGX_SB(0, 1), b2 + hstepB); PGX_STAGEA(PGX_SA(0, 0), a2, 0, last);
            PGX_WAIT_V(8); PGX_WAIT_L(0); PGX_BAR; PGX_MMA(1, 0, At, B0); PGX_MMA(1, 1, At, B1); PGX_BAR; PGX_SCHED;
            PGX_LDB(B0, 1, 0); PGX_LDB(B1, 1, 1); PGX_SCHED; PGX_LDA(At, 1, 0); PGX_STAGEA(PGX_SA(0, 1), a2, 1, last);
            PGX_WAIT_V(8); PGX_WAIT_L(0); PGX_BAR; PGX_MMA(0, 0, At, B0); PGX_MMA(0, 1, At, B1); PGX_BAR; PGX_SCHED;
            PGX_LDA(At, 1, 1); PGX_STAGEB(PGX_SB(1, 0), b3); PGX_STAGEB(PGX_SB(1, 1), b3 + hstepB); PGX_STAGEA(PGX_SA(1, 0), a3, 0, last);
            PGX_WAIT_V(8); PGX_WAIT_L(0); PGX_BAR; PGX_MMA(1, 0, At, B0); PGX_MMA(1, 1, At, B1); PGX_BAR; PGX_SCHED;
        }
        if (wr == 0) PGX_BAR;
        E(acc, cur, wr, wc, fr, fq);
        if (!has_next) break;
#pragma unroll
        for (int a = 0; a < 2; ++a)
#pragma unroll
            for (int b = 0; b < 2; ++b)
#pragma unroll
                for (int m = 0; m < 4; ++m)
#pragma unroll
                    for (int n = 0; n < 2; ++n) acc[a][b][m][n] = (f32x4){0.f, 0.f, 0.f, 0.f};
        cur = nxt; cA = nA; cB = nB; ++ui;
#pragma unroll
        for (int h = 0; h < 2; ++h)
#pragma unroll
            for (int i = 0; i < 2; ++i) cv[h][i] = nv[h][i];
        if (wr == 1) PGX_BAR;
    }
    PGX_WAIT_V(0);
    PGX_BAR;
#undef PGX_SA
#undef PGX_SB
#undef PGX_STAGEA
#undef PGX_STAGEB
#undef PGX_LDA
#undef PGX_LDB
#undef PGX_MMA
#undef PGX_WAIT_V
#undef PGX_WAIT_L
#undef PGX_BAR
#undef PGX_SCHED
}
struct EpiSwiGLUx {
    static constexpr bool PERM = false;
    bf16_t* O;
    __device__ __forceinline__ void operator()(const f32x4 (&acc)[2][2][4][2], const UnitX& u, int wr, int wc, int fr, int fq) const {
        const int row0 = u.pm * BM + wr * 64 + fr, c0 = (u.pn * BM + wc * 32) / 2 + 4 * fq;
#pragma unroll
        for (int ai = 0; ai < 2; ++ai)
#pragma unroll
            for (int m = 0; m < 4; ++m) { bf16_t* rowp = O + (size_t)(row0 + ai * HALF + m * 16) * 256 + c0;
#pragma unroll
                for (int bj = 0; bj < 2; ++bj) { const f32x4 x = acc[ai][bj][m][0], y = acc[ai][bj][m][1]; u32x2 w;
                    w.x = pk2(silu_f(x[0]) * y[0], silu_f(x[1]) * y[1]); w.y = pk2(silu_f(x[2]) * y[2], silu_f(x[3]) * y[3]); *(u32x2*)(rowp + bj * (HALF / 2)) = w; } }
    }
};
struct EpiYx {
    static constexpr bool PERM = true;
    unsigned char* O;
    __device__ __forceinline__ void operator()(const f32x4 (&acc)[2][2][4][2], const UnitX& u, int wr, int wc, int fr, int fq) const {
        const int row0 = u.pm * BM + wr * 64 + fr, col0 = u.pn * BM + wc * 32 + 8 * fq;
#pragma unroll
        for (int ai = 0; ai < 2; ++ai)
#pragma unroll
            for (int m = 0; m < 4; ++m) { unsigned char* rowp = O + (size_t)(row0 + ai * HALF + m * 16) * D + col0;
#pragma unroll
                for (int bj = 0; bj < 2; ++bj) { const f32x4 v0 = acc[ai][bj][m][0], v1 = acc[ai][bj][m][1];
                    int w0 = __builtin_amdgcn_cvt_pk_fp8_f32(v0[0], v0[1], 0, false); w0 = __builtin_amdgcn_cvt_pk_fp8_f32(v0[2], v0[3], w0, true);
                    int w1 = __builtin_amdgcn_cvt_pk_fp8_f32(v1[0], v1[1], 0, false); w1 = __builtin_amdgcn_cvt_pk_fp8_f32(v1[2], v1[3], w1, true);
                    u32x2 w; w.x = (unsigned)w0; w.y = (unsigned)w1; *(u32x2*)(rowp + bj * HALF) = w; } }
    }
};
}

__device__ __forceinline__ void transpose_item(const float* W, int K, int N, bf16_t* WT, int mode, LAS float* scr, int item, int lane) {
    const int nblk = N / 32, kb = item / nblk, nb = item % nblk, k0 = 64 * kb, n0 = 32 * nb;
    f32x4 v[8];
#pragma unroll
    for (int i = 0; i < 8; ++i) v[i] = *(const f32x4*)(W + (size_t)(k0 + 8 * i + (lane >> 3)) * N + n0 + (lane & 7) * 4);
#pragma unroll
    for (int i = 0; i < 8; ++i) { LAS float* d = scr + (8 * i + (lane >> 3)) * 33 + (lane & 7) * 4; d[0] = v[i][0]; d[1] = v[i][1]; d[2] = v[i][2]; d[3] = v[i][3]; }
    LDS_WAIT();
    const int c = lane & 7;
#pragma unroll
    for (int j = 0; j < 4; ++j) { const int n = (lane >> 3) + 8 * j; const LAS float* s = scr + (8 * c) * 33 + n;
        u32x4 o; o.x = pk2(s[0 * 33], s[1 * 33]); o.y = pk2(s[2 * 33], s[3 * 33]); o.z = pk2(s[4 * 33], s[5 * 33]); o.w = pk2(s[6 * 33], s[7 * 33]);
        const int nn = n0 + n; const int row = mode == 0 ? nn : ((nn >> 4) * 32 + (mode == 2 ? 16 : 0) + (nn & 15));
        *(u32x4*)(WT + (size_t)row * K + k0 + 8 * c) = o; }
    LDS_WAIT();
}
__device__ __forceinline__ void convert_expert_weights(const Args& a, int layer, ldsp lds, int gw, int ngw, int wave, int lane) {
    LAS float* scr = (LAS float*)(lds + wave * 16384);
    unsigned char* ws = a.ws;
    constexpr int I13 = (D / 64) * (256 / 32), I2 = (256 / 64) * (D / 32);
    constexpr int NE = 64 * I13;
    constexpr int TOTAL = 3 * NE + 3 * 128;
    for (int it = gw; it < TOTAL; it += ngw) {
        int r = it;
        if (r < NE) { const int e = r / I13; transpose_item(a.in[I_EW1] + ((size_t)layer * 64 + e) * D * 256, D, 256, (bf16_t*)(ws + WS_W13) + (size_t)e * 512 * D, 1, scr, r % I13, lane); continue; } r -= NE;
        if (r < NE) { const int e = r / I13; transpose_item(a.in[I_EW3] + ((size_t)layer * 64 + e) * D * 256, D, 256, (bf16_t*)(ws + WS_W13) + (size_t)e * 512 * D, 2, scr, r % I13, lane); continue; } r -= NE;
        if (r < NE) { const int e = r / I2; transpose_item(a.in[I_EW2] + ((size_t)layer * 64 + e) * 256 * D, 256, D, (bf16_t*)(ws + WS_W2) + (size_t)e * D * 256, 0, scr, r % I2, lane); continue; } r -= NE;
        if (r < 128) { transpose_item(a.in[I_SW1] + (size_t)layer * D * 256, D, 256, (bf16_t*)(ws + WS_WS13), 1, scr, r, lane); continue; } r -= 128;
        if (r < 128) { transpose_item(a.in[I_SW3] + (size_t)layer * D * 256, D, 256, (bf16_t*)(ws + WS_WS13), 2, scr, r, lane); continue; } r -= 128;
        transpose_item(a.in[I_SW2] + (size_t)layer * 256 * D, 256, D, (bf16_t*)(ws + WS_WS2), 0, scr, r, lane);
    }
}
__device__ __forceinline__ void convert_dense_weights(const Args& a, ldsp lds, int gw, int ngw, int wave, int lane) {
    LAS float* scr = (LAS float*)(lds + wave * 16384);
    unsigned char* ws = a.ws;
    constexpr int IQ = 16 * 96, IO = 16 * 32, IRI = 16 * 192, IRO = 32 * 32;
    for (int it = gw; it < IQ + IO + IRI + IRO; it += ngw) {
        int r = it;
        if (r < IQ) { transpose_item(a.in[I_DAWIN], D, 3072, (bf16_t*)(ws + WS_WQKV), 0, scr, r, lane); continue; } r -= IQ;
        if (r < IO) { transpose_item(a.in[I_DAWOUT], D, D, (bf16_t*)(ws + WS_WO), 0, scr, r, lane); continue; } r -= IO;
        if (r < IRI) { transpose_item(a.in[I_RWIN], D, 6144, (bf16_t*)(ws + WS_WRI), 0, scr, r, lane); continue; } r -= IRI;
        transpose_item(a.in[I_RWOUT], 2048, D, (bf16_t*)(ws + WS_WRO), 0, scr, r, lane);
    }
}
__device__ __forceinline__ void mod_items(const Args& a, ldsp lds) {
    const int tid = threadIdx.x;
    LAS float* sl = (LAS float*)lds;
    LAS float* red = (LAS float*)(lds + 65536);
    const float* c = a.in[I_C];
    for (int i = tid; i < 16 * 1024; i += NTHR) sl[i] = silu_f(c[i]);
    __syncthreads();
    float* mod = (float*)(a.ws + WS_MOD);
    for (int item = blockIdx.x; item < 384; item += GRID) {
        const int layer = item / 192, j0 = (item % 192) * 32, kq = tid >> 5, col = tid & 31;
        const float* w = a.in[I_ADAW] + (size_t)layer * D * 6144 + j0 + col;
        float acc[16];
#pragma unroll
        for (int b = 0; b < 16; ++b) acc[b] = 0.f;
        for (int k0 = kq * 64; k0 < kq * 64 + 64; k0 += 8) {
            float wv[8];
#pragma unroll
            for (int u = 0; u < 8; ++u) wv[u] = w[(size_t)(k0 + u) * 6144];
#pragma unroll
            for (int u = 0; u < 8; ++u)
#pragma unroll
                for (int b = 0; b < 16; ++b) acc[b] += sl[b * 1024 + k0 + u] * wv[u];
        }
#pragma unroll
        for (int b = 0; b < 16; ++b) red[(kq * 16 + b) * 32 + col] = acc[b];
        __syncthreads();
        { const int b = tid >> 5, cc = tid & 31; const int j = j0 + cc; float s = a.in[I_ADAB][(size_t)layer * 6144 + j];
#pragma unroll
          for (int q = 0; q < 16; ++q) s += red[(q * 16 + b) * 32 + cc];
          if (j >= 1024 && j < 2048) s = a.in[I_NMIX][layer * D + j - 1024] * (1.f + s);
          if (j >= 4096 && j < 5120) s = a.in[I_NFFN][layer * D + j - 4096] * (1.f + s);
          mod[((size_t)layer * 16 + b) * 6144 + j] = s; }
        __syncthreads();
    }
}

__device__ __forceinline__ void adaln_store(const f32x4 (&v)[4], float rstd, const float* G, const float* sh, bf16_t* hrow, int lane) {
#pragma unroll
    for (int j = 0; j < 4; ++j) { const int col = 4 * lane + 256 * j; const f32x4 g = *(const f32x4*)(G + col), s0 = *(const f32x4*)(sh + col);
        const f32x4 h = v[j] * rstd * g + s0; u32x2 w; w.x = pk2(h[0], h[1]); w.y = pk2(h[2], h[3]); *(u32x2*)(hrow + col) = w; }
}
__device__ __forceinline__ void adaln_phase(const float* X, const float* mod_sh  , const float* mod_G, bf16_t* H, int gw, int ngw, int lane) {
    for (int row0 = gw * 2; row0 < T; row0 += ngw * 2) {
        f32x4 v[2][4]; float ss[2] = {0.f, 0.f};
#pragma unroll
        for (int r = 0; r < 2; ++r)
#pragma unroll
            for (int j = 0; j < 4; ++j) v[r][j] = *(const f32x4*)(X + (size_t)(row0 + r) * D + 4 * lane + 256 * j);
#pragma unroll
        for (int r = 0; r < 2; ++r) {
#pragma unroll
            for (int j = 0; j < 4; ++j) ss[r] += v[r][j][0] * v[r][j][0] + v[r][j][1] * v[r][j][1] + v[r][j][2] * v[r][j][2] + v[r][j][3] * v[r][j][3];
            const float rstd = rsqrtf(wave_sum(ss[r]) * (1.f / D) + 1e-6f); const int b = (row0 + r) >> 11;
            adaln_store(v[r], rstd, mod_G + (size_t)b * 6144, mod_sh + (size_t)b * 6144, H + (size_t)(row0 + r) * D, lane); }
    }
}

__device__ __forceinline__ void attn_phase(ldsp lds, const bf16_t* qkv, bf16_t* ao, float lam, const float* subln_g) {
    const int tid = fresh_tid(), lane = tid & 63, wid = __builtin_amdgcn_readfirstlane(tid >> 6), map = wid & 1, qg = wid >> 1, fr = lane & 15, fq = lane >> 4;
    constexpr int STAGE = 32768;
    const float cs = 0.125f * LOG2E;
    const int kswz = fr >> 1, kok0 = ((fq ^ kswz) << 4), kok1 = (((4 + fq) ^ kswz) << 4), koff = map * 8192 + fr * 128;
    const int vq = fr >> 2, vp = fr & 3, vrow = 4 * fq + vq, vsw = ((vrow & 7) << 1);
    const int vbase0 = 16384 + vrow * 256 + ((((vp >> 1) ^ vsw) & 15) << 4) + (vp & 1) * 8;
    for (int round = 0; round < 8; ++round) {
        const int i = blockIdx.x, jgrp = i >> 7, bh = i & 127;
        const int qb = (round & 1) ? (14 - 2 * round + jgrp) : (15 - 2 * round - jgrp);
        const int b = bh >> 3, h = bh & 7;
        const size_t tok0 = (size_t)b * SEQ;
        const float slope2 = exp2f(-(float)(h + 1)) * LOG2E;
        bf16x8 qf[2][2];
#pragma unroll
        for (int qt = 0; qt < 2; ++qt)
#pragma unroll
            for (int kk = 0; kk < 2; ++kk) qf[qt][kk] = *(const bf16x8*)(qkv + (tok0 + qb * 128 + qg * 32 + qt * 16 + fr) * 3072 + (2 * h + map) * 64 + kk * 32 + fq * 8);
        asm volatile("" :: "v"(qf[0][0]), "v"(qf[0][1]), "v"(qf[1][0]), "v"(qf[1][1]));
        const char* srcK0; const char* srcV0;
        { const int row = 8 * wid + (lane >> 3), ch = (lane & 7) ^ ((row >> 1) & 7);
          srcK0 = (const char*)(qkv + (tok0 + row) * 3072 + 1024 + (2 * h) * 64) + ch * 16; }
        { const int row = 4 * wid + (lane >> 4), ch = (lane & 15) ^ ((row & 7) << 1); srcV0 = (const char*)(qkv + (tok0 + row) * 3072 + 2048 + h * 128) + ch * 16; }
        auto issue = [&](int s, int t) {
            ldsp st = lds + s * STAGE; const size_t adv = (size_t)t * 64 * 3072 * 2;
            glds16(srcK0 + adv, st + wid * 1024); glds16(srcK0 + adv + 128, st + 8192 + wid * 1024);
            glds16(srcV0 + adv, st + 16384 + wid * 1024); glds16(srcV0 + adv + (size_t)32 * 6144, st + 16384 + (wid + 8) * 1024);
        };
        f32x4 o[8][2];
#pragma unroll
        for (int dt = 0; dt < 8; ++dt) { o[dt][0] = (f32x4){0.f, 0.f, 0.f, 0.f}; o[dt][1] = (f32x4){0.f, 0.f, 0.f, 0.f}; }
        float mrow[2] = {-__builtin_inff(), -__builtin_inff()}, lrow[2] = {0.f, 0.f};
        const int ntile = 2 * qb + 2;
        const int qlast = qb * 128 + qg * 32 + 31, qfirst = qb * 128 + qg * 32;
        BAR();
        issue(0, 0); issue(1, 1);
        int s = 0;
        for (int t = 0; t < ntile; ++t) {
            if (t + 1 < ntile) wait_vm<4>(); else wait_vm<0>();
            BAR();
            if (t + 2 < ntile) { int s2 = s + 2; if (s2 >= 3) s2 -= 3; issue(s2, t + 2); }
            ldsp st = lds + s * STAGE;
            const int key0 = 64 * t;
            if (key0 <= qlast) {
                f32x4 sc[4][2];
#pragma unroll
                for (int kt = 0; kt < 4; ++kt) { sc[kt][0] = (f32x4){0.f, 0.f, 0.f, 0.f}; sc[kt][1] = (f32x4){0.f, 0.f, 0.f, 0.f}; }
                __builtin_amdgcn_s_setprio(1);
#pragma unroll
                for (int kk = 0; kk < 2; ++kk) {
                    const int ok = kk ? kok1 : kok0;
#pragma unroll
                    for (int kt = 0; kt < 4; ++kt) { const bf16x8 kf = *(LAS bf16x8*)(st + koff + kt * 2048 + ok);
                        sc[kt][0] = __builtin_amdgcn_mfma_f32_16x16x32_bf16(kf, qf[0][kk], sc[kt][0], 0, 0, 0);
                        sc[kt][1] = __builtin_amdgcn_mfma_f32_16x16x32_bf16(kf, qf[1][kk], sc[kt][1], 0, 0, 0); }
                }
                __builtin_amdgcn_s_setprio(0);
                __builtin_amdgcn_sched_barrier(0);
                const bool need_mask = (key0 + 63 > qfirst);
                const float kb0 = slope2 * (float)(key0 + 4 * fq);
                bf16x8 pf[2][2];
#pragma unroll
                for (int qt = 0; qt < 2; ++qt) {
                    const int qrow = qb * 128 + qg * 32 + qt * 16 + fr;
                    float mx = -__builtin_inff();
#pragma unroll
                    for (int kt = 0; kt < 4; ++kt)
#pragma unroll
                        for (int r = 0; r < 4; ++r) { float v = sc[kt][qt][r] * cs + (kb0 + slope2 * (float)(16 * kt + r));
                            if (need_mask && (key0 + 16 * kt + 4 * fq + r > qrow)) v = -__builtin_inff();
                            sc[kt][qt][r] = v; mx = fmaxf(mx, v); }
                    mx = fmaxf(mx, __shfl_xor(mx, 16)); mx = fmaxf(mx, __shfl_xor(mx, 32));
                    const float mnew = fmaxf(mrow[qt], mx), alpha = fast_exp2(mrow[qt] - mnew);
                    mrow[qt] = mnew;
                    float ps = 0.f;
#pragma unroll
                    for (int kt = 0; kt < 4; ++kt)
#pragma unroll
                        for (int r = 0; r < 4; ++r) { const float p = fast_exp2(sc[kt][qt][r] - mnew); sc[kt][qt][r] = p; ps += p; }
                    lrow[qt] = lrow[qt] * alpha + ps;
#pragma unroll
                    for (int dt = 0; dt < 8; ++dt) o[dt][qt] = o[dt][qt] * alpha;
#pragma unroll
                    for (int s2 = 0; s2 < 2; ++s2) { u32x4 w; w.x = pk2(sc[2 * s2][qt][0], sc[2 * s2][qt][1]); w.y = pk2(sc[2 * s2][qt][2], sc[2 * s2][qt][3]);
                        w.z = pk2(sc[2 * s2 + 1][qt][0], sc[2 * s2 + 1][qt][1]); w.w = pk2(sc[2 * s2 + 1][qt][2], sc[2 * s2 + 1][qt][3]); pf[qt][s2] = __builtin_bit_cast(bf16x8, w); }
                }
                {
                    int vb = vbase0; asm volatile("" : "+v"(vb));
                    bf16x8 vq[3];
                    vq[0] = tr2(st + vb, st + vb + 4096);
                    vq[1] = tr2(st + (vb ^ 32), st + (vb ^ 32) + 4096);
                    __builtin_amdgcn_s_setprio(1);
#pragma unroll
                    for (int i = 0; i < 16; ++i) {
                        const int s2 = i >> 3, dt = i & 7;
                        if (i + 2 < 16) { const int i2 = i + 2, vo = (vb ^ ((i2 & 7) << 5)) + (i2 >> 3) * 8192; vq[i2 % 3] = tr2(st + vo, st + vo + 4096); }
                        o[dt][0] = __builtin_amdgcn_mfma_f32_16x16x32_bf16(vq[i % 3], pf[0][s2], o[dt][0], 0, 0, 0);
                        o[dt][1] = __builtin_amdgcn_mfma_f32_16x16x32_bf16(vq[i % 3], pf[1][s2], o[dt][1], 0, 0, 0);
                        __builtin_amdgcn_sched_barrier(0);
                    }
                    __builtin_amdgcn_s_setprio(0);
                }
            }
            s = (s == 2) ? 0 : s + 1;
        }
#pragma unroll
        for (int qt = 0; qt < 2; ++qt) { float l = lrow[qt]; l += __shfl_xor(l, 16); l += __shfl_xor(l, 32); const float inv = 1.f / l;
#pragma unroll
            for (int dt = 0; dt < 8; ++dt) o[dt][qt] = o[dt][qt] * inv; }
        BAR();
        LAS float* xb = (LAS float*)lds + qg * 4096;
        if (map == 1) {
#pragma unroll
            for (int dt = 0; dt < 8; ++dt)
#pragma unroll
                for (int qt = 0; qt < 2; ++qt)
#pragma unroll
                    for (int r = 0; r < 4; ++r) xb[((dt * 2 + qt) * 4 + r) * 64 + lane] = o[dt][qt][r];
        }
        LDS_WAIT(); BAR();
        if (map == 0) {
            const float* sg = subln_g; asm volatile("" : "+s"(sg));
#pragma unroll
            for (int qt = 0; qt < 2; ++qt) {
                float ss = 0.f;
#pragma unroll
                for (int dt = 0; dt < 8; ++dt)
#pragma unroll
                    for (int r = 0; r < 4; ++r) { const float v = o[dt][qt][r] - lam * xb[((dt * 2 + qt) * 4 + r) * 64 + lane]; o[dt][qt][r] = v; ss += v * v; }
                ss += __shfl_xor(ss, 16); ss += __shfl_xor(ss, 32);
                const float rstd = rsqrtf(ss * (1.f / 128.f) + 1e-6f) * 0.8f;
                bf16_t* orow = ao + (tok0 + qb * 128 + qg * 32 + qt * 16 + fr) * D + h * 128 + 4 * fq;
#pragma unroll
                for (int dt = 0; dt < 8; ++dt) { const f32x4 g = *(const f32x4*)(sg + dt * 16 + 4 * fq); const f32x4 v = o[dt][qt] * rstd * g;
                    u32x2 w; w.x = pk2(v[0], v[1]); w.y = pk2(v[2], v[3]); *(u32x2*)(orow + dt * 16) = w; }
            }
        }
        LDS_WAIT(); BAR();
    }
}

__device__ __forceinline__ void chain_phase(ldsp lds, bf16_t* rp, const bf16_t* P, bool dry) {
    const int tid = fresh_tid(), lane = tid & 63, wid = __builtin_amdgcn_readfirstlane(tid >> 6), fr = lane & 15, fq = lane >> 4;
    constexpr int STAGE = 32768, NSTG = 4;
    const int chain = vcu_of_block(), b = chain >> 4, h = (chain >> 2) & 3, sl = chain & 3;
    const size_t tok0 = (size_t)b * SEQ;
    const float lg = __log2f(1.f - exp2f(-5.f - (float)h));
    const float gamma = exp2f(lg), g127 = exp2f(lg * 127.f), g128 = exp2f(lg * 128.f);
    const bf16_t* vbase = rp + tok0 * 6144 + 2048 + h * 512 + sl * 128;
    const bf16_t* qbase = rp + tok0 * 6144 + h * 256;
    const bf16_t* kbase = rp + tok0 * 6144 + 1024 + h * 256;
    const bf16_t* pbase = P + (size_t)((b * 4 + h) * 16) * 16384;
    unsigned vsrc0, psrc0, qsrc0, ksrc0;
    { const int row = 4 * wid + (lane >> 4); vsrc0 = (unsigned)(row * 6144 * 2 + (((lane & 15) ^ ((row & 7) << 1)) << 4)); psrc0 = (unsigned)(row * 256 + (((lane & 15) ^ (row & 15)) << 4)); }
    { const int row = 8 * wid + (lane >> 3); qsrc0 = (unsigned)(row * 6144 * 2 + (((lane & 7) ^ ((row >> 1) & 7)) << 4)); ksrc0 = (unsigned)(row * 6144 * 2 + (((lane & 7) ^ (((row >> 1) & 3) << 1)) << 4)); }
    auto issue = [&](int s, int g) {
        ldsp st = lds + s * STAGE; const int c = g / 6, kind = g - c * 6; const size_t coff = (size_t)c * 128 * 6144 * 2;
        if (kind == 0) {
            const char* bp = (const char*)vbase + coff;
#pragma unroll
            for (int jj = 0; jj < 4; ++jj) glds16(bp + (size_t)jj * 32 * 12288 + vsrc0, st + (wid + 8 * jj) * 1024);
        } else if (kind == 5) {
            const char* bp = (const char*)pbase + (size_t)c * 32768;
#pragma unroll
            for (int jj = 0; jj < 4; ++jj) glds16(bp + (size_t)jj * 32 * 256 + psrc0, st + (wid + 8 * jj) * 1024);
        } else { const int p = kind - 1;
            const char* bq = (const char*)qbase + coff + p * 128; const char* bk = (const char*)kbase + coff + p * 128;
#pragma unroll
            for (int jj = 0; jj < 2; ++jj) glds16(bq + (size_t)jj * 64 * 12288 + qsrc0, st + (wid + 8 * jj) * 1024);
#pragma unroll
            for (int jj = 0; jj < 2; ++jj) glds16(bk + (size_t)jj * 64 * 12288 + ksrc0, st + 16384 + (wid + 8 * jj) * 1024);
        }
    };
    const int tq = fr >> 2, tp = fr & 3;
    const int vrow = 4 * fq + tq;
    const int vfo = vrow * 256 + ((((2 * wid + (tp >> 1)) ^ ((vrow & 7) << 1)) & 15) << 4) + (tp & 1) * 8;
    const int ksw = ((vrow >> 1) & 3) << 1;
    const int kfo0 = 16384 + vrow * 128 + ((((tp >> 1) ^ ksw) & 7) << 4) + (tp & 1) * 8;
    const int qsw = fr >> 1;
    const int qfo0 = fr * 128 + ((((fq >> 1) ^ qsw) & 7) << 4) + (fq & 1) * 8;
    const int pfo0 = fr * 256 + ((((fq >> 1) ^ fr) & 15) << 4) + (fq & 1) * 8;

    f32x4 R[16];
#pragma unroll
    for (int i = 0; i < 16; ++i) R[i] = (f32x4){0.f, 0.f, 0.f, 0.f};
    f32x4 o[8];
#pragma unroll
    for (int it = 0; it < 8; ++it) o[it] = (f32x4){0.f, 0.f, 0.f, 0.f};
    bf16x8 vf[4];
#pragma unroll
    for (int s4 = 0; s4 < 4; ++s4) vf[s4] = (bf16x8){0, 0, 0, 0, 0, 0, 0, 0};
    constexpr int NG = 16 * 6;
    BAR();
    issue(0, 0); issue(1, 1); issue(2, 2);
    for (int c = 0; c < 16; ++c) {
        auto step = [&](auto KC) {
            constexpr int kind = decltype(KC)::value;
            const int g = c * 6 + kind;
            if (g + 2 < NG) wait_vm<8>(); else if (g + 1 < NG) wait_vm<4>(); else wait_vm<0>();
            BAR();
            if (g + 3 < NG) issue((g + 3) & 3, g + 3);
            ldsp st = lds + (g & 3) * STAGE;
            if constexpr (kind == 0) {
#pragma unroll
                for (int s4 = 0; s4 < 4; ++s4) vf[s4] = tr2(st + vfo + s4 * 8192, st + vfo + s4 * 8192 + 4096);
#pragma unroll
                for (int it = 0; it < 8; ++it) o[it] = (f32x4){0.f, 0.f, 0.f, 0.f};
            } else if constexpr (kind == 5) {
#pragma unroll
                for (int it = 0; it < 8; ++it) o[it] = o[it] * gamma;
#pragma unroll
                for (int s4 = 0; s4 < 4; ++s4) {
                    int pb = pfo0; asm volatile("" : "+v"(pb)); const int p0 = pb ^ ((4 * s4) << 4), p1 = pb ^ ((4 * s4 + 2) << 4);
#pragma unroll
                    for (int it = 0; it < 8; ++it) { const bf16x8 pf = rd2x64(st + p0 + it * 4096, st + p1 + it * 4096);
                        o[it] = __builtin_amdgcn_mfma_f32_16x16x32_bf16(vf[s4], pf, o[it], 0, 0, 0); if (it == 3) __builtin_amdgcn_sched_barrier(0); }
                    __builtin_amdgcn_sched_barrier(0);
                }
                bf16_t* ob = rp + (tok0 + (size_t)c * 128) * 6144 + 2048 + h * 512 + sl * 128 + 16 * wid + 4 * fq;
#pragma unroll
                for (int it = 0; it < 8; ++it) { u32x2 w; w.x = pk2(o[it][0], o[it][1]); w.y = pk2(o[it][2], o[it][3]); if (!dry) *(u32x2*)(ob + (size_t)(16 * it + fr) * 6144) = w; else asm volatile("" :: "v"(w)); }
            } else {
                constexpr int p = kind - 1;
#pragma unroll
                for (int s2 = 0; s2 < 2; ++s2) {
                    u32x4 w; const f32x4 r0 = R[4 * p + 2 * s2], r1 = R[4 * p + 2 * s2 + 1];
                    w.x = pk2(r0[0], r0[1]); w.y = pk2(r0[2], r0[3]); w.z = pk2(r1[0], r1[1]); w.w = pk2(r1[2], r1[3]);
                    const bf16x8 rf = __builtin_bit_cast(bf16x8, w);
                    int qb = qfo0; asm volatile("" : "+v"(qb)); const int q0 = qb ^ ((4 * s2) << 4), q1 = qb ^ ((4 * s2 + 2) << 4);
#pragma unroll
                    for (int it = 0; it < 8; ++it) { const bf16x8 qf = rd2x64(st + q0 + it * 2048, st + q1 + it * 2048);
                        o[it] = __builtin_amdgcn_mfma_f32_16x16x32_bf16(rf, qf, o[it], 0, 0, 0); if (it == 3) __builtin_amdgcn_sched_barrier(0); }
                    __builtin_amdgcn_sched_barrier(0);
                }
#pragma unroll
                for (int dkt = 0; dkt < 4; ++dkt) {
                    f32x4 acc = (f32x4){0.f, 0.f, 0.f, 0.f};
                    int kb = kfo0; asm volatile("" : "+v"(kb)); const int ko = kb ^ (dkt << 5);
#pragma unroll
                    for (int s4 = 0; s4 < 4; ++s4) { const bf16x8 kf = tr2(st + ko + s4 * 4096, st + ko + s4 * 4096 + 2048);
                        acc = __builtin_amdgcn_mfma_f32_16x16x32_bf16(kf, vf[s4], acc, 0, 0, 0); }
                    R[4 * p + dkt] = R[4 * p + dkt] * g128 + acc * g127;
                }
                __builtin_amdgcn_sched_barrier(0);
            }
        };
        step(std::integral_constant<int, 0>{}); step(std::integral_constant<int, 1>{}); step(std::integral_constant<int, 2>{});
        step(std::integral_constant<int, 3>{}); step(std::integral_constant<int, 4>{}); step(std::integral_constant<int, 5>{});
    }
}

__device__ __forceinline__ void gnorm_phase(bf16_t* rp, const float* gn, int gw, int ngw, int lane, bool dry) {
    f32x4 w0[4], w1[4];
#pragma unroll
    for (int hh = 0; hh < 4; ++hh) { w0[hh] = *(const f32x4*)(gn + hh * 512 + 8 * lane); w1[hh] = *(const f32x4*)(gn + hh * 512 + 8 * lane + 4); }
    for (int row = gw; row < T; row += ngw) {
        bf16_t* orow = rp + (size_t)row * 6144 + 2048; const bf16_t* grow = rp + (size_t)row * 6144 + 4096;
        u32x4 ov[4], gv[4];
#pragma unroll
        for (int hh = 0; hh < 4; ++hh) { ov[hh] = *(const u32x4*)(orow + hh * 512 + 8 * lane); gv[hh] = *(const u32x4*)(grow + hh * 512 + 8 * lane); }
#pragma unroll
        for (int hh = 0; hh < 4; ++hh) {
            float of[8] = {bf_lo(ov[hh].x), bf_hi(ov[hh].x), bf_lo(ov[hh].y), bf_hi(ov[hh].y), bf_lo(ov[hh].z), bf_hi(ov[hh].z), bf_lo(ov[hh].w), bf_hi(ov[hh].w)};
            float gf[8] = {bf_lo(gv[hh].x), bf_hi(gv[hh].x), bf_lo(gv[hh].y), bf_hi(gv[hh].y), bf_lo(gv[hh].z), bf_hi(gv[hh].z), bf_lo(gv[hh].w), bf_hi(gv[hh].w)};
            float ss = 0.f;
#pragma unroll
            for (int e = 0; e < 8; ++e) ss += of[e] * of[e];
            const float rstd = rsqrtf(wave_sum(ss) * (1.f / 512.f) + 1e-6f);
            float y[8];
#pragma unroll
            for (int e = 0; e < 8; ++e) y[e] = silu_f(gf[e]) * of[e] * rstd * (e < 4 ? w0[hh][e] : w1[hh][e - 4]);
            u32x4 w; w.x = pk2(y[0], y[1]); w.y = pk2(y[2], y[3]); w.z = pk2(y[4], y[5]); w.w = pk2(y[6], y[7]);
            if (!dry) *(u32x4*)(orow + hh * 512 + 8 * lane) = w; else asm volatile("" :: "v"(w));
        }
    }
}

__device__ __forceinline__ void router_phase(ldsp lds, const bf16_t* XRBp, const float* mod_sh, const float* mod_G, const bf16_t* rwt  , const float* rbias,
                                             bf16_t* H, int* sel_e, float* sel_w, int* sel_p, int* tokl, unsigned* cnt, int tile0, int tile_end, int tstep, int wave, int lane, bool dry) {
    LAS float* lg = (LAS float*)(lds + wave * 8192);
    LAS int* st2 = (LAS int*)(lds + wave * 8192 + 4096);
    LAS float* Gl = (LAS float*)(lds + 131072); LAS float* SHl = Gl + 1024;
    const float rb = rbias[lane];
    const int fr = lane & 15, fq = lane >> 4;
    for (int tile = tile0; tile < tile_end; tile += tstep) {
        const int row = tile * 16 + fr, b = row >> 11;
        const bf16_t* xr = XRBp + (size_t)row * XRB_LD + XRB_OFF + 8 * fq;
        bf16_t* hrow = H + (size_t)row * D + 8 * fq;
        { const int t4 = (wave * 64 + lane) * 4; const float* src = (t4 < 1024 ? mod_G : mod_sh - 1024) + (size_t)b * 6144 + t4; *(LAS f32x4*)(Gl + t4) = *(const f32x4*)src; }
        auto issue_chunk = [&](int ch) {
            ldsp buf = lds + (ch & 1) * 65536;
#pragma unroll
            for (int j = 0; j < 8; ++j) { const int i = wave + 8 * j, r2 = 2 * i + (lane >> 5), lc = (lane & 31) ^ (r2 & 15);
                glds16((const char*)rwt + (size_t)r2 * 2048 + (size_t)ch * 512 + lc * 16, buf + i * 1024); }
        };
        issue_chunk(0);
        float ss = 0.f;
#pragma unroll 8
        for (int s = 0; s < 32; ++s) { const u32x4 xb = *(const u32x4*)(xr + 32 * s);
            const float e0 = bf_lo(xb.x), e1 = bf_hi(xb.x), e2 = bf_lo(xb.y), e3 = bf_hi(xb.y), e4 = bf_lo(xb.z), e5 = bf_hi(xb.z), e6 = bf_lo(xb.w), e7 = bf_hi(xb.w);
            ss += e0 * e0 + e1 * e1 + e2 * e2 + e3 * e3 + e4 * e4 + e5 * e5 + e6 * e6 + e7 * e7; }
        ss += __shfl_xor(ss, 16); ss += __shfl_xor(ss, 32);
        const float rstd = rsqrtf(ss * (1.f / D) + 1e-6f);
        f32x4 acc[4];
#pragma unroll
        for (int et = 0; et < 4; ++et) acc[et] = (f32x4){0.f, 0.f, 0.f, 0.f};
        u32x4 xc[8], xn[8];
#pragma unroll
        for (int i = 0; i < 8; ++i) xc[i] = *(const u32x4*)(xr + 32 * i);
        for (int ch = 0; ch < 4; ++ch) {
            if (ch == 0) wait_vm<0>(); else wait_vm<8>();
            LDS_WAIT();
            BAR();
            if (ch + 1 < 4) issue_chunk(ch + 1);
#pragma unroll
            for (int i = 0; i < 8; ++i) xn[i] = *(const u32x4*)(xr + 256 * ((ch + 1) & 3) + 32 * i);
            ldsp buf = lds + (ch & 1) * 65536;
#pragma unroll
            for (int sl = 0; sl < 8; ++sl) {
                const int s = 8 * ch + sl;
                const u32x4 xb = xc[sl];
                const f32x4 x0 = {bf_lo(xb.x), bf_hi(xb.x), bf_lo(xb.y), bf_hi(xb.y)}, x1 = {bf_lo(xb.z), bf_hi(xb.z), bf_lo(xb.w), bf_hi(xb.w)};
                const f32x4 g0 = *(LAS f32x4*)(Gl + 32 * s + 8 * fq), g1 = *(LAS f32x4*)(Gl + 32 * s + 8 * fq + 4), s0 = *(LAS f32x4*)(SHl + 32 * s + 8 * fq), s1 = *(LAS f32x4*)(SHl + 32 * s + 8 * fq + 4);
                const f32x4 h0 = x0 * rstd * g0 + s0, h1 = x1 * rstd * g1 + s1;
                u32x4 hi; hi.x = pk2(h0[0], h0[1]); hi.y = pk2(h0[2], h0[3]); hi.z = pk2(h1[0], h1[1]); hi.w = pk2(h1[2], h1[3]);
                *(u32x4*)(hrow + 32 * s) = hi;
                u32x4 lo; lo.x = pk2(h0[0] - bf_lo(hi.x), h0[1] - bf_hi(hi.x)); lo.y = pk2(h0[2] - bf_lo(hi.y), h0[3] - bf_hi(hi.y));
                lo.z = pk2(h1[0] - bf_lo(hi.z), h1[1] - bf_hi(hi.z)); lo.w = pk2(h1[2] - bf_lo(hi.w), h1[3] - bf_hi(hi.w));
                const bf16x8 ahi = __builtin_bit_cast(bf16x8, hi), alo = __builtin_bit_cast(bf16x8, lo);
                const int pc = (((4 * sl + fq) ^ fr) & 31) << 4;
#pragma unroll
                for (int et = 0; et < 4; ++et) {
                    const bf16x8 bh = *(LAS bf16x8*)(buf + (16 * et + fr) * 512 + pc), bl = *(LAS bf16x8*)(buf + (64 + 16 * et + fr) * 512 + pc);
                    acc[et] = __builtin_amdgcn_mfma_f32_16x16x32_bf16(ahi, bh, acc[et], 0, 0, 0);
                    acc[et] = __builtin_amdgcn_mfma_f32_16x16x32_bf16(ahi, bl, acc[et], 0, 0, 0);
                    acc[et] = __builtin_amdgcn_mfma_f32_16x16x32_bf16(alo, bh, acc[et], 0, 0, 0); }
            }
#pragma unroll
            for (int i = 0; i < 8; ++i) xc[i] = xn[i];
        }
        LDS_WAIT(); BAR();
#pragma unroll
        for (int et = 0; et < 4; ++et)
#pragma unroll
            for (int r = 0; r < 4; ++r) lg[(4 * fq + r) * 64 + 16 * et + fr] = acc[et][r];
        LDS_WAIT();
        int myc = 0;
        for (int tt = 0; tt < 16; ++tt) {
            const float logit = lg[tt * 64 + lane];
            const float score = 1.f / (1.f + __expf(-logit)), choice = score + rb;
            int rk = 0;
#pragma unroll
            for (int d = 1; d < 8; ++d) { const int oi = (lane + d) & 7; const float other = __shfl(choice, (lane & ~7) | oi); rk += (other > choice || (other == choice && oi < (lane & 7))) ? 1 : 0; }
            float gs = rk < 2 ? choice : 0.f;
            gs += __shfl_xor(gs, 1); gs += __shfl_xor(gs, 2); gs += __shfl_xor(gs, 4);
            int rg = 0;
#pragma unroll
            for (int j = 0; j < 8; ++j) { const float gj = __int_as_float(__builtin_amdgcn_readlane(__float_as_int(gs), 8 * j)); rg += (gj > gs || (gj == gs && j < (lane >> 3))) ? 1 : 0; }
            const float c2 = rg < 4 ? choice : -__builtin_inff();
            const unsigned ub = __float_as_uint(c2); unsigned key = (ub & 0x80000000u) ? ~ub : (ub | 0x80000000u); key = (key & ~63u) | (unsigned)(63 - lane);
            unsigned thr = 0u;
#pragma unroll
            for (int bit = 31; bit >= 0; --bit) { const unsigned cand = thr | (1u << bit); if (__popcll(__ballot(key >= cand)) >= 8) thr = cand; }
            const bool chosen = key >= thr;
            const unsigned long long cm = __ballot(chosen);
            const int r8 = __popcll(cm & ((1ull << lane) - 1ull));
            const float wsum = wave_sum(chosen ? score : 0.f);
            lg[tt * 64 + lane] = score / wsum * 2.5f;
            st2[tt * 64 + lane] = chosen ? ((myc << 8) | r8) : -1;
            myc += chosen ? 1 : 0;
        }
        const int chunk = (tile * 16) / CH_TOK;
        unsigned base = 0;
        if (!dry && myc > 0) base = atomicAdd(&cnt[chunk * 64 + lane], (unsigned)myc);
        if (dry) asm volatile("" :: "v"(myc));
        LDS_WAIT();
        for (int tt = 0; tt < 16; ++tt) {
            const int code = st2[tt * 64 + lane];
            if (!dry && code >= 0) { const int tok = tile * 16 + tt, r8 = code & 255; const unsigned pos = base + (unsigned)(code >> 8);
                sel_e[tok * 8 + r8] = lane; sel_w[tok * 8 + r8] = lg[tt * 64 + lane]; sel_p[tok * 8 + r8] = (int)pos;
                tokl[(size_t)(chunk * 64 + lane) * CH_TOK + pos] = tok; }
        }
        LDS_WAIT();
    }
}

__device__ __forceinline__ void build_tstart(const unsigned* cnt, int c, LAS int* ts) {
    const int l = fresh_tid();
    if (l < 64) {
        const int n = ((int)cnt[c * 64 + l] + MTILE - 1) / MTILE; int incl = n;
#pragma unroll
        for (int o = 1; o < 64; o <<= 1) { const int v = __builtin_amdgcn_ds_bpermute((l >= o ? l - o : l) << 2, incl); if (l >= o) incl += v; }
        ts[l] = incl - n; if (l == 63) { ts[64] = incl; ts[65] = incl + CH_TOK / MTILE; }
    }
}
struct MoeUpSrc {
    using Epi = EpiSwiGLU;
    const unsigned char* ws; const unsigned* cnt; int c; const LAS int* ts; int total, vcu;
    template <int LA> __device__ __forceinline__ bool setup(int i, const char*& bA, unsigned (&oA)[LA], const char*& bB, Epi& e, int& n0, int wid, int lane) const {
        const int Lt = vcu + GRID * i; if (Lt >= total) return false;
        const int mt = Lt >> 1, nt = Lt & 1;
        int ex = 0;
#pragma unroll
        for (int stp = 64; stp >= 1; stp >>= 1) if (ex + stp <= 64 && ts[ex + stp] <= mt) ex += stp;
        const int ml = mt - ts[ex];
        const bf16_t* Bt = ex < 64 ? (const bf16_t*)(ws + WS_W13) + (size_t)ex * 512 * D : (const bf16_t*)(ws + WS_WS13);
        const int* list = (const int*)(ws + WS_TOKL) + (size_t)(c * 64 + (ex & 63)) * CH_TOK; const int n = ex < 64 ? (int)cnt[c * 64 + ex] : 0;
#pragma unroll
        for (int j = 0; j < LA; ++j) { const int row = stage_row(wid, j, lane), g = ml * MTILE + row;
            const int tok = ex < 64 ? (g < n ? list[g] : c * CH_TOK) : c * CH_TOK + g;
            oA[j] = (unsigned)tok * (unsigned)(D * 2) + (unsigned)stage_chunk(row, lane); }
        bA = (const char*)(ws + WS_H); bB = (const char*)(Bt + (size_t)(nt * 256) * D);
        e = EpiSwiGLU{(bf16_t*)(ws + WS_ACT), mt * MTILE}; n0 = nt * 256; return true;
    }
    static constexpr size_t ldb = D;
};
struct MoeUpX {
    static constexpr int K = D, LDA = D; static constexpr bool GATHER = true;
    const unsigned char* ws; const unsigned* cnt; int c; const LAS int* ts; int total, vcu;
    __device__ __forceinline__ bool next(int i, pg8::UnitX& u) const {
        const int Lt = vcu + GRID * i; if (Lt >= total) return false;
        const int mt = Lt >> 1, nt = Lt & 1;
        int ex = 0;
#pragma unroll
        for (int stp = 64; stp >= 1; stp >>= 1) if (ex + stp <= 64 && ts[ex + stp] <= mt) ex += stp;
        const bf16_t* Bt = ex < 64 ? (const bf16_t*)(ws + WS_W13) + (size_t)ex * 512 * D : (const bf16_t*)(ws + WS_WS13);
        u.pm = mt; u.pn = nt; u.aBase = (const char*)(ws + WS_H); u.bBase = (const char*)(Bt + (size_t)(nt * 256) * D);
        u.list = ex < 64 ? (const int*)(ws + WS_TOKL) + (size_t)(c * 64 + ex) * CH_TOK : nullptr; u.cnt = ex < 64 ? (int)cnt[c * 64 + ex] : 0;
        u.r0 = (mt - ts[ex]) * MTILE; u.dummy = c * CH_TOK; return true;
    }
};
__device__ __forceinline__ void moe_up_phase(ldsp lds, const unsigned char* ws, const unsigned* cnt, int c, const LAS int* ts) {
    MoeUpX src{ws, cnt, c, ts, ts[65] * 2, vcu_of_block()};
    pg8::gemm_phase_x(lds, src, pg8::EpiSwiGLUx{(bf16_t*)(ws + WS_ACT)});
}
struct MoeDownSrc {
    using Epi = EpiStoreBf16;
    const unsigned char* ws; const LAS int* ts; int total, vcu;
    template <int LA> __device__ __forceinline__ bool setup(int i, const char*& bA, unsigned (&oA)[LA], const char*& bB, Epi& e, int& n0, int wid, int lane) const {
        const int Lt = vcu + GRID * i; if (Lt >= total) return false;
        const int mt = Lt >> 2, nt = Lt & 3;
        int ex = 0;
#pragma unroll
        for (int stp = 64; stp >= 1; stp >>= 1) if (ex + stp <= 64 && ts[ex + stp] <= mt) ex += stp;
        const bf16_t* act = (const bf16_t*)(ws + WS_ACT);
        const bf16_t* w2 = ex < 64 ? (const bf16_t*)(ws + WS_W2) + (size_t)ex * D * 256 : (const bf16_t*)(ws + WS_WS2);
#pragma unroll
        for (int j = 0; j < LA; ++j) { const int row = stage_row(wid, j, lane); oA[j] = (unsigned)(row * 512 + stage_chunk(row, lane)); }
        bA = (const char*)(act + (size_t)(mt * MTILE) * 256); bB = (const char*)(w2 + (size_t)(nt * 256) * 256);
        e = EpiStoreBf16{(bf16_t*)(ws + WS_YS), (size_t)D, mt * MTILE}; n0 = nt * 256; return true;
    }
    static constexpr size_t ldb = 256;
};
struct MoeDownX {
    static constexpr int K = 256, LDA = 256; static constexpr bool GATHER = false;
    const unsigned char* ws; const LAS int* ts; int total, vcu;
    __device__ __forceinline__ bool next(int i, pg8::UnitX& u) const {
        const int Lt = vcu + GRID * i; if (Lt >= total) return false;
        const int mt = Lt >> 2, nt = Lt & 3;
        int ex = 0;
#pragma unroll
        for (int stp = 64; stp >= 1; stp >>= 1) if (ex + stp <= 64 && ts[ex + stp] <= mt) ex += stp;
        const bf16_t* w2 = ex < 64 ? (const bf16_t*)(ws + WS_W2) + (size_t)ex * D * 256 : (const bf16_t*)(ws + WS_WS2);
        u.pm = mt; u.pn = nt; u.aBase = (const char*)((const bf16_t*)(ws + WS_ACT) + (size_t)(mt * MTILE) * 256); u.bBase = (const char*)(w2 + (size_t)(nt * 256) * 256);
        u.list = nullptr; u.cnt = 0; u.r0 = 0; u.dummy = 0; return true;
    }
};
__device__ __forceinline__ void moe_down_phase(ldsp lds, const unsigned char* ws, const LAS int* ts) {
    MoeDownX src{ws, ts, ts[65] * 4, vcu_of_block()};
    pg8::gemm_phase_x(lds, src, pg8::EpiYx{(unsigned char*)(ws + WS_YS)});
}
__device__ __forceinline__ void moe_combine_phase(const unsigned char* ws, float* OUT, bf16_t* XRBp, int c, const LAS int* ts, const float* gate_f  , bool last_layer,
                                                  const float* mod_sh_next, const float* mod_G_next, bf16_t* H, const float* fnorm, int gw, int ngw, int lane, bool dry) {
    const unsigned char* ys = ws + WS_YS; const int* sel_e = (const int*)(ws + WS_SELE); const float* sel_w = (const float*)(ws + WS_SELW); const int* sel_p = (const int*)(ws + WS_SELP);
    int slot[9]; float wk[9];
    auto selload = [&](int tl, int (&sl)[9], float (&ww)[9]) { const int tok = c * CH_TOK + tl;
#pragma unroll
        for (int k = 0; k < 8; ++k) { const int e = sel_e[tok * 8 + k]; sl[k] = ts[e] * MTILE + sel_p[tok * 8 + k]; ww[k] = sel_w[tok * 8 + k]; }
        sl[8] = ts[64] * MTILE + tl; ww[8] = 1.f; };
    if (gw < CH_TOK) selload(gw, slot, wk);
    for (int tl = gw; tl < CH_TOK; tl += ngw) {
        const int tok = c * CH_TOK + tl; const int b = tok >> 11;
        u32x2 yv[9][2];
#pragma unroll
        for (int k = 0; k < 9; ++k) { const unsigned char* yr = ys + (size_t)slot[k] * D; yv[k][0] = *(const u32x2*)(yr + 8 * lane); yv[k][1] = *(const u32x2*)(yr + 8 * lane + 512); }
        int nslot[9]; float nwk[9];
        if (tl + ngw < CH_TOK) selload(tl + ngw, nslot, nwk);
        else {
#pragma unroll
            for (int k = 0; k < 9; ++k) { nslot[k] = 0; nwk[k] = 0.f; } }
        float acc[16];
#pragma unroll
        for (int i = 0; i < 16; ++i) acc[i] = 0.f;
#pragma unroll
        for (int k = 0; k < 9; ++k) { const float w = wk[k];
#pragma unroll
            for (int j = 0; j < 2; ++j) { const u32x2 v = yv[k][j];
                const f32x2 p0 = __builtin_amdgcn_cvt_pk_f32_fp8((int)v.x, false), p1 = __builtin_amdgcn_cvt_pk_f32_fp8((int)v.x, true);
                const f32x2 p2 = __builtin_amdgcn_cvt_pk_f32_fp8((int)v.y, false), p3 = __builtin_amdgcn_cvt_pk_f32_fp8((int)v.y, true);
                acc[8 * j + 0] += w * p0[0]; acc[8 * j + 1] += w * p0[1]; acc[8 * j + 2] += w * p1[0]; acc[8 * j + 3] += w * p1[1];
                acc[8 * j + 4] += w * p2[0]; acc[8 * j + 5] += w * p2[1]; acc[8 * j + 6] += w * p3[0]; acc[8 * j + 7] += w * p3[1]; } }
#pragma unroll
        for (int k = 0; k < 9; ++k) { slot[k] = nslot[k]; wk[k] = nwk[k]; }
        float* xr = OUT + (size_t)tok * D; bf16_t* xb = XRBp + (size_t)tok * XRB_LD + XRB_OFF; const float* gf = gate_f + (size_t)b * 6144; float ss = 0.f; float xn[16];
#pragma unroll
        for (int j = 0; j < 2; ++j) { const u32x4 xw = *(const u32x4*)(xb + 8 * lane + 512 * j);
            const float xf[8] = {bf_lo(xw.x), bf_hi(xw.x), bf_lo(xw.y), bf_hi(xw.y), bf_lo(xw.z), bf_hi(xw.z), bf_lo(xw.w), bf_hi(xw.w)};
#pragma unroll
            for (int q = 0; q < 2; ++q) { const int col = 8 * lane + 512 * j + 4 * q; const f32x4 gv = *(const f32x4*)(gf + col);
#pragma unroll
                for (int e = 0; e < 4; ++e) { const float v = xf[4 * q + e] + gv[e] * acc[8 * j + 4 * q + e]; xn[8 * j + 4 * q + e] = v; ss += v * v; } } }
        const float rstd = rsqrtf(wave_sum(ss) * (1.f / D) + 1e-6f);
        if (last_layer) {
#pragma unroll
            for (int j = 0; j < 2; ++j)
#pragma unroll
                for (int q = 0; q < 2; ++q) { const int col = 8 * lane + 512 * j + 4 * q; const f32x4 g = *(const f32x4*)(fnorm + col); f32x4 ov;
#pragma unroll
                    for (int e = 0; e < 4; ++e) ov[e] = xn[8 * j + 4 * q + e] * rstd * g[e];
                    if (!dry) *(f32x4*)(xr + col) = ov; else asm volatile("" :: "v"(ov)); }
        } else {
            const float* sh = mod_sh_next + (size_t)b * 6144; const float* Gn = mod_G_next + (size_t)b * 6144; bf16_t* hrow = H + (size_t)tok * D;
#pragma unroll
            for (int j = 0; j < 2; ++j) { u32x4 hw, xw2;
#pragma unroll
                for (int q = 0; q < 2; ++q) { const int col = 8 * lane + 512 * j + 4 * q; const f32x4 g = *(const f32x4*)(Gn + col), s0 = *(const f32x4*)(sh + col); f32x4 xv, hv;
#pragma unroll
                    for (int e = 0; e < 4; ++e) { xv[e] = xn[8 * j + 4 * q + e]; hv[e] = xv[e] * rstd * g[e] + s0[e]; }
                    if (q == 0) { hw.x = pk2(hv[0], hv[1]); hw.y = pk2(hv[2], hv[3]); xw2.x = pk2(xv[0], xv[1]); xw2.y = pk2(xv[2], xv[3]); }
                    else { hw.z = pk2(hv[0], hv[1]); hw.w = pk2(hv[2], hv[3]); xw2.z = pk2(xv[0], xv[1]); xw2.w = pk2(xv[2], xv[3]); } }
                if (!dry) { *(u32x4*)(hrow + 8 * lane + 512 * j) = hw; *(u32x4*)(xb + 8 * lane + 512 * j) = xw2; } else asm volatile("" :: "v"(hw), "v"(xw2)); }
        }
    }
}

struct PSrc {
    using Epi = EpiCausalP;
    const bf16_t* rp; bf16_t* P;
    template <int LA> __device__ __forceinline__ bool setup(int i, const char*& bA, unsigned (&oA)[LA], const char*& bB, Epi& e, int& n0, int wid, int lane) const {
        const int u = blockIdx.x + GRID * i; if (u >= 1024) return false;
        const int bh = u >> 4, c = u & 15, b = bh >> 2, h = bh & 3;
        const bf16_t* qa = rp + ((size_t)b * SEQ + c * 128) * 6144 + h * 256;
#pragma unroll
        for (int j = 0; j < LA; ++j) { const int row = stage_row(wid, j, lane); oA[j] = (unsigned)(row * 6144 * 2 + stage_chunk(row, lane)); }
        bA = (const char*)qa; bB = (const char*)(qa + 1024);
        e = EpiCausalP{P + (size_t)u * 16384}; n0 = 0; return true;
    }
    static constexpr size_t ldb = 6144;
};
#define TIC(cat) do { if (TIME_SEL >= 0 && blockIdx.x == 0 && threadIdx.x == 0) { const unsigned long long now_ = __builtin_amdgcn_s_memrealtime(); LAS unsigned long long* tb_ = (LAS unsigned long long*)(lds + LDS_MISC + 1024); if ((cat) == TIME_SEL) tb_[1] += now_ - tb_[0]; tb_[0] = now_; } } while (0)
#define FRESH_IDS() const int t_ = fresh_tid(); const int lane = t_ & 63, wave = __builtin_amdgcn_readfirstlane(t_ >> 6); const int gw = blockIdx.x * NWAVE + wave, ngw = GRID * NWAVE; (void)lane; (void)gw; (void)ngw
#define SEAM(cat) do { xcd_barrier(bar); TIC(cat); } while (0)
#define OUTPROJ_ROUTER(layer_, A_, lda_, Bt_, ldb_, K_, mk_, cat_) do { \
    pg8::dense(lds, A_, (int)(lda_), Bt_, T, D, K_, mk_); \
    SEAM(cat_); \
    { const float* modl_ = (const float*)(ws + WS_MOD) + (size_t)(layer_) * 16 * 6144; const int m0_ = vcu_of_block() * 128; FRESH_IDS(); \
      router_phase(lds, XRB, modl_ + 3072, modl_ + 4096, (const bf16_t*)(ws + WS_RWT) + (size_t)(layer_) * 2 * 64 * 1024, a.in[I_ROUTB] + (layer_) * 64, \
                   (bf16_t*)(ws + WS_H), (int*)(ws + WS_SELE), (float*)(ws + WS_SELW), (int*)(ws + WS_SELP), (int*)(ws + WS_TOKL), (unsigned*)(ws + WS_CNT) + (layer_) * 256, \
                   m0_ / 16 + wave, m0_ / 16 + wave + 1, 1, wave, lane, false); } \
  } while (0)
__device__ __forceinline__ void moe_layer(const Args& a, ldsp lds, const XcdBarrier& bar, int layer) {
    unsigned char* ws = a.ws;
    float* mod = (float*)(ws + WS_MOD); float* XR = a.out; bf16_t* XRB = (bf16_t*)a.out; bf16_t* H = (bf16_t*)(ws + WS_H);
    const float* modl = mod + (size_t)layer * 16 * 6144;
    const float* modn = mod + (size_t)16 * 6144;
    unsigned* cl = (unsigned*)(ws + WS_CNT) + layer * 256;
    LAS int* ts0 = (LAS int*)(lds + LDS_MISC); LAS int* ts1 = ts0 + 80;
    for (int c = 0; c <= NCHUNK; ++c) {
        __syncthreads();
        if (c < NCHUNK) build_tstart(cl, c, ts0);
        if (c > 0) build_tstart(cl, c - 1, ts1);
        __syncthreads();
        const bool comb_first = (blockIdx.x & 8) != 0;
        if (c > 0 && comb_first) { FRESH_IDS(); moe_combine_phase(ws, XR, XRB, c - 1, ts1, modl + 5120, layer == 1, modn, modn + 1024, H, a.in[I_FNORM], gw, ngw, lane, false); }
        if (c < NCHUNK) moe_up_phase(lds, ws, cl, c, ts0);
        if (c > 0 && !comb_first) { FRESH_IDS(); moe_combine_phase(ws, XR, XRB, c - 1, ts1, modl + 5120, layer == 1, modn, modn + 1024, H, a.in[I_FNORM], gw, ngw, lane, false); }
        if (c == NCHUNK) break;
        SEAM(6);
        moe_down_phase(lds, ws, ts0);
        SEAM(7);
    }
}
__global__ void __launch_bounds__(NTHR, 2) fwd_kernel(Args a) {
    extern __shared__ __attribute__((aligned(16))) unsigned char lds_raw[];
    ldsp lds = (ldsp)lds_raw;
    unsigned char* ws = a.ws;
    volatile LAS unsigned* st = (volatile LAS unsigned*)(lds + LDS_BYTES - 16);
    if (threadIdx.x < 4) st[threadIdx.x] = 0u;
    if (TIME_SEL >= 0 && threadIdx.x == 0) { LAS unsigned long long* tb_ = (LAS unsigned long long*)(lds + LDS_MISC + 1024); tb_[0] = __builtin_amdgcn_s_memrealtime(); tb_[1] = 0ull; }
    __syncthreads();
    XcdBarrier bar = xcd_barrier_post((unsigned*)(ws + WS_BAR), st);
    float* mod = (float*)(ws + WS_MOD);
    float* XR = a.out; bf16_t* XRB = (bf16_t*)a.out;
    bf16_t* H = (bf16_t*)(ws + WS_H);

    mod_items(a, lds);
    __syncthreads();
    { FRESH_IDS(); convert_dense_weights(a, lds, gw, ngw, wave, lane); }
    SEAM(0);
    { FRESH_IDS(); adaln_phase(a.in[I_X], mod, mod + 1024, H, gw, ngw, lane); }
    { FRESH_IDS();
      bf16_t* rwt = (bf16_t*)(ws + WS_RWT);
      for (int idx = blockIdx.x * NTHR + t_; idx < 2 * D * 64; idx += GRID * NTHR) { const int l2 = idx >> 16, k = (idx >> 6) & 1023, e = idx & 63;
          const float w = a.in[I_ROUTW][idx]; const unsigned hi = pk2(w, 0.f) & 0xffffu; const unsigned lo = pk2(w - bf_lo(hi), 0.f) & 0xffffu;
          rwt[((size_t)(l2 * 2 + 0) * 64 + e) * 1024 + k] = (bf16_t)hi; rwt[((size_t)(l2 * 2 + 1) * 64 + e) * 1024 + k] = (bf16_t)lo; } }
    SEAM(1);

    { const bool conv_first = (blockIdx.x & 8) != 0;
      if (conv_first) { FRESH_IDS(); convert_expert_weights(a, 0, lds, gw, ngw, wave, lane); __syncthreads(); }
      pg8::dense(lds, H, D, (const bf16_t*)(ws + WS_WQKV), T, 3072, D, pg8::EpiBf16{(bf16_t*)(ws + WS_QKV), (size_t)3072});
      if (!conv_first) { __syncthreads(); FRESH_IDS(); convert_expert_weights(a, 0, lds, gw, ngw, wave, lane); } }
    SEAM(2);
    { float d1 = 0.f, d2 = 0.f;
      for (int i = 0; i < 64; ++i) { d1 += a.in[I_LQ1][i] * a.in[I_LK1][i]; d2 += a.in[I_LQ2][i] * a.in[I_LK2][i]; }
      const float lam = __expf(d1) - __expf(d2) + 0.2f;
      attn_phase(lds, (const bf16_t*)(ws + WS_QKV), (bf16_t*)(ws + WS_AO), lam, a.in[I_SUBLN]); }
    SEAM(3);
    { const pg8::EpiRes<true> mk{a.in[I_X], XRB, mod + 2048};
      OUTPROJ_ROUTER(0, (const bf16_t*)(ws + WS_AO), D, (const bf16_t*)(ws + WS_WO), D, D, mk, 4); }
    SEAM(5);
    moe_layer(a, lds, bar, 0);
    SEAM(6);

    const float* mod1 = mod + (size_t)16 * 6144;
    { const bool conv_first = (blockIdx.x & 8) != 0;
      if (conv_first) { FRESH_IDS(); convert_expert_weights(a, 1, lds, gw, ngw, wave, lane); __syncthreads(); }
      pg8::dense(lds, H, D, (const bf16_t*)(ws + WS_WRI), T, 6144, D, pg8::EpiRet{(bf16_t*)(ws + WS_RP)});
      if (!conv_first) { __syncthreads(); FRESH_IDS(); convert_expert_weights(a, 1, lds, gw, ngw, wave, lane); } }
    SEAM(8);
    { PSrc src{(const bf16_t*)(ws + WS_RP), (bf16_t*)(ws + WS_P)};
      gemm_stream<2, 4, 4, 2, 3>(lds, 256, src); }
    SEAM(9);
    chain_phase(lds, (bf16_t*)(ws + WS_RP), (const bf16_t*)(ws + WS_P), false);
    SEAM(10);
    { FRESH_IDS(); gnorm_phase((bf16_t*)(ws + WS_RP), a.in[I_RGN], gw, ngw, lane, false); }
    SEAM(11);
    { const pg8::EpiRes<false> mk{XRB, XRB, mod1 + 2048};
      OUTPROJ_ROUTER(1, (const bf16_t*)(ws + WS_RP) + 2048, 6144, (const bf16_t*)(ws + WS_WRO), 2048, 2048, mk, 12); }
    SEAM(5);
    moe_layer(a, lds, bar, 1);
    if (TIME_SEL >= 0) {
        __syncthreads(); TIC(6);
        if (blockIdx.x == 0 && threadIdx.x == 0) { LAS unsigned long long* tb_ = (LAS unsigned long long*)(lds + LDS_MISC + 1024); const unsigned long long t0 = __builtin_amdgcn_s_memrealtime();
            while (__builtin_amdgcn_s_memrealtime() - t0 < tb_[1]) __builtin_amdgcn_s_sleep(8); }
    }
}

extern "C" void kernel_launch(void* const* d_in, const int* in_sizes, int n_in, void* d_out, int out_size, void* d_ws, size_t ws_size, hipStream_t stream) {
    static int ready = 0;
    if (ready == 0) {
        if (n_in != 25 || out_size != T * D || ws_size < WS_END) { fprintf(stderr, "kernel_launch: unexpected shapes (n_in %d out %d ws %zu need %zu)\n", n_in, out_size, ws_size, (size_t)WS_END); ready = -1; return; }
        (void)hipFuncSetAttribute((const void*)fwd_kernel, hipFuncAttributeMaxDynamicSharedMemorySize, LDS_BYTES);
        ready = 1;
    }
    if (ready < 0) return;
    (void)hipMemsetAsync(d_ws, 0, 65536, stream);
    Args a{};
    for (int i = 0; i < 25; ++i) a.in[i] = (const float*)d_in[i];
    a.out = (float*)d_out; a.ws = (unsigned char*)d_ws;
    hipLaunchKernelGGL(fwd_kernel, dim3(GRID), dim3(NTHR), LDS_BYTES, stream, a);
}
```

```cpp
#include <hip/hip_runtime.h>
#include <cstdio>
#include <cstdint>
#include <type_traits>

typedef unsigned short bf16_t;
typedef short bf16x8 __attribute__((ext_vector_type(8)));
typedef short bf16x4 __attribute__((ext_vector_type(4)));
typedef float f32x4 __attribute__((ext_vector_type(4)));
typedef float f32x2 __attribute__((ext_vector_type(2)));
typedef unsigned u32x4 __attribute__((ext_vector_type(4)));
typedef unsigned u32x2 __attribute__((ext_vector_type(2)));
#define LAS __attribute__((address_space(3)))
typedef LAS unsigned char* ldsp;

constexpr int T = 32768, D = 1024, NB = 16, SEQ = 2048;
constexpr int NTHR = 512, NWAVE = 8, GRID = 256;
constexpr int CH_TOK = 16384, NCHUNK = 2, MTILE = 256;
constexpr int SLOT_CAP = 163840;
constexpr float LOG2E = 1.4426950408889634f;
constexpr int XRB_LD = 2048, XRB_OFF = 1024;
#define TIME_SEL -1


constexpr size_t MiB = 1u << 20;
constexpr size_t WS_BAR = 0, WS_CNT = 16384, WS_RWT = 256 * 1024  , WS_MOD = 1 * MiB;
constexpr size_t WS_WQKV = 2 * MiB, WS_WO = 8 * MiB, WS_WRI = 10 * MiB, WS_WRO = 22 * MiB;
constexpr size_t WS_W13 = 26 * MiB, WS_W2 = 90 * MiB, WS_WS13 = 122 * MiB, WS_WS2 = 123 * MiB;
constexpr size_t WS_H = 124 * MiB, WS_P = WS_H;
constexpr size_t WS_BIG = 188 * MiB;
constexpr size_t WS_QKV = WS_BIG, WS_AO = WS_BIG + 192 * MiB;
constexpr size_t WS_RP = WS_BIG;
constexpr size_t WS_SELE = WS_BIG, WS_SELW = WS_BIG + 1 * MiB, WS_SELP = WS_BIG + 2 * MiB, WS_TOKL = WS_BIG + 4 * MiB;
constexpr size_t WS_ACT = WS_BIG + 12 * MiB  , WS_YS = WS_BIG + 92 * MiB  ;
constexpr size_t WS_END = WS_BIG + 412 * MiB;
constexpr int LDS_BYTES = 152 * 1024, LDS_MISC = 144 * 1024;

#define XB_TMO      128
#define XB_XCNT(j)  (256  + 64 * (j))
#define XB_XSUB(j)  (1280 + 64 * (j))
#define XB_XGEN(j)  (2304 + 64 * (j))
#define XB_TOP      3328
#define XB_TOPGEN   3392
#define XCD_BAR_WORDS 3456
#define XB_SPIN_CAP (1u << 20)
__device__ __forceinline__ unsigned xb_ld(unsigned* p)              { return __hip_atomic_load(p, __ATOMIC_RELAXED, __HIP_MEMORY_SCOPE_AGENT); }
__device__ __forceinline__ unsigned xb_add(unsigned* p, unsigned v) { return __hip_atomic_fetch_add(p, v, __ATOMIC_RELAXED, __HIP_MEMORY_SCOPE_AGENT); }
__device__ __forceinline__ unsigned xb_xcc_id() { return (unsigned)__builtin_amdgcn_s_getreg((3 << 11) | 20) & 0xFu; }
#define XB_SPIN(cond, bar) do { unsigned _sp = 0; while (cond) { __builtin_amdgcn_s_sleep(1); \
    if ((++_sp & 255u) == 0u) { if (xb_ld(&(bar)[XB_TMO])) break; if (_sp > XB_SPIN_CAP) { atomicAdd(&(bar)[XB_TMO], 1u); break; } } } } while (0)
struct XcdBarrier { unsigned* bar; unsigned x; volatile LAS unsigned* st; };
__device__ __forceinline__ XcdBarrier xcd_barrier_post(unsigned* bar, volatile LAS unsigned* st) {
    XcdBarrier b; b.bar = bar; b.x = xb_xcc_id(); b.st = st;
    if (threadIdx.x == 0) (void)xb_add(&bar[XB_XCNT(b.x)], 1u);
    return b;
}
__device__ __forceinline__ void xcd_barrier_complete(unsigned* bar, unsigned x, unsigned& nloc, unsigned& nx) {
    const unsigned G = gridDim.x * gridDim.y * gridDim.z;
    unsigned sum, cnt, mine, sp = 0u;
    for (;;) {
        sum = 0u; cnt = 0u; mine = 0u;
#pragma unroll
        for (unsigned j = 0; j < 16; ++j) { const unsigned c = xb_ld(&bar[XB_XCNT(j)]); sum += c; cnt += (c > 0u) ? 1u : 0u; mine = (j == x) ? c : mine; }
        if (sum == G) break;
        __builtin_amdgcn_s_sleep(1);
        if ((++sp & 255u) == 0u) { if (xb_ld(&bar[XB_TMO])) break; if (sp > XB_SPIN_CAP) { atomicAdd(&bar[XB_TMO], 1u); break; } }
    }
    nloc = mine > 0u ? mine : 1u; nx = cnt > 0u ? cnt : 1u;
}
__device__ __forceinline__ void xcd_barrier(const XcdBarrier& b) {
    asm volatile("s_waitcnt vmcnt(0)" ::: "memory");
    __syncthreads();
    if (threadIdx.x == 0) {
        unsigned* bar = b.bar; unsigned bx = b.x;
        asm volatile("" : "+s"(bar), "+s"(bx));
        __builtin_amdgcn_s_waitcnt(0);
        unsigned nloc = b.st[0], nx = b.st[1];
        if (nloc == 0u) { xcd_barrier_complete(bar, bx, nloc, nx); b.st[0] = nloc; b.st[1] = nx; }
        const unsigned old = xb_add(&bar[XB_XSUB(bx)], 1u);
        const unsigned gen = old / nloc;
        if (old + 1u == (gen + 1u) * nloc) {
            __builtin_amdgcn_fence(__ATOMIC_RELEASE, "agent");
            asm volatile("s_waitcnt vmcnt(0)" ::: "memory");
            const unsigned og = xb_add(&bar[XB_TOP], 1u);
            const unsigned tg = og / nx;
            if (og + 1u == (tg + 1u) * nx) xb_add(&bar[XB_TOPGEN], 1u);
            else XB_SPIN(xb_ld(&bar[XB_TOPGEN]) == tg, bar);
            __builtin_amdgcn_fence(__ATOMIC_ACQUIRE, "agent");
            xb_add(&bar[XB_XGEN(bx)], 1u);
            asm volatile("s_waitcnt vmcnt(0)" ::: "memory");
        } else {
            XB_SPIN(xb_ld(&bar[XB_XGEN(bx)]) == gen, bar);
            __builtin_amdgcn_fence(__ATOMIC_ACQUIRE, "agent");
            asm volatile("s_waitcnt vmcnt(0)" ::: "memory");
        }
    }
    __syncthreads();
}

template <int N> __device__ __forceinline__ void wait_vm() { asm volatile("s_waitcnt vmcnt(%0)" :: "n"(N) : "memory"); }
#define BAR() __builtin_amdgcn_s_barrier()
#define LDS_WAIT() asm volatile("s_waitcnt lgkmcnt(0)" ::: "memory")
__device__ __forceinline__ unsigned pk2(float a, float b) {
    typedef __bf16 bf2 __attribute__((ext_vector_type(2)));
    f32x2 v = {a, b}; bf2 r = __builtin_convertvector(v, bf2); return __builtin_bit_cast(unsigned, r);
}
__device__ __forceinline__ float bf_lo(unsigned u) { return __uint_as_float(u << 16); }
__device__ __forceinline__ float bf_hi(unsigned u) { return __uint_as_float(u & 0xffff0000u); }
__device__ __forceinline__ float wave_sum(float v) {
#pragma unroll
    for (int o = 1; o < 64; o <<= 1) v += __shfl_xor(v, o);
    return v;
}
__device__ __forceinline__ float fast_exp2(float x) { return __builtin_amdgcn_exp2f(x); }
__device__ __forceinline__ float silu_f(float v) { return v / (1.f + __expf(-v)); }
__device__ __forceinline__ void glds16(const void* src, ldsp dst) {
    unsigned keep; const unsigned d = (unsigned)(__SIZE_TYPE__)dst;
    asm volatile("s_mov_b32 %0, m0\n\ts_mov_b32 m0, %2\n\ts_nop 0\n\tglobal_load_lds_dwordx4 %1, off\n\ts_mov_b32 m0, %0" : "=&s"(keep) : "v"(src), "s"(d) : "memory");
}
__device__ __forceinline__ bf16x8 tr2(ldsp a0, ldsp a1) {
    const bf16x4 t0 = __builtin_amdgcn_ds_read_tr16_b64_v4i16((LAS bf16x4*)a0);
    const bf16x4 t1 = __builtin_amdgcn_ds_read_tr16_b64_v4i16((LAS bf16x4*)a1);
    return __builtin_shufflevector(t0, t1, 0, 1, 2, 3, 4, 5, 6, 7);
}
__device__ __forceinline__ bf16x8 rd2x64(ldsp a0, ldsp a1) {
    const bf16x4 t0 = *(LAS bf16x4*)a0; const bf16x4 t1 = *(LAS bf16x4*)a1;
    return __builtin_shufflevector(t0, t1, 0, 1, 2, 3, 4, 5, 6, 7);
}
__device__ __forceinline__ int fresh_tid() { int t = threadIdx.x; asm volatile("" : "+v"(t)); return t; }
__device__ __forceinline__ int vcu_of_block() { const int bx = blockIdx.x; return (bx & 7) * (GRID / 8) + (bx >> 3); }

struct Args {
    const float* in[25];
    float* out; unsigned char* ws;
};
enum { I_X = 0, I_C, I_NMIX, I_NFFN, I_ADAW, I_ADAB, I_DAWIN, I_DAWOUT, I_LQ1, I_LK1, I_LQ2, I_LK2, I_SUBLN, I_RWIN, I_RWOUT, I_RGN,
       I_ROUTW, I_ROUTB, I_EW1, I_EW3, I_EW2, I_SW1, I_SW3, I_SW2, I_FNORM };

template <int WM, int WN, int MT, int NT, int NSTAGE, class Src>
__device__ __forceinline__ void gemm_stream(ldsp lds, int K, const Src& src) {
    constexpr int BM = WM * MT * 16, BN = WN * NT * 16, STAGE = (BM + BN) * 128, LA = BM / 64, LB = BN / 64, L = LA + LB, PD = NSTAGE - 1;
    static_assert(WM * WN == NWAVE && NSTAGE * STAGE <= LDS_MISC, "8 waves; ring fits");
    const int tid = fresh_tid(), lane = tid & 63, wid = __builtin_amdgcn_readfirstlane(tid >> 6);
    const int wr = wid / WN, wc = wid % WN, fr = lane & 15, fq = lane >> 4;
    const char* cbA; const char* cbB; const char* nbA; const char* nbB; unsigned cA[LA], nA[LA], oB[LB];
    typename Src::Epi ce, ne; int cn0 = 0, nn0 = 0;
    if (!src.template setup<LA>(0, cbA, cA, cbB, ce, cn0, wid, lane)) return;
#pragma unroll
    for (int j = 0; j < LB; ++j) { const int row = 8 * (wid + 8 * j) + (lane >> 3); oB[j] = (unsigned)(row * (int)src.ldb * 2 + (((lane & 7) ^ ((row >> 1) & 7)) << 4)); }
    const int swz = fr >> 1;
    const int aoff = (wr * MT * 16 + fr) * 128, boff = BM * 128 + (wc * NT * 16 + fr) * 128;
    const int ok0 = ((fq ^ swz) << 4), ok1 = (((4 + fq) ^ swz) << 4);
    auto issue = [&](int s, const char* bA, const unsigned (&oA)[LA], const char* bB, int t) {
        ldsp st = lds + s * STAGE;
#pragma unroll
        for (int j = 0; j < LA; ++j) glds16(bA + (size_t)t * 128 + oA[j], st + (wid + 8 * j) * 1024);
#pragma unroll
        for (int j = 0; j < LB; ++j) glds16(bB + (size_t)t * 128 + oB[j], st + BM * 128 + (wid + 8 * j) * 1024);
    };
    const int nt = K / 64;
    BAR();
#pragma unroll
    for (int d = 0; d < PD; ++d) issue(d, cbA, cA, cbB, d);
    int s = 0;
    for (int i = 0;; ++i) {
        const bool hasn = src.template setup<LA>(i + 1, nbA, nA, nbB, ne, nn0, wid, lane);
        f32x4 acc[MT][NT];
#pragma unroll
        for (int m = 0; m < MT; ++m)
#pragma unroll
            for (int n = 0; n < NT; ++n) acc[m][n] = (f32x4){0.f, 0.f, 0.f, 0.f};
        for (int t = 0; t < nt; ++t) {
            if (PD >= 2 && (hasn || t + 1 < nt)) wait_vm<(PD - 1) * L>(); else wait_vm<0>();
            BAR();
            { int s2 = s + PD; if (s2 >= NSTAGE) s2 -= NSTAGE;
              if (t + PD < nt) issue(s2, cbA, cA, cbB, t + PD); else if (hasn) issue(s2, nbA, nA, nbB, t + PD - nt); }
            ldsp st = lds + s * STAGE;
#pragma unroll
            for (int kk = 0; kk < 2; ++kk) {
                bf16x8 b[NT];
                const int ok = kk ? ok1 : ok0;
#pragma unroll
                for (int n = 0; n < NT; ++n) b[n] = *(LAS bf16x8*)(st + boff + n * 2048 + ok);
#pragma unroll
                for (int mh = 0; mh < MT; mh += 4) {
                    bf16x8 a[4];
#pragma unroll
                    for (int m = 0; m < 4; ++m) a[m] = *(LAS bf16x8*)(st + aoff + (mh + m) * 2048 + ok);
                    __builtin_amdgcn_s_setprio(1);
#pragma unroll
                    for (int m = 0; m < 4; ++m)
#pragma unroll
                        for (int n = 0; n < NT; ++n) acc[mh + m][n] = __builtin_amdgcn_mfma_f32_16x16x32_bf16(b[n], a[m], acc[mh + m][n], 0, 0, 0);
                    __builtin_amdgcn_s_setprio(0);
                    if (MT > 4) __builtin_amdgcn_sched_barrier(0);
                }
            }
            s = (s == NSTAGE - 1) ? 0 : s + 1;
        }
        ce(acc, wr * MT * 16, cn0 + wc * NT * 16, fr, fq);
        if (!hasn) break;
#pragma unroll
        for (int j = 0; j < LA; ++j) cA[j] = nA[j];
        cbA = nbA; cbB = nbB; ce = ne; cn0 = nn0;
    }
}
__device__ __forceinline__ int stage_row(int wid, int j, int lane) { return 8 * (wid + 8 * j) + (lane >> 3); }
__device__ __forceinline__ int stage_chunk(int row, int lane) { return ((lane & 7) ^ ((row >> 1) & 7)) * 16; }
__device__ __forceinline__ const char* uniform_ptr(const void* p) { unsigned long long v = (unsigned long long)p; const unsigned lo = __builtin_amdgcn_readfirstlane((unsigned)v), hi = __builtin_amdgcn_readfirstlane((unsigned)(v >> 32)); return (const char*)(((unsigned long long)hi << 32) | lo); }

template <int BM, int BN, class Mk> struct DenseSrc {
    using Epi = decltype(((Mk*)nullptr)->operator()(0));
    const bf16_t* A; size_t lda; const bf16_t* Bt; size_t ldb; int nN, per_x, xcd, local; const Mk& mk;
    __device__ __forceinline__ DenseSrc(const bf16_t* A_, size_t lda_, const bf16_t* Bt_, size_t ldb_, int M, int N, const Mk& mk_) : A(A_), lda(lda_), Bt(Bt_), ldb(ldb_), mk(mk_) {
        const int vcu = vcu_of_block(); nN = N / BN; per_x = (M / BM) / 8; xcd = vcu >> 5; local = vcu & 31; }
    template <int LA> __device__ __forceinline__ bool setup(int i, const char*& bA, unsigned (&oA)[LA], const char*& bB, Epi& e, int& n0, int wid, int lane) const {
        constexpr int GM = 4;
        const int q = local + 32 * i; if (q >= per_x * nN) return false;
        const int grp = q / (GM * nN), r = q % (GM * nN), m = xcd * per_x + grp * GM + (r % GM), n = r / GM;
#pragma unroll
        for (int j = 0; j < LA; ++j) { const int row = stage_row(wid, j, lane); oA[j] = (unsigned)(row * (int)lda * 2 + stage_chunk(row, lane)); }
        bA = (const char*)(A + (size_t)(m * BM) * lda); bB = (const char*)(Bt + (size_t)(n * BN) * ldb);
        e = mk(m * BM); n0 = n * BN; return true;
    }
};
template <int WM, int WN, int MT, int NT, int NSTAGE, class Mk>
__device__ __forceinline__ void gemm_dense_phase(ldsp lds, const bf16_t* A, size_t lda, const bf16_t* Bt, size_t ldb, int M, int N, int K, const Mk& mk) {
    DenseSrc<WM * MT * 16, WN * NT * 16, Mk> src(A, lda, Bt, ldb, M, N, mk);
    gemm_stream<WM, WN, MT, NT, NSTAGE>(lds, K, src);
}

struct EpiStoreBf16 {
    bf16_t* O; size_t ldc; int m0;
    template <int MT, int NT> __device__ __forceinline__ void operator()(const f32x4 (&acc)[MT][NT], int rb, int cb, int fr, int fq) const {
#pragma unroll
        for (int m = 0; m < MT; ++m) { bf16_t* rp = O + (size_t)(m0 + rb + m * 16 + fr) * ldc + cb + 4 * fq;
#pragma unroll
            for (int n = 0; n < NT; ++n) { u32x2 w; w.x = pk2(acc[m][n][0], acc[m][n][1]); w.y = pk2(acc[m][n][2], acc[m][n][3]); *(u32x2*)(rp + n * 16) = w; } }
    }
};
struct EpiResidual {
    const float* Xin; float* Xout; const float* gate; int m0;
    template <int MT, int NT> __device__ __forceinline__ void operator()(const f32x4 (&acc)[MT][NT], int rb, int cb, int fr, int fq) const {
#pragma unroll
        for (int m = 0; m < MT; ++m) { const int row = m0 + rb + m * 16 + fr; const float* g = gate + (size_t)(row >> 11) * 6144;
#pragma unroll
            for (int n = 0; n < NT; ++n) { const int col = cb + n * 16 + 4 * fq; const f32x4 xv = *(const f32x4*)(Xin + (size_t)row * D + col); const f32x4 gv = *(const f32x4*)(g + col);
                *(f32x4*)(Xout + (size_t)row * D + col) = xv + gv * acc[m][n]; } }
    }
};
struct EpiRetProj {
    bf16_t* O; int m0;
    template <int MT, int NT> __device__ __forceinline__ void operator()(const f32x4 (&acc)[MT][NT], int rb, int cb, int fr, int fq) const {
        float l2g = 0.f, pre = 1.f;
        if (cb < 2048) { const int h = (cb & 1023) >> 8; l2g = __log2f(1.f - exp2f(-5.f - (float)h)); if (cb >= 1024) { l2g = -l2g; pre = 0.0625f; } }
#pragma unroll
        for (int m = 0; m < MT; ++m) { const int row = m0 + rb + m * 16 + fr; const float sc = pre * exp2f(l2g * (float)(row & 127)); bf16_t* rp = O + (size_t)row * 6144 + cb + 4 * fq;
#pragma unroll
            for (int n = 0; n < NT; ++n) { u32x2 w; w.x = pk2(acc[m][n][0] * sc, acc[m][n][1] * sc); w.y = pk2(acc[m][n][2] * sc, acc[m][n][3] * sc); *(u32x2*)(rp + n * 16) = w; } }
    }
};
struct EpiCausalP {
    bf16_t* O;
    template <int MT, int NT> __device__ __forceinline__ void operator()(const f32x4 (&acc)[MT][NT], int rb, int cb, int fr, int fq) const {
#pragma unroll
        for (int m = 0; m < MT; ++m) { const int i = rb + m * 16 + fr; bf16_t* rp = O + (size_t)i * 128 + cb + 4 * fq;
#pragma unroll
            for (int n = 0; n < NT; ++n) { const int j = cb + n * 16 + 4 * fq; f32x4 v = acc[m][n];
                v[0] = (i >= j) ? v[0] : 0.f; v[1] = (i >= j + 1) ? v[1] : 0.f; v[2] = (i >= j + 2) ? v[2] : 0.f; v[3] = (i >= j + 3) ? v[3] : 0.f;
                u32x2 w; w.x = pk2(v[0], v[1]); w.y = pk2(v[2], v[3]); *(u32x2*)(rp + n * 16) = w; } }
    }
};
struct EpiSwiGLU {
    bf16_t* O; int slot0;
    template <int MT, int NT> __device__ __forceinline__ void operator()(const f32x4 (&acc)[MT][NT], int rb, int cb, int fr, int fq) const {
        static_assert(NT == 4, "NT");
#pragma unroll
        for (int m = 0; m < MT; ++m) { bf16_t* rp = O + (size_t)(slot0 + rb + m * 16 + fr) * 256 + (cb >> 1) + 4 * fq;
#pragma unroll
            for (int p = 0; p < 2; ++p) { const f32x4 a = acc[m][2 * p], b = acc[m][2 * p + 1]; u32x2 w;
                w.x = pk2(silu_f(a[0]) * b[0], silu_f(a[1]) * b[1]); w.y = pk2(silu_f(a[2]) * b[2], silu_f(a[3]) * b[3]); *(u32x2*)(rp + p * 16) = w; } }
    }
};

namespace pg8 {
constexpr int BM = 256, BK = 64, HALF = 128, HTB = HALF * BK * 2  , STAGE_BYTES = 8 * HTB, NXCD = 8, WGM = 8;
__device__ __forceinline__ int lds_byte(int r, int c) { const int st = (r >> 4) * 2 + (c >> 5), rr = r & 15, cc = c & 31, ob = rr * 64 + cc * 2; return st * 1024 + (ob ^ (((ob >> 9) & 1) << 5)); }
__device__ __forceinline__ void stage_rc(int b, int& R, int& C) { const int st = b / 1024, sb = b % 1024, swz = sb ^ (((sb >> 9) & 1) << 5); R = (st >> 1) * 16 + swz / 64; C = (st & 1) * 32 + (swz % 64) / 2; }
__device__ __forceinline__ int perm32(int rho) { const int n = rho >> 4, i = rho & 15; return 8 * (i >> 2) + 4 * n + (i & 3); }
struct Unit { int pm, pn; };
struct Gemm { const bf16_t* A; const bf16_t* Bt; int M, N, K, lda; };
struct StaticOrder {
    int nM, nN, nwg, G, c;
    __device__ void init(int M, int N, int G_, int c_) { nM = M / BM; nN = N / BM; nwg = nM * nN; G = G_; c = c_; }
    __device__ bool next(int i, Unit& u) const {
        const long L = (long)i * G + c; if (L >= nwg) return false;
        int wgid = (int)L; { const int q = nwg / NXCD, r = nwg % NXCD, xcd = wgid % NXCD, off = wgid / NXCD; wgid = (xcd < r ? xcd * (q + 1) : r * (q + 1) + (xcd - r) * q) + off; }
        const int nig = WGM * nN, gid = wgid / nig, fm = gid * WGM, gsz = (nM - fm) < WGM ? (nM - fm) : WGM;
        u.pm = fm + ((wgid % nig) % gsz); u.pn = (wgid % nig) / gsz; return true;
    }
};
template <class Epi, bool ALIGN_EPI = true>
__device__ __forceinline__ void gemm_phase(ldsp lds, const Gemm g, const StaticOrder& S, const Epi& E) {
    const int tid = fresh_tid(), wid = __builtin_amdgcn_readfirstlane(tid >> 6), lane = tid & 63, wr = wid >> 2, wc = wid & 3, fr = lane & 15, fq = lane >> 4;
    const int K = g.K, nt = K / BK;
    unsigned voffA[2], voffB[2];
#pragma unroll
    for (int i = 0; i < 2; ++i) { int R, C; stage_rc(tid * 16 + i * 8192, R, C); const int Rb = Epi::PERM ? ((R & ~31) + perm32(R & 31)) : R;
        voffA[i] = (unsigned)(R * g.lda + C) * 2u; voffB[i] = (unsigned)(Rb * K + C) * 2u; }
    const size_t kstep = (size_t)(BK * 2);
    const size_t hstepA = (size_t)HALF * g.lda * 2, hstepB = (size_t)HALF * K * 2;
    const size_t tstepA = 2 * hstepA, tstepB = 2 * hstepB;
    const unsigned ldsw = (unsigned)wid * 1024u;
    const int aoff = lds_byte(wr * 64 + fr, fq * 8), boff = lds_byte(wc * 32 + fr, fq * 8);
#define PG8_SA(b, h) (((b) * 2 + (h)) * HTB)
#define PG8_SB(b, h) ((4 + (b) * 2 + (h)) * HTB)
#define PG8_STAGE(bufoff, gbase, voff) do { _Pragma("unroll") for (int _i = 0; _i < 2; ++_i) glds16((const char*)(gbase) + (voff)[_i], lds + (bufoff) + ldsw + _i * 8192); } while (0)
#define PG8_LDA(dst, b, h) do { _Pragma("unroll") for (int m = 0; m < 4; ++m) _Pragma("unroll") for (int k = 0; k < 2; ++k) dst[m][k] = *(const LAS bf16x8*)(lds + PG8_SA(b, h) + aoff + m * 2048 + k * 1024); } while (0)
#define PG8_LDB(dst, b, h) do { _Pragma("unroll") for (int n = 0; n < 2; ++n) _Pragma("unroll") for (int k = 0; k < 2; ++k) dst[n][k] = *(const LAS bf16x8*)(lds + PG8_SB(b, h) + boff + n * 2048 + k * 1024); } while (0)
#define PG8_MMA(ai, bj, At, Bt) do { __builtin_amdgcn_s_setprio(1); _Pragma("unroll") for (int m = 0; m < 4; ++m) _Pragma("unroll") for (int n = 0; n < 2; ++n) _Pragma("unroll") for (int k = 0; k < 2; ++k) \
        acc[ai][bj][m][n] = __builtin_amdgcn_mfma_f32_16x16x32_bf16(Bt[n][k], At[m][k], acc[ai][bj][m][n], 0, 0, 0); __builtin_amdgcn_s_setprio(0); } while (0)
#define PG8_WAIT_V(n) asm volatile("s_waitcnt vmcnt(" #n ")" ::: "memory")
#define PG8_WAIT_L(n) asm volatile("s_waitcnt lgkmcnt(" #n ")" ::: "memory")
#define PG8_BAR __builtin_amdgcn_s_barrier()
#define PG8_SCHED __builtin_amdgcn_sched_barrier(0)
    Unit cur, nxt; int ui = 0;
    PG8_WAIT_V(0); PG8_BAR;
    if (!S.next(0, cur)) return;
    f32x4 acc[2][2][4][2];
#pragma unroll
    for (int a = 0; a < 2; ++a)
#pragma unroll
        for (int b = 0; b < 2; ++b)
#pragma unroll
            for (int m = 0; m < 4; ++m)
#pragma unroll
                for (int n = 0; n < 2; ++n) acc[a][b][m][n] = (f32x4){0.f, 0.f, 0.f, 0.f};
    bf16x8 At[4][2], B0[2][2], B1[2][2];
    const char* cA = (const char*)g.A + (size_t)cur.pm * tstepA; const char* cB = (const char*)g.Bt + (size_t)cur.pn * tstepB;
    PG8_STAGE(PG8_SB(0, 0), cB, voffB); PG8_STAGE(PG8_SB(0, 1), cB + hstepB, voffB); PG8_STAGE(PG8_SA(0, 0), cA, voffA); PG8_STAGE(PG8_SA(0, 1), cA + hstepA, voffA);
    if (wr == 1) PG8_BAR;
    PG8_WAIT_V(2); PG8_BAR;
    PG8_STAGE(PG8_SB(1, 0), cB + kstep, voffB); PG8_STAGE(PG8_SA(1, 0), cA + kstep, voffA); PG8_STAGE(PG8_SB(1, 1), cB + hstepB + kstep, voffB);
    PG8_WAIT_V(6); PG8_BAR;
    for (;;) {
        const bool has_next = S.next(ui + 1, nxt);
        const char* nA = has_next ? (const char*)g.A + (size_t)nxt.pm * tstepA : cA; const char* nB = has_next ? (const char*)g.Bt + (size_t)nxt.pn * tstepB : cB;
        for (int t = 0; t < nt; t += 2) {
            const bool last = (t == nt - 2);
            const char* a1 = cA + (size_t)(t + 1) * kstep;
            const char* a2 = last ? nA : cA + (size_t)(t + 2) * kstep; const char* b2 = last ? nB : cB + (size_t)(t + 2) * kstep;
            const char* a3 = a2 + kstep; const char* b3 = b2 + kstep;
            PG8_LDB(B0, 0, 0); PG8_LDB(B1, 0, 1); PG8_SCHED; PG8_LDA(At, 0, 0); PG8_STAGE(PG8_SA(1, 1), a1 + hstepA, voffA);
            PG8_WAIT_V(8); PG8_WAIT_L(0); PG8_BAR; PG8_MMA(0, 0, At, B0); PG8_MMA(0, 1, At, B1); PG8_BAR; PG8_SCHED;
            PG8_LDA(At, 0, 1); PG8_STAGE(PG8_SB(0, 0), b2, voffB); PG8_STAGE(PG8_SB(0, 1), b2 + hstepB, voffB); PG8_STAGE(PG8_SA(0, 0), a2, voffA);
            PG8_WAIT_V(8); PG8_WAIT_L(0); PG8_BAR; PG8_MMA(1, 0, At, B0); PG8_MMA(1, 1, At, B1); PG8_BAR; PG8_SCHED;
            PG8_LDB(B0, 1, 0); PG8_LDB(B1, 1, 1); PG8_SCHED; PG8_LDA(At, 1, 0); PG8_STAGE(PG8_SA(0, 1), a2 + hstepA, voffA);
            PG8_WAIT_V(8); PG8_WAIT_L(0); PG8_BAR; PG8_MMA(0, 0, At, B0); PG8_MMA(0, 1, At, B1); PG8_BAR; PG8_SCHED;
            PG8_LDA(At, 1, 1); PG8_STAGE(PG8_SB(1, 0), b3, voffB); PG8_STAGE(PG8_SB(1, 1), b3 + hstepB, voffB); PG8_STAGE(PG8_SA(1, 0), a3, voffA);
            PG8_WAIT_V(8); PG8_WAIT_L(0); PG8_BAR; PG8_MMA(1, 0, At, B0); PG8_MMA(1, 1, At, B1); PG8_BAR; PG8_SCHED;
        }
        if constexpr (ALIGN_EPI) { if (wr == 0) PG8_BAR; }
        E(acc, cur, wr, wc, fr, fq);
        if (!has_next) break;
#pragma unroll
        for (int a = 0; a < 2; ++a)
#pragma unroll
            for (int b = 0; b < 2; ++b)
#pragma unroll
                for (int m = 0; m < 4; ++m)
#pragma unroll
                    for (int n = 0; n < 2; ++n) acc[a][b][m][n] = (f32x4){0.f, 0.f, 0.f, 0.f};
        cur = nxt; cA = nA; cB = nB; ++ui;
        if constexpr (ALIGN_EPI) { if (wr == 1) PG8_BAR; }
    }
    PG8_WAIT_V(0);
    if constexpr (!ALIGN_EPI) { if (wr == 0) PG8_BAR; }
    PG8_BAR;
#undef PG8_SA
#undef PG8_SB
#undef PG8_STAGE
#undef PG8_LDA
#undef PG8_LDB
#undef PG8_MMA
#undef PG8_WAIT_V
#undef PG8_WAIT_L
#undef PG8_BAR
#undef PG8_SCHED
}
struct EpiBf16 {
    static constexpr bool PERM = true;
    bf16_t* O; size_t ldc;
    __device__ __forceinline__ void operator()(const f32x4 (&acc)[2][2][4][2], const Unit& u, int wr, int wc, int fr, int fq) const {
        const int row0 = u.pm * BM + wr * 64 + fr, col0 = u.pn * BM + wc * 32 + 8 * fq;
#pragma unroll
        for (int ai = 0; ai < 2; ++ai)
#pragma unroll
            for (int m = 0; m < 4; ++m) { bf16_t* rowp = O + (size_t)(row0 + ai * HALF + m * 16) * ldc + col0;
#pragma unroll
                for (int bj = 0; bj < 2; ++bj) { const f32x4 v0 = acc[ai][bj][m][0], v1 = acc[ai][bj][m][1];
                    u32x4 w; w.x = pk2(v0[0], v0[1]); w.y = pk2(v0[2], v0[3]); w.z = pk2(v1[0], v1[1]); w.w = pk2(v1[2], v1[3]);
                    *(u32x4*)(rowp + bj * HALF) = w; } }
    }
};
struct EpiRet {
    static constexpr bool PERM = true;
    bf16_t* O;
    __device__ __forceinline__ void operator()(const f32x4 (&acc)[2][2][4][2], const Unit& u, int wr, int wc, int fr, int fq) const {
        const int row0 = u.pm * BM + wr * 64 + fr, colt = u.pn * BM, col0 = colt + wc * 32 + 8 * fq;
        float l2g = 0.f, pre = 1.f;
        if (colt < 2048) { const int h = (colt & 1023) >> 8; l2g = __log2f(1.f - exp2f(-5.f - (float)h)); if (colt >= 1024) { l2g = -l2g; pre = 0.0625f; } }
#pragma unroll
        for (int ai = 0; ai < 2; ++ai)
#pragma unroll
            for (int m = 0; m < 4; ++m) { const int row = row0 + ai * HALF + m * 16; const float sc = pre * exp2f(l2g * (float)(row & 127)); bf16_t* rowp = O + (size_t)row * 6144 + col0;
#pragma unroll
                for (int bj = 0; bj < 2; ++bj) { const f32x4 v0 = acc[ai][bj][m][0] * sc, v1 = acc[ai][bj][m][1] * sc;
                    u32x4 w; w.x = pk2(v0[0], v0[1]); w.y = pk2(v0[2], v0[3]); w.z = pk2(v1[0], v1[1]); w.w = pk2(v1[2], v1[3]);
                    *(u32x4*)(rowp + bj * HALF) = w; } }
    }
};
template <bool SRC_F32> struct EpiRes {
    static constexpr bool PERM = true;
    const void* Xin; bf16_t* Xout; const float* gate;
    __device__ __forceinline__ void operator()(const f32x4 (&acc)[2][2][4][2], const Unit& u, int wr, int wc, int fr, int fq) const {
        const int row0 = u.pm * BM + wr * 64 + fr, col0 = u.pn * BM + wc * 32 + 8 * fq;
        const float* g = gate + (size_t)(row0 >> 11) * 6144 + col0;
        f32x4 gv[2][2];
#pragma unroll
        for (int bj = 0; bj < 2; ++bj)
#pragma unroll
            for (int n = 0; n < 2; ++n) gv[bj][n] = *(const f32x4*)(g + bj * HALF + n * 4);
#pragma unroll
        for (int ai = 0; ai < 2; ++ai)
#pragma unroll
            for (int m = 0; m < 4; ++m) { const int row = row0 + ai * HALF + m * 16;
#pragma unroll
                for (int bj = 0; bj < 2; ++bj) { f32x4 x0, x1;
                    if constexpr (SRC_F32) { const float* xp = (const float*)Xin + (size_t)row * D + col0 + bj * HALF; x0 = *(const f32x4*)xp; x1 = *(const f32x4*)(xp + 4); }
                    else { const u32x4 xb = *(const u32x4*)((const bf16_t*)Xin + (size_t)row * XRB_LD + XRB_OFF + col0 + bj * HALF);
                        x0 = (f32x4){bf_lo(xb.x), bf_hi(xb.x), bf_lo(xb.y), bf_hi(xb.y)}; x1 = (f32x4){bf_lo(xb.z), bf_hi(xb.z), bf_lo(xb.w), bf_hi(xb.w)}; }
                    const f32x4 v0 = x0 + gv[bj][0] * acc[ai][bj][m][0], v1 = x1 + gv[bj][1] * acc[ai][bj][m][1];
                    u32x4 w; w.x = pk2(v0[0], v0[1]); w.y = pk2(v0[2], v0[3]); w.z = pk2(v1[0], v1[1]); w.w = pk2(v1[2], v1[3]);
                    *(u32x4*)(Xout + (size_t)row * XRB_LD + XRB_OFF + col0 + bj * HALF) = w; }
                if (m & 1) asm volatile("" ::: "memory"); }
    }
};
template <class Epi>
__device__ __forceinline__ void dense(ldsp lds, const bf16_t* A, int lda, const bf16_t* Bt, int M, int N, int K, const Epi& E) {
    Gemm g{A, Bt, M, N, K, lda}; StaticOrder S; S.init(M, N, GRID, (int)blockIdx.x);
    gemm_phase<Epi, true>(lds, g, S, E);
}
struct UnitX { int pm, pn; const char* aBase; const char* bBase; const int* list; int cnt, r0, dummy; };
template <class Src, class Epi>
__device__ __forceinline__ void gemm_phase_x(ldsp lds, const Src& S, const Epi& E) {
    const int tid = fresh_tid(), wid = __builtin_amdgcn_readfirstlane(tid >> 6), lane = tid & 63, wr = wid >> 2, wc = wid & 3, fr = lane & 15, fq = lane >> 4;
    constexpr int K = Src::K, nt = K / BK, LDA = Src::LDA;
    int RA[2], CA[2]; unsigned voffB[2];
#pragma unroll
    for (int i = 0; i < 2; ++i) { int R, C; stage_rc(tid * 16 + i * 8192, R, C); RA[i] = R; CA[i] = C * 2; const int Rb = Epi::PERM ? ((R & ~31) + perm32(R & 31)) : R; voffB[i] = (unsigned)(Rb * K + C) * 2u; }
    const size_t kstep = (size_t)(BK * 2), hstepB = (size_t)HALF * K * 2;
    const unsigned ldsw = (unsigned)wid * 1024u;
    const int aoff = lds_byte(wr * 64 + fr, fq * 8), boff = lds_byte(wc * 32 + fr, fq * 8);
    auto rows_of = [&](const UnitX& u, unsigned (&v)[2][2]) {
#pragma unroll
        for (int h = 0; h < 2; ++h)
#pragma unroll
            for (int i = 0; i < 2; ++i) { const int r = h * HALF + RA[i];
                if constexpr (Src::GATHER) { const int gidx = u.r0 + r; const int tok = u.list ? (gidx < u.cnt ? u.list[gidx] : u.dummy) : u.dummy + gidx; v[h][i] = (unsigned)tok * (unsigned)(LDA * 2) + (unsigned)CA[i]; }
                else v[h][i] = (unsigned)(r * LDA * 2 + CA[i]); }
    };
#define PGX_SA(b, h) (((b) * 2 + (h)) * HTB)
#define PGX_SB(b, h) ((4 + (b) * 2 + (h)) * HTB)
#define PGX_STAGEB(bufoff, gbase) do { _Pragma("unroll") for (int _i = 0; _i < 2; ++_i) glds16((const char*)(gbase) + voffB[_i], lds + (bufoff) + ldsw + _i * 8192); } while (0)
#define PGX_STAGEA(bufoff, gbase, h, nx) do { _Pragma("unroll") for (int _i = 0; _i < 2; ++_i) glds16((const char*)(gbase) + ((nx) ? nv[h][_i] : cv[h][_i]), lds + (bufoff) + ldsw + _i * 8192); } while (0)
#define PGX_LDA(dst, b, h) do { _Pragma("unroll") for (int m = 0; m < 4; ++m) _Pragma("unroll") for (int k = 0; k < 2; ++k) dst[m][k] = *(const LAS bf16x8*)(lds + PGX_SA(b, h) + aoff + m * 2048 + k * 1024); } while (0)
#define PGX_LDB(dst, b, h) do { _Pragma("unroll") for (int n = 0; n < 2; ++n) _Pragma("unroll") for (int k = 0; k < 2; ++k) dst[n][k] = *(const LAS bf16x8*)(lds + PGX_SB(b, h) + boff + n * 2048 + k * 1024); } while (0)
#define PGX_MMA(ai, bj, At, Bt) do { __builtin_amdgcn_s_setprio(1); _Pragma("unroll") for (int m = 0; m < 4; ++m) _Pragma("unroll") for (int n = 0; n < 2; ++n) _Pragma("unroll") for (int k = 0; k < 2; ++k) \
        acc[ai][bj][m][n] = __builtin_amdgcn_mfma_f32_16x16x32_bf16(Bt[n][k], At[m][k], acc[ai][bj][m][n], 0, 0, 0); __builtin_amdgcn_s_setprio(0); } while (0)
#define PGX_WAIT_V(n) asm volatile("s_waitcnt vmcnt(" #n ")" ::: "memory")
#define PGX_WAIT_L(n) asm volatile("s_waitcnt lgkmcnt(" #n ")" ::: "memory")
#define PGX_BAR __builtin_amdgcn_s_barrier()
#define PGX_SCHED __builtin_amdgcn_sched_barrier(0)
    UnitX cur, nxt; int ui = 0;
    PGX_WAIT_V(0); PGX_BAR;
    if (!S.next(0, cur)) return;
    unsigned cv[2][2], nv[2][2];
    rows_of(cur, cv);
    asm volatile("" :: "v"(cv[0][0]), "v"(cv[0][1]), "v"(cv[1][0]), "v"(cv[1][1]));
    f32x4 acc[2][2][4][2];
#pragma unroll
    for (int a = 0; a < 2; ++a)
#pragma unroll
        for (int b = 0; b < 2; ++b)
#pragma unroll
            for (int m = 0; m < 4; ++m)
#pragma unroll
                for (int n = 0; n < 2; ++n) acc[a][b][m][n] = (f32x4){0.f, 0.f, 0.f, 0.f};
    bf16x8 At[4][2], B0[2][2], B1[2][2];
    const char* cA = cur.aBase; const char* cB = cur.bBase;
    PGX_STAGEB(PGX_SB(0, 0), cB); PGX_STAGEB(PGX_SB(0, 1), cB + hstepB); PGX_STAGEA(PGX_SA(0, 0), cA, 0, false); PGX_STAGEA(PGX_SA(0, 1), cA, 1, false);
    if (wr == 1) PGX_BAR;
    PGX_WAIT_V(2); PGX_BAR;
    PGX_STAGEB(PGX_SB(1, 0), cB + kstep); PGX_STAGEA(PGX_SA(1, 0), cA + kstep, 0, false); PGX_STAGEB(PGX_SB(1, 1), cB + hstepB + kstep);
    PGX_WAIT_V(6); PGX_BAR;
    LAS int* lbuf = (LAS int*)(lds + LDS_MISC + 2048);
    for (;;) {
        const bool has_next = S.next(ui + 1, nxt);
        if constexpr (Src::GATHER) {
            if (has_next && nxt.list && wid == 0) glds16((const char*)(nxt.list + nxt.r0) + lane * 16, (ldsp)(lbuf + ((ui + 1) & 1) * 256));
        } else {
            if (has_next) rows_of(nxt, nv); else {
#pragma unroll
                for (int h = 0; h < 2; ++h)
#pragma unroll
                    for (int i = 0; i < 2; ++i) nv[h][i] = cv[h][i]; }
        }
        const char* nA = has_next ? nxt.aBase : cA; const char* nB = has_next ? nxt.bBase : cB;
#pragma unroll 1
        for (int t = 0; t < nt; t += 2) {
            const bool last = (t == nt - 2);
            if constexpr (Src::GATHER) { if (last) {
#pragma unroll
                for (int h = 0; h < 2; ++h)
#pragma unroll
                    for (int i = 0; i < 2; ++i) { const int r = h * HALF + RA[i], gidx = nxt.r0 + r; unsigned v = cv[h][i];
                        if (has_next) { int tok;
                            if (nxt.list) { const int tl = lbuf[((ui + 1) & 1) * 256 + r]; tok = gidx < nxt.cnt ? tl : nxt.dummy; } else tok = nxt.dummy + gidx;
                            v = (unsigned)tok * (unsigned)(LDA * 2) + (unsigned)CA[i]; }
                        nv[h][i] = v; } } }
            const char* a1 = cA + (size_t)(t + 1) * kstep;
            const char* a2 = last ? nA : cA + (size_t)(t + 2) * kstep; const char* b2 = last ? nB : cB + (size_t)(t + 2) * kstep;
            const char* a3 = a2 + kstep; const char* b3 = b2 + kstep;
            PGX_LDB(B0, 0, 0); PGX_LDB(B1, 0, 1); PGX_SCHED; PGX_LDA(At, 0, 0); PGX_STAGEA(PGX_SA(1, 1), a1, 1, false);
            PGX_WAIT_V(8); PGX_WAIT_L(0); PGX_BAR; PGX_MMA(0, 0, At, B0); PGX_MMA(0, 1, At, B1); PGX_BAR; PGX_SCHED;
            PGX_LDA(At, 0, 1); PGX_STAGEB(PGX_SB(0, 0), b2); PGX_STAGEB(PGX_SB(0, 1), b2 + hstepB); PGX_STAGEA(PGX_SA(0, 0), a2, 0, last);
            PGX_WAIT_V(8); PGX_WAIT_L(0); PGX_BAR; PGX_MMA(1, 0, At, B0); PGX_MMA(1, 1, At, B1); PGX_BAR; PGX_SCHED;
            PGX_LDB(B0, 1, 0); PGX_LDB(B1, 1, 1); PGX_SCHED; PGX_LDA(At, 1, 0); PGX_STAGEA(PGX_SA(0, 1), a2, 1, last);
            PGX_WAIT_V(8); PGX_WAIT_L(0); PGX_BAR; PGX_MMA(0, 0, At, B0); PGX_MMA(0, 1, At, B1); PGX_BAR; PGX_SCHED;
            PGX_LDA(At, 1, 1); PGX_STAGEB(PGX_SB(1, 0), b3); PGX_STAGEB(PGX_SB(1, 1), b3 + hstepB); PGX_STAGEA(PGX_SA(1, 0), a3, 0, last);
            PGX_WAIT_V(8); PGX_WAIT_L(0); PGX_BAR; PGX_MMA(1, 0, At, B0); PGX_MMA(1, 1, At, B1); PGX_BAR; PGX_SCHED;
        }
        if (wr == 0) PGX_BAR;
        E(acc, cur, wr, wc, fr, fq);
        if (!has_next) break;
#pragma unroll
        for (int a = 0; a < 2; ++a)
#pragma unroll
            for (int b = 0; b < 2; ++b)
#pragma unroll
                for (int m = 0; m < 4; ++m)
#pragma unroll
                    for (int n = 0; n < 2; ++n) acc[a][b][m][n] = (f32x4){0.f, 0.f, 0.f, 0.f};
        cur = nxt; cA = nA; cB = nB; ++ui;
#pragma unroll
        for (int h = 0; h < 2; ++h)
#pragma unroll
            for (int i = 0; i < 2; ++i) cv[h][i] = nv[h][i];
        if (wr == 1) PGX_BAR;
    }
    PGX_WAIT_V(0);
    PGX_BAR;
#undef PGX_SA
#undef PGX_SB
#undef PGX_STAGEA
#undef PGX_STAGEB
#undef PGX_LDA
#undef PGX_LDB
#undef PGX_MMA
#undef PGX_WAIT_V
#undef PGX_WAIT_L
#undef PGX_BAR
#undef PGX_SCHED
}
struct EpiSwiGLUx {
    static constexpr bool PERM = false;
    bf16_t* O;
    __device__ __forceinline__ void operator()(const f32x4 (&acc)[2][2][4][2], const UnitX& u, int wr, int wc, int fr, int fq) const {
        const int row0 = u.pm * BM + wr * 64 + fr, c0 = (u.pn * BM + wc * 32) / 2 + 4 * fq;
#pragma unroll
        for (int ai = 0; ai < 2; ++ai)
#pragma unroll
            for (int m = 0; m < 4; ++m) { bf16_t* rowp = O + (size_t)(row0 + ai * HALF + m * 16) * 256 + c0;
#pragma unroll
                for (int bj = 0; bj < 2; ++bj) { const f32x4 x = acc[ai][bj][m][0], y = acc[ai][bj][m][1]; u32x2 w;
                    w.x = pk2(silu_f(x[0]) * y[0], silu_f(x[1]) * y[1]); w.y = pk2(silu_f(x[2]) * y[2], silu_f(x[3]) * y[3]); *(u32x2*)(rowp + bj * (HALF / 2)) = w; } }
    }
};
struct EpiYx {
    static constexpr bool PERM = true;
    unsigned char* O;
    __device__ __forceinline__ void operator()(const f32x4 (&acc)[2][2][4][2], const UnitX& u, int wr, int wc, int fr, int fq) const {
        const int row0 = u.pm * BM + wr * 64 + fr, col0 = u.pn * BM + wc * 32 + 8 * fq;
#pragma unroll
        for (int ai = 0; ai < 2; ++ai)
#pragma unroll
            for (int m = 0; m < 4; ++m) { unsigned char* rowp = O + (size_t)(row0 + ai * HALF + m * 16) * D + col0;
#pragma unroll
                for (int bj = 0; bj < 2; ++bj) { f32x4 v0 = acc[ai][bj][m][0], v1 = acc[ai][bj][m][1];
#pragma unroll
                    for (int e = 0; e < 4; ++e) { v0[e] = __builtin_amdgcn_fmed3f(v0[e], -448.f, 448.f); v1[e] = __builtin_amdgcn_fmed3f(v1[e], -448.f, 448.f); }
                    int w0 = __builtin_amdgcn_cvt_pk_fp8_f32(v0[0], v0[1], 0, false); w0 = __builtin_amdgcn_cvt_pk_fp8_f32(v0[2], v0[3], w0, true);
                    int w1 = __builtin_amdgcn_cvt_pk_fp8_f32(v1[0], v1[1], 0, false); w1 = __builtin_amdgcn_cvt_pk_fp8_f32(v1[2], v1[3], w1, true);
                    u32x2 w; w.x = (unsigned)w0; w.y = (unsigned)w1; *(u32x2*)(rowp + bj * HALF) = w; } }
    }
};
}

__device__ __forceinline__ void transpose_item(const float* W, int K, int N, bf16_t* WT, int mode, LAS float* scr, int item, int lane) {
    const int nblk = N / 32, kb = item / nblk, nb = item % nblk, k0 = 64 * kb, n0 = 32 * nb;
    f32x4 v[8];
#pragma unroll
    for (int i = 0; i < 8; ++i) v[i] = *(const f32x4*)(W + (size_t)(k0 + 8 * i + (lane >> 3)) * N + n0 + (lane & 7) * 4);
#pragma unroll
    for (int i = 0; i < 8; ++i) { LAS float* d = scr + (8 * i + (lane >> 3)) * 33 + (lane & 7) * 4; d[0] = v[i][0]; d[1] = v[i][1]; d[2] = v[i][2]; d[3] = v[i][3]; }
    LDS_WAIT();
    const int c = lane & 7;
#pragma unroll
    for (int j = 0; j < 4; ++j) { const int n = (lane >> 3) + 8 * j; const LAS float* s = scr + (8 * c) * 33 + n;
        u32x4 o; o.x = pk2(s[0 * 33], s[1 * 33]); o.y = pk2(s[2 * 33], s[3 * 33]); o.z = pk2(s[4 * 33], s[5 * 33]); o.w = pk2(s[6 * 33], s[7 * 33]);
        const int nn = n0 + n; const int row = mode == 0 ? nn : ((nn >> 4) * 32 + (mode == 2 ? 16 : 0) + (nn & 15));
        *(u32x4*)(WT + (size_t)row * K + k0 + 8 * c) = o; }
    LDS_WAIT();
}
__device__ __forceinline__ void convert_expert_weights(const Args& a, int layer, ldsp lds, int gw, int ngw, int wave, int lane) {
    LAS float* scr = (LAS float*)(lds + wave * 16384);
    unsigned char* ws = a.ws;
    constexpr int I13 = (D / 64) * (256 / 32), I2 = (256 / 64) * (D / 32);
    constexpr int NE = 64 * I13;
    constexpr int TOTAL = 3 * NE + 3 * 128;
    for (int it = gw; it < TOTAL; it += ngw) {
        int r = it;
        if (r < NE) { const int e = r / I13; transpose_item(a.in[I_EW1] + ((size_t)layer * 64 + e) * D * 256, D, 256, (bf16_t*)(ws + WS_W13) + (size_t)e * 512 * D, 1, scr, r % I13, lane); continue; } r -= NE;
        if (r < NE) { const int e = r / I13; transpose_item(a.in[I_EW3] + ((size_t)layer * 64 + e) * D * 256, D, 256, (bf16_t*)(ws + WS_W13) + (size_t)e * 512 * D, 2, scr, r % I13, lane); continue; } r -= NE;
        if (r < NE) { const int e = r / I2; transpose_item(a.in[I_EW2] + ((size_t)layer * 64 + e) * 256 * D, 256, D, (bf16_t*)(ws + WS_W2) + (size_t)e * D * 256, 0, scr, r % I2, lane); continue; } r -= NE;
        if (r < 128) { transpose_item(a.in[I_SW1] + (size_t)layer * D * 256, D, 256, (bf16_t*)(ws + WS_WS13), 1, scr, r, lane); continue; } r -= 128;
        if (r < 128) { transpose_item(a.in[I_SW3] + (size_t)layer * D * 256, D, 256, (bf16_t*)(ws + WS_WS13), 2, scr, r, lane); continue; } r -= 128;
        transpose_item(a.in[I_SW2] + (size_t)layer * 256 * D, 256, D, (bf16_t*)(ws + WS_WS2), 0, scr, r, lane);
    }
}
__device__ __forceinline__ void convert_dense_weights(const Args& a, ldsp lds, int gw, int ngw, int wave, int lane) {
    LAS float* scr = (LAS float*)(lds + wave * 16384);
    unsigned char* ws = a.ws;
    constexpr int IQ = 16 * 96, IO = 16 * 32, IRI = 16 * 192, IRO = 32 * 32;
    for (int it = gw; it < IQ + IO + IRI + IRO; it += ngw) {
        int r = it;
        if (r < IQ) { transpose_item(a.in[I_DAWIN], D, 3072, (bf16_t*)(ws + WS_WQKV), 0, scr, r, lane); continue; } r -= IQ;
        if (r < IO) { transpose_item(a.in[I_DAWOUT], D, D, (bf16_t*)(ws + WS_WO), 0, scr, r, lane); continue; } r -= IO;
        if (r < IRI) { transpose_item(a.in[I_RWIN], D, 6144, (bf16_t*)(ws + WS_WRI), 0, scr, r, lane); continue; } r -= IRI;
        transpose_item(a.in[I_RWOUT], 2048, D, (bf16_t*)(ws + WS_WRO), 0, scr, r, lane);
    }
}
__device__ __forceinline__ void mod_items(const Args& a, ldsp lds) {
    const int tid = threadIdx.x;
    LAS float* sl = (LAS float*)lds;
    LAS float* red = (LAS float*)(lds + 65536);
    const float* c = a.in[I_C];
    for (int i = tid; i < 16 * 1024; i += NTHR) sl[i] = silu_f(c[i]);
    __syncthreads();
    float* mod = (float*)(a.ws + WS_MOD);
    for (int item = blockIdx.x; item < 384; item += GRID) {
        const int layer = item / 192, j0 = (item % 192) * 32, kq = tid >> 5, col = tid & 31;
        const float* w = a.in[I_ADAW] + (size_t)layer * D * 6144 + j0 + col;
        float acc[16];
#pragma unroll
        for (int b = 0; b < 16; ++b) acc[b] = 0.f;
        for (int k0 = kq * 64; k0 < kq * 64 + 64; k0 += 8) {
            float wv[8];
#pragma unroll
            for (int u = 0; u < 8; ++u) wv[u] = w[(size_t)(k0 + u) * 6144];
#pragma unroll
            for (int u = 0; u < 8; ++u)
#pragma unroll
                for (int b = 0; b < 16; ++b) acc[b] += sl[b * 1024 + k0 + u] * wv[u];
        }
#pragma unroll
        for (int b = 0; b < 16; ++b) red[(kq * 16 + b) * 32 + col] = acc[b];
        __syncthreads();
        { const int b = tid >> 5, cc = tid & 31; const int j = j0 + cc; float s = a.in[I_ADAB][(size_t)layer * 6144 + j];
#pragma unroll
          for (int q = 0; q < 16; ++q) s += red[(q * 16 + b) * 32 + cc];
          if (j >= 1024 && j < 2048) s = a.in[I_NMIX][layer * D + j - 1024] * (1.f + s);
          if (j >= 4096 && j < 5120) s = a.in[I_NFFN][layer * D + j - 4096] * (1.f + s);
          mod[((size_t)layer * 16 + b) * 6144 + j] = s; }
        __syncthreads();
    }
}

__device__ __forceinline__ void adaln_store(const f32x4 (&v)[4], float rstd, const float* G, const float* sh, bf16_t* hrow, int lane) {
#pragma unroll
    for (int j = 0; j < 4; ++j) { const int col = 4 * lane + 256 * j; const f32x4 g = *(const f32x4*)(G + col), s0 = *(const f32x4*)(sh + col);
        const f32x4 h = v[j] * rstd * g + s0; u32x2 w; w.x = pk2(h[0], h[1]); w.y = pk2(h[2], h[3]); *(u32x2*)(hrow + col) = w; }
}
__device__ __forceinline__ void adaln_phase(const float* X, const float* mod_sh  , const float* mod_G, bf16_t* H, int gw, int ngw, int lane) {
    for (int row0 = gw * 2; row0 < T; row0 += ngw * 2) {
        f32x4 v[2][4]; float ss[2] = {0.f, 0.f};
#pragma unroll
        for (int r = 0; r < 2; ++r)
#pragma unroll
            for (int j = 0; j < 4; ++j) v[r][j] = *(const f32x4*)(X + (size_t)(row0 + r) * D + 4 * lane + 256 * j);
#pragma unroll
        for (int r = 0; r < 2; ++r) {
#pragma unroll
            for (int j = 0; j < 4; ++j) ss[r] += v[r][j][0] * v[r][j][0] + v[r][j][1] * v[r][j][1] + v[r][j][2] * v[r][j][2] + v[r][j][3] * v[r][j][3];
            const float rstd = rsqrtf(wave_sum(ss[r]) * (1.f / D) + 1e-6f); const int b = (row0 + r) >> 11;
            adaln_store(v[r], rstd, mod_G + (size_t)b * 6144, mod_sh + (size_t)b * 6144, H + (size_t)(row0 + r) * D, lane); }
    }
}

__device__ __forceinline__ void attn_phase(ldsp lds, const bf16_t* qkv, bf16_t* ao, float lam, const float* subln_g) {
    const int tid = fresh_tid(), lane = tid & 63, wid = __builtin_amdgcn_readfirstlane(tid >> 6), map = wid & 1, qg = wid >> 1, fr = lane & 15, fq = lane >> 4;
    constexpr int STAGE = 32768;
    const float cs = 0.125f * LOG2E;
    const int kswz = fr >> 1, kok0 = ((fq ^ kswz) << 4), kok1 = (((4 + fq) ^ kswz) << 4), koff = map * 8192 + fr * 128;
    const int vq = fr >> 2, vp = fr & 3, vrow = 4 * fq + vq, vsw = ((vrow & 7) << 1);
    const int vbase0 = 16384 + vrow * 256 + ((((vp >> 1) ^ vsw) & 15) << 4) + (vp & 1) * 8;
    for (int round = 0; round < 8; ++round) {
        const int i = blockIdx.x, jgrp = i >> 7, bh = i & 127;
        const int qb = (round & 1) ? (14 - 2 * round + jgrp) : (15 - 2 * round - jgrp);
        const int b = bh >> 3, h = bh & 7;
        const size_t tok0 = (size_t)b * SEQ;
        const float slope2 = exp2f(-(float)(h + 1)) * LOG2E;
        bf16x8 qf[2][2];
#pragma unroll
        for (int qt = 0; qt < 2; ++qt)
#pragma unroll
            for (int kk = 0; kk < 2; ++kk) qf[qt][kk] = *(const bf16x8*)(qkv + (tok0 + qb * 128 + qg * 32 + qt * 16 + fr) * 3072 + (2 * h + map) * 64 + kk * 32 + fq * 8);
        asm volatile("" :: "v"(qf[0][0]), "v"(qf[0][1]), "v"(qf[1][0]), "v"(qf[1][1]));
        const char* srcK0; const char* srcV0;
        { const int row = 8 * wid + (lane >> 3), ch = (lane & 7) ^ ((row >> 1) & 7);
          srcK0 = (const char*)(qkv + (tok0 + row) * 3072 + 1024 + (2 * h) * 64) + ch * 16; }
        { const int row = 4 * wid + (lane >> 4), ch = (lane & 15) ^ ((row & 7) << 1); srcV0 = (const char*)(qkv + (tok0 + row) * 3072 + 2048 + h * 128) + ch * 16; }
        auto issue = [&](int s, int t) {
            ldsp st = lds + s * STAGE; const size_t adv = (size_t)t * 64 * 3072 * 2;
            glds16(srcK0 + adv, st + wid * 1024); glds16(srcK0 + adv + 128, st + 8192 + wid * 1024);
            glds16(srcV0 + adv, st + 16384 + wid * 1024); glds16(srcV0 + adv + (size_t)32 * 6144, st + 16384 + (wid + 8) * 1024);
        };
        f32x4 o[8][2];
#pragma unroll
        for (int dt = 0; dt < 8; ++dt) { o[dt][0] = (f32x4){0.f, 0.f, 0.f, 0.f}; o[dt][1] = (f32x4){0.f, 0.f, 0.f, 0.f}; }
        float mrow[2] = {-__builtin_inff(), -__builtin_inff()}, lrow[2] = {0.f, 0.f};
        const int ntile = 2 * qb + 2;
        const int qlast = qb * 128 + qg * 32 + 31, qfirst = qb * 128 + qg * 32;
        BAR();
        issue(0, 0); issue(1, 1);
        int s = 0;
        for (int t = 0; t < ntile; ++t) {
            if (t + 1 < ntile) wait_vm<4>(); else wait_vm<0>();
            BAR();
            if (t + 2 < ntile) { int s2 = s + 2; if (s2 >= 3) s2 -= 3; issue(s2, t + 2); }
            ldsp st = lds + s * STAGE;
            const int key0 = 64 * t;
            if (key0 <= qlast) {
                f32x4 sc[4][2];
#pragma unroll
                for (int kt = 0; kt < 4; ++kt) { sc[kt][0] = (f32x4){0.f, 0.f, 0.f, 0.f}; sc[kt][1] = (f32x4){0.f, 0.f, 0.f, 0.f}; }
                __builtin_amdgcn_s_setprio(1);
#pragma unroll
                for (int kk = 0; kk < 2; ++kk) {
                    const int ok = kk ? kok1 : kok0;
#pragma unroll
                    for (int kt = 0; kt < 4; ++kt) { const bf16x8 kf = *(LAS bf16x8*)(st + koff + kt * 2048 + ok);
                        sc[kt][0] = __builtin_amdgcn_mfma_f32_16x16x32_bf16(kf, qf[0][kk], sc[kt][0], 0, 0, 0);
                        sc[kt][1] = __builtin_amdgcn_mfma_f32_16x16x32_bf16(kf, qf[1][kk], sc[kt][1], 0, 0, 0); }
                }
                __builtin_amdgcn_s_setprio(0);
                __builtin_amdgcn_sched_barrier(0);
                const bool need_mask = (key0 + 63 > qfirst);
                const float kb0 = slope2 * (float)(key0 + 4 * fq);
                bf16x8 pf[2][2];
#pragma unroll
                for (int qt = 0; qt < 2; ++qt) {
                    const int qrow = qb * 128 + qg * 32 + qt * 16 + fr;
                    float mx = -__builtin_inff();
#pragma unroll
                    for (int kt = 0; kt < 4; ++kt)
#pragma unroll
                        for (int r = 0; r < 4; ++r) { float v = sc[kt][qt][r] * cs + (kb0 + slope2 * (float)(16 * kt + r));
                            if (need_mask && (key0 + 16 * kt + 4 * fq + r > qrow)) v = -__builtin_inff();
                            sc[kt][qt][r] = v; mx = fmaxf(mx, v); }
                    mx = fmaxf(mx, __shfl_xor(mx, 16)); mx = fmaxf(mx, __shfl_xor(mx, 32));
                    const float mnew = fmaxf(mrow[qt], mx), alpha = fast_exp2(mrow[qt] - mnew);
                    mrow[qt] = mnew;
                    float ps = 0.f;
#pragma unroll
                    for (int kt = 0; kt < 4; ++kt)
#pragma unroll
                        for (int r = 0; r < 4; ++r) { const float p = fast_exp2(sc[kt][qt][r] - mnew); sc[kt][qt][r] = p; ps += p; }
                    lrow[qt] = lrow[qt] * alpha + ps;
#pragma unroll
                    for (int dt = 0; dt < 8; ++dt) o[dt][qt] = o[dt][qt] * alpha;
#pragma unroll
                    for (int s2 = 0; s2 < 2; ++s2) { u32x4 w; w.x = pk2(sc[2 * s2][qt][0], sc[2 * s2][qt][1]); w.y = pk2(sc[2 * s2][qt][2], sc[2 * s2][qt][3]);
                        w.z = pk2(sc[2 * s2 + 1][qt][0], sc[2 * s2 + 1][qt][1]); w.w = pk2(sc[2 * s2 + 1][qt][2], sc[2 * s2 + 1][qt][3]); pf[qt][s2] = __builtin_bit_cast(bf16x8, w); }
                }
                {
                    int vb = vbase0; asm volatile("" : "+v"(vb));
                    bf16x8 vq[3];
                    vq[0] = tr2(st + vb, st + vb + 4096);
                    vq[1] = tr2(st + (vb ^ 32), st + (vb ^ 32) + 4096);
                    __builtin_amdgcn_s_setprio(1);
#pragma unroll
                    for (int i = 0; i < 16; ++i) {
                        const int s2 = i >> 3, dt = i & 7;
                        if (i + 2 < 16) { const int i2 = i + 2, vo = (vb ^ ((i2 & 7) << 5)) + (i2 >> 3) * 8192; vq[i2 % 3] = tr2(st + vo, st + vo + 4096); }
                        o[dt][0] = __builtin_amdgcn_mfma_f32_16x16x32_bf16(vq[i % 3], pf[0][s2], o[dt][0], 0, 0, 0);
                        o[dt][1] = __builtin_amdgcn_mfma_f32_16x16x32_bf16(vq[i % 3], pf[1][s2], o[dt][1], 0, 0, 0);
                        __builtin_amdgcn_sched_barrier(0);
                    }
                    __builtin_amdgcn_s_setprio(0);
                }
            }
            s = (s == 2) ? 0 : s + 1;
        }
#pragma unroll
        for (int qt = 0; qt < 2; ++qt) { float l = lrow[qt]; l += __shfl_xor(l, 16); l += __shfl_xor(l, 32); const float inv = 1.f / l;
#pragma unroll
            for (int dt = 0; dt < 8; ++dt) o[dt][qt] = o[dt][qt] * inv; }
        BAR();
        LAS float* xb = (LAS float*)lds + qg * 4096;
        if (map == 1) {
#pragma unroll
            for (int dt = 0; dt < 8; ++dt)
#pragma unroll
                for (int qt = 0; qt < 2; ++qt)
#pragma unroll
                    for (int r = 0; r < 4; ++r) xb[((dt * 2 + qt) * 4 + r) * 64 + lane] = o[dt][qt][r];
        }
        LDS_WAIT(); BAR();
        if (map == 0) {
            const float* sg = subln_g; asm volatile("" : "+s"(sg));
#pragma unroll
            for (int qt = 0; qt < 2; ++qt) {
                float ss = 0.f;
#pragma unroll
                for (int dt = 0; dt < 8; ++dt)
#pragma unroll
                    for (int r = 0; r < 4; ++r) { const float v = o[dt][qt][r] - lam * xb[((dt * 2 + qt) * 4 + r) * 64 + lane]; o[dt][qt][r] = v; ss += v * v; }
                ss += __shfl_xor(ss, 16); ss += __shfl_xor(ss, 32);
                const float rstd = rsqrtf(ss * (1.f / 128.f) + 1e-6f) * 0.8f;
                bf16_t* orow = ao + (tok0 + qb * 128 + qg * 32 + qt * 16 + fr) * D + h * 128 + 4 * fq;
#pragma unroll
                for (int dt = 0; dt < 8; ++dt) { const f32x4 g = *(const f32x4*)(sg + dt * 16 + 4 * fq); const f32x4 v = o[dt][qt] * rstd * g;
                    u32x2 w; w.x = pk2(v[0], v[1]); w.y = pk2(v[2], v[3]); *(u32x2*)(orow + dt * 16) = w; }
            }
        }
        LDS_WAIT(); BAR();
    }
}

__device__ __forceinline__ void chain_phase(ldsp lds, bf16_t* rp, const bf16_t* P, bool dry) {
    const int tid = fresh_tid(), lane = tid & 63, wid = __builtin_amdgcn_readfirstlane(tid >> 6), fr = lane & 15, fq = lane >> 4;
    constexpr int STAGE = 32768, NSTG = 4;
    const int chain = vcu_of_block(), b = chain >> 4, h = (chain >> 2) & 3, sl = chain & 3;
    const size_t tok0 = (size_t)b * SEQ;
    const float lg = __log2f(1.f - exp2f(-5.f - (float)h));
    const float gamma = exp2f(lg), g127 = exp2f(lg * 127.f), g128 = exp2f(lg * 128.f);
    const bf16_t* vbase = rp + tok0 * 6144 + 2048 + h * 512 + sl * 128;
    const bf16_t* qbase = rp + tok0 * 6144 + h * 256;
    const bf16_t* kbase = rp + tok0 * 6144 + 1024 + h * 256;
    const bf16_t* pbase = P + (size_t)((b * 4 + h) * 16) * 16384;
    unsigned vsrc0, psrc0, qsrc0, ksrc0;
    { const int row = 4 * wid + (lane >> 4); vsrc0 = (unsigned)(row * 6144 * 2 + (((lane & 15) ^ ((row & 7) << 1)) << 4)); psrc0 = (unsigned)(row * 256 + (((lane & 15) ^ (row & 15)) << 4)); }
    { const int row = 8 * wid + (lane >> 3); qsrc0 = (unsigned)(row * 6144 * 2 + (((lane & 7) ^ ((row >> 1) & 7)) << 4)); ksrc0 = (unsigned)(row * 6144 * 2 + (((lane & 7) ^ (((row >> 1) & 3) << 1)) << 4)); }
    auto issue = [&](int s, int g) {
        ldsp st = lds + s * STAGE; const int c = g / 6, kind = g - c * 6; const size_t coff = (size_t)c * 128 * 6144 * 2;
        if (kind == 0) {
            const char* bp = (const char*)vbase + coff;
#pragma unroll
            for (int jj = 0; jj < 4; ++jj) glds16(bp + (size_t)jj * 32 * 12288 + vsrc0, st + (wid + 8 * jj) * 1024);
        } else if (kind == 5) {
            const char* bp = (const char*)pbase + (size_t)c * 32768;
#pragma unroll
            for (int jj = 0; jj < 4; ++jj) glds16(bp + (size_t)jj * 32 * 256 + psrc0, st + (wid + 8 * jj) * 1024);
        } else { const int p = kind - 1;
            const char* bq = (const char*)qbase + coff + p * 128; const char* bk = (const char*)kbase + coff + p * 128;
#pragma unroll
            for (int jj = 0; jj < 2; ++jj) glds16(bq + (size_t)jj * 64 * 12288 + qsrc0, st + (wid + 8 * jj) * 1024);
#pragma unroll
            for (int jj = 0; jj < 2; ++jj) glds16(bk + (size_t)jj * 64 * 12288 + ksrc0, st + 16384 + (wid + 8 * jj) * 1024);
        }
    };
    const int tq = fr >> 2, tp = fr & 3;
    const int vrow = 4 * fq + tq;
    const int vfo = vrow * 256 + ((((2 * wid + (tp >> 1)) ^ ((vrow & 7) << 1)) & 15) << 4) + (tp & 1) * 8;
    const int ksw = ((vrow >> 1) & 3) << 1;
    const int kfo0 = 16384 + vrow * 128 + ((((tp >> 1) ^ ksw) & 7) << 4) + (tp & 1) * 8;
    const int qsw = fr >> 1;
    const int qfo0 = fr * 128 + ((((fq >> 1) ^ qsw) & 7) << 4) + (fq & 1) * 8;
    const int pfo0 = fr * 256 + ((((fq >> 1) ^ fr) & 15) << 4) + (fq & 1) * 8;

    f32x4 R[16];
#pragma unroll
    for (int i = 0; i < 16; ++i) R[i] = (f32x4){0.f, 0.f, 0.f, 0.f};
    f32x4 o[8];
#pragma unroll
    for (int it = 0; it < 8; ++it) o[it] = (f32x4){0.f, 0.f, 0.f, 0.f};
    bf16x8 vf[4];
#pragma unroll
    for (int s4 = 0; s4 < 4; ++s4) vf[s4] = (bf16x8){0, 0, 0, 0, 0, 0, 0, 0};
    constexpr int NG = 16 * 6;
    BAR();
    issue(0, 0); issue(1, 1); issue(2, 2);
    for (int c = 0; c < 16; ++c) {
        auto step = [&](auto KC) {
            constexpr int kind = decltype(KC)::value;
            const int g = c * 6 + kind;
            if (g + 2 < NG) wait_vm<8>(); else if (g + 1 < NG) wait_vm<4>(); else wait_vm<0>();
            BAR();
            if (g + 3 < NG) issue((g + 3) & 3, g + 3);
            ldsp st = lds + (g & 3) * STAGE;
            if constexpr (kind == 0) {
#pragma unroll
                for (int s4 = 0; s4 < 4; ++s4) vf[s4] = tr2(st + vfo + s4 * 8192, st + vfo + s4 * 8192 + 4096);
#pragma unroll
                for (int it = 0; it < 8; ++it) o[it] = (f32x4){0.f, 0.f, 0.f, 0.f};
            } else if constexpr (kind == 5) {
#pragma unroll
                for (int it = 0; it < 8; ++it) o[it] = o[it] * gamma;
#pragma unroll
                for (int s4 = 0; s4 < 4; ++s4) {
                    int pb = pfo0; asm volatile("" : "+v"(pb)); const int p0 = pb ^ ((4 * s4) << 4), p1 = pb ^ ((4 * s4 + 2) << 4);
#pragma unroll
                    for (int it = 0; it < 8; ++it) { const bf16x8 pf = rd2x64(st + p0 + it * 4096, st + p1 + it * 4096);
                        o[it] = __builtin_amdgcn_mfma_f32_16x16x32_bf16(vf[s4], pf, o[it], 0, 0, 0); if (it == 3) __builtin_amdgcn_sched_barrier(0); }
                    __builtin_amdgcn_sched_barrier(0);
                }
                bf16_t* ob = rp + (tok0 + (size_t)c * 128) * 6144 + 2048 + h * 512 + sl * 128 + 16 * wid + 4 * fq;
#pragma unroll
                for (int it = 0; it < 8; ++it) { u32x2 w; w.x = pk2(o[it][0], o[it][1]); w.y = pk2(o[it][2], o[it][3]); if (!dry) *(u32x2*)(ob + (size_t)(16 * it + fr) * 6144) = w; else asm volatile("" :: "v"(w)); }
            } else {
                constexpr int p = kind - 1;
#pragma unroll
                for (int s2 = 0; s2 < 2; ++s2) {
                    u32x4 w; const f32x4 r0 = R[4 * p + 2 * s2], r1 = R[4 * p + 2 * s2 + 1];
                    w.x = pk2(r0[0], r0[1]); w.y = pk2(r0[2], r0[3]); w.z = pk2(r1[0], r1[1]); w.w = pk2(r1[2], r1[3]);
                    const bf16x8 rf = __builtin_bit_cast(bf16x8, w);
                    int qb = qfo0; asm volatile("" : "+v"(qb)); const int q0 = qb ^ ((4 * s2) << 4), q1 = qb ^ ((4 * s2 + 2) << 4);
#pragma unroll
                    for (int it = 0; it < 8; ++it) { const bf16x8 qf = rd2x64(st + q0 + it * 2048, st + q1 + it * 2048);
                        o[it] = __builtin_amdgcn_mfma_f32_16x16x32_bf16(rf, qf, o[it], 0, 0, 0); if (it == 3) __builtin_amdgcn_sched_barrier(0); }
                    __builtin_amdgcn_sched_barrier(0);
                }
#pragma unroll
                for (int dkt = 0; dkt < 4; ++dkt) {
                    f32x4 acc = (f32x4){0.f, 0.f, 0.f, 0.f};
                    int kb = kfo0; asm volatile("" : "+v"(kb)); const int ko = kb ^ (dkt << 5);
#pragma unroll
                    for (int s4 = 0; s4 < 4; ++s4) { const bf16x8 kf = tr2(st + ko + s4 * 4096, st + ko + s4 * 4096 + 2048);
                        acc = __builtin_amdgcn_mfma_f32_16x16x32_bf16(kf, vf[s4], acc, 0, 0, 0); }
                    R[4 * p + dkt] = R[4 * p + dkt] * g128 + acc * g127;
                }
                __builtin_amdgcn_sched_barrier(0);
            }
        };
        step(std::integral_constant<int, 0>{}); step(std::integral_constant<int, 1>{}); step(std::integral_constant<int, 2>{});
        step(std::integral_constant<int, 3>{}); step(std::integral_constant<int, 4>{}); step(std::integral_constant<int, 5>{});
    }
}

__device__ __forceinline__ void gnorm_phase(bf16_t* rp, const float* gn, int gw, int ngw, int lane, bool dry) {
    f32x4 w0[4], w1[4];
#pragma unroll
    for (int hh = 0; hh < 4; ++hh) { w0[hh] = *(const f32x4*)(gn + hh * 512 + 8 * lane); w1[hh] = *(const f32x4*)(gn + hh * 512 + 8 * lane + 4); }
    for (int row = gw; row < T; row += ngw) {
        bf16_t* orow = rp + (size_t)row * 6144 + 2048; const bf16_t* grow = rp + (size_t)row * 6144 + 4096;
        u32x4 ov[4], gv[4];
#pragma unroll
        for (int hh = 0; hh < 4; ++hh) { ov[hh] = *(const u32x4*)(orow + hh * 512 + 8 * lane); gv[hh] = *(const u32x4*)(grow + hh * 512 + 8 * lane); }
#pragma unroll
        for (int hh = 0; hh < 4; ++hh) {
            float of[8] = {bf_lo(ov[hh].x), bf_hi(ov[hh].x), bf_lo(ov[hh].y), bf_hi(ov[hh].y), bf_lo(ov[hh].z), bf_hi(ov[hh].z), bf_lo(ov[hh].w), bf_hi(ov[hh].w)};
            float gf[8] = {bf_lo(gv[hh].x), bf_hi(gv[hh].x), bf_lo(gv[hh].y), bf_hi(gv[hh].y), bf_lo(gv[hh].z), bf_hi(gv[hh].z), bf_lo(gv[hh].w), bf_hi(gv[hh].w)};
            float ss = 0.f;
#pragma unroll
            for (int e = 0; e < 8; ++e) ss += of[e] * of[e];
            const float rstd = rsqrtf(wave_sum(ss) * (1.f / 512.f) + 1e-6f);
            float y[8];
#pragma unroll
            for (int e = 0; e < 8; ++e) y[e] = silu_f(gf[e]) * of[e] * rstd * (e < 4 ? w0[hh][e] : w1[hh][e - 4]);
            u32x4 w; w.x = pk2(y[0], y[1]); w.y = pk2(y[2], y[3]); w.z = pk2(y[4], y[5]); w.w = pk2(y[6], y[7]);
            if (!dry) *(u32x4*)(orow + hh * 512 + 8 * lane) = w; else asm volatile("" :: "v"(w));
        }
    }
}

__device__ __forceinline__ void router_phase(ldsp lds, const bf16_t* XRBp, const float* mod_sh, const float* mod_G, const bf16_t* rwt  , const float* rbias,
                                             bf16_t* H, int* sel_e, float* sel_w, int* sel_p, int* tokl, unsigned* cnt, int tile0, int tile_end, int tstep, int wave, int lane, bool dry) {
    LAS float* lg = (LAS float*)(lds + wave * 8192);
    LAS int* st2 = (LAS int*)(lds + wave * 8192 + 4096);
    LAS float* Gl = (LAS float*)(lds + 131072); LAS float* SHl = Gl + 1024;
    const float rb = rbias[lane];
    const int fr = lane & 15, fq = lane >> 4;
    for (int tile = tile0; tile < tile_end; tile += tstep) {
        const int row = tile * 16 + fr, b = row >> 11;
        const bf16_t* xr = XRBp + (size_t)row * XRB_LD + XRB_OFF + 8 * fq;
        bf16_t* hrow = H + (size_t)row * D + 8 * fq;
        { const int t4 = (wave * 64 + lane) * 4; const float* src = (t4 < 1024 ? mod_G : mod_sh - 1024) + (size_t)b * 6144 + t4; *(LAS f32x4*)(Gl + t4) = *(const f32x4*)src; }
        auto issue_chunk = [&](int ch) {
            ldsp buf = lds + (ch & 1) * 65536;
#pragma unroll
            for (int j = 0; j < 8; ++j) { const int i = wave + 8 * j, r2 = 2 * i + (lane >> 5), lc = (lane & 31) ^ (r2 & 15);
                glds16((const char*)rwt + (size_t)r2 * 2048 + (size_t)ch * 512 + lc * 16, buf + i * 1024); }
        };
        issue_chunk(0);
        float ss = 0.f;
#pragma unroll 8
        for (int s = 0; s < 32; ++s) { const u32x4 xb = *(const u32x4*)(xr + 32 * s);
            const float e0 = bf_lo(xb.x), e1 = bf_hi(xb.x), e2 = bf_lo(xb.y), e3 = bf_hi(xb.y), e4 = bf_lo(xb.z), e5 = bf_hi(xb.z), e6 = bf_lo(xb.w), e7 = bf_hi(xb.w);
            ss += e0 * e0 + e1 * e1 + e2 * e2 + e3 * e3 + e4 * e4 + e5 * e5 + e6 * e6 + e7 * e7; }
        ss += __shfl_xor(ss, 16); ss += __shfl_xor(ss, 32);
        const float rstd = rsqrtf(ss * (1.f / D) + 1e-6f);
        f32x4 acc[4];
#pragma unroll
        for (int et = 0; et < 4; ++et) acc[et] = (f32x4){0.f, 0.f, 0.f, 0.f};
        u32x4 xc[8], xn[8];
#pragma unroll
        for (int i = 0; i < 8; ++i) xc[i] = *(const u32x4*)(xr + 32 * i);
        for (int ch = 0; ch < 4; ++ch) {
            if (ch == 0) wait_vm<0>(); else wait_vm<8>();
            LDS_WAIT();
            BAR();
            if (ch + 1 < 4) issue_chunk(ch + 1);
#pragma unroll
            for (int i = 0; i < 8; ++i) xn[i] = *(const u32x4*)(xr + 256 * ((ch + 1) & 3) + 32 * i);
            ldsp buf = lds + (ch & 1) * 65536;
#pragma unroll
            for (int sl = 0; sl < 8; ++sl) {
                const int s = 8 * ch + sl;
                const u32x4 xb = xc[sl];
                const f32x4 x0 = {bf_lo(xb.x), bf_hi(xb.x), bf_lo(xb.y), bf_hi(xb.y)}, x1 = {bf_lo(xb.z), bf_hi(xb.z), bf_lo(xb.w), bf_hi(xb.w)};
                const f32x4 g0 = *(LAS f32x4*)(Gl + 32 * s + 8 * fq), g1 = *(LAS f32x4*)(Gl + 32 * s + 8 * fq + 4), s0 = *(LAS f32x4*)(SHl + 32 * s + 8 * fq), s1 = *(LAS f32x4*)(SHl + 32 * s + 8 * fq + 4);
                const f32x4 h0 = x0 * rstd * g0 + s0, h1 = x1 * rstd * g1 + s1;
                u32x4 hi; hi.x = pk2(h0[0], h0[1]); hi.y = pk2(h0[2], h0[3]); hi.z = pk2(h1[0], h1[1]); hi.w = pk2(h1[2], h1[3]);
                *(u32x4*)(hrow + 32 * s) = hi;
                u32x4 lo; lo.x = pk2(h0[0] - bf_lo(hi.x), h0[1] - bf_hi(hi.x)); lo.y = pk2(h0[2] - bf_lo(hi.y), h0[3] - bf_hi(hi.y));
                lo.z = pk2(h1[0] - bf_lo(hi.z), h1[1] - bf_hi(hi.z)); lo.w = pk2(h1[2] - bf_lo(hi.w), h1[3] - bf_hi(hi.w));
                const bf16x8 ahi = __builtin_bit_cast(bf16x8, hi), alo = __builtin_bit_cast(bf16x8, lo);
                const int pc = (((4 * sl + fq) ^ fr) & 31) << 4;
#pragma unroll
                for (int et = 0; et < 4; ++et) {
                    const bf16x8 bh = *(LAS bf16x8*)(buf + (16 * et + fr) * 512 + pc), bl = *(LAS bf16x8*)(buf + (64 + 16 * et + fr) * 512 + pc);
                    acc[et] = __builtin_amdgcn_mfma_f32_16x16x32_bf16(ahi, bh, acc[et], 0, 0, 0);
                    acc[et] = __builtin_amdgcn_mfma_f32_16x16x32_bf16(ahi, bl, acc[et], 0, 0, 0);
                    acc[et] = __builtin_amdgcn_mfma_f32_16x16x32_bf16(alo, bh, acc[et], 0, 0, 0); }
            }
#pragma unroll
            for (int i = 0; i < 8; ++i) xc[i] = xn[i];
        }
        LDS_WAIT(); BAR();
#pragma unroll
        for (int et = 0; et < 4; ++et)
#pragma unroll
            for (int r = 0; r < 4; ++r) lg[(4 * fq + r) * 64 + 16 * et + fr] = acc[et][r];
        LDS_WAIT();
        int myc = 0;
        for (int tt = 0; tt < 16; ++tt) {
            const float logit = lg[tt * 64 + lane];
            const float score = 1.f / (1.f + __expf(-logit)), choice = score + rb;
            int rk = 0;
#pragma unroll
            for (int d = 1; d < 8; ++d) { const int oi = (lane + d) & 7; const float other = __shfl(choice, (lane & ~7) | oi); rk += (other > choice || (other == choice && oi < (lane & 7))) ? 1 : 0; }
            float gs = rk < 2 ? choice : 0.f;
            gs += __shfl_xor(gs, 1); gs += __shfl_xor(gs, 2); gs += __shfl_xor(gs, 4);
            int rg = 0;
#pragma unroll
            for (int j = 0; j < 8; ++j) { const float gj = __int_as_float(__builtin_amdgcn_readlane(__float_as_int(gs), 8 * j)); rg += (gj > gs || (gj == gs && j < (lane >> 3))) ? 1 : 0; }
            const float c2 = rg < 4 ? choice : -__builtin_inff();
            const unsigned ub = __float_as_uint(c2); unsigned key = (ub & 0x80000000u) ? ~ub : (ub | 0x80000000u); key = (key & ~63u) | (unsigned)(63 - lane);
            unsigned thr = 0u;
#pragma unroll
            for (int bit = 31; bit >= 0; --bit) { const unsigned cand = thr | (1u << bit); if (__popcll(__ballot(key >= cand)) >= 8) thr = cand; }
            const bool chosen = key >= thr;
            const unsigned long long cm = __ballot(chosen);
            const int r8 = __popcll(cm & ((1ull << lane) - 1ull));
            const float wsum = wave_sum(chosen ? score : 0.f);
            lg[tt * 64 + lane] = score / wsum * 2.5f;
            st2[tt * 64 + lane] = chosen ? ((myc << 8) | r8) : -1;
            myc += chosen ? 1 : 0;
        }
        const int chunk = (tile * 16) / CH_TOK;
        unsigned base = 0;
        if (!dry && myc > 0) base = atomicAdd(&cnt[chunk * 64 + lane], (unsigned)myc);
        if (dry) asm volatile("" :: "v"(myc));
        LDS_WAIT();
        for (int tt = 0; tt < 16; ++tt) {
            const int code = st2[tt * 64 + lane];
            if (!dry && code >= 0) { const int tok = tile * 16 + tt, r8 = code & 255; const unsigned pos = base + (unsigned)(code >> 8);
                sel_e[tok * 8 + r8] = lane; sel_w[tok * 8 + r8] = lg[tt * 64 + lane]; sel_p[tok * 8 + r8] = (int)pos;
                tokl[(size_t)(chunk * 64 + lane) * CH_TOK + pos] = tok; }
        }
        LDS_WAIT();
    }
}

__device__ __forceinline__ void build_tstart(const unsigned* cnt, int c, LAS int* ts) {
    const int l = fresh_tid();
    if (l < 64) {
        const int n = ((int)cnt[c * 64 + l] + MTILE - 1) / MTILE; int incl = n;
#pragma unroll
        for (int o = 1; o < 64; o <<= 1) { const int v = __builtin_amdgcn_ds_bpermute((l >= o ? l - o : l) << 2, incl); if (l >= o) incl += v; }
        ts[l] = incl - n; if (l == 63) { ts[64] = incl; ts[65] = incl + CH_TOK / MTILE; }
    }
}
struct MoeUpSrc {
    using Epi = EpiSwiGLU;
    const unsigned char* ws; const unsigned* cnt; int c; const LAS int* ts; int total, vcu;
    template <int LA> __device__ __forceinline__ bool setup(int i, const char*& bA, unsigned (&oA)[LA], const char*& bB, Epi& e, int& n0, int wid, int lane) const {
        const int Lt = vcu + GRID * i; if (Lt >= total) return false;
        const int mt = Lt >> 1, nt = Lt & 1;
        int ex = 0;
#pragma unroll
        for (int stp = 64; stp >= 1; stp >>= 1) if (ex + stp <= 64 && ts[ex + stp] <= mt) ex += stp;
        const int ml = mt - ts[ex];
        const bf16_t* Bt = ex < 64 ? (const bf16_t*)(ws + WS_W13) + (size_t)ex * 512 * D : (const bf16_t*)(ws + WS_WS13);
        const int* list = (const int*)(ws + WS_TOKL) + (size_t)(c * 64 + (ex & 63)) * CH_TOK; const int n = ex < 64 ? (int)cnt[c * 64 + ex] : 0;
#pragma unroll
        for (int j = 0; j < LA; ++j) { const int row = stage_row(wid, j, lane), g = ml * MTILE + row;
            const int tok = ex < 64 ? (g < n ? list[g] : c * CH_TOK) : c * CH_TOK + g;
            oA[j] = (unsigned)tok * (unsigned)(D * 2) + (unsigned)stage_chunk(row, lane); }
        bA = (const char*)(ws + WS_H); bB = (const char*)(Bt + (size_t)(nt * 256) * D);
        e = EpiSwiGLU{(bf16_t*)(ws + WS_ACT), mt * MTILE}; n0 = nt * 256; return true;
    }
    static constexpr size_t ldb = D;
};
struct MoeUpX {
    static constexpr int K = D, LDA = D; static constexpr bool GATHER = true;
    const unsigned char* ws; const unsigned* cnt; int c; const LAS int* ts; int total, vcu;
    __device__ __forceinline__ bool next(int i, pg8::UnitX& u) const {
        const int Lt = vcu + GRID * i; if (Lt >= total) return false;
        const int mt = Lt >> 1, nt = Lt & 1;
        int ex = 0;
#pragma unroll
        for (int stp = 64; stp >= 1; stp >>= 1) if (ex + stp <= 64 && ts[ex + stp] <= mt) ex += stp;
        const bf16_t* Bt = ex < 64 ? (const bf16_t*)(ws + WS_W13) + (size_t)ex * 512 * D : (const bf16_t*)(ws + WS_WS13);
        u.pm = mt; u.pn = nt; u.aBase = (const char*)(ws + WS_H); u.bBase = (const char*)(Bt + (size_t)(nt * 256) * D);
        u.list = ex < 64 ? (const int*)(ws + WS_TOKL) + (size_t)(c * 64 + ex) * CH_TOK : nullptr; u.cnt = ex < 64 ? (int)cnt[c * 64 + ex] : 0;
        u.r0 = (mt - ts[ex]) * MTILE; u.dummy = c * CH_TOK; return true;
    }
};
__device__ __forceinline__ void moe_up_phase(ldsp lds, const unsigned char* ws, const unsigned* cnt, int c, const LAS int* ts) {
    MoeUpX src{ws, cnt, c, ts, ts[65] * 2, vcu_of_block()};
    pg8::gemm_phase_x(lds, src, pg8::EpiSwiGLUx{(bf16_t*)(ws + WS_ACT)});
}
struct MoeDownSrc {
    using Epi = EpiStoreBf16;
    const unsigned char* ws; const LAS int* ts; int total, vcu;
    template <int LA> __device__ __forceinline__ bool setup(int i, const char*& bA, unsigned (&oA)[LA], const char*& bB, Epi& e, int& n0, int wid, int lane) const {
        const int Lt = vcu + GRID * i; if (Lt >= total) return false;
        const int mt = Lt >> 2, nt = Lt & 3;
        int ex = 0;
#pragma unroll
        for (int stp = 64; stp >= 1; stp >>= 1) if (ex + stp <= 64 && ts[ex + stp] <= mt) ex += stp;
        const bf16_t* act = (const bf16_t*)(ws + WS_ACT);
        const bf16_t* w2 = ex < 64 ? (const bf16_t*)(ws + WS_W2) + (size_t)ex * D * 256 : (const bf16_t*)(ws + WS_WS2);
#pragma unroll
        for (int j = 0; j < LA; ++j) { const int row = stage_row(wid, j, lane); oA[j] = (unsigned)(row * 512 + stage_chunk(row, lane)); }
        bA = (const char*)(act + (size_t)(mt * MTILE) * 256); bB = (const char*)(w2 + (size_t)(nt * 256) * 256);
        e = EpiStoreBf16{(bf16_t*)(ws + WS_YS), (size_t)D, mt * MTILE}; n0 = nt * 256; return true;
    }
    static constexpr size_t ldb = 256;
};
struct MoeDownX {
    static constexpr int K = 256, LDA = 256; static constexpr bool GATHER = false;
    const unsigned char* ws; const LAS int* ts; int total, vcu;
    __device__ __forceinline__ bool next(int i, pg8::UnitX& u) const {
        const int Lt = vcu + GRID * i; if (Lt >= total) return false;
        const int mt = Lt >> 2, nt = Lt & 3;
        int ex = 0;
#pragma unroll
        for (int stp = 64; stp >= 1; stp >>= 1) if (ex + stp <= 64 && ts[ex + stp] <= mt) ex += stp;
        const bf16_t* w2 = ex < 64 ? (const bf16_t*)(ws + WS_W2) + (size_t)ex * D * 256 : (const bf16_t*)(ws + WS_WS2);
        u.pm = mt; u.pn = nt; u.aBase = (const char*)((const bf16_t*)(ws + WS_ACT) + (size_t)(mt * MTILE) * 256); u.bBase = (const char*)(w2 + (size_t)(nt * 256) * 256);
        u.list = nullptr; u.cnt = 0; u.r0 = 0; u.dummy = 0; return true;
    }
};
__device__ __forceinline__ void moe_down_phase(ldsp lds, const unsigned char* ws, const LAS int* ts) {
    MoeDownX src{ws, ts, ts[65] * 4, vcu_of_block()};
    pg8::gemm_phase_x(lds, src, pg8::EpiYx{(unsigned char*)(ws + WS_YS)});
}
__device__ __forceinline__ void moe_combine_phase(const unsigned char* ws, float* OUT, bf16_t* XRBp, int c, const LAS int* ts, const float* gate_f  , bool last_layer,
                                                  const float* mod_sh_next, const float* mod_G_next, bf16_t* H, const float* fnorm, int gw, int ngw, int lane, bool dry) {
    const unsigned char* ys = ws + WS_YS; const int* sel_e = (const int*)(ws + WS_SELE); const float* sel_w = (const float*)(ws + WS_SELW); const int* sel_p = (const int*)(ws + WS_SELP);
    int slot[9]; float wk[9];
    auto selload = [&](int tl, int (&sl)[9], float (&ww)[9]) { const int tok = c * CH_TOK + tl;
#pragma unroll
        for (int k = 0; k < 8; ++k) { const int e = sel_e[tok * 8 + k]; sl[k] = ts[e] * MTILE + sel_p[tok * 8 + k]; ww[k] = sel_w[tok * 8 + k]; }
        sl[8] = ts[64] * MTILE + tl; ww[8] = 1.f; };
    if (gw < CH_TOK) selload(gw, slot, wk);
    for (int tl = gw; tl < CH_TOK; tl += ngw) {
        const int tok = c * CH_TOK + tl; const int b = tok >> 11;
        u32x2 yv[9][2];
#pragma unroll
        for (int k = 0; k < 9; ++k) { const unsigned char* yr = ys + (size_t)slot[k] * D; yv[k][0] = *(const u32x2*)(yr + 8 * lane); yv[k][1] = *(const u32x2*)(yr + 8 * lane + 512); }
        int nslot[9]; float nwk[9];
        if (tl + ngw < CH_TOK) selload(tl + ngw, nslot, nwk);
        else {
#pragma unroll
            for (int k = 0; k < 9; ++k) { nslot[k] = 0; nwk[k] = 0.f; } }
        float acc[16];
#pragma unroll
        for (int i = 0; i < 16; ++i) acc[i] = 0.f;
#pragma unroll
        for (int k = 0; k < 9; ++k) { const float w = wk[k];
#pragma unroll
            for (int j = 0; j < 2; ++j) { const u32x2 v = yv[k][j];
                const f32x2 p0 = __builtin_amdgcn_cvt_pk_f32_fp8((int)v.x, false), p1 = __builtin_amdgcn_cvt_pk_f32_fp8((int)v.x, true);
                const f32x2 p2 = __builtin_amdgcn_cvt_pk_f32_fp8((int)v.y, false), p3 = __builtin_amdgcn_cvt_pk_f32_fp8((int)v.y, true);
                acc[8 * j + 0] += w * p0[0]; acc[8 * j + 1] += w * p0[1]; acc[8 * j + 2] += w * p1[0]; acc[8 * j + 3] += w * p1[1];
                acc[8 * j + 4] += w * p2[0]; acc[8 * j + 5] += w * p2[1]; acc[8 * j + 6] += w * p3[0]; acc[8 * j + 7] += w * p3[1]; } }
#pragma unroll
        for (int k = 0; k < 9; ++k) { slot[k] = nslot[k]; wk[k] = nwk[k]; }
        float* xr = OUT + (size_t)tok * D; bf16_t* xb = XRBp + (size_t)tok * XRB_LD + XRB_OFF; const float* gf = gate_f + (size_t)b * 6144; float ss = 0.f; float xn[16];
#pragma unroll
        for (int j = 0; j < 2; ++j) { const u32x4 xw = *(const u32x4*)(xb + 8 * lane + 512 * j);
            const float xf[8] = {bf_lo(xw.x), bf_hi(xw.x), bf_lo(xw.y), bf_hi(xw.y), bf_lo(xw.z), bf_hi(xw.z), bf_lo(xw.w), bf_hi(xw.w)};
#pragma unroll
            for (int q = 0; q < 2; ++q) { const int col = 8 * lane + 512 * j + 4 * q; const f32x4 gv = *(const f32x4*)(gf + col);
#pragma unroll
                for (int e = 0; e < 4; ++e) { const float v = xf[4 * q + e] + gv[e] * acc[8 * j + 4 * q + e]; xn[8 * j + 4 * q + e] = v; ss += v * v; } } }
        const float rstd = rsqrtf(wave_sum(ss) * (1.f / D) + 1e-6f);
        if (last_layer) {
#pragma unroll
            for (int j = 0; j < 2; ++j)
#pragma unroll
                for (int q = 0; q < 2; ++q) { const int col = 8 * lane + 512 * j + 4 * q; const f32x4 g = *(const f32x4*)(fnorm + col); f32x4 ov;
#pragma unroll
                    for (int e = 0; e < 4; ++e) ov[e] = xn[8 * j + 4 * q + e] * rstd * g[e];
                    if (!dry) *(f32x4*)(xr + col) = ov; else asm volatile("" :: "v"(ov)); }
        } else {
            const float* sh = mod_sh_next + (size_t)b * 6144; const float* Gn = mod_G_next + (size_t)b * 6144; bf16_t* hrow = H + (size_t)tok * D;
#pragma unroll
            for (int j = 0; j < 2; ++j) { u32x4 hw, xw2;
#pragma unroll
                for (int q = 0; q < 2; ++q) { const int col = 8 * lane + 512 * j + 4 * q; const f32x4 g = *(const f32x4*)(Gn + col), s0 = *(const f32x4*)(sh + col); f32x4 xv, hv;
#pragma unroll
                    for (int e = 0; e < 4; ++e) { xv[e] = xn[8 * j + 4 * q + e]; hv[e] = xv[e] * rstd * g[e] + s0[e]; }
                    if (q == 0) { hw.x = pk2(hv[0], hv[1]); hw.y = pk2(hv[2], hv[3]); xw2.x = pk2(xv[0], xv[1]); xw2.y = pk2(xv[2], xv[3]); }
                    else { hw.z = pk2(hv[0], hv[1]); hw.w = pk2(hv[2], hv[3]); xw2.z = pk2(xv[0], xv[1]); xw2.w = pk2(xv[2], xv[3]); } }
                if (!dry) { *(u32x4*)(hrow + 8 * lane + 512 * j) = hw; *(u32x4*)(xb + 8 * lane + 512 * j) = xw2; } else asm volatile("" :: "v"(hw), "v"(xw2)); }
        }
    }
}

struct PSrc {
    using Epi = EpiCausalP;
    const bf16_t* rp; bf16_t* P;
    template <int LA> __device__ __forceinline__ bool setup(int i, const char*& bA, unsigned (&oA)[LA], const char*& bB, Epi& e, int& n0, int wid, int lane) const {
        const int u = blockIdx.x + GRID * i; if (u >= 1024) return false;
        const int bh = u >> 4, c = u & 15, b = bh >> 2, h = bh & 3;
        const bf16_t* qa = rp + ((size_t)b * SEQ + c * 128) * 6144 + h * 256;
#pragma unroll
        for (int j = 0; j < LA; ++j) { const int row = stage_row(wid, j, lane); oA[j] = (unsigned)(row * 6144 * 2 + stage_chunk(row, lane)); }
        bA = (const char*)qa; bB = (const char*)(qa + 1024);
        e = EpiCausalP{P + (size_t)u * 16384}; n0 = 0; return true;
    }
    static constexpr size_t ldb = 6144;
};
#define TIC(cat) do { if (TIME_SEL >= 0 && blockIdx.x == 0 && threadIdx.x == 0) { const unsigned long long now_ = __builtin_amdgcn_s_memrealtime(); LAS unsigned long long* tb_ = (LAS unsigned long long*)(lds + LDS_MISC + 1024); if ((cat) == TIME_SEL) tb_[1] += now_ - tb_[0]; tb_[0] = now_; } } while (0)
#define FRESH_IDS() const int t_ = fresh_tid(); const int lane = t_ & 63, wave = __builtin_amdgcn_readfirstlane(t_ >> 6); const int gw = blockIdx.x * NWAVE + wave, ngw = GRID * NWAVE; (void)lane; (void)gw; (void)ngw
#define SEAM(cat) do { xcd_barrier(bar); TIC(cat); } while (0)
#define OUTPROJ_ROUTER(layer_, A_, lda_, Bt_, ldb_, K_, mk_, cat_) do { \
    pg8::dense(lds, A_, (int)(lda_), Bt_, T, D, K_, mk_); \
    SEAM(cat_); \
    { const float* modl_ = (const float*)(ws + WS_MOD) + (size_t)(layer_) * 16 * 6144; const int m0_ = vcu_of_block() * 128; FRESH_IDS(); \
      router_phase(lds, XRB, modl_ + 3072, modl_ + 4096, (const bf16_t*)(ws + WS_RWT) + (size_t)(layer_) * 2 * 64 * 1024, a.in[I_ROUTB] + (layer_) * 64, \
                   (bf16_t*)(ws + WS_H), (int*)(ws + WS_SELE), (float*)(ws + WS_SELW), (int*)(ws + WS_SELP), (int*)(ws + WS_TOKL), (unsigned*)(ws + WS_CNT) + (layer_) * 256, \
                   m0_ / 16 + wave, m0_ / 16 + wave + 1, 1, wave, lane, false); } \
  } while (0)
__device__ __forceinline__ void moe_layer(const Args& a, ldsp lds, const XcdBarrier& bar, int layer) {
    unsigned char* ws = a.ws;
    float* mod = (float*)(ws + WS_MOD); float* XR = a.out; bf16_t* XRB = (bf16_t*)a.out; bf16_t* H = (bf16_t*)(ws + WS_H);
    const float* modl = mod + (size_t)layer * 16 * 6144;
    const float* modn = mod + (size_t)16 * 6144;
    unsigned* cl = (unsigned*)(ws + WS_CNT) + layer * 256;
    LAS int* ts0 = (LAS int*)(lds + LDS_MISC); LAS int* ts1 = ts0 + 80;
    for (int c = 0; c <= NCHUNK; ++c) {
        __syncthreads();
        if (c < NCHUNK) build_tstart(cl, c, ts0);
        if (c > 0) build_tstart(cl, c - 1, ts1);
        __syncthreads();
        const bool comb_first = (blockIdx.x & 8) != 0;
        if (c > 0 && comb_first) { FRESH_IDS(); moe_combine_phase(ws, XR, XRB, c - 1, ts1, modl + 5120, layer == 1, modn, modn + 1024, H, a.in[I_FNORM], gw, ngw, lane, false); }
        if (c < NCHUNK) moe_up_phase(lds, ws, cl, c, ts0);
        if (c > 0 && !comb_first) { FRESH_IDS(); moe_combine_phase(ws, XR, XRB, c - 1, ts1, modl + 5120, layer == 1, modn, modn + 1024, H, a.in[I_FNORM], gw, ngw, lane, false); }
        if (c == NCHUNK) break;
        SEAM(6);
        moe_down_phase(lds, ws, ts0);
        SEAM(7);
    }
}
__global__ void __launch_bounds__(NTHR, 2) fwd_kernel(Args a) {
    extern __shared__ __attribute__((aligned(16))) unsigned char lds_raw[];
    ldsp lds = (ldsp)lds_raw;
    unsigned char* ws = a.ws;
    volatile LAS unsigned* st = (volatile LAS unsigned*)(lds + LDS_BYTES - 16);
    if (threadIdx.x < 4) st[threadIdx.x] = 0u;
    if (TIME_SEL >= 0 && threadIdx.x == 0) { LAS unsigned long long* tb_ = (LAS unsigned long long*)(lds + LDS_MISC + 1024); tb_[0] = __builtin_amdgcn_s_memrealtime(); tb_[1] = 0ull; }
    __syncthreads();
    XcdBarrier bar = xcd_barrier_post((unsigned*)(ws + WS_BAR), st);
    float* mod = (float*)(ws + WS_MOD);
    float* XR = a.out; bf16_t* XRB = (bf16_t*)a.out;
    bf16_t* H = (bf16_t*)(ws + WS_H);

    mod_items(a, lds);
    __syncthreads();
    { FRESH_IDS(); convert_dense_weights(a, lds, gw, ngw, wave, lane); }
    SEAM(0);
    { FRESH_IDS(); adaln_phase(a.in[I_X], mod, mod + 1024, H, gw, ngw, lane); }
    { FRESH_IDS();
      bf16_t* rwt = (bf16_t*)(ws + WS_RWT);
      for (int idx = blockIdx.x * NTHR + t_; idx < 2 * D * 64; idx += GRID * NTHR) { const int l2 = idx >> 16, k = (idx >> 6) & 1023, e = idx & 63;
          const float w = a.in[I_ROUTW][idx]; const unsigned hi = pk2(w, 0.f) & 0xffffu; const unsigned lo = pk2(w - bf_lo(hi), 0.f) & 0xffffu;
          rwt[((size_t)(l2 * 2 + 0) * 64 + e) * 1024 + k] = (bf16_t)hi; rwt[((size_t)(l2 * 2 + 1) * 64 + e) * 1024 + k] = (bf16_t)lo; } }
    SEAM(1);

    { const bool conv_first = (blockIdx.x & 8) != 0;
      if (conv_first) { FRESH_IDS(); convert_expert_weights(a, 0, lds, gw, ngw, wave, lane); __syncthreads(); }
      pg8::dense(lds, H, D, (const bf16_t*)(ws + WS_WQKV), T, 3072, D, pg8::EpiBf16{(bf16_t*)(ws + WS_QKV), (size_t)3072});
      if (!conv_first) { __syncthreads(); FRESH_IDS(); convert_expert_weights(a, 0, lds, gw, ngw, wave, lane); } }
    SEAM(2);
    { float d1 = 0.f, d2 = 0.f;
      for (int i = 0; i < 64; ++i) { d1 += a.in[I_LQ1][i] * a.in[I_LK1][i]; d2 += a.in[I_LQ2][i] * a.in[I_LK2][i]; }
      const float lam = __expf(d1) - __expf(d2) + 0.2f;
      attn_phase(lds, (const bf16_t*)(ws + WS_QKV), (bf16_t*)(ws + WS_AO), lam, a.in[I_SUBLN]); }
    SEAM(3);
    { const pg8::EpiRes<true> mk{a.in[I_X], XRB, mod + 2048};
      OUTPROJ_ROUTER(0, (const bf16_t*)(ws + WS_AO), D, (const bf16_t*)(ws + WS_WO), D, D, mk, 4); }
    SEAM(5);
    moe_layer(a, lds, bar, 0);
    SEAM(6);

    const float* mod1 = mod + (size_t)16 * 6144;
    { const bool conv_first = (blockIdx.x & 8) != 0;
      if (conv_first) { FRESH_IDS(); convert_expert_weights(a, 1, lds, gw, ngw, wave, lane); __syncthreads(); }
      pg8::dense(lds, H, D, (const bf16_t*)(ws + WS_WRI), T, 6144, D, pg8::EpiRet{(bf16_t*)(ws + WS_RP)});
      if (!conv_first) { __syncthreads(); FRESH_IDS(); convert_expert_weights(a, 1, lds, gw, ngw, wave, lane); } }
    SEAM(8);
    { PSrc src{(const bf16_t*)(ws + WS_RP), (bf16_t*)(ws + WS_P)};
      gemm_stream<2, 4, 4, 2, 3>(lds, 256, src); }
    SEAM(9);
    chain_phase(lds, (bf16_t*)(ws + WS_RP), (const bf16_t*)(ws + WS_P), false);
    SEAM(10);
    { FRESH_IDS(); gnorm_phase((bf16_t*)(ws + WS_RP), a.in[I_RGN], gw, ngw, lane, false); }
    SEAM(11);
    { const pg8::EpiRes<false> mk{XRB, XRB, mod1 + 2048};
      OUTPROJ_ROUTER(1, (const bf16_t*)(ws + WS_RP) + 2048, 6144, (const bf16_t*)(ws + WS_WRO), 2048, 2048, mk, 12); }
    SEAM(5);
    moe_layer(a, lds, bar, 1);
    if (TIME_SEL >= 0) {
        __syncthreads(); TIC(6);
        if (blockIdx.x == 0 && threadIdx.x == 0) { LAS unsigned long long* tb_ = (LAS unsigned long long*)(lds + LDS_MISC + 1024); const unsigned long long t0 = __builtin_amdgcn_s_memrealtime();
            while (__builtin_amdgcn_s_memrealtime() - t0 < tb_[1]) __builtin_amdgcn_s_sleep(8); }
    }
}

extern "C" void kernel_launch(void* const* d_in, const int* in_sizes, int n_in, void* d_out, int out_size, void* d_ws, size_t ws_size, hipStream_t stream) {
    static int ready = 0;
    if (ready == 0) {
        if (n_in != 25 || out_size != T * D || ws_size < WS_END) { fprintf(stderr, "kernel_launch: unexpected shapes (n_in %d out %d ws %zu need %zu)\n", n_in, out_size, ws_size, (size_t)WS_END); ready = -1; return; }
        (void)hipFuncSetAttribute((const void*)fwd_kernel, hipFuncAttributeMaxDynamicSharedMemorySize, LDS_BYTES);
        ready = 1;
    }
    if (ready < 0) return;
    (void)hipMemsetAsync(d_ws, 0, 65536, stream);
    Args a{};
    for (int i = 0; i < 25; ++i) a.in[i] = (const float*)d_in[i];
    a.out = (float*)d_out; a.ws = (unsigned char*)d_ws;
    hipLaunchKernelGGL(fwd_kernel, dim3(GRID), dim3(NTHR), LDS_BYTES, stream, a);
}
```

```cpp
#include <hip/hip_runtime.h>
#include <cstdio>
#include <cstdint>
#include <type_traits>

typedef unsigned short bf16_t;
typedef short bf16x8 __attribute__((ext_vector_type(8)));
typedef short bf16x4 __attribute__((ext_vector_type(4)));
typedef float f32x4 __attribute__((ext_vector_type(4)));
typedef float f32x2 __attribute__((ext_vector_type(2)));
typedef unsigned u32x4 __attribute__((ext_vector_type(4)));
typedef unsigned u32x2 __attribute__((ext_vector_type(2)));
#define LAS __attribute__((address_space(3)))
typedef LAS unsigned char* ldsp;

constexpr int T = 32768, D = 1024, NB = 16, SEQ = 2048;
constexpr int NTHR = 512, NWAVE = 8, GRID = 256;
constexpr int CH_TOK = 16384, NCHUNK = 2, MTILE = 256;
constexpr int SLOT_CAP = 163840;
constexpr float LOG2E = 1.4426950408889634f;
constexpr int XRB_LD = 2048, XRB_OFF = 1024;
#define TIME_SEL -1


constexpr size_t MiB = 1u << 20;
constexpr size_t WS_BAR = 0, WS_CNT = 16384, WS_RWT = 256 * 1024  , WS_MOD = 1 * MiB;
constexpr size_t WS_WQKV = 2 * MiB, WS_WO = 8 * MiB, WS_WRI = 10 * MiB, WS_WRO = 22 * MiB;
constexpr size_t WS_W13 = 26 * MiB, WS_W2 = 90 * MiB, WS_WS13 = 122 * MiB, WS_WS2 = 123 * MiB;
constexpr size_t WS_H = 124 * MiB, WS_P = WS_H;
constexpr size_t WS_BIG = 188 * MiB;
constexpr size_t WS_QKV = WS_BIG, WS_AO = WS_BIG + 192 * MiB;
constexpr size_t WS_RP = WS_BIG;
constexpr size_t WS_SELE = WS_BIG, WS_SELW = WS_BIG + 1 * MiB, WS_SELP = WS_BIG + 2 * MiB, WS_TOKL = WS_BIG + 4 * MiB;
constexpr size_t WS_ACT = WS_BIG + 12 * MiB  , WS_YS = WS_BIG + 92 * MiB  ;
constexpr size_t WS_END = WS_BIG + 412 * MiB;
constexpr int LDS_BYTES = 152 * 1024, LDS_MISC = 144 * 1024;

#define XB_TMO      128
#define XB_XCNT(j)  (256  + 64 * (j))
#define XB_XSUB(j)  (1280 + 64 * (j))
#define XB_XGEN(j)  (2304 + 64 * (j))
#define XB_TOP      3328
#define XB_TOPGEN   3392
#define XCD_BAR_WORDS 3456
#define XB_SPIN_CAP (1u << 20)
__device__ __forceinline__ unsigned xb_ld(unsigned* p)              { return __hip_atomic_load(p, __ATOMIC_RELAXED, __HIP_MEMORY_SCOPE_AGENT); }
__device__ __forceinline__ unsigned xb_add(unsigned* p, unsigned v) { return __hip_atomic_fetch_add(p, v, __ATOMIC_RELAXED, __HIP_MEMORY_SCOPE_AGENT); }
__device__ __forceinline__ unsigned xb_xcc_id() { return (unsigned)__builtin_amdgcn_s_getreg((3 << 11) | 20) & 0xFu; }
#define XB_SPIN(cond, bar) do { unsigned _sp = 0; while (cond) { __builtin_amdgcn_s_sleep(1); \
    if ((++_sp & 255u) == 0u) { if (xb_ld(&(bar)[XB_TMO])) break; if (_sp > XB_SPIN_CAP) { atomicAdd(&(bar)[XB_TMO], 1u); break; } } } } while (0)
struct XcdBarrier { unsigned* bar; unsigned x; volatile LAS unsigned* st; };
__device__ __forceinline__ XcdBarrier xcd_barrier_post(unsigned* bar, volatile LAS unsigned* st) {
    XcdBarrier b; b.bar = bar; b.x = xb_xcc_id(); b.st = st;
    if (threadIdx.x == 0) (void)xb_add(&bar[XB_XCNT(b.x)], 1u);
    return b;
}
__device__ __forceinline__ void xcd_barrier_complete(unsigned* bar, unsigned x, unsigned& nloc, unsigned& nx) {
    const unsigned G = gridDim.x * gridDim.y * gridDim.z;
    unsigned sum, cnt, mine, sp = 0u;
    for (;;) {
        sum = 0u; cnt = 0u; mine = 0u;
#pragma unroll
        for (unsigned j = 0; j < 16; ++j) { const unsigned c = xb_ld(&bar[XB_XCNT(j)]); sum += c; cnt += (c > 0u) ? 1u : 0u; mine = (j == x) ? c : mine; }
        if (sum == G) break;
        __builtin_amdgcn_s_sleep(1);
        if ((++sp & 255u) == 0u) { if (xb_ld(&bar[XB_TMO])) break; if (sp > XB_SPIN_CAP) { atomicAdd(&bar[XB_TMO], 1u); break; } }
    }
    nloc = mine > 0u ? mine : 1u; nx = cnt > 0u ? cnt : 1u;
}
__device__ __forceinline__ void xcd_barrier(const XcdBarrier& b) {
    asm volatile("s_waitcnt vmcnt(0)" ::: "memory");
    __syncthreads();
    if (threadIdx.x == 0) {
        unsigned* bar = b.bar; unsigned bx = b.x;
        asm volatile("" : "+s"(bar), "+s"(bx));
        __builtin_amdgcn_s_waitcnt(0);
        unsigned nloc = b.st[0], nx = b.st[1];
        if (nloc == 0u) { xcd_barrier_complete(bar, bx, nloc, nx); b.st[0] = nloc; b.st[1] = nx; }
        const unsigned old = xb_add(&bar[XB_XSUB(bx)], 1u);
        const unsigned gen = old / nloc;
        if (old + 1u == (gen + 1u) * nloc) {
            __builtin_amdgcn_fence(__ATOMIC_RELEASE, "agent");
            asm volatile("s_waitcnt vmcnt(0)" ::: "memory");
            const unsigned og = xb_add(&bar[XB_TOP], 1u);
            const unsigned tg = og / nx;
            if (og + 1u == (tg + 1u) * nx) xb_add(&bar[XB_TOPGEN], 1u);
            else XB_SPIN(xb_ld(&bar[XB_TOPGEN]) == tg, bar);
            __builtin_amdgcn_fence(__ATOMIC_ACQUIRE, "agent");
            xb_add(&bar[XB_XGEN(bx)], 1u);
            asm volatile("s_waitcnt vmcnt(0)" ::: "memory");
        } else {
            XB_SPIN(xb_ld(&bar[XB_XGEN(bx)]) == gen, bar);
            __builtin_amdgcn_fence(__ATOMIC_ACQUIRE, "agent");
            asm volatile("s_waitcnt vmcnt(0)" ::: "memory");
        }
    }
    __syncthreads();
}

template <int N> __device__ __forceinline__ void wait_vm() { asm volatile("s_waitcnt vmcnt(%0)" :: "n"(N) : "memory"); }
#define BAR() __builtin_amdgcn_s_barrier()
#define LDS_WAIT() asm volatile("s_waitcnt lgkmcnt(0)" ::: "memory")
__device__ __forceinline__ unsigned pk2(float a, float b) {
    typedef __bf16 bf2 __attribute__((ext_vector_type(2)));
    f32x2 v = {a, b}; bf2 r = __builtin_convertvector(v, bf2); return __builtin_bit_cast(unsigned, r);
}
__device__ __forceinline__ float bf_lo(unsigned u) { return __uint_as_float(u << 16); }
__device__ __forceinline__ float bf_hi(unsigned u) { return __uint_as_float(u & 0xffff0000u); }
__device__ __forceinline__ float wave_sum(float v) {
#pragma unroll
    for (int o = 1; o < 64; o <<= 1) v += __shfl_xor(v, o);
    return v;
}
__device__ __forceinline__ float fast_exp2(float x) { return __builtin_amdgcn_exp2f(x); }
__device__ __forceinline__ float silu_f(float v) { return v / (1.f + __expf(-v)); }
__device__ __forceinline__ void glds16(const void* src, ldsp dst) {
    unsigned keep; const unsigned d = (unsigned)(__SIZE_TYPE__)dst;
    asm volatile("s_mov_b32 %0, m0\n\ts_mov_b32 m0, %2\n\ts_nop 0\n\tglobal_load_lds_dwordx4 %1, off\n\ts_mov_b32 m0, %0" : "=&s"(keep) : "v"(src), "s"(d) : "memory");
}
__device__ __forceinline__ bf16x8 tr2(ldsp a0, ldsp a1) {
    const bf16x4 t0 = __builtin_amdgcn_ds_read_tr16_b64_v4i16((LAS bf16x4*)a0);
    const bf16x4 t1 = __builtin_amdgcn_ds_read_tr16_b64_v4i16((LAS bf16x4*)a1);
    return __builtin_shufflevector(t0, t1, 0, 1, 2, 3, 4, 5, 6, 7);
}
__device__ __forceinline__ bf16x8 rd2x64(ldsp a0, ldsp a1) {
    const bf16x4 t0 = *(LAS bf16x4*)a0; const bf16x4 t1 = *(LAS bf16x4*)a1;
    return __builtin_shufflevector(t0, t1, 0, 1, 2, 3, 4, 5, 6, 7);
}
__device__ __forceinline__ int fresh_tid() { int t = threadIdx.x; asm volatile("" : "+v"(t)); return t; }
__device__ __forceinline__ int vcu_of_block() { const int bx = blockIdx.x; return (bx & 7) * (GRID / 8) + (bx >> 3); }

struct Args {
    const float* in[25];
    float* out; unsigned char* ws;
};
enum { I_X = 0, I_C, I_NMIX, I_NFFN, I_ADAW, I_ADAB, I_DAWIN, I_DAWOUT, I_LQ1, I_LK1, I_LQ2, I_LK2, I_SUBLN, I_RWIN, I_RWOUT, I_RGN,
       I_ROUTW, I_ROUTB, I_EW1, I_EW3, I_EW2, I_SW1, I_SW3, I_SW2, I_FNORM };

template <int WM, int WN, int MT, int NT, int NSTAGE, class Src>
__device__ __forceinline__ void gemm_stream(ldsp lds, int K, const Src& src) {
    constexpr int BM = WM * MT * 16, BN = WN * NT * 16, STAGE = (BM + BN) * 128, LA = BM / 64, LB = BN / 64, L = LA + LB, PD = NSTAGE - 1;
    static_assert(WM * WN == NWAVE && NSTAGE * STAGE <= LDS_MISC, "8 waves; ring fits");
    const int tid = fresh_tid(), lane = tid & 63, wid = __builtin_amdgcn_readfirstlane(tid >> 6);
    const int wr = wid / WN, wc = wid % WN, fr = lane & 15, fq = lane >> 4;
    const char* cbA; const char* cbB; const char* nbA; const char* nbB; unsigned cA[LA], nA[LA], oB[LB];
    typename Src::Epi ce, ne; int cn0 = 0, nn0 = 0;
    if (!src.template setup<LA>(0, cbA, cA, cbB, ce, cn0, wid, lane)) return;
#pragma unroll
    for (int j = 0; j < LB; ++j) { const int row = 8 * (wid + 8 * j) + (lane >> 3); oB[j] = (unsigned)(row * (int)src.ldb * 2 + (((lane & 7) ^ ((row >> 1) & 7)) << 4)); }
    const int swz = fr >> 1;
    const int aoff = (wr * MT * 16 + fr) * 128, boff = BM * 128 + (wc * NT * 16 + fr) * 128;
    const int ok0 = ((fq ^ swz) << 4), ok1 = (((4 + fq) ^ swz) << 4);
    auto issue = [&](int s, const char* bA, const unsigned (&oA)[LA], const char* bB, int t) {
        ldsp st = lds + s * STAGE;
#pragma unroll
        for (int j = 0; j < LA; ++j) glds16(bA + (size_t)t * 128 + oA[j], st + (wid + 8 * j) * 1024);
#pragma unroll
        for (int j = 0; j < LB; ++j) glds16(bB + (size_t)t * 128 + oB[j], st + BM * 128 + (wid + 8 * j) * 1024);
    };
    const int nt = K / 64;
    BAR();
#pragma unroll
    for (int d = 0; d < PD; ++d) issue(d, cbA, cA, cbB, d);
    int s = 0;
    for (int i = 0;; ++i) {
        const bool hasn = src.template setup<LA>(i + 1, nbA, nA, nbB, ne, nn0, wid, lane);
        f32x4 acc[MT][NT];
#pragma unroll
        for (int m = 0; m < MT; ++m)
#pragma unroll
            for (int n = 0; n < NT; ++n) acc[m][n] = (f32x4){0.f, 0.f, 0.f, 0.f};
        for (int t = 0; t < nt; ++t) {
            if (PD >= 2 && (hasn || t + 1 < nt)) wait_vm<(PD - 1) * L>(); else wait_vm<0>();
            BAR();
            { int s2 = s + PD; if (s2 >= NSTAGE) s2 -= NSTAGE;
              if (t + PD < nt) issue(s2, cbA, cA, cbB, t + PD); else if (hasn) issue(s2, nbA, nA, nbB, t + PD - nt); }
            ldsp st = lds + s * STAGE;
#pragma unroll
            for (int kk = 0; kk < 2; ++kk) {
                bf16x8 b[NT];
                const int ok = kk ? ok1 : ok0;
#pragma unroll
                for (int n = 0; n < NT; ++n) b[n] = *(LAS bf16x8*)(st + boff + n * 2048 + ok);
#pragma unroll
                for (int mh = 0; mh < MT; mh += 4) {
                    bf16x8 a[4];
#pragma unroll
                    for (int m = 0; m < 4; ++m) a[m] = *(LAS bf16x8*)(st + aoff + (mh + m) * 2048 + ok);
                    __builtin_amdgcn_s_setprio(1);
#pragma unroll
                    for (int m = 0; m < 4; ++m)
#pragma unroll
                        for (int n = 0; n < NT; ++n) acc[mh + m][n] = __builtin_amdgcn_mfma_f32_16x16x32_bf16(b[n], a[m], acc[mh + m][n], 0, 0, 0);
                    __builtin_amdgcn_s_setprio(0);
                    if (MT > 4) __builtin_amdgcn_sched_barrier(0);
                }
            }
            s = (s == NSTAGE - 1) ? 0 : s + 1;
        }
        ce(acc, wr * MT * 16, cn0 + wc * NT * 16, fr, fq);
        if (!hasn) break;
#pragma unroll
        for (int j = 0; j < LA; ++j) cA[j] = nA[j];
        cbA = nbA; cbB = nbB; ce = ne; cn0 = nn0;
    }
}
__device__ __forceinline__ int stage_row(int wid, int j, int lane) { return 8 * (wid + 8 * j) + (lane >> 3); }
__device__ __forceinline__ int stage_chunk(int row, int lane) { return ((lane & 7) ^ ((row >> 1) & 7)) * 16; }
__device__ __forceinline__ const char* uniform_ptr(const void* p) { unsigned long long v = (unsigned long long)p; const unsigned lo = __builtin_amdgcn_readfirstlane((unsigned)v), hi = __builtin_amdgcn_readfirstlane((unsigned)(v >> 32)); return (const char*)(((unsigned long long)hi << 32) | lo); }

template <int BM, int BN, class Mk> struct DenseSrc {
    using Epi = decltype(((Mk*)nullptr)->operator()(0));
    const bf16_t* A; size_t lda; const bf16_t* Bt; size_t ldb; int nN, per_x, xcd, local; const Mk& mk;
    __device__ __forceinline__ DenseSrc(const bf16_t* A_, size_t lda_, const bf16_t* Bt_, size_t ldb_, int M, int N, const Mk& mk_) : A(A_), lda(lda_), Bt(Bt_), ldb(ldb_), mk(mk_) {
        const int vcu = vcu_of_block(); nN = N / BN; per_x = (M / BM) / 8; xcd = vcu >> 5; local = vcu & 31; }
    template <int LA> __device__ __forceinline__ bool setup(int i, const char*& bA, unsigned (&oA)[LA], const char*& bB, Epi& e, int& n0, int wid, int lane) const {
        constexpr int GM = 4;
        const int q = local + 32 * i; if (q >= per_x * nN) return false;
        const int grp = q / (GM * nN), r = q % (GM * nN), m = xcd * per_x + grp * GM + (r % GM), n = r / GM;
#pragma unroll
        for (int j = 0; j < LA; ++j) { const int row = stage_row(wid, j, lane); oA[j] = (unsigned)(row * (int)lda * 2 + stage_chunk(row, lane)); }
        bA = (const char*)(A + (size_t)(m * BM) * lda); bB = (const char*)(Bt + (size_t)(n * BN) * ldb);
        e = mk(m * BM); n0 = n * BN; return true;
    }
};
template <int WM, int WN, int MT, int NT, int NSTAGE, class Mk>
__device__ __forceinline__ void gemm_dense_phase(ldsp lds, const bf16_t* A, size_t lda, const bf16_t* Bt, size_t ldb, int M, int N, int K, const Mk& mk) {
    DenseSrc<WM * MT * 16, WN * NT * 16, Mk> src(A, lda, Bt, ldb, M, N, mk);
    gemm_stream<WM, WN, MT, NT, NSTAGE>(lds, K, src);
}

struct EpiStoreBf16 {
    bf16_t* O; size_t ldc; int m0;
    template <int MT, int NT> __device__ __forceinline__ void operator()(const f32x4 (&acc)[MT][NT], int rb, int cb, int fr, int fq) const {
#pragma unroll
        for (int m = 0; m < MT; ++m) { bf16_t* rp = O + (size_t)(m0 + rb + m * 16 + fr) * ldc + cb + 4 * fq;
#pragma unroll
            for (int n = 0; n < NT; ++n) { u32x2 w; w.x = pk2(acc[m][n][0], acc[m][n][1]); w.y = pk2(acc[m][n][2], acc[m][n][3]); *(u32x2*)(rp + n * 16) = w; } }
    }
};
struct EpiResidual {
    const float* Xin; float* Xout; const float* gate; int m0;
    template <int MT, int NT> __device__ __forceinline__ void operator()(const f32x4 (&acc)[MT][NT], int rb, int cb, int fr, int fq) const {
#pragma unroll
        for (int m = 0; m < MT; ++m) { const int row = m0 + rb + m * 16 + fr; const float* g = gate + (size_t)(row >> 11) * 6144;
#pragma unroll
            for (int n = 0; n < NT; ++n) { const int col = cb + n * 16 + 4 * fq; const f32x4 xv = *(const f32x4*)(Xin + (size_t)row * D + col); const f32x4 gv = *(const f32x4*)(g + col);
                *(f32x4*)(Xout + (size_t)row * D + col) = xv + gv * acc[m][n]; } }
    }
};
struct EpiRetProj {
    bf16_t* O; int m0;
    template <int MT, int NT> __device__ __forceinline__ void operator()(const f32x4 (&acc)[MT][NT], int rb, int cb, int fr, int fq) const {
        float l2g = 0.f, pre = 1.f;
        if (cb < 2048) { const int h = (cb & 1023) >> 8; l2g = __log2f(1.f - exp2f(-5.f - (float)h)); if (cb >= 1024) { l2g = -l2g; pre = 0.0625f; } }
#pragma unroll
        for (int m = 0; m < MT; ++m) { const int row = m0 + rb + m * 16 + fr; const float sc = pre * exp2f(l2g * (float)(row & 127)); bf16_t* rp = O + (size_t)row * 6144 + cb + 4 * fq;
#pragma unroll
            for (int n = 0; n < NT; ++n) { u32x2 w; w.x = pk2(acc[m][n][0] * sc, acc[m][n][1] * sc); w.y = pk2(acc[m][n][2] * sc, acc[m][n][3] * sc); *(u32x2*)(rp + n * 16) = w; } }
    }
};
struct EpiCausalP {
    bf16_t* O;
    template <int MT, int NT> __device__ __forceinline__ void operator()(const f32x4 (&acc)[MT][NT], int rb, int cb, int fr, int fq) const {
#pragma unroll
        for (int m = 0; m < MT; ++m) { const int i = rb + m * 16 + fr; bf16_t* rp = O + (size_t)i * 128 + cb + 4 * fq;
#pragma unroll
            for (int n = 0; n < NT; ++n) { const int j = cb + n * 16 + 4 * fq; f32x4 v = acc[m][n];
                v[0] = (i >= j) ? v[0] : 0.f; v[1] = (i >= j + 1) ? v[1] : 0.f; v[2] = (i >= j + 2) ? v[2] : 0.f; v[3] = (i >= j + 3) ? v[3] : 0.f;
                u32x2 w; w.x = pk2(v[0], v[1]); w.y = pk2(v[2], v[3]); *(u32x2*)(rp + n * 16) = w; } }
    }
};
struct EpiSwiGLU {
    bf16_t* O; int slot0;
    template <int MT, int NT> __device__ __forceinline__ void operator()(const f32x4 (&acc)[MT][NT], int rb, int cb, int fr, int fq) const {
        static_assert(NT == 4, "NT");
#pragma unroll
        for (int m = 0; m < MT; ++m) { bf16_t* rp = O + (size_t)(slot0 + rb + m * 16 + fr) * 256 + (cb >> 1) + 4 * fq;
#pragma unroll
            for (int p = 0; p < 2; ++p) { const f32x4 a = acc[m][2 * p], b = acc[m][2 * p + 1]; u32x2 w;
                w.x = pk2(silu_f(a[0]) * b[0], silu_f(a[1]) * b[1]); w.y = pk2(silu_f(a[2]) * b[2], silu_f(a[3]) * b[3]); *(u32x2*)(rp + p * 16) = w; } }
    }
};

namespace pg8 {
constexpr int BM = 256, BK = 64, HALF = 128, HTB = HALF * BK * 2  , STAGE_BYTES = 8 * HTB, NXCD = 8, WGM = 8;
__device__ __forceinline__ int lds_byte(int r, int c) { const int st = (r >> 4) * 2 + (c >> 5), rr = r & 15, cc = c & 31, ob = rr * 64 + cc * 2; return st * 1024 + (ob ^ (((ob >> 9) & 1) << 5)); }
__device__ __forceinline__ void stage_rc(int b, int& R, int& C) { const int st = b / 1024, sb = b % 1024, swz = sb ^ (((sb >> 9) & 1) << 5); R = (st >> 1) * 16 + swz / 64; C = (st & 1) * 32 + (swz % 64) / 2; }
__device__ __forceinline__ int perm32(int rho) { const int n = rho >> 4, i = rho & 15; return 8 * (i >> 2) + 4 * n + (i & 3); }
struct Unit { int pm, pn; };
struct Gemm { const bf16_t* A; const bf16_t* Bt; int M, N, K, lda; };
struct StaticOrder {
    int nM, nN, nwg, G, c;
    __device__ void init(int M, int N, int G_, int c_) { nM = M / BM; nN = N / BM; nwg = nM * nN; G = G_; c = c_; }
    __device__ bool next(int i, Unit& u) const {
        const long L = (long)i * G + c; if (L >= nwg) return false;
        int wgid = (int)L; { const int q = nwg / NXCD, r = nwg % NXCD, xcd = wgid % NXCD, off = wgid / NXCD; wgid = (xcd < r ? xcd * (q + 1) : r * (q + 1) + (xcd - r) * q) + off; }
        const int nig = WGM * nN, gid = wgid / nig, fm = gid * WGM, gsz = (nM - fm) < WGM ? (nM - fm) : WGM;
        u.pm = fm + ((wgid % nig) % gsz); u.pn = (wgid % nig) / gsz; return true;
    }
};
template <class Epi, bool ALIGN_EPI = true>
__device__ __forceinline__ void gemm_phase(ldsp lds, const Gemm g, const StaticOrder& S, const Epi& E) {
    const int tid = fresh_tid(), wid = __builtin_amdgcn_readfirstlane(tid >> 6), lane = tid & 63, wr = wid >> 2, wc = wid & 3, fr = lane & 15, fq = lane >> 4;
    const int K = g.K, nt = K / BK;
    unsigned voffA[2], voffB[2];
#pragma unroll
    for (int i = 0; i < 2; ++i) { int R, C; stage_rc(tid * 16 + i * 8192, R, C); const int Rb = Epi::PERM ? ((R & ~31) + perm32(R & 31)) : R;
        voffA[i] = (unsigned)(R * g.lda + C) * 2u; voffB[i] = (unsigned)(Rb * K + C) * 2u; }
    const size_t kstep = (size_t)(BK * 2);
    const size_t hstepA = (size_t)HALF * g.lda * 2, hstepB = (size_t)HALF * K * 2;
    const size_t tstepA = 2 * hstepA, tstepB = 2 * hstepB;
    const unsigned ldsw = (unsigned)wid * 1024u;
    const int aoff = lds_byte(wr * 64 + fr, fq * 8), boff = lds_byte(wc * 32 + fr, fq * 8);
#define PG8_SA(b, h) (((b) * 2 + (h)) * HTB)
#define PG8_SB(b, h) ((4 + (b) * 2 + (h)) * HTB)
#define PG8_STAGE(bufoff, gbase, voff) do { _Pragma("unroll") for (int _i = 0; _i < 2; ++_i) glds16((const char*)(gbase) + (voff)[_i], lds + (bufoff) + ldsw + _i * 8192); } while (0)
#define PG8_LDA(dst, b, h) do { _Pragma("unroll") for (int m = 0; m < 4; ++m) _Pragma("unroll") for (int k = 0; k < 2; ++k) dst[m][k] = *(const LAS bf16x8*)(lds + PG8_SA(b, h) + aoff + m * 2048 + k * 1024); } while (0)
#define PG8_LDB(dst, b, h) do { _Pragma("unroll") for (int n = 0; n < 2; ++n) _Pragma("unroll") for (int k = 0; k < 2; ++k) dst[n][k] = *(const LAS bf16x8*)(lds + PG8_SB(b, h) + boff + n * 2048 + k * 1024); } while (0)
#define PG8_MMA(ai, bj, At, Bt) do { __builtin_amdgcn_s_setprio(1); _Pragma("unroll") for (int m = 0; m < 4; ++m) _Pragma("unroll") for (int n = 0; n < 2; ++n) _Pragma("unroll") for (int k = 0; k < 2; ++k) \
        acc[ai][bj][m][n] = __builtin_amdgcn_mfma_f32_16x16x32_bf16(Bt[n][k], At[m][k], acc[ai][bj][m][n], 0, 0, 0); __builtin_amdgcn_s_setprio(0); } while (0)
#define PG8_WAIT_V(n) asm volatile("s_waitcnt vmcnt(" #n ")" ::: "memory")
#define PG8_WAIT_L(n) asm volatile("s_waitcnt lgkmcnt(" #n ")" ::: "memory")
#define PG8_BAR __builtin_amdgcn_s_barrier()
#define PG8_SCHED __builtin_amdgcn_sched_barrier(0)
    Unit cur, nxt; int ui = 0;
    PG8_WAIT_V(0); PG8_BAR;
    if (!S.next(0, cur)) return;
    f32x4 acc[2][2][4][2];
#pragma unroll
    for (int a = 0; a < 2; ++a)
#pragma unroll
        for (int b = 0; b < 2; ++b)
#pragma unroll
            for (int m = 0; m < 4; ++m)
#pragma unroll
                for (int n = 0; n < 2; ++n) acc[a][b][m][n] = (f32x4){0.f, 0.f, 0.f, 0.f};
    bf16x8 At[4][2], B0[2][2], B1[2][2];
    const char* cA = (const char*)g.A + (size_t)cur.pm * tstepA; const char* cB = (const char*)g.Bt + (size_t)cur.pn * tstepB;
    PG8_STAGE(PG8_SB(0, 0), cB, voffB); PG8_STAGE(PG8_SB(0, 1), cB + hstepB, voffB); PG8_STAGE(PG8_SA(0, 0), cA, voffA); PG8_STAGE(PG8_SA(0, 1), cA + hstepA, voffA);
    if (wr == 1) PG8_BAR;
    PG8_WAIT_V(2); PG8_BAR;
    PG8_STAGE(PG8_SB(1, 0), cB + kstep, voffB); PG8_STAGE(PG8_SA(1, 0), cA + kstep, voffA); PG8_STAGE(PG8_SB(1, 1), cB + hstepB + kstep, voffB);
    PG8_WAIT_V(6); PG8_BAR;
    for (;;) {
        const bool has_next = S.next(ui + 1, nxt);
        const char* nA = has_next ? (const char*)g.A + (size_t)nxt.pm * tstepA : cA; const char* nB = has_next ? (const char*)g.Bt + (size_t)nxt.pn * tstepB : cB;
        for (int t = 0; t < nt; t += 2) {
            const bool last = (t == nt - 2);
            const char* a1 = cA + (size_t)(t + 1) * kstep;
            const char* a2 = last ? nA : cA + (size_t)(t + 2) * kstep; const char* b2 = last ? nB : cB + (size_t)(t + 2) * kstep;
            const char* a3 = a2 + kstep; const char* b3 = b2 + kstep;
            PG8_LDB(B0, 0, 0); PG8_LDB(B1, 0, 1); PG8_SCHED; PG8_LDA(At, 0, 0); PG8_STAGE(PG8_SA(1, 1), a1 + hstepA, voffA);
            PG8_WAIT_V(8); PG8_WAIT_L(0); PG8_BAR; PG8_MMA(0, 0, At, B0); PG8_MMA(0, 1, At, B1); PG8_BAR; PG8_SCHED;
            PG8_LDA(At, 0, 1); PG8_STAGE(PG8_SB(0, 0), b2, voffB); PG8_STAGE(PG8_SB(0, 1), b2 + hstepB, voffB); PG8_STAGE(PG8_SA(0, 0), a2, voffA);
            PG8_WAIT_V(8); PG8_WAIT_L(0); PG8_BAR; PG8_MMA(1, 0, At, B0); PG8_MMA(1, 1, At, B1); PG8_BAR; PG8_SCHED;
            PG8_LDB(B0, 1, 0); PG8_LDB(B1, 1, 1); PG8_SCHED; PG8_LDA(At, 1, 0); PG8_STAGE(PG8_SA(0, 1), a2 + hstepA, voffA);
            PG8_WAIT_V(8); PG8_WAIT_L(0); PG8_BAR; PG8_MMA(0, 0, At, B0); PG8_MMA(0, 1, At, B1); PG8_BAR; PG8_SCHED;
            PG8_LDA(At, 1, 1); PG8_STAGE(PG8_SB(1, 0), b3, voffB); PG8_STAGE(PG8_SB(1, 1), b3 + hstepB, voffB); PG8_STAGE(PG8_SA(1, 0), a3, voffA);
            PG8_WAIT_V(8); PG8_WAIT_L(0); PG8_BAR; PG8_MMA(1, 0, At, B0); PG8_MMA(1, 1, At, B1); PG8_BAR; PG8_SCHED;
        }
        if constexpr (ALIGN_EPI) { if (wr == 0) PG8_BAR; }
        E(acc, cur, wr, wc, fr, fq);
        if (!has_next) break;
#pragma unroll
        for (int a = 0; a < 2; ++a)
#pragma unroll
            for (int b = 0; b < 2; ++b)
#pragma unroll
                for (int m = 0; m < 4; ++m)
#pragma unroll
                    for (int n = 0; n < 2; ++n) acc[a][b][m][n] = (f32x4){0.f, 0.f, 0.f, 0.f};
        cur = nxt; cA = nA; cB = nB; ++ui;
        if constexpr (ALIGN_EPI) { if (wr == 1) PG8_BAR; }
    }
    PG8_WAIT_V(0);
    if constexpr (!ALIGN_EPI) { if (wr == 0) PG8_BAR; }
    PG8_BAR;
#undef PG8_SA
#undef PG8_SB
#undef PG8_STAGE
#undef PG8_LDA
#undef PG8_LDB
#undef PG8_MMA
#undef PG8_WAIT_V
#undef PG8_WAIT_L
#undef PG8_BAR
#undef PG8_SCHED
}
struct EpiBf16 {
    static constexpr bool PERM = true;
    bf16_t* O; size_t ldc;
    __device__ __forceinline__ void operator()(const f32x4 (&acc)[2][2][4][2], const Unit& u, int wr, int wc, int fr, int fq) const {
        const int row0 = u.pm * BM + wr * 64 + fr, col0 = u.pn * BM + wc * 32 + 8 * fq;
#pragma unroll
        for (int ai = 0; ai < 2; ++ai)
#pragma unroll
            for (int m = 0; m < 4; ++m) { bf16_t* rowp = O + (size_t)(row0 + ai * HALF + m * 16) * ldc + col0;
#pragma unroll
                for (int bj = 0; bj < 2; ++bj) { const f32x4 v0 = acc[ai][bj][m][0], v1 = acc[ai][bj][m][1];
                    u32x4 w; w.x = pk2(v0[0], v0[1]); w.y = pk2(v0[2], v0[3]); w.z = pk2(v1[0], v1[1]); w.w = pk2(v1[2], v1[3]);
                    *(u32x4*)(rowp + bj * HALF) = w; } }
    }
};
struct EpiRet {
    static constexpr bool PERM = true;
    bf16_t* O;
    __device__ __forceinline__ void operator()(const f32x4 (&acc)[2][2][4][2], const Unit& u, int wr, int wc, int fr, int fq) const {
        const int row0 = u.pm * BM + wr * 64 + fr, colt = u.pn * BM, col0 = colt + wc * 32 + 8 * fq;
        float l2g = 0.f, pre = 1.f;
        if (colt < 2048) { const int h = (colt & 1023) >> 8; l2g = __log2f(1.f - exp2f(-5.f - (float)h)); if (colt >= 1024) { l2g = -l2g; pre = 0.0625f; } }
#pragma unroll
        for (int ai = 0; ai < 2; ++ai)
#pragma unroll
            for (int m = 0; m < 4; ++m) { const int row = row0 + ai * HALF + m * 16; const float sc = pre * exp2f(l2g * (float)(row & 127)); bf16_t* rowp = O + (size_t)row * 6144 + col0;
#pragma unroll
                for (int bj = 0; bj < 2; ++bj) { const f32x4 v0 = acc[ai][bj][m][0] * sc, v1 = acc[ai][bj][m][1] * sc;
                    u32x4 w; w.x = pk2(v0[0], v0[1]); w.y = pk2(v0[2], v0[3]); w.z = pk2(v1[0], v1[1]); w.w = pk2(v1[2], v1[3]);
                    *(u32x4*)(rowp + bj * HALF) = w; } }
    }
};
template <bool SRC_F32> struct EpiRes {
    static constexpr bool PERM = true;
    const void* Xin; bf16_t* Xout; const float* gate;
    __device__ __forceinline__ void operator()(const f32x4 (&acc)[2][2][4][2], const Unit& u, int wr, int wc, int fr, int fq) const {
        const int row0 = u.pm * BM + wr * 64 + fr, col0 = u.pn * BM + wc * 32 + 8 * fq;
        const float* g = gate + (size_t)(row0 >> 11) * 6144 + col0;
        f32x4 gv[2][2];
#pragma unroll
        for (int bj = 0; bj < 2; ++bj)
#pragma unroll
            for (int n = 0; n < 2; ++n) gv[bj][n] = *(const f32x4*)(g + bj * HALF + n * 4);
#pragma unroll
        for (int ai = 0; ai < 2; ++ai)
#pragma unroll
            for (int m = 0; m < 4; ++m) { const int row = row0 + ai * HALF + m * 16;
#pragma unroll
                for (int bj = 0; bj < 2; ++bj) { f32x4 x0, x1;
                    if constexpr (SRC_F32) { const float* xp = (const float*)Xin + (size_t)row * D + col0 + bj * HALF; x0 = *(const f32x4*)xp; x1 = *(const f32x4*)(xp + 4); }
                    else { const u32x4 xb = *(const u32x4*)((const bf16_t*)Xin + (size_t)row * XRB_LD + XRB_OFF + col0 + bj * HALF);
                        x0 = (f32x4){bf_lo(xb.x), bf_hi(xb.x), bf_lo(xb.y), bf_hi(xb.y)}; x1 = (f32x4){bf_lo(xb.z), bf_hi(xb.z), bf_lo(xb.w), bf_hi(xb.w)}; }
                    const f32x4 v0 = x0 + gv[bj][0] * acc[ai][bj][m][0], v1 = x1 + gv[bj][1] * acc[ai][bj][m][1];
                    u32x4 w; w.x = pk2(v0[0], v0[1]); w.y = pk2(v0[2], v0[3]); w.z = pk2(v1[0], v1[1]); w.w = pk2(v1[2], v1[3]);
                    *(u32x4*)(Xout + (size_t)row * XRB_LD + XRB_OFF + col0 + bj * HALF) = w; }
                if (m & 1) asm volatile("" ::: "memory"); }
    }
};
template <class Epi>
__device__ __forceinline__ void dense(ldsp lds, const bf16_t* A, int lda, const bf16_t* Bt, int M, int N, int K, const Epi& E) {
    Gemm g{A, Bt, M, N, K, lda}; StaticOrder S; S.init(M, N, GRID, (int)blockIdx.x);
    gemm_phase<Epi, true>(lds, g, S, E);
}
struct UnitX { int pm, pn; const char* aBase; const char* bBase; const int* list; int cnt, r0, dummy; };
template <class Src, class Epi>
__device__ __forceinline__ void gemm_phase_x(ldsp lds, const Src& S, const Epi& E) {
    const int tid = fresh_tid(), wid = __builtin_amdgcn_readfirstlane(tid >> 6), lane = tid & 63, wr = wid >> 2, wc = wid & 3, fr = lane & 15, fq = lane >> 4;
    constexpr int K = Src::K, nt = K / BK, LDA = Src::LDA;
    int RA[2], CA[2]; unsigned voffB[2];
#pragma unroll
    for (int i = 0; i < 2; ++i) { int R, C; stage_rc(tid * 16 + i * 8192, R, C); RA[i] = R; CA[i] = C * 2; const int Rb = Epi::PERM ? ((R & ~31) + perm32(R & 31)) : R; voffB[i] = (unsigned)(Rb * K + C) * 2u; }
    const size_t kstep = (size_t)(BK * 2), hstepB = (size_t)HALF * K * 2;
    const unsigned ldsw = (unsigned)wid * 1024u;
    const int aoff = lds_byte(wr * 64 + fr, fq * 8), boff = lds_byte(wc * 32 + fr, fq * 8);
    auto rows_of = [&](const UnitX& u, unsigned (&v)[2][2]) {
#pragma unroll
        for (int h = 0; h < 2; ++h)
#pragma unroll
            for (int i = 0; i < 2; ++i) { const int r = h * HALF + RA[i];
                if constexpr (Src::GATHER) { const int gidx = u.r0 + r; const int tok = u.list ? (gidx < u.cnt ? u.list[gidx] : u.dummy) : u.dummy + gidx; v[h][i] = (unsigned)tok * (unsigned)(LDA * 2) + (unsigned)CA[i]; }
                else v[h][i] = (unsigned)(r * LDA * 2 + CA[i]); }
    };
#define PGX_SA(b, h) (((b) * 2 + (h)) * HTB)
#define PGX_SB(b, h) ((4 + (b) * 2 + (h)) * HTB)
#define PGX_STAGEB(bufoff, gbase) do { _Pragma("unroll") for (int _i = 0; _i < 2; ++_i) glds16((const char*)(gbase) + voffB[_i], lds + (bufoff) + ldsw + _i * 8192); } while (0)
#define PGX_STAGEA(bufoff, gbase, h, nx) do { _Pragma("unroll") for (int _i = 0; _i < 2; ++_i) glds16((const char*)(gbase) + ((nx) ? nv[h][_i] : cv[h][_i]), lds + (bufoff) + ldsw + _i * 8192); } while (0)
#define PGX_LDA(dst, b, h) do { _Pragma("unroll") for (int m = 0; m < 4; ++m) _Pragma("unroll") for (int k = 0; k < 2; ++k) dst[m][k] = *(const LAS bf16x8*)(lds + PGX_SA(b, h) + aoff + m * 2048 + k * 1024); } while (0)
#define PGX_LDB(dst, b, h) do { _Pragma("unroll") for (int n = 0; n < 2; ++n) _Pragma("unroll") for (int k = 0; k < 2; ++k) dst[n][k] = *(const LAS bf16x8*)(lds + PGX_SB(b, h) + boff + n * 2048 + k * 1024); } while (0)
#define PGX_MMA(ai, bj, At, Bt) do { __builtin_amdgcn_s_setprio(1); _Pragma("unroll") for (int m = 0; m < 4; ++m) _Pragma("unroll") for (int n = 0; n < 2; ++n) _Pragma("unroll") for (int k = 0; k < 2; ++k) \
        acc[ai][bj][m][n] = __builtin_amdgcn_mfma_f32_16x16x32_bf16(Bt[n][k], At[m][k], acc[ai][bj][m][n], 0, 0, 0); __builtin_amdgcn_s_setprio(0); } while (0)
#define PGX_WAIT_V(n) asm volatile("s_waitcnt vmcnt(" #n ")" ::: "memory")
#define PGX_WAIT_L(n) asm volatile("s_waitcnt lgkmcnt(" #n ")" ::: "memory")
#define PGX_BAR __builtin_amdgcn_s_barrier()
#define PGX_SCHED __builtin_amdgcn_sched_barrier(0)
    UnitX cur, nxt; int ui = 0;
    PGX_WAIT_V(0); PGX_BAR;
    if (!S.next(0, cur)) return;
    unsigned cv[2][2], nv[2][2];
    rows_of(cur, cv);
    asm volatile("" :: "v"(cv[0][0]), "v"(cv[0][1]), "v"(cv[1][0]), "v"(cv[1][1]));
    f32x4 acc[2][2][4][2];
#pragma unroll
    for (int a = 0; a < 2; ++a)
#pragma unroll
        for (int b = 0; b < 2; ++b)
#pragma unroll
            for (int m = 0; m < 4; ++m)
#pragma unroll
                for (int n = 0; n < 2; ++n) acc[a][b][m][n] = (f32x4){0.f, 0.f, 0.f, 0.f};
    bf16x8 At[4][2], B0[2][2], B1[2][2];
    const char* cA = cur.aBase; const char* cB = cur.bBase;
    PGX_STAGEB(PGX_SB(0, 0), cB); PGX_STAGEB(PGX_SB(0, 1), cB + hstepB); PGX_STAGEA(PGX_SA(0, 0), cA, 0, false); PGX_STAGEA(PGX_SA(0, 1), cA, 1, false);
    if (wr == 1) PGX_BAR;
    PGX_WAIT_V(2); PGX_BAR;
    PGX_STAGEB(PGX_SB(1, 0), cB + kstep); PGX_STAGEA(PGX_SA(1, 0), cA + kstep, 0, false); PGX_STAGEB(PGX_SB(1, 1), cB + hstepB + kstep);
    PGX_WAIT_V(6); PGX_BAR;
    LAS int* lbuf = (LAS int*)(lds + LDS_MISC + 2048);
    for (;;) {
        const bool has_next = S.next(ui + 1, nxt);
        if constexpr (Src::GATHER) {
            if (has_next && nxt.list && wid == 0) glds16((const char*)(nxt.list + nxt.r0) + lane * 16, (ldsp)(lbuf + ((ui + 1) & 1) * 256));
        } else {
            if (has_next) rows_of(nxt, nv); else {
#pragma unroll
                for (int h = 0; h < 2; ++h)
#pragma unroll
                    for (int i = 0; i < 2; ++i) nv[h][i] = cv[h][i]; }
        }
        const char* nA = has_next ? nxt.aBase : cA; const char* nB = has_next ? nxt.bBase : cB;
#pragma unroll 1
        for (int t = 0; t < nt; t += 2) {
            const bool last = (t == nt - 2);
            if constexpr (Src::GATHER) { if (last) {
#pragma unroll
                for (int h = 0; h < 2; ++h)
#pragma unroll
                    for (int i = 0; i < 2; ++i) { const int r = h * HALF + RA[i], gidx = nxt.r0 + r; unsigned v = cv[h][i];
                        if (has_next) { int tok;
                            if (nxt.list) { const int tl = lbuf[((ui + 1) & 1) * 256 + r]; tok = gidx < nxt.cnt ? tl : nxt.dummy; } else tok = nxt.dummy + gidx;
                            v = (unsigned)tok * (unsigned)(LDA * 2) + (unsigned)CA[i]; }
                        nv[h][i] = v; } } }
            const char* a1 = cA + (size_t)(t + 1) * kstep;
            const char* a2 = last ? nA : cA + (size_t)(t + 2) * kstep; const char* b2 = last ? nB : cB + (size_t)(t + 2) * kstep;
            const char* a3 = a2 + kstep; const char* b3 = b2 + kstep;
            PGX_LDB(B0, 0, 0); PGX_LDB(B1, 0, 1); PGX_SCHED; PGX_LDA(At, 0, 0); PGX_STAGEA(PGX_SA(1, 1), a1, 1, false);
            PGX_WAIT_V(8); PGX_WAIT_L(0); PGX_BAR; PGX_MMA(0, 0, At, B0); PGX_MMA(0, 1, At, B1); PGX_BAR; PGX_SCHED;
            PGX_LDA(At, 0, 1); PGX_STAGEB(PGX_SB(0, 0), b2); PGX_STAGEB(PGX_SB(0, 1), b2 + hstepB); PGX_STAGEA(PGX_SA(0, 0), a2, 0, last);
            PGX_WAIT_V(8); PGX_WAIT_L(0); PGX_BAR; PGX_MMA(1, 0, At, B0); PGX_MMA(1, 1, At, B1); PGX_BAR; PGX_SCHED;
            PGX_LDB(B0, 1, 0); PGX_LDB(B1, 1, 1); PGX_SCHED; PGX_LDA(At, 1, 0); PGX_STAGEA(PGX_SA(0, 1), a2, 1, last);
            PGX_WAIT_V(8); PGX_WAIT_L(0); PGX_BAR; PGX_MMA(0, 0, At, B0); PGX_MMA(0, 1, At, B1); PGX_BAR; PGX_SCHED;
            PGX_LDA(At, 1, 1); PGX_STAGEB(PGX_SB(1, 0), b3); PGX_STAGEB(PGX_SB(1, 1), b3 + hstepB); PGX_STAGEA(PGX_SA(1, 0), a3, 0, last);
            PGX_WAIT_V(8); PGX_WAIT_L(0); PGX_BAR; PGX_MMA(1, 0, At, B0); PGX_MMA(1, 1, At, B1); PGX_BAR; PGX_SCHED;
        }
        if (wr == 0) PGX_BAR;
        E(acc, cur, wr, wc, fr, fq);
        if (!has_next) break;
#pragma unroll
        for (int a = 0; a < 2; ++a)
#pragma unroll
            for (int b = 0; b < 2; ++b)
#pragma unroll
                for (int m = 0; m < 4; ++m)
#pragma unroll
                    for (int n = 0; n < 2; ++n) acc[a][b][m][n] = (f32x4){0.f, 0.f, 0.f, 0.f};
        cur = nxt; cA = nA; cB = nB; ++ui;
#pragma unroll
        for (int h = 0; h < 2; ++h)
#pragma unroll
            for (int i = 0; i < 2; ++i) cv[h][i] = nv[h][i];
        if (wr == 1) PGX_BAR;
    }
    PGX_WAIT_V(0);
    PGX_BAR;
#undef PGX_SA
#undef PGX_SB
#undef PGX_STAGEA
#undef PGX_STAGEB
#undef PGX_LDA
#undef PGX_LDB
#undef PGX_MMA
#undef PGX_WAIT_V
#undef PGX_WAIT_L
#undef PGX_BAR
#undef PGX_SCHED
}
struct EpiSwiGLUx {
    static constexpr bool PERM = false;
    bf16_t* O;
    __device__ __forceinline__ void operator()(const f32x4 (&acc)[2][2][4][2], const UnitX& u, int wr, int wc, int fr, int fq) const {
        const int row0 = u.pm * BM + wr * 64 + fr, c0 = (u.pn * BM + wc * 32) / 2 + 4 * fq;
#pragma unroll
        for (int ai = 0; ai < 2; ++ai)
#pragma unroll
            for (int m = 0; m < 4; ++m) { bf16_t* rowp = O + (size_t)(row0 + ai * HALF + m * 16) * 256 + c0;
#pragma unroll
                for (int bj = 0; bj < 2; ++bj) { const f32x4 x = acc[ai][bj][m][0], y = acc[ai][bj][m][1]; u32x2 w;
                    w.x = pk2(silu_f(x[0]) * y[0], silu_f(x[1]) * y[1]); w.y = pk2(silu_f(x[2]) * y[2], silu_f(x[3]) * y[3]); *(u32x2*)(rowp + bj * (HALF / 2)) = w; } }
    }
};
struct EpiYx {
    static constexpr bool PERM = true;
    unsigned char* O;
    __device__ __forceinline__ void operator()(const f32x4 (&acc)[2][2][4][2], const UnitX& u, int wr, int wc, int fr, int fq) const {
        const int row0 = u.pm * BM + wr * 64 + fr, col0 = u.pn * BM + wc * 32 + 8 * fq;
#pragma unroll
        for (int ai = 0; ai < 2; ++ai)
#pragma unroll
            for (int m = 0; m < 4; ++m) { unsigned char* rowp = O + (size_t)(row0 + ai * HALF + m * 16) * D + col0;
#pragma unroll
                for (int bj = 0; bj < 2; ++bj) { f32x4 v0 = acc[ai][bj][m][0], v1 = acc[ai][bj][m][1];
#pragma unroll
                    for (int e = 0; e < 4; ++e) { v0[e] = __builtin_amdgcn_fmed3f(v0[e], -448.f, 448.f); v1[e] = __builtin_amdgcn_fmed3f(v1[e], -448.f, 448.f); }
                    int w0 = __builtin_amdgcn_cvt_pk_fp8_f32(v0[0], v0[1], 0, false); w0 = __builtin_amdgcn_cvt_pk_fp8_f32(v0[2], v0[3], w0, true);
                    int w1 = __builtin_amdgcn_cvt_pk_fp8_f32(v1[0], v1[1], 0, false); w1 = __builtin_amdgcn_cvt_pk_fp8_f32(v1[2], v1[3], w1, true);
                    u32x2 w; w.x = (unsigned)w0; w.y = (unsigned)w1; *(u32x2*)(rowp + bj * HALF) = w; } }
    }
};
}

__device__ __forceinline__ void transpose_item(const float* W, int K, int N, bf16_t* WT, int mode, LAS float* scr, int item, int lane) {
    const int nblk = N / 32, kb = item / nblk, nb = item % nblk, k0 = 64 * kb, n0 = 32 * nb;
    f32x4 v[8];
#pragma unroll
    for (int i = 0; i < 8; ++i) v[i] = *(const f32x4*)(W + (size_t)(k0 + 8 * i + (lane >> 3)) * N + n0 + (lane & 7) * 4);
#pragma unroll
    for (int i = 0; i < 8; ++i) { LAS float* d = scr + (8 * i + (lane >> 3)) * 33 + (lane & 7) * 4; d[0] = v[i][0]; d[1] = v[i][1]; d[2] = v[i][2]; d[3] = v[i][3]; }
    LDS_WAIT();
    const int c = lane & 7;
#pragma unroll
    for (int j = 0; j < 4; ++j) { const int n = (lane >> 3) + 8 * j; const LAS float* s = scr + (8 * c) * 33 + n;
        u32x4 o; o.x = pk2(s[0 * 33], s[1 * 33]); o.y = pk2(s[2 * 33], s[3 * 33]); o.z = pk2(s[4 * 33], s[5 * 33]); o.w = pk2(s[6 * 33], s[7 * 33]);
        const int nn = n0 + n; const int row = mode == 0 ? nn : ((nn >> 4) * 32 + (mode == 2 ? 16 : 0) + (nn & 15));
        *(u32x4*)(WT + (size_t)row * K + k0 + 8 * c) = o; }
    LDS_WAIT();
}
__device__ __forceinline__ void convert_expert_weights(const Args& a, int layer, ldsp lds, int gw, int ngw, int wave, int lane) {
    LAS float* scr = (LAS float*)(lds + wave * 16384);
    unsigned char* ws = a.ws;
    constexpr int I13 = (D / 64) * (256 / 32), I2 = (256 / 64) * (D / 32);
    constexpr int NE = 64 * I13;
    constexpr int TOTAL = 3 * NE + 3 * 128;
    for (int it = gw; it < TOTAL; it += ngw) {
        int r = it;
        if (r < NE) { const int e = r / I13; transpose_item(a.in[I_EW1] + ((size_t)layer * 64 + e) * D * 256, D, 256, (bf16_t*)(ws + WS_W13) + (size_t)e * 512 * D, 1, scr, r % I13, lane); continue; } r -= NE;
        if (r < NE) { const int e = r / I13; transpose_item(a.in[I_EW3] + ((size_t)layer * 64 + e) * D * 256, D, 256, (bf16_t*)(ws + WS_W13) + (size_t)e * 512 * D, 2, scr, r % I13, lane); continue; } r -= NE;
        if (r < NE) { const int e = r / I2; transpose_item(a.in[I_EW2] + ((size_t)layer * 64 + e) * 256 * D, 256, D, (bf16_t*)(ws + WS_W2) + (size_t)e * D * 256, 0, scr, r % I2, lane); continue; } r -= NE;
        if (r < 128) { transpose_item(a.in[I_SW1] + (size_t)layer * D * 256, D, 256, (bf16_t*)(ws + WS_WS13), 1, scr, r, lane); continue; } r -= 128;
        if (r < 128) { transpose_item(a.in[I_SW3] + (size_t)layer * D * 256, D, 256, (bf16_t*)(ws + WS_WS13), 2, scr, r, lane); continue; } r -= 128;
        transpose_item(a.in[I_SW2] + (size_t)layer * 256 * D, 256, D, (bf16_t*)(ws + WS_WS2), 0, scr, r, lane);
    }
}
__device__ __forceinline__ void convert_dense_weights(const Args& a, ldsp lds, int gw, int ngw, int wave, int lane) {
    LAS float* scr = (LAS float*)(lds + wave * 16384);
    unsigned char* ws = a.ws;
    constexpr int IQ = 16 * 96, IO = 16 * 32, IRI = 16 * 192, IRO = 32 * 32;
    for (int it = gw; it < IQ + IO + IRI + IRO; it += ngw) {
        int r = it;
        if (r < IQ) { transpose_item(a.in[I_DAWIN], D, 3072, (bf16_t*)(ws + WS_WQKV), 0, scr, r, lane); continue; } r -= IQ;
        if (r < IO) { transpose_item(a.in[I_DAWOUT], D, D, (bf16_t*)(ws + WS_WO), 0, scr, r, lane); continue; } r -= IO;
        if (r < IRI) { transpose_item(a.in[I_RWIN], D, 6144, (bf16_t*)(ws + WS_WRI), 0, scr, r, lane); continue; } r -= IRI;
        transpose_item(a.in[I_RWOUT], 2048, D, (bf16_t*)(ws + WS_WRO), 0, scr, r, lane);
    }
}
__device__ __forceinline__ void mod_items(const Args& a, ldsp lds) {
    const int tid = threadIdx.x;
    LAS float* sl = (LAS float*)lds;
    LAS float* red = (LAS float*)(lds + 65536);
    const float* c = a.in[I_C];
    for (int i = tid; i < 16 * 1024; i += NTHR) sl[i] = silu_f(c[i]);
    __syncthreads();
    float* mod = (float*)(a.ws + WS_MOD);
    for (int item = blockIdx.x; item < 384; item += GRID) {
        const int layer = item / 192, j0 = (item % 192) * 32, kq = tid >> 5, col = tid & 31;
        const float* w = a.in[I_ADAW] + (size_t)layer * D * 6144 + j0 + col;
        float acc[16];
#pragma unroll
        for (int b = 0; b < 16; ++b) acc[b] = 0.f;
        for (int k0 = kq * 64; k0 < kq * 64 + 64; k0 += 8) {
            float wv[8];
#pragma unroll
            for (int u = 0; u < 8; ++u) wv[u] = w[(size_t)(k0 + u) * 6144];
#pragma unroll
            for (int u = 0; u < 8; ++u)
#pragma unroll
                for (int b = 0; b < 16; ++b) acc[b] += sl[b * 1024 + k0 + u] * wv[u];
        }
#pragma unroll
        for (int b = 0; b < 16; ++b) red[(kq * 16 + b) * 32 + col] = acc[b];
        __syncthreads();
        { const int b = tid >> 5, cc = tid & 31; const int j = j0 + cc; float s = a.in[I_ADAB][(size_t)layer * 6144 + j];
#pragma unroll
          for (int q = 0; q < 16; ++q) s += red[(q * 16 + b) * 32 + cc];
          if (j >= 1024 && j < 2048) s = a.in[I_NMIX][layer * D + j - 1024] * (1.f + s);
          if (j >= 4096 && j < 5120) s = a.in[I_NFFN][layer * D + j - 4096] * (1.f + s);
          mod[((size_t)layer * 16 + b) * 6144 + j] = s; }
        __syncthreads();
    }
}

__device__ __forceinline__ void adaln_store(const f32x4 (&v)[4], float rstd, const float* G, const float* sh, bf16_t* hrow, int lane) {
#pragma unroll
    for (int j = 0; j < 4; ++j) { const int col = 4 * lane + 256 * j; const f32x4 g = *(const f32x4*)(G + col), s0 = *(const f32x4*)(sh + col);
        const f32x4 h = v[j] * rstd * g + s0; u32x2 w; w.x = pk2(h[0], h[1]); w.y = pk2(h[2], h[3]); *(u32x2*)(hrow + col) = w; }
}
__device__ __forceinline__ void adaln_phase(const float* X, const float* mod_sh  , const float* mod_G, bf16_t* H, int gw, int ngw, int lane) {
    for (int row0 = gw * 2; row0 < T; row0 += ngw * 2) {
        f32x4 v[2][4]; float ss[2] = {0.f, 0.f};
#pragma unroll
        for (int r = 0; r < 2; ++r)
#pragma unroll
            for (int j = 0; j < 4; ++j) v[r][j] = *(const f32x4*)(X + (size_t)(row0 + r) * D + 4 * lane + 256 * j);
#pragma unroll
        for (int r = 0; r < 2; ++r) {
#pragma unroll
            for (int j = 0; j < 4; ++j) ss[r] += v[r][j][0] * v[r][j][0] + v[r][j][1] * v[r][j][1] + v[r][j][2] * v[r][j][2] + v[r][j][3] * v[r][j][3];
            const float rstd = rsqrtf(wave_sum(ss[r]) * (1.f / D) + 1e-6f); const int b = (row0 + r) >> 11;
            adaln_store(v[r], rstd, mod_G + (size_t)b * 6144, mod_sh + (size_t)b * 6144, H + (size_t)(row0 + r) * D, lane); }
    }
}

__device__ __forceinline__ void attn_phase(ldsp lds, const bf16_t* qkv, bf16_t* ao, float lam, const float* subln_g) {
    const int tid = fresh_tid(), lane = tid & 63, wid = __builtin_amdgcn_readfirstlane(tid >> 6), map = wid & 1, qg = wid >> 1, fr = lane & 15, fq = lane >> 4;
    constexpr int STAGE = 32768;
    const float cs = 0.125f * LOG2E;
    const int kswz = fr >> 1, kok0 = ((fq ^ kswz) << 4), kok1 = (((4 + fq) ^ kswz) << 4), koff = map * 8192 + fr * 128;
    const int vq = fr >> 2, vp = fr & 3, vrow = 4 * fq + vq, vsw = ((vrow & 7) << 1);
    const int vbase0 = 16384 + vrow * 256 + ((((vp >> 1) ^ vsw) & 15) << 4) + (vp & 1) * 8;
    for (int round = 0; round < 8; ++round) {
        const int i = blockIdx.x, jgrp = i >> 7, bh = i & 127;
        const int qb = (round & 1) ? (14 - 2 * round + jgrp) : (15 - 2 * round - jgrp);
        const int b = bh >> 3, h = bh & 7;
        const size_t tok0 = (size_t)b * SEQ;
        const float slope2 = exp2f(-(float)(h + 1)) * LOG2E;
        bf16x8 qf[2][2];
#pragma unroll
        for (int qt = 0; qt < 2; ++qt)
#pragma unroll
            for (int kk = 0; kk < 2; ++kk) qf[qt][kk] = *(const bf16x8*)(qkv + (tok0 + qb * 128 + qg * 32 + qt * 16 + fr) * 3072 + (2 * h + map) * 64 + kk * 32 + fq * 8);
        asm volatile("" :: "v"(qf[0][0]), "v"(qf[0][1]), "v"(qf[1][0]), "v"(qf[1][1]));
        const char* srcK0; const char* srcV0;
        { const int row = 8 * wid + (lane >> 3), ch = (lane & 7) ^ ((row >> 1) & 7);
          srcK0 = (const char*)(qkv + (tok0 + row) * 3072 + 1024 + (2 * h) * 64) + ch * 16; }
        { const int row = 4 * wid + (lane >> 4), ch = (lane & 15) ^ ((row & 7) << 1); srcV0 = (const char*)(qkv + (tok0 + row) * 3072 + 2048 + h * 128) + ch * 16; }
        auto issue = [&](int s, int t) {
            ldsp st = lds + s * STAGE; const size_t adv = (size_t)t * 64 * 3072 * 2;
            glds16(srcK0 + adv, st + wid * 1024); glds16(srcK0 + adv + 128, st + 8192 + wid * 1024);
            glds16(srcV0 + adv, st + 16384 + wid * 1024); glds16(srcV0 + adv + (size_t)32 * 6144, st + 16384 + (wid + 8) * 1024);
        };
        f32x4 o[8][2];
#pragma unroll
        for (int dt = 0; dt < 8; ++dt) { o[dt][0] = (f32x4){0.f, 0.f, 0.f, 0.f}; o[dt][1] = (f32x4){0.f, 0.f, 0.f, 0.f}; }
        float mrow[2] = {-__builtin_inff(), -__builtin_inff()}, lrow[2] = {0.f, 0.f};
        const int ntile = 2 * qb + 2;
        const int qlast = qb * 128 + qg * 32 + 31, qfirst = qb * 128 + qg * 32;
        BAR();
        issue(0, 0); issue(1, 1);
        int s = 0;
        for (int t = 0; t < ntile; ++t) {
            if (t + 1 < ntile) wait_vm<4>(); else wait_vm<0>();
            BAR();
            if (t + 2 < ntile) { int s2 = s + 2; if (s2 >= 3) s2 -= 3; issue(s2, t + 2); }
            ldsp st = lds + s * STAGE;
            const int key0 = 64 * t;
            if (key0 <= qlast) {
                f32x4 sc[4][2];
#pragma unroll
                for (int kt = 0; kt < 4; ++kt) { sc[kt][0] = (f32x4){0.f, 0.f, 0.f, 0.f}; sc[kt][1] = (f32x4){0.f, 0.f, 0.f, 0.f}; }
                __builtin_amdgcn_s_setprio(1);
#pragma unroll
                for (int kk = 0; kk < 2; ++kk) {
                    const int ok = kk ? kok1 : kok0;
#pragma unroll
                    for (int kt = 0; kt < 4; ++kt) { const bf16x8 kf = *(LAS bf16x8*)(st + koff + kt * 2048 + ok);
                        sc[kt][0] = __builtin_amdgcn_mfma_f32_16x16x32_bf16(kf, qf[0][kk], sc[kt][0], 0, 0, 0);
                        sc[kt][1] = __builtin_amdgcn_mfma_f32_16x16x32_bf16(kf, qf[1][kk], sc[kt][1], 0, 0, 0); }
                }
                __builtin_amdgcn_s_setprio(0);
                __builtin_amdgcn_sched_barrier(0);
                const bool need_mask = (key0 + 63 > qfirst);
                const float kb0 = slope2 * (float)(key0 + 4 * fq);
                bf16x8 pf[2][2];
#pragma unroll
                for (int qt = 0; qt < 2; ++qt) {
                    const int qrow = qb * 128 + qg * 32 + qt * 16 + fr;
                    float mx = -__builtin_inff();
#pragma unroll
                    for (int kt = 0; kt < 4; ++kt)
#pragma unroll
                        for (int r = 0; r < 4; ++r) { float v = sc[kt][qt][r] * cs + (kb0 + slope2 * (float)(16 * kt + r));
                            if (need_mask && (key0 + 16 * kt + 4 * fq + r > qrow)) v = -__builtin_inff();
                            sc[kt][qt][r] = v; mx = fmaxf(mx, v); }
                    mx = fmaxf(mx, __shfl_xor(mx, 16)); mx = fmaxf(mx, __shfl_xor(mx, 32));
                    const float mnew = fmaxf(mrow[qt], mx), alpha = fast_exp2(mrow[qt] - mnew);
                    mrow[qt] = mnew;
                    float ps = 0.f;
#pragma unroll
                    for (int kt = 0; kt < 4; ++kt)
#pragma unroll
                        for (int r = 0; r < 4; ++r) { const float p = fast_exp2(sc[kt][qt][r] - mnew); sc[kt][qt][r] = p; ps += p; }
                    lrow[qt] = lrow[qt] * alpha + ps;
#pragma unroll
                    for (int dt = 0; dt < 8; ++dt) o[dt][qt] = o[dt][qt] * alpha;
#pragma unroll
                    for (int s2 = 0; s2 < 2; ++s2) { u32x4 w; w.x = pk2(sc[2 * s2][qt][0], sc[2 * s2][qt][1]); w.y = pk2(sc[2 * s2][qt][2], sc[2 * s2][qt][3]);
                        w.z = pk2(sc[2 * s2 + 1][qt][0], sc[2 * s2 + 1][qt][1]); w.w = pk2(sc[2 * s2 + 1][qt][2], sc[2 * s2 + 1][qt][3]); pf[qt][s2] = __builtin_bit_cast(bf16x8, w); }
                }
                {
                    int vb = vbase0; asm volatile("" : "+v"(vb));
                    bf16x8 vq[3];
                    vq[0] = tr2(st + vb, st + vb + 4096);
                    vq[1] = tr2(st + (vb ^ 32), st + (vb ^ 32) + 4096);
                    __builtin_amdgcn_s_setprio(1);
#pragma unroll
                    for (int i = 0; i < 16; ++i) {
                        const int s2 = i >> 3, dt = i & 7;
                        if (i + 2 < 16) { const int i2 = i + 2, vo = (vb ^ ((i2 & 7) << 5)) + (i2 >> 3) * 8192; vq[i2 % 3] = tr2(st + vo, st + vo + 4096); }
                        o[dt][0] = __builtin_amdgcn_mfma_f32_16x16x32_bf16(vq[i % 3], pf[0][s2], o[dt][0], 0, 0, 0);
                        o[dt][1] = __builtin_amdgcn_mfma_f32_16x16x32_bf16(vq[i % 3], pf[1][s2], o[dt][1], 0, 0, 0);
                        __builtin_amdgcn_sched_barrier(0);
                    }
                    __builtin_amdgcn_s_setprio(0);
                }
            }
            s = (s == 2) ? 0 : s + 1;
        }
#pragma unroll
        for (int qt = 0; qt < 2; ++qt) { float l = lrow[qt]; l += __shfl_xor(l, 16); l += __shfl_xor(l, 32); const float inv = 1.f / l;
#pragma unroll
            for (int dt = 0; dt < 8; ++dt) o[dt][qt] = o[dt][qt] * inv; }
        BAR();
        LAS float* xb = (LAS float*)lds + qg * 4096;
        if (map == 1) {
#pragma unroll
            for (int dt = 0; dt < 8; ++dt)
#pragma unroll
                for (int qt = 0; qt < 2; ++qt)
#pragma unroll
                    for (int r = 0; r < 4; ++r) xb[((dt * 2 + qt) * 4 + r) * 64 + lane] = o[dt][qt][r];
        }
        LDS_WAIT(); BAR();
        if (map == 0) {
            const float* sg = subln_g; asm volatile("" : "+s"(sg));
#pragma unroll
            for (int qt = 0; qt < 2; ++qt) {
                float ss = 0.f;
#pragma unroll
                for (int dt = 0; dt < 8; ++dt)
#pragma unroll
                    for (int r = 0; r < 4; ++r) { const float v = o[dt][qt][r] - lam * xb[((dt * 2 + qt) * 4 + r) * 64 + lane]; o[dt][qt][r] = v; ss += v * v; }
                ss += __shfl_xor(ss, 16); ss += __shfl_xor(ss, 32);
                const float rstd = rsqrtf(ss * (1.f / 128.f) + 1e-6f) * 0.8f;
                bf16_t* orow = ao + (tok0 + qb * 128 + qg * 32 + qt * 16 + fr) * D + h * 128 + 4 * fq;
#pragma unroll
                for (int dt = 0; dt < 8; ++dt) { const f32x4 g = *(const f32x4*)(sg + dt * 16 + 4 * fq); const f32x4 v = o[dt][qt] * rstd * g;
                    u32x2 w; w.x = pk2(v[0], v[1]); w.y = pk2(v[2], v[3]); *(u32x2*)(orow + dt * 16) = w; }
            }
        }
        LDS_WAIT(); BAR();
    }
}

__device__ __forceinline__ void chain_phase(ldsp lds, bf16_t* rp, const bf16_t* P, bool dry) {
    const int tid = fresh_tid(), lane = tid & 63, wid = __builtin_amdgcn_readfirstlane(tid >> 6), fr = lane & 15, fq = lane >> 4;
    constexpr int STAGE = 32768, NSTG = 4;
    const int chain = vcu_of_block(), b = chain >> 4, h = (chain >> 2) & 3, sl = chain & 3;
    const size_t tok0 = (size_t)b * SEQ;
    const float lg = __log2f(1.f - exp2f(-5.f - (float)h));
    const float gamma = exp2f(lg), g127 = exp2f(lg * 127.f), g128 = exp2f(lg * 128.f);
    const bf16_t* vbase = rp + tok0 * 6144 + 2048 + h * 512 + sl * 128;
    const bf16_t* qbase = rp + tok0 * 6144 + h * 256;
    const bf16_t* kbase = rp + tok0 * 6144 + 1024 + h * 256;
    const bf16_t* pbase = P + (size_t)((b * 4 + h) * 16) * 16384;
    unsigned vsrc0, psrc0, qsrc0, ksrc0;
    { const int row = 4 * wid + (lane >> 4); vsrc0 = (unsigned)(row * 6144 * 2 + (((lane & 15) ^ ((row & 7) << 1)) << 4)); psrc0 = (unsigned)(row * 256 + (((lane & 15) ^ (row & 15)) << 4)); }
    { const int row = 8 * wid + (lane >> 3); qsrc0 = (unsigned)(row * 6144 * 2 + (((lane & 7) ^ ((row >> 1) & 7)) << 4)); ksrc0 = (unsigned)(row * 6144 * 2 + (((lane & 7) ^ (((row >> 1) & 3) << 1)) << 4)); }
    auto issue = [&](int s, int g) {
        ldsp st = lds + s * STAGE; const int c = g / 6, kind = g - c * 6; const size_t coff = (size_t)c * 128 * 6144 * 2;
        if (kind == 0) {
            const char* bp = (const char*)vbase + coff;
#pragma unroll
            for (int jj = 0; jj < 4; ++jj) glds16(bp + (size_t)jj * 32 * 12288 + vsrc0, st + (wid + 8 * jj) * 1024);
        } else if (kind == 5) {
            const char* bp = (const char*)pbase + (size_t)c * 32768;
#pragma unroll
            for (int jj = 0; jj < 4; ++jj) glds16(bp + (size_t)jj * 32 * 256 + psrc0, st + (wid + 8 * jj) * 1024);
        } else { const int p = kind - 1;
            const char* bq = (const char*)qbase + coff + p * 128; const char* bk = (const char*)kbase + coff + p * 128;
#pragma unroll
            for (int jj = 0; jj < 2; ++jj) glds16(bq + (size_t)jj * 64 * 12288 + qsrc0, st + (wid + 8 * jj) * 1024);
#pragma unroll
            for (int jj = 0; jj < 2; ++jj) glds16(bk + (size_t)jj * 64 * 12288 + ksrc0, st + 16384 + (wid + 8 * jj) * 1024);
        }
    };
    const int tq = fr >> 2, tp = fr & 3;
    const int vrow = 4 * fq + tq;
    const int vfo = vrow * 256 + ((((2 * wid + (tp >> 1)) ^ ((vrow & 7) << 1)) & 15) << 4) + (tp & 1) * 8;
    const int ksw = ((vrow >> 1) & 3) << 1;
    const int kfo0 = 16384 + vrow * 128 + ((((tp >> 1) ^ ksw) & 7) << 4) + (tp & 1) * 8;
    const int qsw = fr >> 1;
    const int qfo0 = fr * 128 + ((((fq >> 1) ^ qsw) & 7) << 4) + (fq & 1) * 8;
    const int pfo0 = fr * 256 + ((((fq >> 1) ^ fr) & 15) << 4) + (fq & 1) * 8;

    f32x4 R[16];
#pragma unroll
    for (int i = 0; i < 16; ++i) R[i] = (f32x4){0.f, 0.f, 0.f, 0.f};
    f32x4 o[8];
#pragma unroll
    for (int it = 0; it < 8; ++it) o[it] = (f32x4){0.f, 0.f, 0.f, 0.f};
    bf16x8 vf[4];
#pragma unroll
    for (int s4 = 0; s4 < 4; ++s4) vf[s4] = (bf16x8){0, 0, 0, 0, 0, 0, 0, 0};
    constexpr int NG = 16 * 6;
    BAR();
    issue(0, 0); issue(1, 1); issue(2, 2);
    for (int c = 0; c < 16; ++c) {
        auto step = [&](auto KC) {
            constexpr int kind = decltype(KC)::value;
            const int g = c * 6 + kind;
            if (g + 2 < NG) wait_vm<8>(); else if (g + 1 < NG) wait_vm<4>(); else wait_vm<0>();
            BAR();
            if (g + 3 < NG) issue((g + 3) & 3, g + 3);
            ldsp st = lds + (g & 3) * STAGE;
            if constexpr (kind == 0) {
#pragma unroll
                for (int s4 = 0; s4 < 4; ++s4) vf[s4] = tr2(st + vfo + s4 * 8192, st + vfo + s4 * 8192 + 4096);
#pragma unroll
                for (int it = 0; it < 8; ++it) o[it] = (f32x4){0.f, 0.f, 0.f, 0.f};
            } else if constexpr (kind == 5) {
#pragma unroll
                for (int it = 0; it < 8; ++it) o[it] = o[it] * gamma;
                int pb = pfo0; asm volatile("" : "+v"(pb));
                bf16x8 fa[4], fb[4];
                auto loadp = [&](bf16x8 (&d)[4], int grp) { const int s4 = grp >> 1, hb = (grp & 1) * 4; const int p0 = pb ^ ((4 * s4) << 4), p1 = pb ^ ((4 * s4 + 2) << 4);
#pragma unroll
                    for (int i = 0; i < 4; ++i) d[i] = rd2x64(st + p0 + (hb + i) * 4096, st + p1 + (hb + i) * 4096); };
                auto mmap = [&](const bf16x8 (&f)[4], int grp) { const int s4 = grp >> 1, hb = (grp & 1) * 4;
#pragma unroll
                    for (int i = 0; i < 4; ++i) o[hb + i] = __builtin_amdgcn_mfma_f32_16x16x32_bf16(vf[s4], f[i], o[hb + i], 0, 0, 0); };
                loadp(fa, 0);
#pragma unroll
                for (int grp = 0; grp < 8; grp += 2) {
                    loadp(fb, grp + 1); mmap(fa, grp); __builtin_amdgcn_sched_barrier(0);
                    if (grp + 2 < 8) loadp(fa, grp + 2);
                    mmap(fb, grp + 1); __builtin_amdgcn_sched_barrier(0);
                }
                bf16_t* ob = rp + (tok0 + (size_t)c * 128) * 6144 + 2048 + h * 512 + sl * 128 + 16 * wid + 4 * fq;
#pragma unroll
                for (int it = 0; it < 8; ++it) { u32x2 w; w.x = pk2(o[it][0], o[it][1]); w.y = pk2(o[it][2], o[it][3]); if (!dry) *(u32x2*)(ob + (size_t)(16 * it + fr) * 6144) = w; else asm volatile("" :: "v"(w)); }
            } else {
                constexpr int p = kind - 1;
                bf16x8 rf[2];
#pragma unroll
                for (int s2 = 0; s2 < 2; ++s2) { u32x4 w; const f32x4 r0 = R[4 * p + 2 * s2], r1 = R[4 * p + 2 * s2 + 1];
                    w.x = pk2(r0[0], r0[1]); w.y = pk2(r0[2], r0[3]); w.z = pk2(r1[0], r1[1]); w.w = pk2(r1[2], r1[3]); rf[s2] = __builtin_bit_cast(bf16x8, w); }
                int qb = qfo0; asm volatile("" : "+v"(qb));
                int kb = kfo0; asm volatile("" : "+v"(kb));
                bf16x8 fa[4], fb[4];
                auto loadq = [&](bf16x8 (&d)[4], int grp) { const int s2 = grp >> 1, hb = (grp & 1) * 4; const int q0 = qb ^ ((4 * s2) << 4), q1 = qb ^ ((4 * s2 + 2) << 4);
#pragma unroll
                    for (int i = 0; i < 4; ++i) d[i] = rd2x64(st + q0 + (hb + i) * 2048, st + q1 + (hb + i) * 2048); };
                auto mmaq = [&](const bf16x8 (&f)[4], int grp) { const int s2 = grp >> 1, hb = (grp & 1) * 4;
#pragma unroll
                    for (int i = 0; i < 4; ++i) o[hb + i] = __builtin_amdgcn_mfma_f32_16x16x32_bf16(rf[s2], f[i], o[hb + i], 0, 0, 0); };
                auto loadk = [&](bf16x8 (&d)[4], int s4) {
#pragma unroll
                    for (int dkt = 0; dkt < 4; ++dkt) { const int ko = kb ^ (dkt << 5); d[dkt] = tr2(st + ko + s4 * 4096, st + ko + s4 * 4096 + 2048); } };
                f32x4 au[4];
#pragma unroll
                for (int dkt = 0; dkt < 4; ++dkt) au[dkt] = (f32x4){0.f, 0.f, 0.f, 0.f};
                auto mmak = [&](const bf16x8 (&f)[4], int s4) {
#pragma unroll
                    for (int dkt = 0; dkt < 4; ++dkt) au[dkt] = __builtin_amdgcn_mfma_f32_16x16x32_bf16(f[dkt], vf[s4], au[dkt], 0, 0, 0); };
                loadq(fa, 0);
                loadq(fb, 1); mmaq(fa, 0); __builtin_amdgcn_sched_barrier(0);
                loadq(fa, 2); mmaq(fb, 1); __builtin_amdgcn_sched_barrier(0);
                loadq(fb, 3); mmaq(fa, 2); __builtin_amdgcn_sched_barrier(0);
                loadk(fa, 0); mmaq(fb, 3); __builtin_amdgcn_sched_barrier(0);
                loadk(fb, 1); mmak(fa, 0); __builtin_amdgcn_sched_barrier(0);
                loadk(fa, 2); mmak(fb, 1); __builtin_amdgcn_sched_barrier(0);
                loadk(fb, 3); mmak(fa, 2); __builtin_amdgcn_sched_barrier(0);
                mmak(fb, 3);
#pragma unroll
                for (int dkt = 0; dkt < 4; ++dkt) R[4 * p + dkt] = R[4 * p + dkt] * g128 + au[dkt] * g127;
                __builtin_amdgcn_sched_barrier(0);
            }
        };
        step(std::integral_constant<int, 0>{}); step(std::integral_constant<int, 1>{}); step(std::integral_constant<int, 2>{});
        step(std::integral_constant<int, 3>{}); step(std::integral_constant<int, 4>{}); step(std::integral_constant<int, 5>{});
    }
}

__device__ __forceinline__ void gnorm_phase(bf16_t* rp, const float* gn, int gw, int ngw, int lane, bool dry) {
    f32x4 w0[4], w1[4];
#pragma unroll
    for (int hh = 0; hh < 4; ++hh) { w0[hh] = *(const f32x4*)(gn + hh * 512 + 8 * lane); w1[hh] = *(const f32x4*)(gn + hh * 512 + 8 * lane + 4); }
    for (int row = gw; row < T; row += ngw) {
        bf16_t* orow = rp + (size_t)row * 6144 + 2048; const bf16_t* grow = rp + (size_t)row * 6144 + 4096;
        u32x4 ov[4], gv[4];
#pragma unroll
        for (int hh = 0; hh < 4; ++hh) { ov[hh] = *(const u32x4*)(orow + hh * 512 + 8 * lane); gv[hh] = *(const u32x4*)(grow + hh * 512 + 8 * lane); }
#pragma unroll
        for (int hh = 0; hh < 4; ++hh) {
            float of[8] = {bf_lo(ov[hh].x), bf_hi(ov[hh].x), bf_lo(ov[hh].y), bf_hi(ov[hh].y), bf_lo(ov[hh].z), bf_hi(ov[hh].z), bf_lo(ov[hh].w), bf_hi(ov[hh].w)};
            float gf[8] = {bf_lo(gv[hh].x), bf_hi(gv[hh].x), bf_lo(gv[hh].y), bf_hi(gv[hh].y), bf_lo(gv[hh].z), bf_hi(gv[hh].z), bf_lo(gv[hh].w), bf_hi(gv[hh].w)};
            float ss = 0.f;
#pragma unroll
            for (int e = 0; e < 8; ++e) ss += of[e] * of[e];
            const float rstd = rsqrtf(wave_sum(ss) * (1.f / 512.f) + 1e-6f);
            float y[8];
#pragma unroll
            for (int e = 0; e < 8; ++e) y[e] = silu_f(gf[e]) * of[e] * rstd * (e < 4 ? w0[hh][e] : w1[hh][e - 4]);
            u32x4 w; w.x = pk2(y[0], y[1]); w.y = pk2(y[2], y[3]); w.z = pk2(y[4], y[5]); w.w = pk2(y[6], y[7]);
            if (!dry) *(u32x4*)(orow + hh * 512 + 8 * lane) = w; else asm volatile("" :: "v"(w));
        }
    }
}

__device__ __forceinline__ void router_phase(ldsp lds, const bf16_t* XRBp, const float* mod_sh, const float* mod_G, const bf16_t* rwt  , const float* rbias,
                                             bf16_t* H, int* sel_e, float* sel_w, int* sel_p, int* tokl, unsigned* cnt, int tile0, int tile_end, int tstep, int wave, int lane, bool dry) {
    LAS float* lg = (LAS float*)(lds + wave * 8192);
    LAS int* st2 = (LAS int*)(lds + wave * 8192 + 4096);
    LAS float* Gl = (LAS float*)(lds + 131072); LAS float* SHl = Gl + 1024;
    const float rb = rbias[lane];
    const int fr = lane & 15, fq = lane >> 4;
    for (int tile = tile0; tile < tile_end; tile += tstep) {
        const int row = tile * 16 + fr, b = row >> 11;
        const bf16_t* xr = XRBp + (size_t)row * XRB_LD + XRB_OFF + 8 * fq;
        bf16_t* hrow = H + (size_t)row * D + 8 * fq;
        { const int t4 = (wave * 64 + lane) * 4; const float* src = (t4 < 1024 ? mod_G : mod_sh - 1024) + (size_t)b * 6144 + t4; *(LAS f32x4*)(Gl + t4) = *(const f32x4*)src; }
        auto issue_chunk = [&](int ch) {
            ldsp buf = lds + (ch & 1) * 65536;
#pragma unroll
            for (int j = 0; j < 8; ++j) { const int i = wave + 8 * j, r2 = 2 * i + (lane >> 5), lc = (lane & 31) ^ (r2 & 15);
                glds16((const char*)rwt + (size_t)r2 * 2048 + (size_t)ch * 512 + lc * 16, buf + i * 1024); }
        };
        issue_chunk(0);
        float ss = 0.f;
#pragma unroll 8
        for (int s = 0; s < 32; ++s) { const u32x4 xb = *(const u32x4*)(xr + 32 * s);
            const float e0 = bf_lo(xb.x), e1 = bf_hi(xb.x), e2 = bf_lo(xb.y), e3 = bf_hi(xb.y), e4 = bf_lo(xb.z), e5 = bf_hi(xb.z), e6 = bf_lo(xb.w), e7 = bf_hi(xb.w);
            ss += e0 * e0 + e1 * e1 + e2 * e2 + e3 * e3 + e4 * e4 + e5 * e5 + e6 * e6 + e7 * e7; }
        ss += __shfl_xor(ss, 16); ss += __shfl_xor(ss, 32);
        const float rstd = rsqrtf(ss * (1.f / D) + 1e-6f);
        f32x4 acc[4];
#pragma unroll
        for (int et = 0; et < 4; ++et) acc[et] = (f32x4){0.f, 0.f, 0.f, 0.f};
        u32x4 xc[8], xn[8];
#pragma unroll
        for (int i = 0; i < 8; ++i) xc[i] = *(const u32x4*)(xr + 32 * i);
        for (int ch = 0; ch < 4; ++ch) {
            if (ch == 0) wait_vm<0>(); else wait_vm<8>();
            LDS_WAIT();
            BAR();
            if (ch + 1 < 4) issue_chunk(ch + 1);
#pragma unroll
            for (int i = 0; i < 8; ++i) xn[i] = *(const u32x4*)(xr + 256 * ((ch + 1) & 3) + 32 * i);
            ldsp buf = lds + (ch & 1) * 65536;
#pragma unroll
            for (int sl = 0; sl < 8; ++sl) {
                const int s = 8 * ch + sl;
                const u32x4 xb = xc[sl];
                const f32x4 x0 = {bf_lo(xb.x), bf_hi(xb.x), bf_lo(xb.y), bf_hi(xb.y)}, x1 = {bf_lo(xb.z), bf_hi(xb.z), bf_lo(xb.w), bf_hi(xb.w)};
                const f32x4 g0 = *(LAS f32x4*)(Gl + 32 * s + 8 * fq), g1 = *(LAS f32x4*)(Gl + 32 * s + 8 * fq + 4), s0 = *(LAS f32x4*)(SHl + 32 * s + 8 * fq), s1 = *(LAS f32x4*)(SHl + 32 * s + 8 * fq + 4);
                const f32x4 h0 = x0 * rstd * g0 + s0, h1 = x1 * rstd * g1 + s1;
                u32x4 hi; hi.x = pk2(h0[0], h0[1]); hi.y = pk2(h0[2], h0[3]); hi.z = pk2(h1[0], h1[1]); hi.w = pk2(h1[2], h1[3]);
                *(u32x4*)(hrow + 32 * s) = hi;
                u32x4 lo; lo.x = pk2(h0[0] - bf_lo(hi.x), h0[1] - bf_hi(hi.x)); lo.y = pk2(h0[2] - bf_lo(hi.y), h0[3] - bf_hi(hi.y));
                lo.z = pk2(h1[0] - bf_lo(hi.z), h1[1] - bf_hi(hi.z)); lo.w = pk2(h1[2] - bf_lo(hi.w), h1[3] - bf_hi(hi.w));
                const bf16x8 ahi = __builtin_bit_cast(bf16x8, hi), alo = __builtin_bit_cast(bf16x8, lo);
                const int pc = (((4 * sl + fq) ^ fr) & 31) << 4;
#pragma unroll
                for (int et = 0; et < 4; ++et) {
                    const bf16x8 bh = *(LAS bf16x8*)(buf + (16 * et + fr) * 512 + pc), bl = *(LAS bf16x8*)(buf + (64 + 16 * et + fr) * 512 + pc);
                    acc[et] = __builtin_amdgcn_mfma_f32_16x16x32_bf16(ahi, bh, acc[et], 0, 0, 0);
                    acc[et] = __builtin_amdgcn_mfma_f32_16x16x32_bf16(ahi, bl, acc[et], 0, 0, 0);
                    acc[et] = __builtin_amdgcn_mfma_f32_16x16x32_bf16(alo, bh, acc[et], 0, 0, 0); }
            }
#pragma unroll
            for (int i = 0; i < 8; ++i) xc[i] = xn[i];
        }
        LDS_WAIT(); BAR();
#pragma unroll
        for (int et = 0; et < 4; ++et)
#pragma unroll
            for (int r = 0; r < 4; ++r) lg[(4 * fq + r) * 64 + 16 * et + fr] = acc[et][r];
        LDS_WAIT();
        int myc = 0;
        for (int tt = 0; tt < 16; ++tt) {
            const float logit = lg[tt * 64 + lane];
            const float score = 1.f / (1.f + __expf(-logit)), choice = score + rb;
            int rk = 0;
#pragma unroll
            for (int d = 1; d < 8; ++d) { const int oi = (lane + d) & 7; const float other = __shfl(choice, (lane & ~7) | oi); rk += (other > choice || (other == choice && oi < (lane & 7))) ? 1 : 0; }
            float gs = rk < 2 ? choice : 0.f;
            gs += __shfl_xor(gs, 1); gs += __shfl_xor(gs, 2); gs += __shfl_xor(gs, 4);
            int rg = 0;
#pragma unroll
            for (int j = 0; j < 8; ++j) { const float gj = __int_as_float(__builtin_amdgcn_readlane(__float_as_int(gs), 8 * j)); rg += (gj > gs || (gj == gs && j < (lane >> 3))) ? 1 : 0; }
            const float c2 = rg < 4 ? choice : -__builtin_inff();
            const unsigned ub = __float_as_uint(c2); unsigned key = (ub & 0x80000000u) ? ~ub : (ub | 0x80000000u); key = (key & ~63u) | (unsigned)(63 - lane);
            unsigned thr = 0u;
#pragma unroll
            for (int bit = 31; bit >= 0; --bit) { const unsigned cand = thr | (1u << bit); if (__popcll(__ballot(key >= cand)) >= 8) thr = cand; }
            const bool chosen = key >= thr;
            const unsigned long long cm = __ballot(chosen);
            const int r8 = __popcll(cm & ((1ull << lane) - 1ull));
            const float wsum = wave_sum(chosen ? score : 0.f);
            lg[tt * 64 + lane] = score / wsum * 2.5f;
            st2[tt * 64 + lane] = chosen ? ((myc << 8) | r8) : -1;
            myc += chosen ? 1 : 0;
        }
        const int chunk = (tile * 16) / CH_TOK;
        unsigned base = 0;
        if (!dry && myc > 0) base = atomicAdd(&cnt[chunk * 64 + lane], (unsigned)myc);
        if (dry) asm volatile("" :: "v"(myc));
        LDS_WAIT();
        for (int tt = 0; tt < 16; ++tt) {
            const int code = st2[tt * 64 + lane];
            if (!dry && code >= 0) { const int tok = tile * 16 + tt, r8 = code & 255; const unsigned pos = base + (unsigned)(code >> 8);
                sel_e[tok * 8 + r8] = lane; sel_w[tok * 8 + r8] = lg[tt * 64 + lane]; sel_p[tok * 8 + r8] = (int)pos;
                tokl[(size_t)(chunk * 64 + lane) * CH_TOK + pos] = tok; }
        }
        LDS_WAIT();
    }
}

__device__ __forceinline__ void build_tstart(const unsigned* cnt, int c, LAS int* ts) {
    const int l = fresh_tid();
    if (l < 64) {
        const int n = ((int)cnt[c * 64 + l] + MTILE - 1) / MTILE; int incl = n;
#pragma unroll
        for (int o = 1; o < 64; o <<= 1) { const int v = __builtin_amdgcn_ds_bpermute((l >= o ? l - o : l) << 2, incl); if (l >= o) incl += v; }
        ts[l] = incl - n; if (l == 63) { ts[64] = incl; ts[65] = incl + CH_TOK / MTILE; }
    }
}
struct MoeUpSrc {
    using Epi = EpiSwiGLU;
    const unsigned char* ws; const unsigned* cnt; int c; const LAS int* ts; int total, vcu;
    template <int LA> __device__ __forceinline__ bool setup(int i, const char*& bA, unsigned (&oA)[LA], const char*& bB, Epi& e, int& n0, int wid, int lane) const {
        const int Lt = vcu + GRID * i; if (Lt >= total) return false;
        const int mt = Lt >> 1, nt = Lt & 1;
        int ex = 0;
#pragma unroll
        for (int stp = 64; stp >= 1; stp >>= 1) if (ex + stp <= 64 && ts[ex + stp] <= mt) ex += stp;
        const int ml = mt - ts[ex];
        const bf16_t* Bt = ex < 64 ? (const bf16_t*)(ws + WS_W13) + (size_t)ex * 512 * D : (const bf16_t*)(ws + WS_WS13);
        const int* list = (const int*)(ws + WS_TOKL) + (size_t)(c * 64 + (ex & 63)) * CH_TOK; const int n = ex < 64 ? (int)cnt[c * 64 + ex] : 0;
#pragma unroll
        for (int j = 0; j < LA; ++j) { const int row = stage_row(wid, j, lane), g = ml * MTILE + row;
            const int tok = ex < 64 ? (g < n ? list[g] : c * CH_TOK) : c * CH_TOK + g;
            oA[j] = (unsigned)tok * (unsigned)(D * 2) + (unsigned)stage_chunk(row, lane); }
        bA = (const char*)(ws + WS_H); bB = (const char*)(Bt + (size_t)(nt * 256) * D);
        e = EpiSwiGLU{(bf16_t*)(ws + WS_ACT), mt * MTILE}; n0 = nt * 256; return true;
    }
    static constexpr size_t ldb = D;
};
struct MoeUpX {
    static constexpr int K = D, LDA = D; static constexpr bool GATHER = true;
    const unsigned char* ws; const unsigned* cnt; int c; const LAS int* ts; int total, vcu;
    __device__ __forceinline__ bool next(int i, pg8::UnitX& u) const {
        const int Lt = vcu + GRID * i; if (Lt >= total) return false;
        const int mt = Lt >> 1, nt = Lt & 1;
        int ex = 0;
#pragma unroll
        for (int stp = 64; stp >= 1; stp >>= 1) if (ex + stp <= 64 && ts[ex + stp] <= mt) ex += stp;
        const bf16_t* Bt = ex < 64 ? (const bf16_t*)(ws + WS_W13) + (size_t)ex * 512 * D : (const bf16_t*)(ws + WS_WS13);
        u.pm = mt; u.pn = nt; u.aBase = (const char*)(ws + WS_H); u.bBase = (const char*)(Bt + (size_t)(nt * 256) * D);
        u.list = ex < 64 ? (const int*)(ws + WS_TOKL) + (size_t)(c * 64 + ex) * CH_TOK : nullptr; u.cnt = ex < 64 ? (int)cnt[c * 64 + ex] : 0;
        u.r0 = (mt - ts[ex]) * MTILE; u.dummy = c * CH_TOK; return true;
    }
};
__device__ __forceinline__ void moe_up_phase(ldsp lds, const unsigned char* ws, const unsigned* cnt, int c, const LAS int* ts) {
    MoeUpX src{ws, cnt, c, ts, ts[65] * 2, vcu_of_block()};
    pg8::gemm_phase_x(lds, src, pg8::EpiSwiGLUx{(bf16_t*)(ws + WS_ACT)});
}
struct MoeDownSrc {
    using Epi = EpiStoreBf16;
    const unsigned char* ws; const LAS int* ts; int total, vcu;
    template <int LA> __device__ __forceinline__ bool setup(int i, const char*& bA, unsigned (&oA)[LA], const char*& bB, Epi& e, int& n0, int wid, int lane) const {
        const int Lt = vcu + GRID * i; if (Lt >= total) return false;
        const int mt = Lt >> 2, nt = Lt & 3;
        int ex = 0;
#pragma unroll
        for (int stp = 64; stp >= 1; stp >>= 1) if (ex + stp <= 64 && ts[ex + stp] <= mt) ex += stp;
        const bf16_t* act = (const bf16_t*)(ws + WS_ACT);
        const bf16_t* w2 = ex < 64 ? (const bf16_t*)(ws + WS_W2) + (size_t)ex * D * 256 : (const bf16_t*)(ws + WS_WS2);
#pragma unroll
        for (int j = 0; j < LA; ++j) { const int row = stage_row(wid, j, lane); oA[j] = (unsigned)(row * 512 + stage_chunk(row, lane)); }
        bA = (const char*)(act + (size_t)(mt * MTILE) * 256); bB = (const char*)(w2 + (size_t)(nt * 256) * 256);
        e = EpiStoreBf16{(bf16_t*)(ws + WS_YS), (size_t)D, mt * MTILE}; n0 = nt * 256; return true;
    }
    static constexpr size_t ldb = 256;
};
struct MoeDownX {
    static constexpr int K = 256, LDA = 256; static constexpr bool GATHER = false;
    const unsigned char* ws; const LAS int* ts; int total, vcu;
    __device__ __forceinline__ bool next(int i, pg8::UnitX& u) const {
        const int Lt = vcu + GRID * i; if (Lt >= total) return false;
        const int mt = Lt >> 2, nt = Lt & 3;
        int ex = 0;
#pragma unroll
        for (int stp = 64; stp >= 1; stp >>= 1) if (ex + stp <= 64 && ts[ex + stp] <= mt) ex += stp;
        const bf16_t* w2 = ex < 64 ? (const bf16_t*)(ws + WS_W2) + (size_t)ex * D * 256 : (const bf16_t*)(ws + WS_WS2);
        u.pm = mt; u.pn = nt; u.aBase = (const char*)((const bf16_t*)(ws + WS_ACT) + (size_t)(mt * MTILE) * 256); u.bBase = (const char*)(w2 + (size_t)(nt * 256) * 256);
        u.list = nullptr; u.cnt = 0; u.r0 = 0; u.dummy = 0; return true;
    }
};
__device__ __forceinline__ void moe_down_phase(ldsp lds, const unsigned char* ws, const LAS int* ts) {
    MoeDownX src{ws, ts, ts[65] * 4, vcu_of_block()};
    pg8::gemm_phase_x(lds, src, pg8::EpiYx{(unsigned char*)(ws + WS_YS)});
}
__device__ __forceinline__ void moe_combine_phase(const unsigned char* ws, float* OUT, bf16_t* XRBp, int c, const LAS int* ts, const float* gate_f  , bool last_layer,
                                                  const float* mod_sh_next, const float* mod_G_next, bf16_t* H, const float* fnorm, int gw, int ngw, int lane, bool dry) {
    const unsigned char* ys = ws + WS_YS; const int* sel_e = (const int*)(ws + WS_SELE); const float* sel_w = (const float*)(ws + WS_SELW); const int* sel_p = (const int*)(ws + WS_SELP);
    int slot[9]; float wk[9];
    auto selload = [&](int tl, int (&sl)[9], float (&ww)[9]) { const int tok = c * CH_TOK + tl;
#pragma unroll
        for (int k = 0; k < 8; ++k) { const int e = sel_e[tok * 8 + k]; sl[k] = ts[e] * MTILE + sel_p[tok * 8 + k]; ww[k] = sel_w[tok * 8 + k]; }
        sl[8] = ts[64] * MTILE + tl; ww[8] = 1.f; };
    if (gw < CH_TOK) selload(gw, slot, wk);
    for (int tl = gw; tl < CH_TOK; tl += ngw) {
        const int tok = c * CH_TOK + tl; const int b = tok >> 11;
        u32x2 yv[9][2];
#pragma unroll
        for (int k = 0; k < 9; ++k) { const unsigned char* yr = ys + (size_t)slot[k] * D; yv[k][0] = *(const u32x2*)(yr + 8 * lane); yv[k][1] = *(const u32x2*)(yr + 8 * lane + 512); }
        int nslot[9]; float nwk[9];
        if (tl + ngw < CH_TOK) selload(tl + ngw, nslot, nwk);
        else {
#pragma unroll
            for (int k = 0; k < 9; ++k) { nslot[k] = 0; nwk[k] = 0.f; } }
        float acc[16];
#pragma unroll
        for (int i = 0; i < 16; ++i) acc[i] = 0.f;
#pragma unroll
        for (int k = 0; k < 9; ++k) { const float w = wk[k];
#pragma unroll
            for (int j = 0; j < 2; ++j) { const u32x2 v = yv[k][j];
                const f32x2 p0 = __builtin_amdgcn_cvt_pk_f32_fp8((int)v.x, false), p1 = __builtin_amdgcn_cvt_pk_f32_fp8((int)v.x, true);
                const f32x2 p2 = __builtin_amdgcn_cvt_pk_f32_fp8((int)v.y, false), p3 = __builtin_amdgcn_cvt_pk_f32_fp8((int)v.y, true);
                acc[8 * j + 0] += w * p0[0]; acc[8 * j + 1] += w * p0[1]; acc[8 * j + 2] += w * p1[0]; acc[8 * j + 3] += w * p1[1];
                acc[8 * j + 4] += w * p2[0]; acc[8 * j + 5] += w * p2[1]; acc[8 * j + 6] += w * p3[0]; acc[8 * j + 7] += w * p3[1]; } }
#pragma unroll
        for (int k = 0; k < 9; ++k) { slot[k] = nslot[k]; wk[k] = nwk[k]; }
        float* xr = OUT + (size_t)tok * D; bf16_t* xb = XRBp + (size_t)tok * XRB_LD + XRB_OFF; const float* gf = gate_f + (size_t)b * 6144; float ss = 0.f; float xn[16];
#pragma unroll
        for (int j = 0; j < 2; ++j) { const u32x4 xw = *(const u32x4*)(xb + 8 * lane + 512 * j);
            const float xf[8] = {bf_lo(xw.x), bf_hi(xw.x), bf_lo(xw.y), bf_hi(xw.y), bf_lo(xw.z), bf_hi(xw.z), bf_lo(xw.w), bf_hi(xw.w)};
#pragma unroll
            for (int q = 0; q < 2; ++q) { const int col = 8 * lane + 512 * j + 4 * q; const f32x4 gv = *(const f32x4*)(gf + col);
#pragma unroll
                for (int e = 0; e < 4; ++e) { const float v = xf[4 * q + e] + gv[e] * acc[8 * j + 4 * q + e]; xn[8 * j + 4 * q + e] = v; ss += v * v; } } }
        const float rstd = rsqrtf(wave_sum(ss) * (1.f / D) + 1e-6f);
        if (last_layer) {
#pragma unroll
            for (int j = 0; j < 2; ++j)
#pragma unroll
                for (int q = 0; q < 2; ++q) { const int col = 8 * lane + 512 * j + 4 * q; const f32x4 g = *(const f32x4*)(fnorm + col); f32x4 ov;
#pragma unroll
                    for (int e = 0; e < 4; ++e) ov[e] = xn[8 * j + 4 * q + e] * rstd * g[e];
                    if (!dry) *(f32x4*)(xr + col) = ov; else asm volatile("" :: "v"(ov)); }
        } else {
            const float* sh = mod_sh_next + (size_t)b * 6144; const float* Gn = mod_G_next + (size_t)b * 6144; bf16_t* hrow = H + (size_t)tok * D;
#pragma unroll
            for (int j = 0; j < 2; ++j) { u32x4 hw, xw2;
#pragma unroll
                for (int q = 0; q < 2; ++q) { const int col = 8 * lane + 512 * j + 4 * q; const f32x4 g = *(const f32x4*)(Gn + col), s0 = *(const f32x4*)(sh + col); f32x4 xv, hv;
#pragma unroll
                    for (int e = 0; e < 4; ++e) { xv[e] = xn[8 * j + 4 * q + e]; hv[e] = xv[e] * rstd * g[e] + s0[e]; }
                    if (q == 0) { hw.x = pk2(hv[0], hv[1]); hw.y = pk2(hv[2], hv[3]); xw2.x = pk2(xv[0], xv[1]); xw2.y = pk2(xv[2], xv[3]); }
                    else { hw.z = pk2(hv[0], hv[1]); hw.w = pk2(hv[2], hv[3]); xw2.z = pk2(xv[0], xv[1]); xw2.w = pk2(xv[2], xv[3]); } }
                if (!dry) { *(u32x4*)(hrow + 8 * lane + 512 * j) = hw; *(u32x4*)(xb + 8 * lane + 512 * j) = xw2; } else asm volatile("" :: "v"(hw), "v"(xw2)); }
        }
    }
}

struct PSrc {
    using Epi = EpiCausalP;
    const bf16_t* rp; bf16_t* P;
    template <int LA> __device__ __forceinline__ bool setup(int i, const char*& bA, unsigned (&oA)[LA], const char*& bB, Epi& e, int& n0, int wid, int lane) const {
        const int u = blockIdx.x + GRID * i; if (u >= 1024) return false;
        const int bh = u >> 4, c = u & 15, b = bh >> 2, h = bh & 3;
        const bf16_t* qa = rp + ((size_t)b * SEQ + c * 128) * 6144 + h * 256;
#pragma unroll
        for (int j = 0; j < LA; ++j) { const int row = stage_row(wid, j, lane); oA[j] = (unsigned)(row * 6144 * 2 + stage_chunk(row, lane)); }
        bA = (const char*)qa; bB = (const char*)(qa + 1024);
        e = EpiCausalP{P + (size_t)u * 16384}; n0 = 0; return true;
    }
    static constexpr size_t ldb = 6144;
};
#define TIC(cat) do { if (TIME_SEL >= 0 && blockIdx.x == 0 && threadIdx.x == 0) { const unsigned long long now_ = __builtin_amdgcn_s_memrealtime(); LAS unsigned long long* tb_ = (LAS unsigned long long*)(lds + LDS_MISC + 1024); if ((cat) == TIME_SEL) tb_[1] += now_ - tb_[0]; tb_[0] = now_; } } while (0)
#define FRESH_IDS() const int t_ = fresh_tid(); const int lane = t_ & 63, wave = __builtin_amdgcn_readfirstlane(t_ >> 6); const int gw = blockIdx.x * NWAVE + wave, ngw = GRID * NWAVE; (void)lane; (void)gw; (void)ngw
#define SEAM(cat) do { xcd_barrier(bar); TIC(cat); } while (0)
#define OUTPROJ_ROUTER(layer_, A_, lda_, Bt_, ldb_, K_, mk_, cat_) do { \
    pg8::dense(lds, A_, (int)(lda_), Bt_, T, D, K_, mk_); \
    SEAM(cat_); \
    { const float* modl_ = (const float*)(ws + WS_MOD) + (size_t)(layer_) * 16 * 6144; const int m0_ = vcu_of_block() * 128; FRESH_IDS(); \
      router_phase(lds, XRB, modl_ + 3072, modl_ + 4096, (const bf16_t*)(ws + WS_RWT) + (size_t)(layer_) * 2 * 64 * 1024, a.in[I_ROUTB] + (layer_) * 64, \
                   (bf16_t*)(ws + WS_H), (int*)(ws + WS_SELE), (float*)(ws + WS_SELW), (int*)(ws + WS_SELP), (int*)(ws + WS_TOKL), (unsigned*)(ws + WS_CNT) + (layer_) * 256, \
                   m0_ / 16 + wave, m0_ / 16 + wave + 1, 1, wave, lane, false); } \
  } while (0)
__device__ __forceinline__ void moe_layer(const Args& a, ldsp lds, const XcdBarrier& bar, int layer) {
    unsigned char* ws = a.ws;
    float* mod = (float*)(ws + WS_MOD); float* XR = a.out; bf16_t* XRB = (bf16_t*)a.out; bf16_t* H = (bf16_t*)(ws + WS_H);
    const float* modl = mod + (size_t)layer * 16 * 6144;
    const float* modn = mod + (size_t)16 * 6144;
    unsigned* cl = (unsigned*)(ws + WS_CNT) + layer * 256;
    LAS int* ts0 = (LAS int*)(lds + LDS_MISC); LAS int* ts1 = ts0 + 80;
    for (int c = 0; c <= NCHUNK; ++c) {
        __syncthreads();
        if (c < NCHUNK) build_tstart(cl, c, ts0);
        if (c > 0) build_tstart(cl, c - 1, ts1);
        __syncthreads();
        const bool comb_first = (blockIdx.x & 8) != 0;
        if (c > 0 && comb_first) { FRESH_IDS(); moe_combine_phase(ws, XR, XRB, c - 1, ts1, modl + 5120, layer == 1, modn, modn + 1024, H, a.in[I_FNORM], gw, ngw, lane, false); }
        if (c < NCHUNK) moe_up_phase(lds, ws, cl, c, ts0);
        if (c > 0 && !comb_first) { FRESH_IDS(); moe_combine_phase(ws, XR, XRB, c - 1, ts1, modl + 5120, layer == 1, modn, modn + 1024, H, a.in[I_FNORM], gw, ngw, lane, false); }
        if (c == NCHUNK) break;
        SEAM(6);
        moe_down_phase(lds, ws, ts0);
        SEAM(7);
    }
}
__global__ void __launch_bounds__(NTHR, 2) fwd_kernel(Args a) {
    extern __shared__ __attribute__((aligned(16))) unsigned char lds_raw[];
    ldsp lds = (ldsp)lds_raw;
    unsigned char* ws = a.ws;
    volatile LAS unsigned* st = (volatile LAS unsigned*)(lds + LDS_BYTES - 16);
    if (threadIdx.x < 4) st[threadIdx.x] = 0u;
    if (TIME_SEL >= 0 && threadIdx.x == 0) { LAS unsigned long long* tb_ = (LAS unsigned long long*)(lds + LDS_MISC + 1024); tb_[0] = __builtin_amdgcn_s_memrealtime(); tb_[1] = 0ull; }
    __syncthreads();
    XcdBarrier bar = xcd_barrier_post((unsigned*)(ws + WS_BAR), st);
    float* mod = (float*)(ws + WS_MOD);
    float* XR = a.out; bf16_t* XRB = (bf16_t*)a.out;
    bf16_t* H = (bf16_t*)(ws + WS_H);

    mod_items(a, lds);
    __syncthreads();
    { FRESH_IDS(); convert_dense_weights(a, lds, gw, ngw, wave, lane); }
    SEAM(0);
    { FRESH_IDS(); adaln_phase(a.in[I_X], mod, mod + 1024, H, gw, ngw, lane); }
    { FRESH_IDS();
      bf16_t* rwt = (bf16_t*)(ws + WS_RWT);
      for (int idx = blockIdx.x * NTHR + t_; idx < 2 * D * 64; idx += GRID * NTHR) { const int l2 = idx >> 16, k = (idx >> 6) & 1023, e = idx & 63;
          const float w = a.in[I_ROUTW][idx]; const unsigned hi = pk2(w, 0.f) & 0xffffu; const unsigned lo = pk2(w - bf_lo(hi), 0.f) & 0xffffu;
          rwt[((size_t)(l2 * 2 + 0) * 64 + e) * 1024 + k] = (bf16_t)hi; rwt[((size_t)(l2 * 2 + 1) * 64 + e) * 1024 + k] = (bf16_t)lo; } }
    SEAM(1);

    { const bool conv_first = (blockIdx.x & 8) != 0;
      if (conv_first) { FRESH_IDS(); convert_expert_weights(a, 0, lds, gw, ngw, wave, lane); __syncthreads(); }
      pg8::dense(lds, H, D, (const bf16_t*)(ws + WS_WQKV), T, 3072, D, pg8::EpiBf16{(bf16_t*)(ws + WS_QKV), (size_t)3072});
      if (!conv_first) { __syncthreads(); FRESH_IDS(); convert_expert_weights(a, 0, lds, gw, ngw, wave, lane); } }
    SEAM(2);
    { float d1 = 0.f, d2 = 0.f;
      for (int i = 0; i < 64; ++i) { d1 += a.in[I_LQ1][i] * a.in[I_LK1][i]; d2 += a.in[I_LQ2][i] * a.in[I_LK2][i]; }
      const float lam = __expf(d1) - __expf(d2) + 0.2f;
      attn_phase(lds, (const bf16_t*)(ws + WS_QKV), (bf16_t*)(ws + WS_AO), lam, a.in[I_SUBLN]); }
    SEAM(3);
    { const pg8::EpiRes<true> mk{a.in[I_X], XRB, mod + 2048};
      OUTPROJ_ROUTER(0, (const bf16_t*)(ws + WS_AO), D, (const bf16_t*)(ws + WS_WO), D, D, mk, 4); }
    SEAM(5);
    moe_layer(a, lds, bar, 0);
    SEAM(6);

    const float* mod1 = mod + (size_t)16 * 6144;
    { const bool conv_first = (blockIdx.x & 8) != 0;
      if (conv_first) { FRESH_IDS(); convert_expert_weights(a, 1, lds, gw, ngw, wave, lane); __syncthreads(); }
      pg8::dense(lds, H, D, (const bf16_t*)(ws + WS_WRI), T, 6144, D, pg8::EpiRet{(bf16_t*)(ws + WS_RP)});
      if (!conv_first) { __syncthreads(); FRESH_IDS(); convert_expert_weights(a, 1, lds, gw, ngw, wave, lane); } }
    SEAM(8);
    { PSrc src{(const bf16_t*)(ws + WS_RP), (bf16_t*)(ws + WS_P)};
      gemm_stream<2, 4, 4, 2, 3>(lds, 256, src); }
    SEAM(9);
    chain_phase(lds, (bf16_t*)(ws + WS_RP), (const bf16_t*)(ws + WS_P), false);
    SEAM(10);
    { FRESH_IDS(); gnorm_phase((bf16_t*)(ws + WS_RP), a.in[I_RGN], gw, ngw, lane, false); }
    SEAM(11);
    { const pg8::EpiRes<false> mk{XRB, XRB, mod1 + 2048};
      OUTPROJ_ROUTER(1, (const bf16_t*)(ws + WS_RP) + 2048, 6144, (const bf16_t*)(ws + WS_WRO), 2048, 2048, mk, 12); }
    SEAM(5);
    moe_layer(a, lds, bar, 1);
    if (TIME_SEL >= 0) {
        __syncthreads(); TIC(6);
        if (blockIdx.x == 0 && threadIdx.x == 0) { LAS unsigned long long* tb_ = (LAS unsigned long long*)(lds + LDS_MISC + 1024); const unsigned long long t0 = __builtin_amdgcn_s_memrealtime();
            while (__builtin_amdgcn_s_memrealtime() - t0 < tb_[1]) __builtin_amdgcn_s_sleep(8); }
    }
}

extern "C" void kernel_launch(void* const* d_in, const int* in_sizes, int n_in, void* d_out, int out_size, void* d_ws, size_t ws_size, hipStream_t stream) {
    static int ready = 0;
    if (ready == 0) {
        if (n_in != 25 || out_size != T * D || ws_size < WS_END) { fprintf(stderr, "kernel_launch: unexpected shapes (n_in %d out %d ws %zu need %zu)\n", n_in, out_size, ws_size, (size_t)WS_END); ready = -1; return; }
        (void)hipFuncSetAttribute((const void*)fwd_kernel, hipFuncAttributeMaxDynamicSharedMemorySize, LDS_BYTES);
        ready = 1;
    }
    if (ready < 0) return;
    (void)hipMemsetAsync(d_ws, 0, 65536, stream);
    Args a{};
    for (int i = 0; i < 25; ++i) a.in[i] = (const float*)d_in[i];
    a.out = (float*)d_out; a.ws = (unsigned char*)d_ws;
    hipLaunchKernelGGL(fwd_kernel, dim3(GRID), dim3(NTHR), LDS_BYTES, stream, a);
}
```

```cpp
#include <hip/hip_runtime.h>
#include <cstdio>
#include <cstdint>
#include <type_traits>

typedef unsigned short bf16_t;
typedef short bf16x8 __attribute__((ext_vector_type(8)));
typedef short bf16x4 __attribute__((ext_vector_type(4)));
typedef float f32x4 __attribute__((ext_vector_type(4)));
typedef float f32x2 __attribute__((ext_vector_type(2)));
typedef unsigned u32x4 __attribute__((ext_vector_type(4)));
typedef unsigned u32x2 __attribute__((ext_vector_type(2)));
#define LAS __attribute__((address_space(3)))
typedef LAS unsigned char* ldsp;

constexpr int T = 32768, D = 1024, NB = 16, SEQ = 2048;
constexpr int NTHR = 512, NWAVE = 8, GRID = 256;
constexpr int CH_TOK = 16384, NCHUNK = 2, MTILE = 256;
constexpr int SLOT_CAP = 163840;
constexpr float LOG2E = 1.4426950408889634f;
constexpr int XRB_LD = 2048, XRB_OFF = 1024;
#define TIME_SEL -1


constexpr size_t MiB = 1u << 20;
constexpr size_t WS_BAR = 0, WS_CNT = 16384, WS_RWT = 256 * 1024  , WS_MOD = 1 * MiB;
constexpr size_t WS_WQKV = 2 * MiB, WS_WO = 8 * MiB, WS_WRI = 10 * MiB, WS_WRO = 22 * MiB;
constexpr size_t WS_W13 = 26 * MiB, WS_W2 = 90 * MiB, WS_WS13 = 122 * MiB, WS_WS2 = 123 * MiB;
constexpr size_t WS_H = 124 * MiB, WS_P = WS_H;
constexpr size_t WS_BIG = 188 * MiB;
constexpr size_t WS_QKV = WS_BIG, WS_AO = WS_BIG + 192 * MiB;
constexpr size_t WS_RP = WS_BIG;
constexpr size_t WS_SELE = WS_BIG, WS_SELW = WS_BIG + 1 * MiB, WS_SELP = WS_BIG + 2 * MiB, WS_TOKL = WS_BIG + 4 * MiB;
constexpr size_t WS_ACT = WS_BIG + 12 * MiB  , WS_YS = WS_BIG + 92 * MiB  ;
constexpr size_t WS_END = WS_BIG + 412 * MiB;
constexpr int LDS_BYTES = 152 * 1024, LDS_MISC = 144 * 1024;

#define XB_TMO      128
#define XB_XCNT(j)  (256  + 64 * (j))
#define XB_XSUB(j)  (1280 + 64 * (j))
#define XB_XGEN(j)  (2304 + 64 * (j))
#define XB_TOP      3328
#define XB_TOPGEN   3392
#define XCD_BAR_WORDS 3456
#define XB_SPIN_CAP (1u << 20)
__device__ __forceinline__ unsigned xb_ld(unsigned* p)              { return __hip_atomic_load(p, __ATOMIC_RELAXED, __HIP_MEMORY_SCOPE_AGENT); }
__device__ __forceinline__ unsigned xb_add(unsigned* p, unsigned v) { return __hip_atomic_fetch_add(p, v, __ATOMIC_RELAXED, __HIP_MEMORY_SCOPE_AGENT); }
__device__ __forceinline__ unsigned xb_xcc_id() { return (unsigned)__builtin_amdgcn_s_getreg((3 << 11) | 20) & 0xFu; }
#define XB_SPIN(cond, bar) do { unsigned _sp = 0; while (cond) { __builtin_amdgcn_s_sleep(1); \
    if ((++_sp & 255u) == 0u) { if (xb_ld(&(bar)[XB_TMO])) break; if (_sp > XB_SPIN_CAP) { atomicAdd(&(bar)[XB_TMO], 1u); break; } } } } while (0)
struct XcdBarrier { unsigned* bar; unsigned x; volatile LAS unsigned* st; };
__device__ __forceinline__ XcdBarrier xcd_barrier_post(unsigned* bar, volatile LAS unsigned* st) {
    XcdBarrier b; b.bar = bar; b.x = xb_xcc_id(); b.st = st;
    if (threadIdx.x == 0) (void)xb_add(&bar[XB_XCNT(b.x)], 1u);
    return b;
}
__device__ __forceinline__ void xcd_barrier_complete(unsigned* bar, unsigned x, unsigned& nloc, unsigned& nx) {
    const unsigned G = gridDim.x * gridDim.y * gridDim.z;
    unsigned sum, cnt, mine, sp = 0u;
    for (;;) {
        sum = 0u; cnt = 0u; mine = 0u;
#pragma unroll
        for (unsigned j = 0; j < 16; ++j) { const unsigned c = xb_ld(&bar[XB_XCNT(j)]); sum += c; cnt += (c > 0u) ? 1u : 0u; mine = (j == x) ? c : mine; }
        if (sum == G) break;
        __builtin_amdgcn_s_sleep(1);
        if ((++sp & 255u) == 0u) { if (xb_ld(&bar[XB_TMO])) break; if (sp > XB_SPIN_CAP) { atomicAdd(&bar[XB_TMO], 1u); break; } }
    }
    nloc = mine > 0u ? mine : 1u; nx = cnt > 0u ? cnt : 1u;
}
__device__ __forceinline__ void xcd_barrier(const XcdBarrier& b) {
    asm volatile("s_waitcnt vmcnt(0)" ::: "memory");
    __syncthreads();
    if (threadIdx.x == 0) {
        unsigned* bar = b.bar; unsigned bx = b.x;
        asm volatile("" : "+s"(bar), "+s"(bx));
        __builtin_amdgcn_s_waitcnt(0);
        unsigned nloc = b.st[0], nx = b.st[1];
        if (nloc == 0u) { xcd_barrier_complete(bar, bx, nloc, nx); b.st[0] = nloc; b.st[1] = nx; }
        const unsigned old = xb_add(&bar[XB_XSUB(bx)], 1u);
        const unsigned gen = old / nloc;
        if (old + 1u == (gen + 1u) * nloc) {
            __builtin_amdgcn_fence(__ATOMIC_RELEASE, "agent");
            asm volatile("s_waitcnt vmcnt(0)" ::: "memory");
            const unsigned og = xb_add(&bar[XB_TOP], 1u);
            const unsigned tg = og / nx;
            if (og + 1u == (tg + 1u) * nx) xb_add(&bar[XB_TOPGEN], 1u);
            else XB_SPIN(xb_ld(&bar[XB_TOPGEN]) == tg, bar);
            __builtin_amdgcn_fence(__ATOMIC_ACQUIRE, "agent");
            xb_add(&bar[XB_XGEN(bx)], 1u);
            asm volatile("s_waitcnt vmcnt(0)" ::: "memory");
        } else {
            XB_SPIN(xb_ld(&bar[XB_XGEN(bx)]) == gen, bar);
            __builtin_amdgcn_fence(__ATOMIC_ACQUIRE, "agent");
            asm volatile("s_waitcnt vmcnt(0)" ::: "memory");
        }
    }
    __syncthreads();
}

template <int N> __device__ __forceinline__ void wait_vm() { asm volatile("s_waitcnt vmcnt(%0)" :: "n"(N) : "memory"); }
#define BAR() __builtin_amdgcn_s_barrier()
#define LDS_WAIT() asm volatile("s_waitcnt lgkmcnt(0)" ::: "memory")
__device__ __forceinline__ unsigned pk2(float a, float b) {
    typedef __bf16 bf2 __attribute__((ext_vector_type(2)));
    f32x2 v = {a, b}; bf2 r = __builtin_convertvector(v, bf2); return __builtin_bit_cast(unsigned, r);
}
__device__ __forceinline__ float bf_lo(unsigned u) { return __uint_as_float(u << 16); }
__device__ __forceinline__ float bf_hi(unsigned u) { return __uint_as_float(u & 0xffff0000u); }
template <int K> __device__ __forceinline__ float lane_xor(float v) {
    if constexpr (K == 32) { auto rr = __builtin_amdgcn_permlane32_swap(__float_as_uint(v), __float_as_uint(v), false, false); return __uint_as_float(rr[0]) == v ? __uint_as_float(rr[1]) : __uint_as_float(rr[0]); }
    else return __int_as_float(__builtin_amdgcn_ds_swizzle(__float_as_int(v), (K << 10) | 0x1f));
}
__device__ __forceinline__ float wave_sum(float v) {
    v += lane_xor<1>(v); v += lane_xor<2>(v); v += lane_xor<4>(v); v += lane_xor<8>(v); v += lane_xor<16>(v);
    auto rr = __builtin_amdgcn_permlane32_swap(__float_as_uint(v), __float_as_uint(v), false, false);
    return __uint_as_float(rr[0]) + __uint_as_float(rr[1]);
}
__device__ __forceinline__ float fast_exp2(float x) { return __builtin_amdgcn_exp2f(x); }
__device__ __forceinline__ float silu_f(float v) { return v / (1.f + __expf(-v)); }
__device__ __forceinline__ void glds16(const void* src, ldsp dst) {
    unsigned keep; const unsigned d = (unsigned)(__SIZE_TYPE__)dst;
    asm volatile("s_mov_b32 %0, m0\n\ts_mov_b32 m0, %2\n\ts_nop 0\n\tglobal_load_lds_dwordx4 %1, off\n\ts_mov_b32 m0, %0" : "=&s"(keep) : "v"(src), "s"(d) : "memory");
}
__device__ __forceinline__ bf16x8 tr2(ldsp a0, ldsp a1) {
    const bf16x4 t0 = __builtin_amdgcn_ds_read_tr16_b64_v4i16((LAS bf16x4*)a0);
    const bf16x4 t1 = __builtin_amdgcn_ds_read_tr16_b64_v4i16((LAS bf16x4*)a1);
    return __builtin_shufflevector(t0, t1, 0, 1, 2, 3, 4, 5, 6, 7);
}
__device__ __forceinline__ bf16x8 rd2x64(ldsp a0, ldsp a1) {
    const bf16x4 t0 = *(LAS bf16x4*)a0; const bf16x4 t1 = *(LAS bf16x4*)a1;
    return __builtin_shufflevector(t0, t1, 0, 1, 2, 3, 4, 5, 6, 7);
}
__device__ __forceinline__ int fresh_tid() { int t = threadIdx.x; asm volatile("" : "+v"(t)); return t; }
__device__ __forceinline__ int vcu_of_block() { const int bx = blockIdx.x; return (bx & 7) * (GRID / 8) + (bx >> 3); }

struct Args {
    const float* in[25];
    float* out; unsigned char* ws;
};
enum { I_X = 0, I_C, I_NMIX, I_NFFN, I_ADAW, I_ADAB, I_DAWIN, I_DAWOUT, I_LQ1, I_LK1, I_LQ2, I_LK2, I_SUBLN, I_RWIN, I_RWOUT, I_RGN,
       I_ROUTW, I_ROUTB, I_EW1, I_EW3, I_EW2, I_SW1, I_SW3, I_SW2, I_FNORM };

template <int WM, int WN, int MT, int NT, int NSTAGE, class Src>
__device__ __forceinline__ void gemm_stream(ldsp lds, int K, const Src& src) {
    constexpr int BM = WM * MT * 16, BN = WN * NT * 16, STAGE = (BM + BN) * 128, LA = BM / 64, LB = BN / 64, L = LA + LB, PD = NSTAGE - 1;
    static_assert(WM * WN == NWAVE && NSTAGE * STAGE <= LDS_MISC, "8 waves; ring fits");
    const int tid = fresh_tid(), lane = tid & 63, wid = __builtin_amdgcn_readfirstlane(tid >> 6);
    const int wr = wid / WN, wc = wid % WN, fr = lane & 15, fq = lane >> 4;
    const char* cbA; const char* cbB; const char* nbA; const char* nbB; unsigned cA[LA], nA[LA], oB[LB];
    typename Src::Epi ce, ne; int cn0 = 0, nn0 = 0;
    if (!src.template setup<LA>(0, cbA, cA, cbB, ce, cn0, wid, lane)) return;
#pragma unroll
    for (int j = 0; j < LB; ++j) { const int row = 8 * (wid + 8 * j) + (lane >> 3); oB[j] = (unsigned)(row * (int)src.ldb * 2 + (((lane & 7) ^ ((row >> 1) & 7)) << 4)); }
    const int swz = fr >> 1;
    const int aoff = (wr * MT * 16 + fr) * 128, boff = BM * 128 + (wc * NT * 16 + fr) * 128;
    const int ok0 = ((fq ^ swz) << 4), ok1 = (((4 + fq) ^ swz) << 4);
    auto issue = [&](int s, const char* bA, const unsigned (&oA)[LA], const char* bB, int t) {
        ldsp st = lds + s * STAGE;
#pragma unroll
        for (int j = 0; j < LA; ++j) glds16(bA + (size_t)t * 128 + oA[j], st + (wid + 8 * j) * 1024);
#pragma unroll
        for (int j = 0; j < LB; ++j) glds16(bB + (size_t)t * 128 + oB[j], st + BM * 128 + (wid + 8 * j) * 1024);
    };
    const int nt = K / 64;
    BAR();
#pragma unroll
    for (int d = 0; d < PD; ++d) issue(d, cbA, cA, cbB, d);
    int s = 0;
    for (int i = 0;; ++i) {
        const bool hasn = src.template setup<LA>(i + 1, nbA, nA, nbB, ne, nn0, wid, lane);
        f32x4 acc[MT][NT];
#pragma unroll
        for (int m = 0; m < MT; ++m)
#pragma unroll
            for (int n = 0; n < NT; ++n) acc[m][n] = (f32x4){0.f, 0.f, 0.f, 0.f};
        for (int t = 0; t < nt; ++t) {
            if (PD >= 2 && (hasn || t + 1 < nt)) wait_vm<(PD - 1) * L>(); else wait_vm<0>();
            BAR();
            { int s2 = s + PD; if (s2 >= NSTAGE) s2 -= NSTAGE;
              if (t + PD < nt) issue(s2, cbA, cA, cbB, t + PD); else if (hasn) issue(s2, nbA, nA, nbB, t + PD - nt); }
            ldsp st = lds + s * STAGE;
#pragma unroll
            for (int kk = 0; kk < 2; ++kk) {
                bf16x8 b[NT];
                const int ok = kk ? ok1 : ok0;
#pragma unroll
                for (int n = 0; n < NT; ++n) b[n] = *(LAS bf16x8*)(st + boff + n * 2048 + ok);
#pragma unroll
                for (int mh = 0; mh < MT; mh += 4) {
                    bf16x8 a[4];
#pragma unroll
                    for (int m = 0; m < 4; ++m) a[m] = *(LAS bf16x8*)(st + aoff + (mh + m) * 2048 + ok);
                    __builtin_amdgcn_s_setprio(1);
#pragma unroll
                    for (int m = 0; m < 4; ++m)
#pragma unroll
                        for (int n = 0; n < NT; ++n) acc[mh + m][n] = __builtin_amdgcn_mfma_f32_16x16x32_bf16(b[n], a[m], acc[mh + m][n], 0, 0, 0);
                    __builtin_amdgcn_s_setprio(0);
                    if (MT > 4) __builtin_amdgcn_sched_barrier(0);
                }
            }
            s = (s == NSTAGE - 1) ? 0 : s + 1;
        }
        ce(acc, wr * MT * 16, cn0 + wc * NT * 16, fr, fq);
        if (!hasn) break;
#pragma unroll
        for (int j = 0; j < LA; ++j) cA[j] = nA[j];
        cbA = nbA; cbB = nbB; ce = ne; cn0 = nn0;
    }
}
__device__ __forceinline__ int stage_row(int wid, int j, int lane) { return 8 * (wid + 8 * j) + (lane >> 3); }
__device__ __forceinline__ int stage_chunk(int row, int lane) { return ((lane & 7) ^ ((row >> 1) & 7)) * 16; }
__device__ __forceinline__ const char* uniform_ptr(const void* p) { unsigned long long v = (unsigned long long)p; const unsigned lo = __builtin_amdgcn_readfirstlane((unsigned)v), hi = __builtin_amdgcn_readfirstlane((unsigned)(v >> 32)); return (const char*)(((unsigned long long)hi << 32) | lo); }

template <int BM, int BN, class Mk> struct DenseSrc {
    using Epi = decltype(((Mk*)nullptr)->operator()(0));
    const bf16_t* A; size_t lda; const bf16_t* Bt; size_t ldb; int nN, per_x, xcd, local; const Mk& mk;
    __device__ __forceinline__ DenseSrc(const bf16_t* A_, size_t lda_, const bf16_t* Bt_, size_t ldb_, int M, int N, const Mk& mk_) : A(A_), lda(lda_), Bt(Bt_), ldb(ldb_), mk(mk_) {
        const int vcu = vcu_of_block(); nN = N / BN; per_x = (M / BM) / 8; xcd = vcu >> 5; local = vcu & 31; }
    template <int LA> __device__ __forceinline__ bool setup(int i, const char*& bA, unsigned (&oA)[LA], const char*& bB, Epi& e, int& n0, int wid, int lane) const {
        constexpr int GM = 4;
        const int q = local + 32 * i; if (q >= per_x * nN) return false;
        const int grp = q / (GM * nN), r = q % (GM * nN), m = xcd * per_x + grp * GM + (r % GM), n = r / GM;
#pragma unroll
        for (int j = 0; j < LA; ++j) { const int row = stage_row(wid, j, lane); oA[j] = (unsigned)(row * (int)lda * 2 + stage_chunk(row, lane)); }
        bA = (const char*)(A + (size_t)(m * BM) * lda); bB = (const char*)(Bt + (size_t)(n * BN) * ldb);
        e = mk(m * BM); n0 = n * BN; return true;
    }
};
template <int WM, int WN, int MT, int NT, int NSTAGE, class Mk>
__device__ __forceinline__ void gemm_dense_phase(ldsp lds, const bf16_t* A, size_t lda, const bf16_t* Bt, size_t ldb, int M, int N, int K, const Mk& mk) {
    DenseSrc<WM * MT * 16, WN * NT * 16, Mk> src(A, lda, Bt, ldb, M, N, mk);
    gemm_stream<WM, WN, MT, NT, NSTAGE>(lds, K, src);
}

struct EpiStoreBf16 {
    bf16_t* O; size_t ldc; int m0;
    template <int MT, int NT> __device__ __forceinline__ void operator()(const f32x4 (&acc)[MT][NT], int rb, int cb, int fr, int fq) const {
#pragma unroll
        for (int m = 0; m < MT; ++m) { bf16_t* rp = O + (size_t)(m0 + rb + m * 16 + fr) * ldc + cb + 4 * fq;
#pragma unroll
            for (int n = 0; n < NT; ++n) { u32x2 w; w.x = pk2(acc[m][n][0], acc[m][n][1]); w.y = pk2(acc[m][n][2], acc[m][n][3]); *(u32x2*)(rp + n * 16) = w; } }
    }
};
struct EpiResidual {
    const float* Xin; float* Xout; const float* gate; int m0;
    template <int MT, int NT> __device__ __forceinline__ void operator()(const f32x4 (&acc)[MT][NT], int rb, int cb, int fr, int fq) const {
#pragma unroll
        for (int m = 0; m < MT; ++m) { const int row = m0 + rb + m * 16 + fr; const float* g = gate + (size_t)(row >> 11) * 6144;
#pragma unroll
            for (int n = 0; n < NT; ++n) { const int col = cb + n * 16 + 4 * fq; const f32x4 xv = *(const f32x4*)(Xin + (size_t)row * D + col); const f32x4 gv = *(const f32x4*)(g + col);
                *(f32x4*)(Xout + (size_t)row * D + col) = xv + gv * acc[m][n]; } }
    }
};
struct EpiRetProj {
    bf16_t* O; int m0;
    template <int MT, int NT> __device__ __forceinline__ void operator()(const f32x4 (&acc)[MT][NT], int rb, int cb, int fr, int fq) const {
        float l2g = 0.f, pre = 1.f;
        if (cb < 2048) { const int h = (cb & 1023) >> 8; l2g = __log2f(1.f - exp2f(-5.f - (float)h)); if (cb >= 1024) { l2g = -l2g; pre = 0.0625f; } }
#pragma unroll
        for (int m = 0; m < MT; ++m) { const int row = m0 + rb + m * 16 + fr; const float sc = pre * exp2f(l2g * (float)(row & 127)); bf16_t* rp = O + (size_t)row * 6144 + cb + 4 * fq;
#pragma unroll
            for (int n = 0; n < NT; ++n) { u32x2 w; w.x = pk2(acc[m][n][0] * sc, acc[m][n][1] * sc); w.y = pk2(acc[m][n][2] * sc, acc[m][n][3] * sc); *(u32x2*)(rp + n * 16) = w; } }
    }
};
struct EpiCausalP {
    bf16_t* O;
    template <int MT, int NT> __device__ __forceinline__ void operator()(const f32x4 (&acc)[MT][NT], int rb, int cb, int fr, int fq) const {
#pragma unroll
        for (int m = 0; m < MT; ++m) { const int i = rb + m * 16 + fr; bf16_t* rp = O + (size_t)i * 128 + cb + 4 * fq;
#pragma unroll
            for (int n = 0; n < NT; ++n) { const int j = cb + n * 16 + 4 * fq; f32x4 v = acc[m][n];
                v[0] = (i >= j) ? v[0] : 0.f; v[1] = (i >= j + 1) ? v[1] : 0.f; v[2] = (i >= j + 2) ? v[2] : 0.f; v[3] = (i >= j + 3) ? v[3] : 0.f;
                u32x2 w; w.x = pk2(v[0], v[1]); w.y = pk2(v[2], v[3]); *(u32x2*)(rp + n * 16) = w; } }
    }
};
struct EpiSwiGLU {
    bf16_t* O; int slot0;
    template <int MT, int NT> __device__ __forceinline__ void operator()(const f32x4 (&acc)[MT][NT], int rb, int cb, int fr, int fq) const {
        static_assert(NT == 4, "NT");
#pragma unroll
        for (int m = 0; m < MT; ++m) { bf16_t* rp = O + (size_t)(slot0 + rb + m * 16 + fr) * 256 + (cb >> 1) + 4 * fq;
#pragma unroll
            for (int p = 0; p < 2; ++p) { const f32x4 a = acc[m][2 * p], b = acc[m][2 * p + 1]; u32x2 w;
                w.x = pk2(silu_f(a[0]) * b[0], silu_f(a[1]) * b[1]); w.y = pk2(silu_f(a[2]) * b[2], silu_f(a[3]) * b[3]); *(u32x2*)(rp + p * 16) = w; } }
    }
};

namespace pg8 {
constexpr int BM = 256, BK = 64, HALF = 128, HTB = HALF * BK * 2  , STAGE_BYTES = 8 * HTB, NXCD = 8, WGM = 8;
__device__ __forceinline__ int lds_byte(int r, int c) { const int st = (r >> 4) * 2 + (c >> 5), rr = r & 15, cc = c & 31, ob = rr * 64 + cc * 2; return st * 1024 + (ob ^ (((ob >> 9) & 1) << 5)); }
__device__ __forceinline__ void stage_rc(int b, int& R, int& C) { const int st = b / 1024, sb = b % 1024, swz = sb ^ (((sb >> 9) & 1) << 5); R = (st >> 1) * 16 + swz / 64; C = (st & 1) * 32 + (swz % 64) / 2; }
__device__ __forceinline__ int perm32(int rho) { const int n = rho >> 4, i = rho & 15; return 8 * (i >> 2) + 4 * n + (i & 3); }
struct Unit { int pm, pn; };
struct Gemm { const bf16_t* A; const bf16_t* Bt; int M, N, K, lda; };
struct StaticOrder {
    int nM, nN, nwg, G, c;
    __device__ void init(int M, int N, int G_, int c_) { nM = M / BM; nN = N / BM; nwg = nM * nN; G = G_; c = c_; }
    __device__ bool next(int i, Unit& u) const {
        const long L = (long)i * G + c; if (L >= nwg) return false;
        int wgid = (int)L; { const int q = nwg / NXCD, r = nwg % NXCD, xcd = wgid % NXCD, off = wgid / NXCD; wgid = (xcd < r ? xcd * (q + 1) : r * (q + 1) + (xcd - r) * q) + off; }
        const int nig = WGM * nN, gid = wgid / nig, fm = gid * WGM, gsz = (nM - fm) < WGM ? (nM - fm) : WGM;
        u.pm = fm + ((wgid % nig) % gsz); u.pn = (wgid % nig) / gsz; return true;
    }
};
template <class Epi, bool ALIGN_EPI = true>
__device__ __forceinline__ void gemm_phase(ldsp lds, const Gemm g, const StaticOrder& S, const Epi& E) {
    const int tid = fresh_tid(), wid = __builtin_amdgcn_readfirstlane(tid >> 6), lane = tid & 63, wr = wid >> 2, wc = wid & 3, fr = lane & 15, fq = lane >> 4;
    const int K = g.K, nt = K / BK;
    unsigned voffA[2], voffB[2];
#pragma unroll
    for (int i = 0; i < 2; ++i) { int R, C; stage_rc(tid * 16 + i * 8192, R, C); const int Rb = Epi::PERM ? ((R & ~31) + perm32(R & 31)) : R;
        voffA[i] = (unsigned)(R * g.lda + C) * 2u; voffB[i] = (unsigned)(Rb * K + C) * 2u; }
    const size_t kstep = (size_t)(BK * 2);
    const size_t hstepA = (size_t)HALF * g.lda * 2, hstepB = (size_t)HALF * K * 2;
    const size_t tstepA = 2 * hstepA, tstepB = 2 * hstepB;
    const unsigned ldsw = (unsigned)wid * 1024u;
    const int aoff = lds_byte(wr * 64 + fr, fq * 8), boff = lds_byte(wc * 32 + fr, fq * 8);
#define PG8_SA(b, h) (((b) * 2 + (h)) * HTB)
#define PG8_SB(b, h) ((4 + (b) * 2 + (h)) * HTB)
#define PG8_STAGE(bufoff, gbase, voff) do { _Pragma("unroll") for (int _i = 0; _i < 2; ++_i) glds16((const char*)(gbase) + (voff)[_i], lds + (bufoff) + ldsw + _i * 8192); } while (0)
#define PG8_LDA(dst, b, h) do { _Pragma("unroll") for (int m = 0; m < 4; ++m) _Pragma("unroll") for (int k = 0; k < 2; ++k) dst[m][k] = *(const LAS bf16x8*)(lds + PG8_SA(b, h) + aoff + m * 2048 + k * 1024); } while (0)
#define PG8_LDB(dst, b, h) do { _Pragma("unroll") for (int n = 0; n < 2; ++n) _Pragma("unroll") for (int k = 0; k < 2; ++k) dst[n][k] = *(const LAS bf16x8*)(lds + PG8_SB(b, h) + boff + n * 2048 + k * 1024); } while (0)
#define PG8_MMA(ai, bj, At, Bt) do { __builtin_amdgcn_s_setprio(1); _Pragma("unroll") for (int m = 0; m < 4; ++m) _Pragma("unroll") for (int n = 0; n < 2; ++n) _Pragma("unroll") for (int k = 0; k < 2; ++k) \
        acc[ai][bj][m][n] = __builtin_amdgcn_mfma_f32_16x16x32_bf16(Bt[n][k], At[m][k], acc[ai][bj][m][n], 0, 0, 0); __builtin_amdgcn_s_setprio(0); } while (0)
#define PG8_WAIT_V(n) asm volatile("s_waitcnt vmcnt(" #n ")" ::: "memory")
#define PG8_WAIT_L(n) asm volatile("s_waitcnt lgkmcnt(" #n ")" ::: "memory")
#define PG8_BAR __builtin_amdgcn_s_barrier()
#define PG8_SCHED __builtin_amdgcn_sched_barrier(0)
    Unit cur, nxt; int ui = 0;
    PG8_WAIT_V(0); PG8_BAR;
    if (!S.next(0, cur)) return;
    f32x4 acc[2][2][4][2];
#pragma unroll
    for (int a = 0; a < 2; ++a)
#pragma unroll
        for (int b = 0; b < 2; ++b)
#pragma unroll
            for (int m = 0; m < 4; ++m)
#pragma unroll
                for (int n = 0; n < 2; ++n) acc[a][b][m][n] = (f32x4){0.f, 0.f, 0.f, 0.f};
    bf16x8 At[4][2], B0[2][2], B1[2][2];
    const char* cA = (const char*)g.A + (size_t)cur.pm * tstepA; const char* cB = (const char*)g.Bt + (size_t)cur.pn * tstepB;
    PG8_STAGE(PG8_SB(0, 0), cB, voffB); PG8_STAGE(PG8_SB(0, 1), cB + hstepB, voffB); PG8_STAGE(PG8_SA(0, 0), cA, voffA); PG8_STAGE(PG8_SA(0, 1), cA + hstepA, voffA);
    if (wr == 1) PG8_BAR;
    PG8_WAIT_V(2); PG8_BAR;
    PG8_STAGE(PG8_SB(1, 0), cB + kstep, voffB); PG8_STAGE(PG8_SA(1, 0), cA + kstep, voffA); PG8_STAGE(PG8_SB(1, 1), cB + hstepB + kstep, voffB);
    PG8_WAIT_V(6); PG8_BAR;
    for (;;) {
        const bool has_next = S.next(ui + 1, nxt);
        const char* nA = has_next ? (const char*)g.A + (size_t)nxt.pm * tstepA : cA; const char* nB = has_next ? (const char*)g.Bt + (size_t)nxt.pn * tstepB : cB;
        for (int t = 0; t < nt; t += 2) {
            const bool last = (t == nt - 2);
            const char* a1 = cA + (size_t)(t + 1) * kstep;
            const char* a2 = last ? nA : cA + (size_t)(t + 2) * kstep; const char* b2 = last ? nB : cB + (size_t)(t + 2) * kstep;
            const char* a3 = a2 + kstep; const char* b3 = b2 + kstep;
            PG8_LDB(B0, 0, 0); PG8_LDB(B1, 0, 1); PG8_SCHED; PG8_LDA(At, 0, 0); PG8_STAGE(PG8_SA(1, 1), a1 + hstepA, voffA);
            PG8_WAIT_V(8); PG8_WAIT_L(0); PG8_BAR; PG8_MMA(0, 0, At, B0); PG8_MMA(0, 1, At, B1); PG8_BAR; PG8_SCHED;
            PG8_LDA(At, 0, 1); PG8_STAGE(PG8_SB(0, 0), b2, voffB); PG8_STAGE(PG8_SB(0, 1), b2 + hstepB, voffB); PG8_STAGE(PG8_SA(0, 0), a2, voffA);
            PG8_WAIT_V(8); PG8_WAIT_L(0); PG8_BAR; PG8_MMA(1, 0, At, B0); PG8_MMA(1, 1, At, B1); PG8_BAR; PG8_SCHED;
            PG8_LDB(B0, 1, 0); PG8_LDB(B1, 1, 1); PG8_SCHED; PG8_LDA(At, 1, 0); PG8_STAGE(PG8_SA(0, 1), a2 + hstepA, voffA);
            PG8_WAIT_V(8); PG8_WAIT_L(0); PG8_BAR; PG8_MMA(0, 0, At, B0); PG8_MMA(0, 1, At, B1); PG8_BAR; PG8_SCHED;
            PG8_LDA(At, 1, 1); PG8_STAGE(PG8_SB(1, 0), b3, voffB); PG8_STAGE(PG8_SB(1, 1), b3 + hstepB, voffB); PG8_STAGE(PG8_SA(1, 0), a3, voffA);
            PG8_WAIT_V(8); PG8_WAIT_L(0); PG8_BAR; PG8_MMA(1, 0, At, B0); PG8_MMA(1, 1, At, B1); PG8_BAR; PG8_SCHED;
        }
        if constexpr (ALIGN_EPI) { if (wr == 0) PG8_BAR; }
        E(acc, cur, wr, wc, fr, fq);
        if (!has_next) break;
#pragma unroll
        for (int a = 0; a < 2; ++a)
#pragma unroll
            for (int b = 0; b < 2; ++b)
#pragma unroll
                for (int m = 0; m < 4; ++m)
#pragma unroll
                    for (int n = 0; n < 2; ++n) acc[a][b][m][n] = (f32x4){0.f, 0.f, 0.f, 0.f};
        cur = nxt; cA = nA; cB = nB; ++ui;
        if constexpr (ALIGN_EPI) { if (wr == 1) PG8_BAR; }
    }
    PG8_WAIT_V(0);
    if constexpr (!ALIGN_EPI) { if (wr == 0) PG8_BAR; }
    PG8_BAR;
#undef PG8_SA
#undef PG8_SB
#undef PG8_STAGE
#undef PG8_LDA
#undef PG8_LDB
#undef PG8_MMA
#undef PG8_WAIT_V
#undef PG8_WAIT_L
#undef PG8_BAR
#undef PG8_SCHED
}
struct EpiBf16 {
    static constexpr bool PERM = true;
    bf16_t* O; size_t ldc;
    __device__ __forceinline__ void operator()(const f32x4 (&acc)[2][2][4][2], const Unit& u, int wr, int wc, int fr, int fq) const {
        const int row0 = u.pm * BM + wr * 64 + fr, col0 = u.pn * BM + wc * 32 + 8 * fq;
#pragma unroll
        for (int ai = 0; ai < 2; ++ai)
#pragma unroll
            for (int m = 0; m < 4; ++m) { bf16_t* rowp = O + (size_t)(row0 + ai * HALF + m * 16) * ldc + col0;
#pragma unroll
                for (int bj = 0; bj < 2; ++bj) { const f32x4 v0 = acc[ai][bj][m][0], v1 = acc[ai][bj][m][1];
                    u32x4 w; w.x = pk2(v0[0], v0[1]); w.y = pk2(v0[2], v0[3]); w.z = pk2(v1[0], v1[1]); w.w = pk2(v1[2], v1[3]);
                    *(u32x4*)(rowp + bj * HALF) = w; } }
    }
};
struct EpiQKV {
    static constexpr bool PERM = true;
    bf16_t* O; size_t ldc;
    __device__ __forceinline__ void operator()(const f32x4 (&acc)[2][2][4][2], const Unit& u, int wr, int wc, int fr, int fq) const {
        const int row0 = u.pm * BM + wr * 64 + fr, col0 = u.pn * BM + wc * 32 + 8 * fq;
        const float sc = (u.pn * BM < 1024) ? 0.125f * LOG2E : 1.f;
#pragma unroll
        for (int ai = 0; ai < 2; ++ai)
#pragma unroll
            for (int m = 0; m < 4; ++m) { bf16_t* rowp = O + (size_t)(row0 + ai * HALF + m * 16) * ldc + col0;
#pragma unroll
                for (int bj = 0; bj < 2; ++bj) { const f32x4 v0 = acc[ai][bj][m][0] * sc, v1 = acc[ai][bj][m][1] * sc;
                    u32x4 w; w.x = pk2(v0[0], v0[1]); w.y = pk2(v0[2], v0[3]); w.z = pk2(v1[0], v1[1]); w.w = pk2(v1[2], v1[3]);
                    *(u32x4*)(rowp + bj * HALF) = w; } }
    }
};
struct EpiRet {
    static constexpr bool PERM = true;
    bf16_t* O;
    __device__ __forceinline__ void operator()(const f32x4 (&acc)[2][2][4][2], const Unit& u, int wr, int wc, int fr, int fq) const {
        const int row0 = u.pm * BM + wr * 64 + fr, colt = u.pn * BM, col0 = colt + wc * 32 + 8 * fq;
        float l2g = 0.f, pre = 1.f;
        if (colt < 2048) { const int h = (colt & 1023) >> 8; l2g = __log2f(1.f - exp2f(-5.f - (float)h)); if (colt >= 1024) { l2g = -l2g; pre = 0.0625f; } }
#pragma unroll
        for (int ai = 0; ai < 2; ++ai)
#pragma unroll
            for (int m = 0; m < 4; ++m) { const int row = row0 + ai * HALF + m * 16; const float sc = pre * exp2f(l2g * (float)(row & 127)); bf16_t* rowp = O + (size_t)row * 6144 + col0;
#pragma unroll
                for (int bj = 0; bj < 2; ++bj) { const f32x4 v0 = acc[ai][bj][m][0] * sc, v1 = acc[ai][bj][m][1] * sc;
                    u32x4 w; w.x = pk2(v0[0], v0[1]); w.y = pk2(v0[2], v0[3]); w.z = pk2(v1[0], v1[1]); w.w = pk2(v1[2], v1[3]);
                    *(u32x4*)(rowp + bj * HALF) = w; } }
    }
};
template <bool SRC_F32> struct EpiRes {
    static constexpr bool PERM = true;
    const void* Xin; bf16_t* Xout; const float* gate;
    __device__ __forceinline__ void operator()(const f32x4 (&acc)[2][2][4][2], const Unit& u, int wr, int wc, int fr, int fq) const {
        const int row0 = u.pm * BM + wr * 64 + fr, col0 = u.pn * BM + wc * 32 + 8 * fq;
        const float* g = gate + (size_t)(row0 >> 11) * 6144 + col0;
        f32x4 gv[2][2];
#pragma unroll
        for (int bj = 0; bj < 2; ++bj)
#pragma unroll
            for (int n = 0; n < 2; ++n) gv[bj][n] = *(const f32x4*)(g + bj * HALF + n * 4);
#pragma unroll
        for (int ai = 0; ai < 2; ++ai)
#pragma unroll
            for (int m = 0; m < 4; ++m) { const int row = row0 + ai * HALF + m * 16;
#pragma unroll
                for (int bj = 0; bj < 2; ++bj) { f32x4 x0, x1;
                    if constexpr (SRC_F32) { const float* xp = (const float*)Xin + (size_t)row * D + col0 + bj * HALF; x0 = *(const f32x4*)xp; x1 = *(const f32x4*)(xp + 4); }
                    else { const u32x4 xb = *(const u32x4*)((const bf16_t*)Xin + (size_t)row * XRB_LD + XRB_OFF + col0 + bj * HALF);
                        x0 = (f32x4){bf_lo(xb.x), bf_hi(xb.x), bf_lo(xb.y), bf_hi(xb.y)}; x1 = (f32x4){bf_lo(xb.z), bf_hi(xb.z), bf_lo(xb.w), bf_hi(xb.w)}; }
                    const f32x4 v0 = x0 + gv[bj][0] * acc[ai][bj][m][0], v1 = x1 + gv[bj][1] * acc[ai][bj][m][1];
                    u32x4 w; w.x = pk2(v0[0], v0[1]); w.y = pk2(v0[2], v0[3]); w.z = pk2(v1[0], v1[1]); w.w = pk2(v1[2], v1[3]);
                    *(u32x4*)(Xout + (size_t)row * XRB_LD + XRB_OFF + col0 + bj * HALF) = w; }
                if (m & 1) asm volatile("" ::: "memory"); }
    }
};
template <class Epi>
__device__ __forceinline__ void dense(ldsp lds, const bf16_t* A, int lda, const bf16_t* Bt, int M, int N, int K, const Epi& E) {
    Gemm g{A, Bt, M, N, K, lda}; StaticOrder S; S.init(M, N, GRID, (int)blockIdx.x);
    gemm_phase<Epi, true>(lds, g, S, E);
}
struct UnitX { int pm, pn; const char* aBase; const char* bBase; const int* list; int cnt, r0, dummy; };
template <class Src, class Epi>
__device__ __forceinline__ void gemm_phase_x(ldsp lds, const Src& S, const Epi& E) {
    const int tid = fresh_tid(), wid = __builtin_amdgcn_readfirstlane(tid >> 6), lane = tid & 63, wr = wid >> 2, wc = wid & 3, fr = lane & 15, fq = lane >> 4;
    constexpr int K = Src::K, nt = K / BK, LDA = Src::LDA;
    int RA[2], CA[2]; unsigned voffB[2];
#pragma unroll
    for (int i = 0; i < 2; ++i) { int R, C; stage_rc(tid * 16 + i * 8192, R, C); RA[i] = R; CA[i] = C * 2; const int Rb = Epi::PERM ? ((R & ~31) + perm32(R & 31)) : R; voffB[i] = (unsigned)(Rb * K + C) * 2u; }
    const size_t kstep = (size_t)(BK * 2), hstepB = (size_t)HALF * K * 2;
    const unsigned ldsw = (unsigned)wid * 1024u;
    const int aoff = lds_byte(wr * 64 + fr, fq * 8), boff = lds_byte(wc * 32 + fr, fq * 8);
    auto rows_of = [&](const UnitX& u, unsigned (&v)[2][2]) {
#pragma unroll
        for (int h = 0; h < 2; ++h)
#pragma unroll
            for (int i = 0; i < 2; ++i) { const int r = h * HALF + RA[i];
                if constexpr (Src::GATHER) { const int gidx = u.r0 + r; const int tok = u.list ? (gidx < u.cnt ? u.list[gidx] : u.dummy) : u.dummy + gidx; v[h][i] = (unsigned)tok * (unsigned)(LDA * 2) + (unsigned)CA[i]; }
                else v[h][i] = (unsigned)(r * LDA * 2 + CA[i]); }
    };
#define PGX_SA(b, h) (((b) * 2 + (h)) * HTB)
#define PGX_SB(b, h) ((4 + (b) * 2 + (h)) * HTB)
#define PGX_STAGEB(bufoff, gbase) do { _Pragma("unroll") for (int _i = 0; _i < 2; ++_i) glds16((const char*)(gbase) + voffB[_i], lds + (bufoff) + ldsw + _i * 8192); } while (0)
#define PGX_STAGEA(bufoff, gbase, h, nx) do { _Pragma("unroll") for (int _i = 0; _i < 2; ++_i) glds16((const char*)(gbase) + ((nx) ? nv[h][_i] : cv[h][_i]), lds + (bufoff) + ldsw + _i * 8192); } while (0)
#define PGX_LDA(dst, b, h) do { _Pragma("unroll") for (int m = 0; m < 4; ++m) _Pragma("unroll") for (int k = 0; k < 2; ++k) dst[m][k] = *(const LAS bf16x8*)(lds + PGX_SA(b, h) + aoff + m * 2048 + k * 1024); } while (0)
#define PGX_LDB(dst, b, h) do { _Pragma("unroll") for (int n = 0; n < 2; ++n) _Pragma("unroll") for (int k = 0; k < 2; ++k) dst[n][k] = *(const LAS bf16x8*)(lds + PGX_SB(b, h) + boff + n * 2048 + k * 1024); } while (0)
#define PGX_MMA(ai, bj, At, Bt) do { __builtin_amdgcn_s_setprio(1); _Pragma("unroll") for (int m = 0; m < 4; ++m) _Pragma("unroll") for (int n = 0; n < 2; ++n) _Pragma("unroll") for (int k = 0; k < 2; ++k) \
        acc[ai][bj][m][n] = __builtin_amdgcn_mfma_f32_16x16x32_bf16(Bt[n][k], At[m][k], acc[ai][bj][m][n], 0, 0, 0); __builtin_amdgcn_s_setprio(0); } while (0)
#define PGX_WAIT_V(n) asm volatile("s_waitcnt vmcnt(" #n ")" ::: "memory")
#define PGX_WAIT_L(n) asm volatile("s_waitcnt lgkmcnt(" #n ")" ::: "memory")
#define PGX_BAR __builtin_amdgcn_s_barrier()
#define PGX_SCHED __builtin_amdgcn_sched_barrier(0)
    UnitX cur, nxt; int ui = 0;
    PGX_WAIT_V(0); PGX_BAR;
    if (!S.next(0, cur)) return;
    unsigned cv[2][2], nv[2][2];
    rows_of(cur, cv);
    asm volatile("" :: "v"(cv[0][0]), "v"(cv[0][1]), "v"(cv[1][0]), "v"(cv[1][1]));
    f32x4 acc[2][2][4][2];
#pragma unroll
    for (int a = 0; a < 2; ++a)
#pragma unroll
        for (int b = 0; b < 2; ++b)
#pragma unroll
            for (int m = 0; m < 4; ++m)
#pragma unroll
                for (int n = 0; n < 2; ++n) acc[a][b][m][n] = (f32x4){0.f, 0.f, 0.f, 0.f};
    bf16x8 At[4][2], B0[2][2], B1[2][2];
    const char* cA = cur.aBase; const char* cB = cur.bBase;
    PGX_STAGEB(PGX_SB(0, 0), cB); PGX_STAGEB(PGX_SB(0, 1), cB + hstepB); PGX_STAGEA(PGX_SA(0, 0), cA, 0, false); PGX_STAGEA(PGX_SA(0, 1), cA, 1, false);
    if (wr == 1) PGX_BAR;
    PGX_WAIT_V(2); PGX_BAR;
    PGX_STAGEB(PGX_SB(1, 0), cB + kstep); PGX_STAGEA(PGX_SA(1, 0), cA + kstep, 0, false); PGX_STAGEB(PGX_SB(1, 1), cB + hstepB + kstep);
    PGX_WAIT_V(6); PGX_BAR;
    LAS int* lbuf = (LAS int*)(lds + LDS_MISC + 2048);
    for (;;) {
        const bool has_next = S.next(ui + 1, nxt);
        if constexpr (Src::GATHER) {
            if (has_next && nxt.list && wid == 0) glds16((const char*)(nxt.list + nxt.r0) + lane * 16, (ldsp)(lbuf + ((ui + 1) & 1) * 256));
        } else {
            if (has_next) rows_of(nxt, nv); else {
#pragma unroll
                for (int h = 0; h < 2; ++h)
#pragma unroll
                    for (int i = 0; i < 2; ++i) nv[h][i] = cv[h][i]; }
        }
        const char* nA = has_next ? nxt.aBase : cA; const char* nB = has_next ? nxt.bBase : cB;
#pragma unroll 1
        for (int t = 0; t < nt; t += 2) {
            const bool last = (t == nt - 2);
            if constexpr (Src::GATHER) { if (last) {
#pragma unroll
                for (int h = 0; h < 2; ++h)
#pragma unroll
                    for (int i = 0; i < 2; ++i) { const int r = h * HALF + RA[i], gidx = nxt.r0 + r; unsigned v = cv[h][i];
                        if (has_next) { int tok;
                            if (nxt.list) { const int tl = lbuf[((ui + 1) & 1) * 256 + r]; tok = gidx < nxt.cnt ? tl : nxt.dummy; } else tok = nxt.dummy + gidx;
                            v = (unsigned)tok * (unsigned)(LDA * 2) + (unsigned)CA[i]; }
                        nv[h][i] = v; } } }
            const char* a1 = cA + (size_t)(t + 1) * kstep;
            const char* a2 = last ? nA : cA + (size_t)(t + 2) * kstep; const char* b2 = last ? nB : cB + (size_t)(t + 2) * kstep;
            const char* a3 = a2 + kstep; const char* b3 = b2 + kstep;
            PGX_LDB(B0, 0, 0); PGX_LDB(B1, 0, 1); PGX_SCHED; PGX_LDA(At, 0, 0); PGX_STAGEA(PGX_SA(1, 1), a1, 1, false);
            PGX_WAIT_V(8); PGX_WAIT_L(0); PGX_BAR; PGX_MMA(0, 0, At, B0); PGX_MMA(0, 1, At, B1); PGX_BAR; PGX_SCHED;
            PGX_LDA(At, 0, 1); PGX_STAGEB(PGX_SB(0, 0), b2); PGX_STAGEB(PGX_SB(0, 1), b2 + hstepB); PGX_STAGEA(PGX_SA(0, 0), a2, 0, last);
            PGX_WAIT_V(8); PGX_WAIT_L(0); PGX_BAR; PGX_MMA(1, 0, At, B0); PGX_MMA(1, 1, At, B1); PGX_BAR; PGX_SCHED;
            PGX_LDB(B0, 1, 0); PGX_LDB(B1, 1, 1); PGX_SCHED; PGX_LDA(At, 1, 0); PGX_STAGEA(PGX_SA(0, 1), a2, 1, last);
            PGX_WAIT_V(8); PGX_WAIT_L(0); PGX_BAR; PGX_MMA(0, 0, At, B0); PGX_MMA(0, 1, At, B1); PGX_BAR; PGX_SCHED;
            PGX_LDA(At, 1, 1); PGX_STAGEB(PGX_SB(1, 0), b3); PGX_STAGEB(PGX_SB(1, 1), b3 + hstepB); PGX_STAGEA(PGX_SA(1, 0), a3, 0, last);
            PGX_WAIT_V(8); PGX_WAIT_L(0); PGX_BAR; PGX_MMA(1, 0, At, B0); PGX_MMA(1, 1, At, B1); PGX_BAR; PGX_SCHED;
        }
        if (wr == 0) PGX_BAR;
        E(acc, cur, wr, wc, fr, fq);
        if (!has_next) break;
#pragma unroll
        for (int a = 0; a < 2; ++a)
#pragma unroll
            for (int b = 0; b < 2; ++b)
#pragma unroll
                for (int m = 0; m < 4; ++m)
#pragma unroll
                    for (int n = 0; n < 2; ++n) acc[a][b][m][n] = (f32x4){0.f, 0.f, 0.f, 0.f};
        cur = nxt; cA = nA; cB = nB; ++ui;
#pragma unroll
        for (int h = 0; h < 2; ++h)
#pragma unroll
            for (int i = 0; i < 2; ++i) cv[h][i] = nv[h][i];
        if (wr == 1) PGX_BAR;
    }
    PGX_WAIT_V(0);
    PGX_BAR;
#undef PGX_SA
#undef PGX_SB
#undef PGX_STAGEA
#undef PGX_STAGEB
#undef PGX_LDA
#undef PGX_LDB
#undef PGX_MMA
#undef PGX_WAIT_V
#undef PGX_WAIT_L
#undef PGX_BAR
#undef PGX_SCHED
}
struct EpiSwiGLUx {
    static constexpr bool PERM = false;
    bf16_t* O;
    __device__ __forceinline__ void operator()(const f32x4 (&acc)[2][2][4][2], const UnitX& u, int wr, int wc, int fr, int fq) const {
        const int row0 = u.pm * BM + wr * 64 + fr, c0 = (u.pn * BM + wc * 32) / 2 + 4 * fq;
#pragma unroll
        for (int ai = 0; ai < 2; ++ai)
#pragma unroll
            for (int m = 0; m < 4; ++m) { bf16_t* rowp = O + (size_t)(row0 + ai * HALF + m * 16) * 256 + c0;
#pragma unroll
                for (int bj = 0; bj < 2; ++bj) { const f32x4 x = acc[ai][bj][m][0], y = acc[ai][bj][m][1]; u32x2 w;
                    w.x = pk2(silu_f(x[0]) * y[0], silu_f(x[1]) * y[1]); w.y = pk2(silu_f(x[2]) * y[2], silu_f(x[3]) * y[3]); *(u32x2*)(rowp + bj * (HALF / 2)) = w; } }
    }
};
struct EpiYx {
    static constexpr bool PERM = true;
    unsigned char* O;
    __device__ __forceinline__ void operator()(const f32x4 (&acc)[2][2][4][2], const UnitX& u, int wr, int wc, int fr, int fq) const {
        const int row0 = u.pm * BM + wr * 64 + fr, col0 = u.pn * BM + wc * 32 + 8 * fq;
#pragma unroll
        for (int ai = 0; ai < 2; ++ai)
#pragma unroll
            for (int m = 0; m < 4; ++m) { unsigned char* rowp = O + (size_t)(row0 + ai * HALF + m * 16) * D + col0;
#pragma unroll
                for (int bj = 0; bj < 2; ++bj) { f32x4 v0 = acc[ai][bj][m][0], v1 = acc[ai][bj][m][1];
#pragma unroll
                    for (int e = 0; e < 4; ++e) { v0[e] = __builtin_amdgcn_fmed3f(v0[e], -448.f, 448.f); v1[e] = __builtin_amdgcn_fmed3f(v1[e], -448.f, 448.f); }
                    int w0 = __builtin_amdgcn_cvt_pk_fp8_f32(v0[0], v0[1], 0, false); w0 = __builtin_amdgcn_cvt_pk_fp8_f32(v0[2], v0[3], w0, true);
                    int w1 = __builtin_amdgcn_cvt_pk_fp8_f32(v1[0], v1[1], 0, false); w1 = __builtin_amdgcn_cvt_pk_fp8_f32(v1[2], v1[3], w1, true);
                    u32x2 w; w.x = (unsigned)w0; w.y = (unsigned)w1; *(u32x2*)(rowp + bj * HALF) = w; } }
    }
};
}

__device__ __forceinline__ void transpose_item(const float* W, int K, int N, bf16_t* WT, int mode, LAS float* scr, int item, int lane) {
    const int nblk = N / 32, kb = item / nblk, nb = item % nblk, k0 = 64 * kb, n0 = 32 * nb;
    f32x4 v[8];
#pragma unroll
    for (int i = 0; i < 8; ++i) v[i] = *(const f32x4*)(W + (size_t)(k0 + 8 * i + (lane >> 3)) * N + n0 + (lane & 7) * 4);
#pragma unroll
    for (int i = 0; i < 8; ++i) { LAS float* d = scr + (8 * i + (lane >> 3)) * 33 + (lane & 7) * 4; d[0] = v[i][0]; d[1] = v[i][1]; d[2] = v[i][2]; d[3] = v[i][3]; }
    LDS_WAIT();
    const int c = lane & 7;
#pragma unroll
    for (int j = 0; j < 4; ++j) { const int n = (lane >> 3) + 8 * j; const LAS float* s = scr + (8 * c) * 33 + n;
        u32x4 o; o.x = pk2(s[0 * 33], s[1 * 33]); o.y = pk2(s[2 * 33], s[3 * 33]); o.z = pk2(s[4 * 33], s[5 * 33]); o.w = pk2(s[6 * 33], s[7 * 33]);
        const int nn = n0 + n; const int row = mode == 0 ? nn : ((nn >> 4) * 32 + (mode == 2 ? 16 : 0) + (nn & 15));
        *(u32x4*)(WT + (size_t)row * K + k0 + 8 * c) = o; }
    LDS_WAIT();
}
__device__ __forceinline__ void convert_expert_weights(const Args& a, int layer, ldsp lds, int gw, int ngw, int wave, int lane) {
    LAS float* scr = (LAS float*)(lds + wave * 16384);
    unsigned char* ws = a.ws;
    constexpr int I13 = (D / 64) * (256 / 32), I2 = (256 / 64) * (D / 32);
    constexpr int NE = 64 * I13;
    constexpr int TOTAL = 3 * NE + 3 * 128;
    for (int it = gw; it < TOTAL; it += ngw) {
        int r = it;
        if (r < NE) { const int e = r / I13; transpose_item(a.in[I_EW1] + ((size_t)layer * 64 + e) * D * 256, D, 256, (bf16_t*)(ws + WS_W13) + (size_t)e * 512 * D, 1, scr, r % I13, lane); continue; } r -= NE;
        if (r < NE) { const int e = r / I13; transpose_item(a.in[I_EW3] + ((size_t)layer * 64 + e) * D * 256, D, 256, (bf16_t*)(ws + WS_W13) + (size_t)e * 512 * D, 2, scr, r % I13, lane); continue; } r -= NE;
        if (r < NE) { const int e = r / I2; transpose_item(a.in[I_EW2] + ((size_t)layer * 64 + e) * 256 * D, 256, D, (bf16_t*)(ws + WS_W2) + (size_t)e * D * 256, 0, scr, r % I2, lane); continue; } r -= NE;
        if (r < 128) { transpose_item(a.in[I_SW1] + (size_t)layer * D * 256, D, 256, (bf16_t*)(ws + WS_WS13), 1, scr, r, lane); continue; } r -= 128;
        if (r < 128) { transpose_item(a.in[I_SW3] + (size_t)layer * D * 256, D, 256, (bf16_t*)(ws + WS_WS13), 2, scr, r, lane); continue; } r -= 128;
        transpose_item(a.in[I_SW2] + (size_t)layer * 256 * D, 256, D, (bf16_t*)(ws + WS_WS2), 0, scr, r, lane);
    }
}
__device__ __forceinline__ void convert_dense_weights(const Args& a, ldsp lds, int gw, int ngw, int wave, int lane) {
    LAS float* scr = (LAS float*)(lds + wave * 16384);
    unsigned char* ws = a.ws;
    constexpr int IQ = 16 * 96, IO = 16 * 32, IRI = 16 * 192, IRO = 32 * 32;
    for (int it = gw; it < IQ + IO + IRI + IRO; it += ngw) {
        int r = it;
        if (r < IQ) { transpose_item(a.in[I_DAWIN], D, 3072, (bf16_t*)(ws + WS_WQKV), 0, scr, r, lane); continue; } r -= IQ;
        if (r < IO) { transpose_item(a.in[I_DAWOUT], D, D, (bf16_t*)(ws + WS_WO), 0, scr, r, lane); continue; } r -= IO;
        if (r < IRI) { transpose_item(a.in[I_RWIN], D, 6144, (bf16_t*)(ws + WS_WRI), 0, scr, r, lane); continue; } r -= IRI;
        transpose_item(a.in[I_RWOUT], 2048, D, (bf16_t*)(ws + WS_WRO), 0, scr, r, lane);
    }
}
__device__ __forceinline__ void mod_items(const Args& a, ldsp lds) {
    const int tid = threadIdx.x;
    LAS float* sl = (LAS float*)lds;
    LAS float* red = (LAS float*)(lds + 65536);
    const float* c = a.in[I_C];
    for (int i = tid; i < 16 * 1024; i += NTHR) sl[i] = silu_f(c[i]);
    __syncthreads();
    float* mod = (float*)(a.ws + WS_MOD);
    for (int item = blockIdx.x; item < 384; item += GRID) {
        const int layer = item / 192, j0 = (item % 192) * 32, kq = tid >> 5, col = tid & 31;
        const float* w = a.in[I_ADAW] + (size_t)layer * D * 6144 + j0 + col;
        float acc[16];
#pragma unroll
        for (int b = 0; b < 16; ++b) acc[b] = 0.f;
        for (int k0 = kq * 64; k0 < kq * 64 + 64; k0 += 8) {
            float wv[8];
#pragma unroll
            for (int u = 0; u < 8; ++u) wv[u] = w[(size_t)(k0 + u) * 6144];
#pragma unroll
            for (int u = 0; u < 8; ++u)
#pragma unroll
                for (int b = 0; b < 16; ++b) acc[b] += sl[b * 1024 + k0 + u] * wv[u];
        }
#pragma unroll
        for (int b = 0; b < 16; ++b) red[(kq * 16 + b) * 32 + col] = acc[b];
        __syncthreads();
        { const int b = tid >> 5, cc = tid & 31; const int j = j0 + cc; float s = a.in[I_ADAB][(size_t)layer * 6144 + j];
#pragma unroll
          for (int q = 0; q < 16; ++q) s += red[(q * 16 + b) * 32 + cc];
          if (j >= 1024 && j < 2048) s = a.in[I_NMIX][layer * D + j - 1024] * (1.f + s);
          if (j >= 4096 && j < 5120) s = a.in[I_NFFN][layer * D + j - 4096] * (1.f + s);
          mod[((size_t)layer * 16 + b) * 6144 + j] = s; }
        __syncthreads();
    }
}

__device__ __forceinline__ void adaln_store(const f32x4 (&v)[4], float rstd, const float* G, const float* sh, bf16_t* hrow, int lane) {
#pragma unroll
    for (int j = 0; j < 4; ++j) { const int col = 4 * lane + 256 * j; const f32x4 g = *(const f32x4*)(G + col), s0 = *(const f32x4*)(sh + col);
        const f32x4 h = v[j] * rstd * g + s0; u32x2 w; w.x = pk2(h[0], h[1]); w.y = pk2(h[2], h[3]); *(u32x2*)(hrow + col) = w; }
}
__device__ __forceinline__ void adaln_phase(const float* X, const float* mod_sh  , const float* mod_G, bf16_t* H, int gw, int ngw, int lane) {
    for (int row0 = gw * 2; row0 < T; row0 += ngw * 2) {
        f32x4 v[2][4]; float ss[2] = {0.f, 0.f};
#pragma unroll
        for (int r = 0; r < 2; ++r)
#pragma unroll
            for (int j = 0; j < 4; ++j) v[r][j] = *(const f32x4*)(X + (size_t)(row0 + r) * D + 4 * lane + 256 * j);
#pragma unroll
        for (int r = 0; r < 2; ++r) {
#pragma unroll
            for (int j = 0; j < 4; ++j) ss[r] += v[r][j][0] * v[r][j][0] + v[r][j][1] * v[r][j][1] + v[r][j][2] * v[r][j][2] + v[r][j][3] * v[r][j][3];
            const float rstd = rsqrtf(wave_sum(ss[r]) * (1.f / D) + 1e-6f); const int b = (row0 + r) >> 11;
            adaln_store(v[r], rstd, mod_G + (size_t)b * 6144, mod_sh + (size_t)b * 6144, H + (size_t)(row0 + r) * D, lane); }
    }
}

typedef float f32x16 __attribute__((ext_vector_type(16)));
__device__ __forceinline__ float half_swap_max(float m) { auto rr = __builtin_amdgcn_permlane32_swap(__float_as_uint(m), __float_as_uint(m), false, false);
    return fmaxf(__uint_as_float(rr[0]), __uint_as_float(rr[1])); }
__device__ __forceinline__ float half_swap_sum(float m) { auto rr = __builtin_amdgcn_permlane32_swap(__float_as_uint(m), __float_as_uint(m), false, false);
    return __uint_as_float(rr[0]) + __uint_as_float(rr[1]); }
#define MX3(a, b, c) __builtin_fmaxf(__builtin_fmaxf((a), (b)), (c))
__device__ __forceinline__ void attn_phase(ldsp lds, const bf16_t* qkv, bf16_t* ao, float lam, const float* subln_g) {
    const int tid = fresh_tid(), lane = tid & 63, wid = __builtin_amdgcn_readfirstlane(tid >> 6), map = wid & 1, qg = wid >> 1, half = wid >> 2, r32 = lane & 31, hi = lane >> 5;
    constexpr int STAGE = 32768;
    constexpr float THR = 8.f;
    const int kb0 = map * 8192 + r32 * 128 + ((hi ^ ((r32 >> 1) & 7)) << 4);
    const int vb0 = 16384 + (4 * hi + ((lane & 15) >> 2)) * 256 + (((lane >> 2) & 3) << 6) + ((2 * ((lane >> 4) & 1) + ((lane & 3) >> 1)) << 4) + (lane & 1) * 8;
    for (int round = 0; round < 8; ++round) {
        const int i = blockIdx.x, jgrp = i >> 7, bh = i & 127;
        const int qb = (round & 1) ? (14 - 2 * round + jgrp) : (15 - 2 * round - jgrp);
        const int b = bh >> 3, h = bh & 7;
        const size_t tok0 = (size_t)b * SEQ;
        const float slope2 = exp2f(-(float)(h + 1)) * LOG2E, d32 = 32.f * slope2, d64 = 64.f * slope2;
        const int qrow = qb * 128 + qg * 32 + r32;
        bf16x8 qr[4];
#pragma unroll
        for (int d0 = 0; d0 < 4; ++d0) qr[d0] = *(const bf16x8*)(qkv + (tok0 + qrow) * 3072 + (2 * h + map) * 64 + d0 * 16 + hi * 8);
        asm volatile("" :: "v"(qr[0]), "v"(qr[1]), "v"(qr[2]), "v"(qr[3]));
        f32x16 bt0;
#pragma unroll
        for (int r = 0; r < 16; ++r) bt0[r] = slope2 * (float)((r & 3) + 8 * (r >> 2) + 4 * hi);
        const char* srcK0; const char* srcV0;
        { const int row = 8 * wid + (lane >> 3), ch = (lane & 7) ^ ((row >> 1) & 7);
          srcK0 = (const char*)(qkv + (tok0 + row) * 3072 + 1024 + (2 * h) * 64) + ch * 16; }
        { const int row = 4 * wid + (lane >> 4), ch = (lane & 15) ^ ((row & 3) << 2); srcV0 = (const char*)(qkv + (tok0 + row) * 3072 + 2048 + h * 128) + ch * 16; }
        auto issue = [&](int s, int t) {
            ldsp st = lds + s * STAGE; const size_t adv = (size_t)t * 64 * 3072 * 2;
            glds16(srcK0 + adv, st + wid * 1024); glds16(srcK0 + adv + 128, st + 8192 + wid * 1024);
            glds16(srcV0 + adv, st + 16384 + wid * 1024); glds16(srcV0 + adv + (size_t)32 * 6144, st + 16384 + (wid + 8) * 1024);
        };
        f32x16 o[4];
#pragma unroll
        for (int dvt = 0; dvt < 4; ++dvt)
#pragma unroll
            for (int r = 0; r < 16; ++r) o[dvt][r] = 0.f;
        bf16x8 pw[4];
#pragma unroll
        for (int g = 0; g < 4; ++g) pw[g] = (bf16x8){0, 0, 0, 0, 0, 0, 0, 0};
        float mrel = -__builtin_inff(), lsum = 0.f;
        const int ntile = 2 * qb + 2;
        const int qfirst = qb * 128 + qg * 32;
        f32x16 pS0, pS1;
        auto pv = [&](ldsp stv) {
            int vb = vb0; asm volatile("" : "+v"(vb));
            bf16x8 vq[3];
            vq[0] = tr2(stv + vb, stv + vb + 2048);
            vq[1] = tr2(stv + (vb ^ 64), stv + (vb ^ 64) + 2048);
#pragma unroll
            for (int i = 0; i < 16; ++i) {
                const int g = i >> 2, dvt = i & 3;
                if (i + 2 < 16) { const int i2 = i + 2, vo = (vb ^ ((i2 & 3) << 6)) + (i2 >> 2) * 4096; vq[i2 % 3] = tr2(stv + vo, stv + vo + 2048); }
                o[dvt] = __builtin_amdgcn_mfma_f32_32x32x16_bf16(vq[i % 3], pw[g], o[dvt], 0, 0, 0);
                __builtin_amdgcn_sched_barrier(0);
            }
        };
        auto mslot = [&](int t) {
            pv(lds + ((t > 0 ? t - 1 : 0) & 3) * STAGE);
            ldsp stk = lds + (t & 3) * STAGE;
            int kb = kb0; asm volatile("" : "+v"(kb));
            bf16x8 kf[4];
            kf[0] = *(LAS bf16x8*)(stk + kb); kf[1] = *(LAS bf16x8*)(stk + kb + 4096);
            kf[2] = *(LAS bf16x8*)(stk + (kb ^ 32)); kf[3] = *(LAS bf16x8*)(stk + (kb ^ 32) + 4096);
            pS0 = __builtin_amdgcn_mfma_f32_32x32x16_bf16(kf[0], qr[0], bt0, 0, 0, 0);
            pS1 = __builtin_amdgcn_mfma_f32_32x32x16_bf16(kf[1], qr[0], bt0, 0, 0, 0);
            __builtin_amdgcn_sched_barrier(0);
            kf[0] = *(LAS bf16x8*)(stk + (kb ^ 64)); kf[1] = *(LAS bf16x8*)(stk + (kb ^ 64) + 4096);
            pS0 = __builtin_amdgcn_mfma_f32_32x32x16_bf16(kf[2], qr[1], pS0, 0, 0, 0);
            pS1 = __builtin_amdgcn_mfma_f32_32x32x16_bf16(kf[3], qr[1], pS1, 0, 0, 0);
            __builtin_amdgcn_sched_barrier(0);
            kf[2] = *(LAS bf16x8*)(stk + (kb ^ 96)); kf[3] = *(LAS bf16x8*)(stk + (kb ^ 96) + 4096);
            pS0 = __builtin_amdgcn_mfma_f32_32x32x16_bf16(kf[0], qr[2], pS0, 0, 0, 0);
            pS1 = __builtin_amdgcn_mfma_f32_32x32x16_bf16(kf[1], qr[2], pS1, 0, 0, 0);
            __builtin_amdgcn_sched_barrier(0);
            pS0 = __builtin_amdgcn_mfma_f32_32x32x16_bf16(kf[2], qr[3], pS0, 0, 0, 0);
            pS1 = __builtin_amdgcn_mfma_f32_32x32x16_bf16(kf[3], qr[3], pS1, 0, 0, 0);
        };
        auto sslot = [&](int t) {
            const int key0 = 64 * t;
            if (key0 + 63 > qfirst) {
                const int kq = qrow - key0 - 4 * hi;
#pragma unroll
                for (int r = 0; r < 16; ++r) { const int kr = (r & 3) + 8 * (r >> 2); if (kr > kq) pS0[r] = -__builtin_inff(); if (kr + 32 > kq) pS1[r] = -__builtin_inff(); }
            }
            float ma = MX3(pS0[0], pS0[1], pS0[2]), mb = MX3(pS1[0], pS1[1], pS1[2]);
            ma = MX3(ma, pS0[3], pS0[4]); mb = MX3(mb, pS1[3], pS1[4]);
#pragma unroll
            for (int r = 5; r < 15; r += 2) { ma = MX3(ma, pS0[r], pS0[r + 1]); mb = MX3(mb, pS1[r], pS1[r + 1]); }
            ma = fmaxf(ma, pS0[15]); mb = fmaxf(mb, pS1[15]);
            const float mx = half_swap_max(fmaxf(ma, mb + d32));
            if (__any(mx - mrel > THR)) {
                const float mnew = fmaxf(mrel, mx); float alpha = fast_exp2(mrel - mnew);
                asm volatile("s_nop 1" : "+v"(alpha));
                mrel = mnew; lsum *= alpha;
#pragma unroll
                for (int dvt = 0; dvt < 4; ++dvt)
#pragma unroll
                    for (int r = 0; r < 16; ++r) asm volatile("v_mul_f32 %0, %0, %1" : "+v"(o[dvt][r]) : "v"(alpha));
            }
            const float e0 = mrel, e1 = mrel - d32;
            float s0 = 0.f, s1 = 0.f;
#pragma unroll
            for (int r = 0; r < 16; ++r) { pS0[r] = fast_exp2(pS0[r] - e0); pS1[r] = fast_exp2(pS1[r] - e1); s0 += pS0[r]; asm volatile("" : "+v"(s0)); s1 += pS1[r]; asm volatile("" : "+v"(s1)); }
            lsum += s0 + s1;
#pragma unroll
            for (int g = 0; g < 2; ++g) { u32x4 w0, w1;
                w0.x = pk2(pS0[8 * g + 0], pS0[8 * g + 1]); w0.y = pk2(pS0[8 * g + 2], pS0[8 * g + 3]); w0.z = pk2(pS0[8 * g + 4], pS0[8 * g + 5]); w0.w = pk2(pS0[8 * g + 6], pS0[8 * g + 7]);
                w1.x = pk2(pS1[8 * g + 0], pS1[8 * g + 1]); w1.y = pk2(pS1[8 * g + 2], pS1[8 * g + 3]); w1.z = pk2(pS1[8 * g + 4], pS1[8 * g + 5]); w1.w = pk2(pS1[8 * g + 6], pS1[8 * g + 7]);
                pw[g] = __builtin_bit_cast(bf16x8, w0); pw[2 + g] = __builtin_bit_cast(bf16x8, w1); }
            mrel -= d64;
        };
        BAR();
        issue(0, 0); issue(1, 1);
        auto barseq = [&](int k) {
            if (k < ntile) { if (k + 1 < ntile) wait_vm<4>(); else wait_vm<0>(); }
            BAR();
            if (k + 2 < ntile) issue((k + 2) & 3, k + 2);
        };
        if (half) barseq(0);
#pragma unroll 1
        for (int t = 0; t < ntile; ++t) {
            if (!half) barseq(t);
            mslot(t);
            if (half) barseq(t + 1);
            sslot(t);
        }
        if (!half) barseq(ntile);
        pv(lds + ((ntile - 1) & 3) * STAGE);
        const float inv = __builtin_amdgcn_rcpf(half_swap_sum(lsum));
        BAR();
        LAS float* xb = (LAS float*)lds + qg * 4096;
        if (map == 1) {
#pragma unroll
            for (int dvt = 0; dvt < 4; ++dvt)
#pragma unroll
                for (int r = 0; r < 16; ++r) xb[(dvt * 16 + r) * 64 + lane] = o[dvt][r] * inv;
        }
        LDS_WAIT(); BAR();
        if (map == 0) {
            const float* sg = subln_g; asm volatile("" : "+s"(sg));
            float ss = 0.f;
#pragma unroll
            for (int dvt = 0; dvt < 4; ++dvt) {
#pragma unroll
                for (int r = 0; r < 16; ++r) { const float v = o[dvt][r] * inv - lam * xb[(dvt * 16 + r) * 64 + lane]; o[dvt][r] = v; ss += v * v; }
                __builtin_amdgcn_sched_barrier(0);
            }
            ss = half_swap_sum(ss);
            const float rstd = rsqrtf(ss * (1.f / 128.f) + 1e-6f) * 0.8f;
            bf16_t* orow = ao + (tok0 + qrow) * D + h * 128 + 4 * hi;
#pragma unroll
            for (int dvt = 0; dvt < 4; ++dvt) {
#pragma unroll
                for (int j = 0; j < 4; ++j) { const f32x4 g = *(const f32x4*)(sg + dvt * 32 + 8 * j + 4 * hi);
                    u32x2 w; w.x = pk2(o[dvt][4 * j] * rstd * g[0], o[dvt][4 * j + 1] * rstd * g[1]); w.y = pk2(o[dvt][4 * j + 2] * rstd * g[2], o[dvt][4 * j + 3] * rstd * g[3]);
                    *(u32x2*)(orow + dvt * 32 + 8 * j) = w; }
                __builtin_amdgcn_sched_barrier(0);
            }
        }
        LDS_WAIT(); BAR();
    }
}

__device__ __forceinline__ void chain_phase(ldsp lds, bf16_t* rp, const bf16_t* P, bool dry) {
    const int tid = fresh_tid(), lane = tid & 63, wid = __builtin_amdgcn_readfirstlane(tid >> 6), fr = lane & 15, fq = lane >> 4;
    constexpr int STAGE = 32768, NSTG = 4;
    const int chain = vcu_of_block(), b = chain >> 4, h = (chain >> 2) & 3, sl = chain & 3;
    const size_t tok0 = (size_t)b * SEQ;
    const float lg = __log2f(1.f - exp2f(-5.f - (float)h));
    const float gamma = exp2f(lg), g127 = exp2f(lg * 127.f), g128 = exp2f(lg * 128.f);
    const bf16_t* vbase = rp + tok0 * 6144 + 2048 + h * 512 + sl * 128;
    const bf16_t* qbase = rp + tok0 * 6144 + h * 256;
    const bf16_t* kbase = rp + tok0 * 6144 + 1024 + h * 256;
    const bf16_t* pbase = P + (size_t)((b * 4 + h) * 16) * 16384;
    unsigned vsrc0, psrc0, qsrc0, ksrc0;
    { const int row = 4 * wid + (lane >> 4); vsrc0 = (unsigned)(row * 6144 * 2 + (((lane & 15) ^ ((row & 7) << 1)) << 4)); psrc0 = (unsigned)(row * 256 + (((lane & 15) ^ (row & 15)) << 4)); }
    { const int row = 8 * wid + (lane >> 3); qsrc0 = (unsigned)(row * 6144 * 2 + (((lane & 7) ^ ((row >> 1) & 7)) << 4)); ksrc0 = (unsigned)(row * 6144 * 2 + (((lane & 7) ^ (((row >> 1) & 3) << 1)) << 4)); }
    auto issue = [&](int s, int g) {
        ldsp st = lds + s * STAGE; const int c = g / 6, kind = g - c * 6; const size_t coff = (size_t)c * 128 * 6144 * 2;
        if (kind == 0) {
            const char* bp = (const char*)vbase + coff;
#pragma unroll
            for (int jj = 0; jj < 4; ++jj) glds16(bp + (size_t)jj * 32 * 12288 + vsrc0, st + (wid + 8 * jj) * 1024);
        } else if (kind == 5) {
            const char* bp = (const char*)pbase + (size_t)c * 32768;
#pragma unroll
            for (int jj = 0; jj < 4; ++jj) glds16(bp + (size_t)jj * 32 * 256 + psrc0, st + (wid + 8 * jj) * 1024);
        } else { const int p = kind - 1;
            const char* bq = (const char*)qbase + coff + p * 128; const char* bk = (const char*)kbase + coff + p * 128;
#pragma unroll
            for (int jj = 0; jj < 2; ++jj) glds16(bq + (size_t)jj * 64 * 12288 + qsrc0, st + (wid + 8 * jj) * 1024);
#pragma unroll
            for (int jj = 0; jj < 2; ++jj) glds16(bk + (size_t)jj * 64 * 12288 + ksrc0, st + 16384 + (wid + 8 * jj) * 1024);
        }
    };
    const int tq = fr >> 2, tp = fr & 3;
    const int vrow = 4 * fq + tq;
    const int vfo = vrow * 256 + ((((2 * wid + (tp >> 1)) ^ ((vrow & 7) << 1)) & 15) << 4) + (tp & 1) * 8;
    const int ksw = ((vrow >> 1) & 3) << 1;
    const int kfo0 = 16384 + vrow * 128 + ((((tp >> 1) ^ ksw) & 7) << 4) + (tp & 1) * 8;
    const int qsw = fr >> 1;
    const int qfo0 = fr * 128 + ((((fq >> 1) ^ qsw) & 7) << 4) + (fq & 1) * 8;
    const int pfo0 = fr * 256 + ((((fq >> 1) ^ fr) & 15) << 4) + (fq & 1) * 8;

    f32x4 R[16];
#pragma unroll
    for (int i = 0; i < 16; ++i) R[i] = (f32x4){0.f, 0.f, 0.f, 0.f};
    f32x4 o[8];
#pragma unroll
    for (int it = 0; it < 8; ++it) o[it] = (f32x4){0.f, 0.f, 0.f, 0.f};
    bf16x8 vf[4];
#pragma unroll
    for (int s4 = 0; s4 < 4; ++s4) vf[s4] = (bf16x8){0, 0, 0, 0, 0, 0, 0, 0};
    constexpr int NG = 16 * 6;
    BAR();
    issue(0, 0); issue(1, 1); issue(2, 2);
    for (int c = 0; c < 16; ++c) {
        auto step = [&](auto KC) {
            constexpr int kind = decltype(KC)::value;
            const int g = c * 6 + kind;
            if (g + 2 < NG) wait_vm<8>(); else if (g + 1 < NG) wait_vm<4>(); else wait_vm<0>();
            BAR();
            if (g + 3 < NG) issue((g + 3) & 3, g + 3);
            ldsp st = lds + (g & 3) * STAGE;
            if constexpr (kind == 0) {
#pragma unroll
                for (int s4 = 0; s4 < 4; ++s4) vf[s4] = tr2(st + vfo + s4 * 8192, st + vfo + s4 * 8192 + 4096);
#pragma unroll
                for (int it = 0; it < 8; ++it) o[it] = (f32x4){0.f, 0.f, 0.f, 0.f};
            } else if constexpr (kind == 5) {
#pragma unroll
                for (int it = 0; it < 8; ++it) o[it] = o[it] * gamma;
                int pb = pfo0; asm volatile("" : "+v"(pb));
                bf16x8 fa[4], fb[4];
                auto loadp = [&](bf16x8 (&d)[4], int grp) { const int s4 = grp >> 1, hb = (grp & 1) * 4; const int p0 = pb ^ ((4 * s4) << 4), p1 = pb ^ ((4 * s4 + 2) << 4);
#pragma unroll
                    for (int i = 0; i < 4; ++i) d[i] = rd2x64(st + p0 + (hb + i) * 4096, st + p1 + (hb + i) * 4096); };
                auto mmap = [&](const bf16x8 (&f)[4], int grp) { const int s4 = grp >> 1, hb = (grp & 1) * 4;
#pragma unroll
                    for (int i = 0; i < 4; ++i) o[hb + i] = __builtin_amdgcn_mfma_f32_16x16x32_bf16(vf[s4], f[i], o[hb + i], 0, 0, 0); };
                loadp(fa, 0);
#pragma unroll
                for (int grp = 0; grp < 8; grp += 2) {
                    loadp(fb, grp + 1); mmap(fa, grp); __builtin_amdgcn_sched_barrier(0);
                    if (grp + 2 < 8) loadp(fa, grp + 2);
                    mmap(fb, grp + 1); __builtin_amdgcn_sched_barrier(0);
                }
                bf16_t* ob = rp + (tok0 + (size_t)c * 128) * 6144 + 2048 + h * 512 + sl * 128 + 16 * wid + 4 * fq;
#pragma unroll
                for (int it = 0; it < 8; ++it) { u32x2 w; w.x = pk2(o[it][0], o[it][1]); w.y = pk2(o[it][2], o[it][3]); if (!dry) *(u32x2*)(ob + (size_t)(16 * it + fr) * 6144) = w; else asm volatile("" :: "v"(w)); }
            } else {
                constexpr int p = kind - 1;
                bf16x8 rf[2];
#pragma unroll
                for (int s2 = 0; s2 < 2; ++s2) { u32x4 w; const f32x4 r0 = R[4 * p + 2 * s2], r1 = R[4 * p + 2 * s2 + 1];
                    w.x = pk2(r0[0], r0[1]); w.y = pk2(r0[2], r0[3]); w.z = pk2(r1[0], r1[1]); w.w = pk2(r1[2], r1[3]); rf[s2] = __builtin_bit_cast(bf16x8, w); }
                int qb = qfo0; asm volatile("" : "+v"(qb));
                int kb = kfo0; asm volatile("" : "+v"(kb));
                bf16x8 fa[4], fb[4];
                auto loadq = [&](bf16x8 (&d)[4], int grp) { const int s2 = grp >> 1, hb = (grp & 1) * 4; const int q0 = qb ^ ((4 * s2) << 4), q1 = qb ^ ((4 * s2 + 2) << 4);
#pragma unroll
                    for (int i = 0; i < 4; ++i) d[i] = rd2x64(st + q0 + (hb + i) * 2048, st + q1 + (hb + i) * 2048); };
                auto mmaq = [&](const bf16x8 (&f)[4], int grp) { const int s2 = grp >> 1, hb = (grp & 1) * 4;
#pragma unroll
                    for (int i = 0; i < 4; ++i) o[hb + i] = __builtin_amdgcn_mfma_f32_16x16x32_bf16(rf[s2], f[i], o[hb + i], 0, 0, 0); };
                auto loadk = [&](bf16x8 (&d)[4], int s4) {
#pragma unroll
                    for (int dkt = 0; dkt < 4; ++dkt) { const int ko = kb ^ (dkt << 5); d[dkt] = tr2(st + ko + s4 * 4096, st + ko + s4 * 4096 + 2048); } };
                f32x4 au[4];
#pragma unroll
                for (int dkt = 0; dkt < 4; ++dkt) au[dkt] = (f32x4){0.f, 0.f, 0.f, 0.f};
                auto mmak = [&](const bf16x8 (&f)[4], int s4) {
#pragma unroll
                    for (int dkt = 0; dkt < 4; ++dkt) au[dkt] = __builtin_amdgcn_mfma_f32_16x16x32_bf16(f[dkt], vf[s4], au[dkt], 0, 0, 0); };
                loadq(fa, 0);
                loadq(fb, 1); mmaq(fa, 0); __builtin_amdgcn_sched_barrier(0);
                loadq(fa, 2); mmaq(fb, 1); __builtin_amdgcn_sched_barrier(0);
                loadq(fb, 3); mmaq(fa, 2); __builtin_amdgcn_sched_barrier(0);
                loadk(fa, 0); mmaq(fb, 3); __builtin_amdgcn_sched_barrier(0);
                loadk(fb, 1); mmak(fa, 0); __builtin_amdgcn_sched_barrier(0);
                loadk(fa, 2); mmak(fb, 1); __builtin_amdgcn_sched_barrier(0);
                loadk(fb, 3); mmak(fa, 2); __builtin_amdgcn_sched_barrier(0);
                mmak(fb, 3);
#pragma unroll
                for (int dkt = 0; dkt < 4; ++dkt) R[4 * p + dkt] = R[4 * p + dkt] * g128 + au[dkt] * g127;
                __builtin_amdgcn_sched_barrier(0);
            }
        };
        step(std::integral_constant<int, 0>{}); step(std::integral_constant<int, 1>{}); step(std::integral_constant<int, 2>{});
        step(std::integral_constant<int, 3>{}); step(std::integral_constant<int, 4>{}); step(std::integral_constant<int, 5>{});
    }
}

__device__ __forceinline__ void gnorm_phase(bf16_t* rp, const float* gn, int gw, int ngw, int lane, bool dry) {
    f32x4 w0[4], w1[4];
#pragma unroll
    for (int hh = 0; hh < 4; ++hh) { w0[hh] = *(const f32x4*)(gn + hh * 512 + 8 * lane); w1[hh] = *(const f32x4*)(gn + hh * 512 + 8 * lane + 4); }
    for (int row = gw; row < T; row += ngw) {
        bf16_t* orow = rp + (size_t)row * 6144 + 2048; const bf16_t* grow = rp + (size_t)row * 6144 + 4096;
        u32x4 ov[4], gv[4];
#pragma unroll
        for (int hh = 0; hh < 4; ++hh) { ov[hh] = *(const u32x4*)(orow + hh * 512 + 8 * lane); gv[hh] = *(const u32x4*)(grow + hh * 512 + 8 * lane); }
#pragma unroll
        for (int hh = 0; hh < 4; ++hh) {
            float of[8] = {bf_lo(ov[hh].x), bf_hi(ov[hh].x), bf_lo(ov[hh].y), bf_hi(ov[hh].y), bf_lo(ov[hh].z), bf_hi(ov[hh].z), bf_lo(ov[hh].w), bf_hi(ov[hh].w)};
            float gf[8] = {bf_lo(gv[hh].x), bf_hi(gv[hh].x), bf_lo(gv[hh].y), bf_hi(gv[hh].y), bf_lo(gv[hh].z), bf_hi(gv[hh].z), bf_lo(gv[hh].w), bf_hi(gv[hh].w)};
            float ss = 0.f;
#pragma unroll
            for (int e = 0; e < 8; ++e) ss += of[e] * of[e];
            const float rstd = rsqrtf(wave_sum(ss) * (1.f / 512.f) + 1e-6f);
            float y[8];
#pragma unroll
            for (int e = 0; e < 8; ++e) y[e] = silu_f(gf[e]) * of[e] * rstd * (e < 4 ? w0[hh][e] : w1[hh][e - 4]);
            u32x4 w; w.x = pk2(y[0], y[1]); w.y = pk2(y[2], y[3]); w.z = pk2(y[4], y[5]); w.w = pk2(y[6], y[7]);
            if (!dry) *(u32x4*)(orow + hh * 512 + 8 * lane) = w; else asm volatile("" :: "v"(w));
        }
    }
}

__device__ __forceinline__ void router_phase(ldsp lds, const bf16_t* XRBp, const float* mod_sh, const float* mod_G, const bf16_t* rwt  , const float* rbias,
                                             bf16_t* H, int* sel_e, float* sel_w, int* sel_p, int* tokl, unsigned* cnt, int tile0, int tile_end, int tstep, int wave, int lane, bool dry) {
    LAS float* lg = (LAS float*)(lds + wave * 8192);
    LAS int* st2 = (LAS int*)(lds + wave * 8192 + 4096);
    LAS float* Gl = (LAS float*)(lds + 131072); LAS float* SHl = Gl + 1024;
    const float rb = rbias[lane];
    const int fr = lane & 15, fq = lane >> 4;
    for (int tile = tile0; tile < tile_end; tile += tstep) {
        const int row = tile * 16 + fr, b = row >> 11;
        const bf16_t* xr = XRBp + (size_t)row * XRB_LD + XRB_OFF + 8 * fq;
        bf16_t* hrow = H + (size_t)row * D + 8 * fq;
        { const int t4 = (wave * 64 + lane) * 4; const float* src = (t4 < 1024 ? mod_G : mod_sh - 1024) + (size_t)b * 6144 + t4; *(LAS f32x4*)(Gl + t4) = *(const f32x4*)src; }
        auto issue_chunk = [&](int ch) {
            ldsp buf = lds + (ch & 1) * 65536;
#pragma unroll
            for (int j = 0; j < 8; ++j) { const int i = wave + 8 * j, r2 = 2 * i + (lane >> 5), lc = (lane & 31) ^ (r2 & 15);
                glds16((const char*)rwt + (size_t)r2 * 2048 + (size_t)ch * 512 + lc * 16, buf + i * 1024); }
        };
        issue_chunk(0);
        float ss = 0.f;
#pragma unroll 8
        for (int s = 0; s < 32; ++s) { const u32x4 xb = *(const u32x4*)(xr + 32 * s);
            const float e0 = bf_lo(xb.x), e1 = bf_hi(xb.x), e2 = bf_lo(xb.y), e3 = bf_hi(xb.y), e4 = bf_lo(xb.z), e5 = bf_hi(xb.z), e6 = bf_lo(xb.w), e7 = bf_hi(xb.w);
            ss += e0 * e0 + e1 * e1 + e2 * e2 + e3 * e3 + e4 * e4 + e5 * e5 + e6 * e6 + e7 * e7; }
        ss += lane_xor<16>(ss);
        { auto rr = __builtin_amdgcn_permlane32_swap(__float_as_uint(ss), __float_as_uint(ss), false, false); ss = __uint_as_float(rr[0]) + __uint_as_float(rr[1]); }
        const float rstd = rsqrtf(ss * (1.f / D) + 1e-6f);
        f32x4 acc[4];
#pragma unroll
        for (int et = 0; et < 4; ++et) acc[et] = (f32x4){0.f, 0.f, 0.f, 0.f};
        u32x4 xc[8], xn[8];
#pragma unroll
        for (int i = 0; i < 8; ++i) xc[i] = *(const u32x4*)(xr + 32 * i);
        for (int ch = 0; ch < 4; ++ch) {
            if (ch == 0) wait_vm<0>(); else wait_vm<8>();
            LDS_WAIT();
            BAR();
            if (ch + 1 < 4) issue_chunk(ch + 1);
#pragma unroll
            for (int i = 0; i < 8; ++i) xn[i] = *(const u32x4*)(xr + 256 * ((ch + 1) & 3) + 32 * i);
            ldsp buf = lds + (ch & 1) * 65536;
#pragma unroll
            for (int sl = 0; sl < 8; ++sl) {
                const int s = 8 * ch + sl;
                const u32x4 xb = xc[sl];
                const f32x4 x0 = {bf_lo(xb.x), bf_hi(xb.x), bf_lo(xb.y), bf_hi(xb.y)}, x1 = {bf_lo(xb.z), bf_hi(xb.z), bf_lo(xb.w), bf_hi(xb.w)};
                const f32x4 g0 = *(LAS f32x4*)(Gl + 32 * s + 8 * fq), g1 = *(LAS f32x4*)(Gl + 32 * s + 8 * fq + 4), s0 = *(LAS f32x4*)(SHl + 32 * s + 8 * fq), s1 = *(LAS f32x4*)(SHl + 32 * s + 8 * fq + 4);
                const f32x4 h0 = x0 * rstd * g0 + s0, h1 = x1 * rstd * g1 + s1;
                u32x4 hi; hi.x = pk2(h0[0], h0[1]); hi.y = pk2(h0[2], h0[3]); hi.z = pk2(h1[0], h1[1]); hi.w = pk2(h1[2], h1[3]);
                *(u32x4*)(hrow + 32 * s) = hi;
                u32x4 lo; lo.x = pk2(h0[0] - bf_lo(hi.x), h0[1] - bf_hi(hi.x)); lo.y = pk2(h0[2] - bf_lo(hi.y), h0[3] - bf_hi(hi.y));
                lo.z = pk2(h1[0] - bf_lo(hi.z), h1[1] - bf_hi(hi.z)); lo.w = pk2(h1[2] - bf_lo(hi.w), h1[3] - bf_hi(hi.w));
                const bf16x8 ahi = __builtin_bit_cast(bf16x8, hi), alo = __builtin_bit_cast(bf16x8, lo);
                const int pc = (((4 * sl + fq) ^ fr) & 31) << 4;
#pragma unroll
                for (int et = 0; et < 4; ++et) {
                    const bf16x8 bh = *(LAS bf16x8*)(buf + (16 * et + fr) * 512 + pc), bl = *(LAS bf16x8*)(buf + (64 + 16 * et + fr) * 512 + pc);
                    acc[et] = __builtin_amdgcn_mfma_f32_16x16x32_bf16(ahi, bh, acc[et], 0, 0, 0);
                    acc[et] = __builtin_amdgcn_mfma_f32_16x16x32_bf16(ahi, bl, acc[et], 0, 0, 0);
                    acc[et] = __builtin_amdgcn_mfma_f32_16x16x32_bf16(alo, bh, acc[et], 0, 0, 0); }
            }
#pragma unroll
            for (int i = 0; i < 8; ++i) xc[i] = xn[i];
        }
        LDS_WAIT(); BAR();
#pragma unroll
        for (int et = 0; et < 4; ++et)
#pragma unroll
            for (int r = 0; r < 4; ++r) lg[(4 * fq + r) * 64 + 16 * et + fr] = acc[et][r];
        LDS_WAIT();
        int myc = 0;
        for (int tt = 0; tt < 16; ++tt) {
            const float logit = lg[tt * 64 + lane];
            const float score = 1.f / (1.f + __expf(-logit)), choice = score + rb;
            int rk = 0;
#pragma unroll
            for (int d = 1; d < 8; ++d) { const int oi = (lane + d) & 7; const float other = __int_as_float(__builtin_amdgcn_ds_bpermute(((lane & ~7) | oi) << 2, __float_as_int(choice))); rk += (other > choice || (other == choice && oi < (lane & 7))) ? 1 : 0; }
            float gs = rk < 2 ? choice : 0.f;
            gs += lane_xor<1>(gs); gs += lane_xor<2>(gs); gs += lane_xor<4>(gs);
            int rg = 0;
#pragma unroll
            for (int j = 0; j < 8; ++j) { const float gj = __int_as_float(__builtin_amdgcn_readlane(__float_as_int(gs), 8 * j)); rg += (gj > gs || (gj == gs && j < (lane >> 3))) ? 1 : 0; }
            const float c2 = rg < 4 ? choice : -__builtin_inff();
            const unsigned ub = __float_as_uint(c2); unsigned key = (ub & 0x80000000u) ? ~ub : (ub | 0x80000000u); key = (key & ~63u) | (unsigned)(63 - lane);
            unsigned thr = 0u;
#pragma unroll
            for (int bit = 31; bit >= 0; --bit) { const unsigned cand = thr | (1u << bit); if (__popcll(__ballot(key >= cand)) >= 8) thr = cand; }
            const bool chosen = key >= thr;
            const unsigned long long cm = __ballot(chosen);
            const int r8 = __popcll(cm & ((1ull << lane) - 1ull));
            const float wsum = wave_sum(chosen ? score : 0.f);
            lg[tt * 64 + lane] = score / wsum * 2.5f;
            st2[tt * 64 + lane] = chosen ? ((myc << 8) | r8) : -1;
            myc += chosen ? 1 : 0;
        }
        const int chunk = (tile * 16) / CH_TOK;
        unsigned base = 0;
        if (!dry && myc > 0) base = atomicAdd(&cnt[chunk * 64 + lane], (unsigned)myc);
        if (dry) asm volatile("" :: "v"(myc));
        LDS_WAIT();
        for (int tt = 0; tt < 16; ++tt) {
            const int code = st2[tt * 64 + lane];
            if (!dry && code >= 0) { const int tok = tile * 16 + tt, r8 = code & 255; const unsigned pos = base + (unsigned)(code >> 8);
                sel_e[tok * 8 + r8] = lane; sel_w[tok * 8 + r8] = lg[tt * 64 + lane]; sel_p[tok * 8 + r8] = (int)pos;
                tokl[(size_t)(chunk * 64 + lane) * CH_TOK + pos] = tok; }
        }
        LDS_WAIT();
    }
}

__device__ __forceinline__ void build_tstart(const unsigned* cnt, int c, LAS int* ts) {
    const int l = fresh_tid();
    if (l < 64) {
        const int n = ((int)cnt[c * 64 + l] + MTILE - 1) / MTILE; int incl = n;
#pragma unroll
        for (int o = 1; o < 64; o <<= 1) { const int v = __builtin_amdgcn_ds_bpermute((l >= o ? l - o : l) << 2, incl); if (l >= o) incl += v; }
        ts[l] = incl - n; if (l == 63) { ts[64] = incl; ts[65] = incl + CH_TOK / MTILE; }
    }
}
struct MoeUpSrc {
    using Epi = EpiSwiGLU;
    const unsigned char* ws; const unsigned* cnt; int c; const LAS int* ts; int total, vcu;
    template <int LA> __device__ __forceinline__ bool setup(int i, const char*& bA, unsigned (&oA)[LA], const char*& bB, Epi& e, int& n0, int wid, int lane) const {
        const int Lt = vcu + GRID * i; if (Lt >= total) return false;
        const int mt = Lt >> 1, nt = Lt & 1;
        int ex = 0;
#pragma unroll
        for (int stp = 64; stp >= 1; stp >>= 1) if (ex + stp <= 64 && ts[ex + stp] <= mt) ex += stp;
        const int ml = mt - ts[ex];
        const bf16_t* Bt = ex < 64 ? (const bf16_t*)(ws + WS_W13) + (size_t)ex * 512 * D : (const bf16_t*)(ws + WS_WS13);
        const int* list = (const int*)(ws + WS_TOKL) + (size_t)(c * 64 + (ex & 63)) * CH_TOK; const int n = ex < 64 ? (int)cnt[c * 64 + ex] : 0;
#pragma unroll
        for (int j = 0; j < LA; ++j) { const int row = stage_row(wid, j, lane), g = ml * MTILE + row;
            const int tok = ex < 64 ? (g < n ? list[g] : c * CH_TOK) : c * CH_TOK + g;
            oA[j] = (unsigned)tok * (unsigned)(D * 2) + (unsigned)stage_chunk(row, lane); }
        bA = (const char*)(ws + WS_H); bB = (const char*)(Bt + (size_t)(nt * 256) * D);
        e = EpiSwiGLU{(bf16_t*)(ws + WS_ACT), mt * MTILE}; n0 = nt * 256; return true;
    }
    static constexpr size_t ldb = D;
};
struct MoeUpX {
    static constexpr int K = D, LDA = D; static constexpr bool GATHER = true;
    const unsigned char* ws; const unsigned* cnt; int c; const LAS int* ts; int total, vcu;
    __device__ __forceinline__ bool next(int i, pg8::UnitX& u) const {
        const int Lt = vcu + GRID * i; if (Lt >= total) return false;
        const int mt = Lt >> 1, nt = Lt & 1;
        int ex = 0;
#pragma unroll
        for (int stp = 64; stp >= 1; stp >>= 1) if (ex + stp <= 64 && ts[ex + stp] <= mt) ex += stp;
        const bf16_t* Bt = ex < 64 ? (const bf16_t*)(ws + WS_W13) + (size_t)ex * 512 * D : (const bf16_t*)(ws + WS_WS13);
        u.pm = mt; u.pn = nt; u.aBase = (const char*)(ws + WS_H); u.bBase = (const char*)(Bt + (size_t)(nt * 256) * D);
        u.list = ex < 64 ? (const int*)(ws + WS_TOKL) + (size_t)(c * 64 + ex) * CH_TOK : nullptr; u.cnt = ex < 64 ? (int)cnt[c * 64 + ex] : 0;
        u.r0 = (mt - ts[ex]) * MTILE; u.dummy = c * CH_TOK; return true;
    }
};
__device__ __forceinline__ void moe_up_phase(ldsp lds, const unsigned char* ws, const unsigned* cnt, int c, const LAS int* ts) {
    MoeUpX src{ws, cnt, c, ts, ts[65] * 2, vcu_of_block()};
    pg8::gemm_phase_x(lds, src, pg8::EpiSwiGLUx{(bf16_t*)(ws + WS_ACT)});
}
struct MoeDownSrc {
    using Epi = EpiStoreBf16;
    const unsigned char* ws; const LAS int* ts; int total, vcu;
    template <int LA> __device__ __forceinline__ bool setup(int i, const char*& bA, unsigned (&oA)[LA], const char*& bB, Epi& e, int& n0, int wid, int lane) const {
        const int Lt = vcu + GRID * i; if (Lt >= total) return false;
        const int mt = Lt >> 2, nt = Lt & 3;
        int ex = 0;
#pragma unroll
        for (int stp = 64; stp >= 1; stp >>= 1) if (ex + stp <= 64 && ts[ex + stp] <= mt) ex += stp;
        const bf16_t* act = (const bf16_t*)(ws + WS_ACT);
        const bf16_t* w2 = ex < 64 ? (const bf16_t*)(ws + WS_W2) + (size_t)ex * D * 256 : (const bf16_t*)(ws + WS_WS2);
#pragma unroll
        for (int j = 0; j < LA; ++j) { const int row = stage_row(wid, j, lane); oA[j] = (unsigned)(row * 512 + stage_chunk(row, lane)); }
        bA = (const char*)(act + (size_t)(mt * MTILE) * 256); bB = (const char*)(w2 + (size_t)(nt * 256) * 256);
        e = EpiStoreBf16{(bf16_t*)(ws + WS_YS), (size_t)D, mt * MTILE}; n0 = nt * 256; return true;
    }
    static constexpr size_t ldb = 256;
};
struct MoeDownX {
    static constexpr int K = 256, LDA = 256; static constexpr bool GATHER = false;
    const unsigned char* ws; const LAS int* ts; int total, vcu;
    __device__ __forceinline__ bool next(int i, pg8::UnitX& u) const {
        const int Lt = vcu + GRID * i; if (Lt >= total) return false;
        const int mt = Lt >> 2, nt = Lt & 3;
        int ex = 0;
#pragma unroll
        for (int stp = 64; stp >= 1; stp >>= 1) if (ex + stp <= 64 && ts[ex + stp] <= mt) ex += stp;
        const bf16_t* w2 = ex < 64 ? (const bf16_t*)(ws + WS_W2) + (size_t)ex * D * 256 : (const bf16_t*)(ws + WS_WS2);
        u.pm = mt; u.pn = nt; u.aBase = (const char*)((const bf16_t*)(ws + WS_ACT) + (size_t)(mt * MTILE) * 256); u.bBase = (const char*)(w2 + (size_t)(nt * 256) * 256);
        u.list = nullptr; u.cnt = 0; u.r0 = 0; u.dummy = 0; return true;
    }
};
__device__ __forceinline__ void moe_down_phase(ldsp lds, const unsigned char* ws, const LAS int* ts) {
    MoeDownX src{ws, ts, ts[65] * 4, vcu_of_block()};
    pg8::gemm_phase_x(lds, src, pg8::EpiYx{(unsigned char*)(ws + WS_YS)});
}
__device__ __forceinline__ void moe_combine_phase(const unsigned char* ws, float* OUT, bf16_t* XRBp, int c, const LAS int* ts, const float* gate_f  , bool last_layer,
                                                  const float* mod_sh_next, const float* mod_G_next, bf16_t* H, const float* fnorm, int gw, int ngw, int lane, bool dry) {
    const unsigned char* ys = ws + WS_YS; const int* sel_e = (const int*)(ws + WS_SELE); const float* sel_w = (const float*)(ws + WS_SELW); const int* sel_p = (const int*)(ws + WS_SELP);
    int slot[9]; float wk[9];
    auto selload = [&](int tl, int (&sl)[9], float (&ww)[9]) { const int tok = c * CH_TOK + tl;
#pragma unroll
        for (int k = 0; k < 8; ++k) { const int e = sel_e[tok * 8 + k]; sl[k] = ts[e] * MTILE + sel_p[tok * 8 + k]; ww[k] = sel_w[tok * 8 + k]; }
        sl[8] = ts[64] * MTILE + tl; ww[8] = 1.f; };
    if (gw < CH_TOK) selload(gw, slot, wk);
    for (int tl = gw; tl < CH_TOK; tl += ngw) {
        const int tok = c * CH_TOK + tl; const int b = tok >> 11;
        u32x2 yv[9][2];
#pragma unroll
        for (int k = 0; k < 9; ++k) { const unsigned char* yr = ys + (size_t)slot[k] * D; yv[k][0] = *(const u32x2*)(yr + 8 * lane); yv[k][1] = *(const u32x2*)(yr + 8 * lane + 512); }
        int nslot[9]; float nwk[9];
        if (tl + ngw < CH_TOK) selload(tl + ngw, nslot, nwk);
        else {
#pragma unroll
            for (int k = 0; k < 9; ++k) { nslot[k] = 0; nwk[k] = 0.f; } }
        float acc[16];
#pragma unroll
        for (int i = 0; i < 16; ++i) acc[i] = 0.f;
#pragma unroll
        for (int k = 0; k < 9; ++k) { const float w = wk[k];
#pragma unroll
            for (int j = 0; j < 2; ++j) { const u32x2 v = yv[k][j];
                const f32x2 p0 = __builtin_amdgcn_cvt_pk_f32_fp8((int)v.x, false), p1 = __builtin_amdgcn_cvt_pk_f32_fp8((int)v.x, true);
                const f32x2 p2 = __builtin_amdgcn_cvt_pk_f32_fp8((int)v.y, false), p3 = __builtin_amdgcn_cvt_pk_f32_fp8((int)v.y, true);
                acc[8 * j + 0] += w * p0[0]; acc[8 * j + 1] += w * p0[1]; acc[8 * j + 2] += w * p1[0]; acc[8 * j + 3] += w * p1[1];
                acc[8 * j + 4] += w * p2[0]; acc[8 * j + 5] += w * p2[1]; acc[8 * j + 6] += w * p3[0]; acc[8 * j + 7] += w * p3[1]; } }
#pragma unroll
        for (int k = 0; k < 9; ++k) { slot[k] = nslot[k]; wk[k] = nwk[k]; }
        float* xr = OUT + (size_t)tok * D; bf16_t* xb = XRBp + (size_t)tok * XRB_LD + XRB_OFF; const float* gf = gate_f + (size_t)b * 6144; float ss = 0.f; float xn[16];
#pragma unroll
        for (int j = 0; j < 2; ++j) { const u32x4 xw = *(const u32x4*)(xb + 8 * lane + 512 * j);
            const float xf[8] = {bf_lo(xw.x), bf_hi(xw.x), bf_lo(xw.y), bf_hi(xw.y), bf_lo(xw.z), bf_hi(xw.z), bf_lo(xw.w), bf_hi(xw.w)};
#pragma unroll
            for (int q = 0; q < 2; ++q) { const int col = 8 * lane + 512 * j + 4 * q; const f32x4 gv = *(const f32x4*)(gf + col);
#pragma unroll
                for (int e = 0; e < 4; ++e) { const float v = xf[4 * q + e] + gv[e] * acc[8 * j + 4 * q + e]; xn[8 * j + 4 * q + e] = v; ss += v * v; } } }
        const float rstd = rsqrtf(wave_sum(ss) * (1.f / D) + 1e-6f);
        if (last_layer) {
#pragma unroll
            for (int j = 0; j < 2; ++j)
#pragma unroll
                for (int q = 0; q < 2; ++q) { const int col = 8 * lane + 512 * j + 4 * q; const f32x4 g = *(const f32x4*)(fnorm + col); f32x4 ov;
#pragma unroll
                    for (int e = 0; e < 4; ++e) ov[e] = xn[8 * j + 4 * q + e] * rstd * g[e];
                    if (!dry) *(f32x4*)(xr + col) = ov; else asm volatile("" :: "v"(ov)); }
        } else {
            const float* sh = mod_sh_next + (size_t)b * 6144; const float* Gn = mod_G_next + (size_t)b * 6144; bf16_t* hrow = H + (size_t)tok * D;
#pragma unroll
            for (int j = 0; j < 2; ++j) { u32x4 hw, xw2;
#pragma unroll
                for (int q = 0; q < 2; ++q) { const int col = 8 * lane + 512 * j + 4 * q; const f32x4 g = *(const f32x4*)(Gn + col), s0 = *(const f32x4*)(sh + col); f32x4 xv, hv;
#pragma unroll
                    for (int e = 0; e < 4; ++e) { xv[e] = xn[8 * j + 4 * q + e]; hv[e] = xv[e] * rstd * g[e] + s0[e]; }
                    if (q == 0) { hw.x = pk2(hv[0], hv[1]); hw.y = pk2(hv[2], hv[3]); xw2.x = pk2(xv[0], xv[1]); xw2.y = pk2(xv[2], xv[3]); }
                    else { hw.z = pk2(hv[0], hv[1]); hw.w = pk2(hv[2], hv[3]); xw2.z = pk2(xv[0], xv[1]); xw2.w = pk2(xv[2], xv[3]); } }
                if (!dry) { *(u32x4*)(hrow + 8 * lane + 512 * j) = hw; *(u32x4*)(xb + 8 * lane + 512 * j) = xw2; } else asm volatile("" :: "v"(hw), "v"(xw2)); }
        }
    }
}

struct PSrc {
    using Epi = EpiCausalP;
    const bf16_t* rp; bf16_t* P;
    template <int LA> __device__ __forceinline__ bool setup(int i, const char*& bA, unsigned (&oA)[LA], const char*& bB, Epi& e, int& n0, int wid, int lane) const {
        const int u = blockIdx.x + GRID * i; if (u >= 1024) return false;
        const int bh = u >> 4, c = u & 15, b = bh >> 2, h = bh & 3;
        const bf16_t* qa = rp + ((size_t)b * SEQ + c * 128) * 6144 + h * 256;
#pragma unroll
        for (int j = 0; j < LA; ++j) { const int row = stage_row(wid, j, lane); oA[j] = (unsigned)(row * 6144 * 2 + stage_chunk(row, lane)); }
        bA = (const char*)qa; bB = (const char*)(qa + 1024);
        e = EpiCausalP{P + (size_t)u * 16384}; n0 = 0; return true;
    }
    static constexpr size_t ldb = 6144;
};
#define TIC(cat) do { if (TIME_SEL >= 0 && blockIdx.x == 0 && threadIdx.x == 0) { const unsigned long long now_ = __builtin_amdgcn_s_memrealtime(); LAS unsigned long long* tb_ = (LAS unsigned long long*)(lds + LDS_MISC + 1024); if ((cat) == TIME_SEL) tb_[1] += now_ - tb_[0]; tb_[0] = now_; } } while (0)
#define FRESH_IDS() const int t_ = fresh_tid(); const int lane = t_ & 63, wave = __builtin_amdgcn_readfirstlane(t_ >> 6); const int gw = blockIdx.x * NWAVE + wave, ngw = GRID * NWAVE; (void)lane; (void)gw; (void)ngw
#define SEAM(cat) do { xcd_barrier(bar); TIC(cat); } while (0)
#define OUTPROJ_ROUTER(layer_, A_, lda_, Bt_, ldb_, K_, mk_, cat_) do { \
    pg8::dense(lds, A_, (int)(lda_), Bt_, T, D, K_, mk_); \
    SEAM(cat_); \
    { const float* modl_ = (const float*)(ws + WS_MOD) + (size_t)(layer_) * 16 * 6144; const int m0_ = vcu_of_block() * 128; FRESH_IDS(); \
      router_phase(lds, XRB, modl_ + 3072, modl_ + 4096, (const bf16_t*)(ws + WS_RWT) + (size_t)(layer_) * 2 * 64 * 1024, a.in[I_ROUTB] + (layer_) * 64, \
                   (bf16_t*)(ws + WS_H), (int*)(ws + WS_SELE), (float*)(ws + WS_SELW), (int*)(ws + WS_SELP), (int*)(ws + WS_TOKL), (unsigned*)(ws + WS_CNT) + (layer_) * 256, \
                   m0_ / 16 + wave, m0_ / 16 + wave + 1, 1, wave, lane, false); } \
  } while (0)
__device__ __forceinline__ void moe_layer(const Args& a, ldsp lds, const XcdBarrier& bar, int layer) {
    unsigned char* ws = a.ws;
    float* mod = (float*)(ws + WS_MOD); float* XR = a.out; bf16_t* XRB = (bf16_t*)a.out; bf16_t* H = (bf16_t*)(ws + WS_H);
    const float* modl = mod + (size_t)layer * 16 * 6144;
    const float* modn = mod + (size_t)16 * 6144;
    unsigned* cl = (unsigned*)(ws + WS_CNT) + layer * 256;
    LAS int* ts0 = (LAS int*)(lds + LDS_MISC); LAS int* ts1 = ts0 + 80;
    for (int c = 0; c <= NCHUNK; ++c) {
        __syncthreads();
        if (c < NCHUNK) build_tstart(cl, c, ts0);
        if (c > 0) build_tstart(cl, c - 1, ts1);
        __syncthreads();
        const bool comb_first = (blockIdx.x & 8) != 0;
        if (c > 0 && comb_first) { FRESH_IDS(); moe_combine_phase(ws, XR, XRB, c - 1, ts1, modl + 5120, layer == 1, modn, modn + 1024, H, a.in[I_FNORM], gw, ngw, lane, false); }
        if (c < NCHUNK) moe_up_phase(lds, ws, cl, c, ts0);
        if (c > 0 && !comb_first) { FRESH_IDS(); moe_combine_phase(ws, XR, XRB, c - 1, ts1, modl + 5120, layer == 1, modn, modn + 1024, H, a.in[I_FNORM], gw, ngw, lane, false); }
        if (c == NCHUNK) break;
        SEAM(6);
        moe_down_phase(lds, ws, ts0);
        SEAM(7);
    }
}
__global__ void __launch_bounds__(NTHR, 2) fwd_kernel(Args a) {
    extern __shared__ __attribute__((aligned(16))) unsigned char lds_raw[];
    ldsp lds = (ldsp)lds_raw;
    unsigned char* ws = a.ws;
    volatile LAS unsigned* st = (volatile LAS unsigned*)(lds + LDS_BYTES - 16);
    if (threadIdx.x < 4) st[threadIdx.x] = 0u;
    if (TIME_SEL >= 0 && threadIdx.x == 0) { LAS unsigned long long* tb_ = (LAS unsigned long long*)(lds + LDS_MISC + 1024); tb_[0] = __builtin_amdgcn_s_memrealtime(); tb_[1] = 0ull; }
    __syncthreads();
    XcdBarrier bar = xcd_barrier_post((unsigned*)(ws + WS_BAR), st);
    float* mod = (float*)(ws + WS_MOD);
    float* XR = a.out; bf16_t* XRB = (bf16_t*)a.out;
    bf16_t* H = (bf16_t*)(ws + WS_H);

    mod_items(a, lds);
    __syncthreads();
    { FRESH_IDS(); convert_dense_weights(a, lds, gw, ngw, wave, lane); }
    SEAM(0);
    { FRESH_IDS(); adaln_phase(a.in[I_X], mod, mod + 1024, H, gw, ngw, lane); }
    { FRESH_IDS();
      bf16_t* rwt = (bf16_t*)(ws + WS_RWT);
      for (int idx = blockIdx.x * NTHR + t_; idx < 2 * D * 64; idx += GRID * NTHR) { const int l2 = idx >> 16, k = (idx >> 6) & 1023, e = idx & 63;
          const float w = a.in[I_ROUTW][idx]; const unsigned hi = pk2(w, 0.f) & 0xffffu; const unsigned lo = pk2(w - bf_lo(hi), 0.f) & 0xffffu;
          rwt[((size_t)(l2 * 2 + 0) * 64 + e) * 1024 + k] = (bf16_t)hi; rwt[((size_t)(l2 * 2 + 1) * 64 + e) * 1024 + k] = (bf16_t)lo; } }
    SEAM(1);

    { const bool conv_first = (blockIdx.x & 8) != 0;
      if (conv_first) { FRESH_IDS(); convert_expert_weights(a, 0, lds, gw, ngw, wave, lane); __syncthreads(); }
      pg8::dense(lds, H, D, (const bf16_t*)(ws + WS_WQKV), T, 3072, D, pg8::EpiQKV{(bf16_t*)(ws + WS_QKV), (size_t)3072});
      if (!conv_first) { __syncthreads(); FRESH_IDS(); convert_expert_weights(a, 0, lds, gw, ngw, wave, lane); } }
    SEAM(2);
    { float d1 = 0.f, d2 = 0.f;
      for (int i = 0; i < 64; ++i) { d1 += a.in[I_LQ1][i] * a.in[I_LK1][i]; d2 += a.in[I_LQ2][i] * a.in[I_LK2][i]; }
      const float lam = __expf(d1) - __expf(d2) + 0.2f;
      attn_phase(lds, (const bf16_t*)(ws + WS_QKV), (bf16_t*)(ws + WS_AO), lam, a.in[I_SUBLN]); }
    SEAM(3);
    { const pg8::EpiRes<true> mk{a.in[I_X], XRB, mod + 2048};
      OUTPROJ_ROUTER(0, (const bf16_t*)(ws + WS_AO), D, (const bf16_t*)(ws + WS_WO), D, D, mk, 4); }
    SEAM(5);
    moe_layer(a, lds, bar, 0);
    SEAM(6);

    const float* mod1 = mod + (size_t)16 * 6144;
    { const bool conv_first = (blockIdx.x & 8) != 0;
      if (conv_first) { FRESH_IDS(); convert_expert_weights(a, 1, lds, gw, ngw, wave, lane); __syncthreads(); }
      pg8::dense(lds, H, D, (const bf16_t*)(ws + WS_WRI), T, 6144, D, pg8::EpiRet{(bf16_t*)(ws + WS_RP)});
      if (!conv_first) { __syncthreads(); FRESH_IDS(); convert_expert_weights(a, 1, lds, gw, ngw, wave, lane); } }
    SEAM(8);
    { PSrc src{(const bf16_t*)(ws + WS_RP), (bf16_t*)(ws + WS_P)};
      gemm_stream<2, 4, 4, 2, 3>(lds, 256, src); }
    SEAM(9);
    chain_phase(lds, (bf16_t*)(ws + WS_RP), (const bf16_t*)(ws + WS_P), false);
    SEAM(10);
    { FRESH_IDS(); gnorm_phase((bf16_t*)(ws + WS_RP), a.in[I_RGN], gw, ngw, lane, false); }
    SEAM(11);
    { const pg8::EpiRes<false> mk{XRB, XRB, mod1 + 2048};
      OUTPROJ_ROUTER(1, (const bf16_t*)(ws + WS_RP) + 2048, 6144, (const bf16_t*)(ws + WS_WRO), 2048, 2048, mk, 12); }
    SEAM(5);
    moe_layer(a, lds, bar, 1);
    if (TIME_SEL >= 0) {
        __syncthreads(); TIC(6);
        if (blockIdx.x == 0 && threadIdx.x == 0) { LAS unsigned long long* tb_ = (LAS unsigned long long*)(lds + LDS_MISC + 1024); const unsigned long long t0 = __builtin_amdgcn_s_memrealtime();
            while (__builtin_amdgcn_s_memrealtime() - t0 < tb_[1]) __builtin_amdgcn_s_sleep(8); }
    }
}

extern "C" void kernel_launch(void* const* d_in, const int* in_sizes, int n_in, void* d_out, int out_size, void* d_ws, size_t ws_size, hipStream_t stream) {
    static int ready = 0;
    if (ready == 0) {
        if (n_in != 25 || out_size != T * D || ws_size < WS_END) { fprintf(stderr, "kernel_launch: unexpected shapes (n_in %d out %d ws %zu need %zu)\n", n_in, out_size, ws_size, (size_t)WS_END); ready = -1; return; }
        (void)hipFuncSetAttribute((const void*)fwd_kernel, hipFuncAttributeMaxDynamicSharedMemorySize, LDS_BYTES);
        ready = 1;
    }
    if (ready < 0) return;
    (void)hipMemsetAsync(d_ws, 0, 65536, stream);
    Args a{};
    for (int i = 0; i < 25; ++i) a.in[i] = (const float*)d_in[i];
    a.out = (float*)d_out; a.ws = (unsigned char*)d_ws;
    hipLaunchKernelGGL(fwd_kernel, dim3(GRID), dim3(NTHR), LDS_BYTES, stream, a);
}
```

```cpp
#include <hip/hip_runtime.h>
#include <cstdio>
#include <cstdint>
#include <type_traits>

typedef unsigned short bf16_t;
typedef short bf16x8 __attribute__((ext_vector_type(8)));
typedef short bf16x4 __attribute__((ext_vector_type(4)));
typedef float f32x4 __attribute__((ext_vector_type(4)));
typedef float f32x2 __attribute__((ext_vector_type(2)));
typedef unsigned u32x4 __attribute__((ext_vector_type(4)));
typedef unsigned u32x2 __attribute__((ext_vector_type(2)));
#define LAS __attribute__((address_space(3)))
typedef LAS unsigned char* ldsp;

constexpr int T = 32768, D = 1024, NB = 16, SEQ = 2048;
constexpr int NTHR = 512, NWAVE = 8, GRID = 256;
constexpr int CH_TOK = 16384, NCHUNK = 2, MTILE = 256;
constexpr int SLOT_CAP = 163840;
constexpr float LOG2E = 1.4426950408889634f;
constexpr int XRB_LD = 2048, XRB_OFF = 1024;
#define TIME_SEL -1


constexpr size_t MiB = 1u << 20;
constexpr size_t WS_BAR = 0, WS_CNT = 16384, WS_RWT = 256 * 1024  , WS_MOD = 1 * MiB;
constexpr size_t WS_WQKV = 2 * MiB, WS_WO = 8 * MiB, WS_WRI = 10 * MiB, WS_WRO = 22 * MiB;
constexpr size_t WS_W13 = 26 * MiB, WS_W2 = 90 * MiB, WS_WS13 = 122 * MiB, WS_WS2 = 123 * MiB;
constexpr size_t WS_H = 124 * MiB, WS_P = WS_H;
constexpr size_t WS_BIG = 188 * MiB;
constexpr size_t WS_QKV = WS_BIG, WS_AO = WS_BIG + 192 * MiB;
constexpr size_t WS_RP = WS_BIG;
constexpr size_t WS_SELE = WS_BIG, WS_SELW = WS_BIG + 1 * MiB, WS_SELP = WS_BIG + 2 * MiB, WS_TOKL = WS_BIG + 4 * MiB;
constexpr size_t WS_ACT = WS_BIG + 12 * MiB  , WS_YS = WS_BIG + 92 * MiB  ;
constexpr size_t WS_END = WS_BIG + 412 * MiB;
constexpr int LDS_BYTES = 152 * 1024, LDS_MISC = 144 * 1024;

#define XB_TMO      128
#define XB_XCNT(j)  (256  + 64 * (j))
#define XB_XSUB(j)  (1280 + 64 * (j))
#define XB_XGEN(j)  (2304 + 64 * (j))
#define XB_TOP      3328
#define XB_TOPGEN   3392
#define XCD_BAR_WORDS 3456
#define XB_SPIN_CAP (1u << 20)
__device__ __forceinline__ unsigned xb_ld(unsigned* p)              { return __hip_atomic_load(p, __ATOMIC_RELAXED, __HIP_MEMORY_SCOPE_AGENT); }
__device__ __forceinline__ unsigned xb_add(unsigned* p, unsigned v) { return __hip_atomic_fetch_add(p, v, __ATOMIC_RELAXED, __HIP_MEMORY_SCOPE_AGENT); }
__device__ __forceinline__ unsigned xb_xcc_id() { return (unsigned)__builtin_amdgcn_s_getreg((3 << 11) | 20) & 0xFu; }
#define XB_SPIN(cond, bar) do { unsigned _sp = 0; while (cond) { __builtin_amdgcn_s_sleep(1); \
    if ((++_sp & 255u) == 0u) { if (xb_ld(&(bar)[XB_TMO])) break; if (_sp > XB_SPIN_CAP) { atomicAdd(&(bar)[XB_TMO], 1u); break; } } } } while (0)
struct XcdBarrier { unsigned* bar; unsigned x; volatile LAS unsigned* st; };
__device__ __forceinline__ XcdBarrier xcd_barrier_post(unsigned* bar, volatile LAS unsigned* st) {
    XcdBarrier b; b.bar = bar; b.x = xb_xcc_id(); b.st = st;
    if (threadIdx.x == 0) (void)xb_add(&bar[XB_XCNT(b.x)], 1u);
    return b;
}
__device__ __forceinline__ void xcd_barrier_complete(unsigned* bar, unsigned x, unsigned& nloc, unsigned& nx) {
    const unsigned G = gridDim.x * gridDim.y * gridDim.z;
    unsigned sum, cnt, mine, sp = 0u;
    for (;;) {
        sum = 0u; cnt = 0u; mine = 0u;
#pragma unroll
        for (unsigned j = 0; j < 16; ++j) { const unsigned c = xb_ld(&bar[XB_XCNT(j)]); sum += c; cnt += (c > 0u) ? 1u : 0u; mine = (j == x) ? c : mine; }
        if (sum == G) break;
        __builtin_amdgcn_s_sleep(1);
        if ((++sp & 255u) == 0u) { if (xb_ld(&bar[XB_TMO])) break; if (sp > XB_SPIN_CAP) { atomicAdd(&bar[XB_TMO], 1u); break; } }
    }
    nloc = mine > 0u ? mine : 1u; nx = cnt > 0u ? cnt : 1u;
}
__device__ __forceinline__ void xcd_barrier(const XcdBarrier& b) {
    asm volatile("s_waitcnt vmcnt(0)" ::: "memory");
    __syncthreads();
    if (threadIdx.x == 0) {
        unsigned* bar = b.bar; unsigned bx = b.x;
        asm volatile("" : "+s"(bar), "+s"(bx));
        __builtin_amdgcn_s_waitcnt(0);
        unsigned nloc = b.st[0], nx = b.st[1];
        if (nloc == 0u) { xcd_barrier_complete(bar, bx, nloc, nx); b.st[0] = nloc; b.st[1] = nx; }
        const unsigned old = xb_add(&bar[XB_XSUB(bx)], 1u);
        const unsigned gen = old / nloc;
        if (old + 1u == (gen + 1u) * nloc) {
            __builtin_amdgcn_fence(__ATOMIC_RELEASE, "agent");
            asm volatile("s_waitcnt vmcnt(0)" ::: "memory");
            const unsigned og = xb_add(&bar[XB_TOP], 1u);
            const unsigned tg = og / nx;
            if (og + 1u == (tg + 1u) * nx) xb_add(&bar[XB_TOPGEN], 1u);
            else XB_SPIN(xb_ld(&bar[XB_TOPGEN]) == tg, bar);
            __builtin_amdgcn_fence(__ATOMIC_ACQUIRE, "agent");
            xb_add(&bar[XB_XGEN(bx)], 1u);
            asm volatile("s_waitcnt vmcnt(0)" ::: "memory");
        } else {
            XB_SPIN(xb_ld(&bar[XB_XGEN(bx)]) == gen, bar);
            __builtin_amdgcn_fence(__ATOMIC_ACQUIRE, "agent");
            asm volatile("s_waitcnt vmcnt(0)" ::: "memory");
        }
    }
    __syncthreads();
}

template <int N> __device__ __forceinline__ void wait_vm() { asm volatile("s_waitcnt vmcnt(%0)" :: "n"(N) : "memory"); }
#define BAR() __builtin_amdgcn_s_barrier()
#define LDS_WAIT() asm volatile("s_waitcnt lgkmcnt(0)" ::: "memory")
__device__ __forceinline__ unsigned pk2(float a, float b) {
    typedef __bf16 bf2 __attribute__((ext_vector_type(2)));
    f32x2 v = {a, b}; bf2 r = __builtin_convertvector(v, bf2); return __builtin_bit_cast(unsigned, r);
}
__device__ __forceinline__ float bf_lo(unsigned u) { return __uint_as_float(u << 16); }
__device__ __forceinline__ float bf_hi(unsigned u) { return __uint_as_float(u & 0xffff0000u); }
template <int K> __device__ __forceinline__ float lane_xor(float v) {
    if constexpr (K == 32) { auto rr = __builtin_amdgcn_permlane32_swap(__float_as_uint(v), __float_as_uint(v), false, false); return __uint_as_float(rr[0]) == v ? __uint_as_float(rr[1]) : __uint_as_float(rr[0]); }
    else return __int_as_float(__builtin_amdgcn_ds_swizzle(__float_as_int(v), (K << 10) | 0x1f));
}
__device__ __forceinline__ float wave_sum(float v) {
    v += lane_xor<1>(v); v += lane_xor<2>(v); v += lane_xor<4>(v); v += lane_xor<8>(v); v += lane_xor<16>(v);
    auto rr = __builtin_amdgcn_permlane32_swap(__float_as_uint(v), __float_as_uint(v), false, false);
    return __uint_as_float(rr[0]) + __uint_as_float(rr[1]);
}
__device__ __forceinline__ float fast_exp2(float x) { return __builtin_amdgcn_exp2f(x); }
__device__ __forceinline__ float silu_f(float v) { return v / (1.f + __expf(-v)); }
__device__ __forceinline__ void glds16(const void* src, ldsp dst) {
    unsigned keep; const unsigned d = (unsigned)(__SIZE_TYPE__)dst;
    asm volatile("s_mov_b32 %0, m0\n\ts_mov_b32 m0, %2\n\ts_nop 0\n\tglobal_load_lds_dwordx4 %1, off\n\ts_mov_b32 m0, %0" : "=&s"(keep) : "v"(src), "s"(d) : "memory");
}
__device__ __forceinline__ bf16x8 tr2(ldsp a0, ldsp a1) {
    const bf16x4 t0 = __builtin_amdgcn_ds_read_tr16_b64_v4i16((LAS bf16x4*)a0);
    const bf16x4 t1 = __builtin_amdgcn_ds_read_tr16_b64_v4i16((LAS bf16x4*)a1);
    return __builtin_shufflevector(t0, t1, 0, 1, 2, 3, 4, 5, 6, 7);
}
__device__ __forceinline__ bf16x8 rd2x64(ldsp a0, ldsp a1) {
    const bf16x4 t0 = *(LAS bf16x4*)a0; const bf16x4 t1 = *(LAS bf16x4*)a1;
    return __builtin_shufflevector(t0, t1, 0, 1, 2, 3, 4, 5, 6, 7);
}
__device__ __forceinline__ int fresh_tid() { int t = threadIdx.x; asm volatile("" : "+v"(t)); return t; }
__device__ __forceinline__ int vcu_of_block() { const int bx = blockIdx.x; return (bx & 7) * (GRID / 8) + (bx >> 3); }

struct Args {
    const float* in[25];
    float* out; unsigned char* ws;
};
enum { I_X = 0, I_C, I_NMIX, I_NFFN, I_ADAW, I_ADAB, I_DAWIN, I_DAWOUT, I_LQ1, I_LK1, I_LQ2, I_LK2, I_SUBLN, I_RWIN, I_RWOUT, I_RGN,
       I_ROUTW, I_ROUTB, I_EW1, I_EW3, I_EW2, I_SW1, I_SW3, I_SW2, I_FNORM };

template <int WM, int WN, int MT, int NT, int NSTAGE, class Src>
__device__ __forceinline__ void gemm_stream(ldsp lds, int K, const Src& src) {
    constexpr int BM = WM * MT * 16, BN = WN * NT * 16, STAGE = (BM + BN) * 128, LA = BM / 64, LB = BN / 64, L = LA + LB, PD = NSTAGE - 1;
    static_assert(WM * WN == NWAVE && NSTAGE * STAGE <= LDS_MISC, "8 waves; ring fits");
    const int tid = fresh_tid(), lane = tid & 63, wid = __builtin_amdgcn_readfirstlane(tid >> 6);
    const int wr = wid / WN, wc = wid % WN, fr = lane & 15, fq = lane >> 4;
    const char* cbA; const char* cbB; const char* nbA; const char* nbB; unsigned cA[LA], nA[LA], oB[LB];
    typename Src::Epi ce, ne; int cn0 = 0, nn0 = 0;
    if (!src.template setup<LA>(0, cbA, cA, cbB, ce, cn0, wid, lane)) return;
#pragma unroll
    for (int j = 0; j < LB; ++j) { const int row = 8 * (wid + 8 * j) + (lane >> 3); oB[j] = (unsigned)(row * (int)src.ldb * 2 + (((lane & 7) ^ ((row >> 1) & 7)) << 4)); }
    const int swz = fr >> 1;
    const int aoff = (wr * MT * 16 + fr) * 128, boff = BM * 128 + (wc * NT * 16 + fr) * 128;
    const int ok0 = ((fq ^ swz) << 4), ok1 = (((4 + fq) ^ swz) << 4);
    auto issue = [&](int s, const char* bA, const unsigned (&oA)[LA], const char* bB, int t) {
        ldsp st = lds + s * STAGE;
#pragma unroll
        for (int j = 0; j < LA; ++j) glds16(bA + (size_t)t * 128 + oA[j], st + (wid + 8 * j) * 1024);
#pragma unroll
        for (int j = 0; j < LB; ++j) glds16(bB + (size_t)t * 128 + oB[j], st + BM * 128 + (wid + 8 * j) * 1024);
    };
    const int nt = K / 64;
    BAR();
#pragma unroll
    for (int d = 0; d < PD; ++d) issue(d, cbA, cA, cbB, d);
    int s = 0;
    for (int i = 0;; ++i) {
        const bool hasn = src.template setup<LA>(i + 1, nbA, nA, nbB, ne, nn0, wid, lane);
        f32x4 acc[MT][NT];
#pragma unroll
        for (int m = 0; m < MT; ++m)
#pragma unroll
            for (int n = 0; n < NT; ++n) acc[m][n] = (f32x4){0.f, 0.f, 0.f, 0.f};
        for (int t = 0; t < nt; ++t) {
            if (PD >= 2 && (hasn || t + 1 < nt)) wait_vm<(PD - 1) * L>(); else wait_vm<0>();
            BAR();
            { int s2 = s + PD; if (s2 >= NSTAGE) s2 -= NSTAGE;
              if (t + PD < nt) issue(s2, cbA, cA, cbB, t + PD); else if (hasn) issue(s2, nbA, nA, nbB, t + PD - nt); }
            ldsp st = lds + s * STAGE;
#pragma unroll
            for (int kk = 0; kk < 2; ++kk) {
                bf16x8 b[NT];
                const int ok = kk ? ok1 : ok0;
#pragma unroll
                for (int n = 0; n < NT; ++n) b[n] = *(LAS bf16x8*)(st + boff + n * 2048 + ok);
#pragma unroll
                for (int mh = 0; mh < MT; mh += 4) {
                    bf16x8 a[4];
#pragma unroll
                    for (int m = 0; m < 4; ++m) a[m] = *(LAS bf16x8*)(st + aoff + (mh + m) * 2048 + ok);
                    __builtin_amdgcn_s_setprio(1);
#pragma unroll
                    for (int m = 0; m < 4; ++m)
#pragma unroll
                        for (int n = 0; n < NT; ++n) acc[mh + m][n] = __builtin_amdgcn_mfma_f32_16x16x32_bf16(b[n], a[m], acc[mh + m][n], 0, 0, 0);
                    __builtin_amdgcn_s_setprio(0);
                    if (MT > 4) __builtin_amdgcn_sched_barrier(0);
                }
            }
            s = (s == NSTAGE - 1) ? 0 : s + 1;
        }
        ce(acc, wr * MT * 16, cn0 + wc * NT * 16, fr, fq);
        if (!hasn) break;
#pragma unroll
        for (int j = 0; j < LA; ++j) cA[j] = nA[j];
        cbA = nbA; cbB = nbB; ce = ne; cn0 = nn0;
    }
}
__device__ __forceinline__ int stage_row(int wid, int j, int lane) { return 8 * (wid + 8 * j) + (lane >> 3); }
__device__ __forceinline__ int stage_chunk(int row, int lane) { return ((lane & 7) ^ ((row >> 1) & 7)) * 16; }
__device__ __forceinline__ const char* uniform_ptr(const void* p) { unsigned long long v = (unsigned long long)p; const unsigned lo = __builtin_amdgcn_readfirstlane((unsigned)v), hi = __builtin_amdgcn_readfirstlane((unsigned)(v >> 32)); return (const char*)(((unsigned long long)hi << 32) | lo); }

template <int BM, int BN, class Mk> struct DenseSrc {
    using Epi = decltype(((Mk*)nullptr)->operator()(0));
    const bf16_t* A; size_t lda; const bf16_t* Bt; size_t ldb; int nN, per_x, xcd, local; const Mk& mk;
    __device__ __forceinline__ DenseSrc(const bf16_t* A_, size_t lda_, const bf16_t* Bt_, size_t ldb_, int M, int N, const Mk& mk_) : A(A_), lda(lda_), Bt(Bt_), ldb(ldb_), mk(mk_) {
        const int vcu = vcu_of_block(); nN = N / BN; per_x = (M / BM) / 8; xcd = vcu >> 5; local = vcu & 31; }
    template <int LA> __device__ __forceinline__ bool setup(int i, const char*& bA, unsigned (&oA)[LA], const char*& bB, Epi& e, int& n0, int wid, int lane) const {
        constexpr int GM = 4;
        const int q = local + 32 * i; if (q >= per_x * nN) return false;
        const int grp = q / (GM * nN), r = q % (GM * nN), m = xcd * per_x + grp * GM + (r % GM), n = r / GM;
#pragma unroll
        for (int j = 0; j < LA; ++j) { const int row = stage_row(wid, j, lane); oA[j] = (unsigned)(row * (int)lda * 2 + stage_chunk(row, lane)); }
        bA = (const char*)(A + (size_t)(m * BM) * lda); bB = (const char*)(Bt + (size_t)(n * BN) * ldb);
        e = mk(m * BM); n0 = n * BN; return true;
    }
};
template <int WM, int WN, int MT, int NT, int NSTAGE, class Mk>
__device__ __forceinline__ void gemm_dense_phase(ldsp lds, const bf16_t* A, size_t lda, const bf16_t* Bt, size_t ldb, int M, int N, int K, const Mk& mk) {
    DenseSrc<WM * MT * 16, WN * NT * 16, Mk> src(A, lda, Bt, ldb, M, N, mk);
    gemm_stream<WM, WN, MT, NT, NSTAGE>(lds, K, src);
}

struct EpiStoreBf16 {
    bf16_t* O; size_t ldc; int m0;
    template <int MT, int NT> __device__ __forceinline__ void operator()(const f32x4 (&acc)[MT][NT], int rb, int cb, int fr, int fq) const {
#pragma unroll
        for (int m = 0; m < MT; ++m) { bf16_t* rp = O + (size_t)(m0 + rb + m * 16 + fr) * ldc + cb + 4 * fq;
#pragma unroll
            for (int n = 0; n < NT; ++n) { u32x2 w; w.x = pk2(acc[m][n][0], acc[m][n][1]); w.y = pk2(acc[m][n][2], acc[m][n][3]); *(u32x2*)(rp + n * 16) = w; } }
    }
};
struct EpiResidual {
    const float* Xin; float* Xout; const float* gate; int m0;
    template <int MT, int NT> __device__ __forceinline__ void operator()(const f32x4 (&acc)[MT][NT], int rb, int cb, int fr, int fq) const {
#pragma unroll
        for (int m = 0; m < MT; ++m) { const int row = m0 + rb + m * 16 + fr; const float* g = gate + (size_t)(row >> 11) * 6144;
#pragma unroll
            for (int n = 0; n < NT; ++n) { const int col = cb + n * 16 + 4 * fq; const f32x4 xv = *(const f32x4*)(Xin + (size_t)row * D + col); const f32x4 gv = *(const f32x4*)(g + col);
                *(f32x4*)(Xout + (size_t)row * D + col) = xv + gv * acc[m][n]; } }
    }
};
struct EpiRetProj {
    bf16_t* O; int m0;
    template <int MT, int NT> __device__ __forceinline__ void operator()(const f32x4 (&acc)[MT][NT], int rb, int cb, int fr, int fq) const {
        float l2g = 0.f, pre = 1.f;
        if (cb < 2048) { const int h = (cb & 1023) >> 8; l2g = __log2f(1.f - exp2f(-5.f - (float)h)); if (cb >= 1024) { l2g = -l2g; pre = 0.0625f; } }
#pragma unroll
        for (int m = 0; m < MT; ++m) { const int row = m0 + rb + m * 16 + fr; const float sc = pre * exp2f(l2g * (float)(row & 127)); bf16_t* rp = O + (size_t)row * 6144 + cb + 4 * fq;
#pragma unroll
            for (int n = 0; n < NT; ++n) { u32x2 w; w.x = pk2(acc[m][n][0] * sc, acc[m][n][1] * sc); w.y = pk2(acc[m][n][2] * sc, acc[m][n][3] * sc); *(u32x2*)(rp + n * 16) = w; } }
    }
};
struct EpiCausalP {
    bf16_t* O;
    template <int MT, int NT> __device__ __forceinline__ void operator()(const f32x4 (&acc)[MT][NT], int rb, int cb, int fr, int fq) const {
#pragma unroll
        for (int m = 0; m < MT; ++m) { const int i = rb + m * 16 + fr; bf16_t* rp = O + (size_t)i * 128 + cb + 4 * fq;
#pragma unroll
            for (int n = 0; n < NT; ++n) { const int j = cb + n * 16 + 4 * fq; f32x4 v = acc[m][n];
                v[0] = (i >= j) ? v[0] : 0.f; v[1] = (i >= j + 1) ? v[1] : 0.f; v[2] = (i >= j + 2) ? v[2] : 0.f; v[3] = (i >= j + 3) ? v[3] : 0.f;
                u32x2 w; w.x = pk2(v[0], v[1]); w.y = pk2(v[2], v[3]); *(u32x2*)(rp + n * 16) = w; } }
    }
};
struct EpiSwiGLU {
    bf16_t* O; int slot0;
    template <int MT, int NT> __device__ __forceinline__ void operator()(const f32x4 (&acc)[MT][NT], int rb, int cb, int fr, int fq) const {
        static_assert(NT == 4, "NT");
#pragma unroll
        for (int m = 0; m < MT; ++m) { bf16_t* rp = O + (size_t)(slot0 + rb + m * 16 + fr) * 256 + (cb >> 1) + 4 * fq;
#pragma unroll
            for (int p = 0; p < 2; ++p) { const f32x4 a = acc[m][2 * p], b = acc[m][2 * p + 1]; u32x2 w;
                w.x = pk2(silu_f(a[0]) * b[0], silu_f(a[1]) * b[1]); w.y = pk2(silu_f(a[2]) * b[2], silu_f(a[3]) * b[3]); *(u32x2*)(rp + p * 16) = w; } }
    }
};

namespace pg8 {
constexpr int BM = 256, BK = 64, HALF = 128, HTB = HALF * BK * 2  , STAGE_BYTES = 8 * HTB, NXCD = 8, WGM = 8;
__device__ __forceinline__ int lds_byte(int r, int c) { const int st = (r >> 4) * 2 + (c >> 5), rr = r & 15, cc = c & 31, ob = rr * 64 + cc * 2; return st * 1024 + (ob ^ (((ob >> 9) & 1) << 5)); }
__device__ __forceinline__ void stage_rc(int b, int& R, int& C) { const int st = b / 1024, sb = b % 1024, swz = sb ^ (((sb >> 9) & 1) << 5); R = (st >> 1) * 16 + swz / 64; C = (st & 1) * 32 + (swz % 64) / 2; }
__device__ __forceinline__ int perm32(int rho) { const int n = rho >> 4, i = rho & 15; return 8 * (i >> 2) + 4 * n + (i & 3); }
struct Unit { int pm, pn; };
struct Gemm { const bf16_t* A; const bf16_t* Bt; int M, N, K, lda; };
struct StaticOrder {
    int nM, nN, nwg, G, c;
    __device__ void init(int M, int N, int G_, int c_) { nM = M / BM; nN = N / BM; nwg = nM * nN; G = G_; c = c_; }
    __device__ bool next(int i, Unit& u) const {
        const long L = (long)i * G + c; if (L >= nwg) return false;
        int wgid = (int)L; { const int q = nwg / NXCD, r = nwg % NXCD, xcd = wgid % NXCD, off = wgid / NXCD; wgid = (xcd < r ? xcd * (q + 1) : r * (q + 1) + (xcd - r) * q) + off; }
        const int nig = WGM * nN, gid = wgid / nig, fm = gid * WGM, gsz = (nM - fm) < WGM ? (nM - fm) : WGM;
        u.pm = fm + ((wgid % nig) % gsz); u.pn = (wgid % nig) / gsz; return true;
    }
};
template <class Epi, bool ALIGN_EPI = true>
__device__ __forceinline__ void gemm_phase(ldsp lds, const Gemm g, const StaticOrder& S, const Epi& E) {
    const int tid = fresh_tid(), wid = __builtin_amdgcn_readfirstlane(tid >> 6), lane = tid & 63, wr = wid >> 2, wc = wid & 3, fr = lane & 15, fq = lane >> 4;
    const int K = g.K, nt = K / BK;
    unsigned voffA[2], voffB[2];
#pragma unroll
    for (int i = 0; i < 2; ++i) { int R, C; stage_rc(tid * 16 + i * 8192, R, C); const int Rb = Epi::PERM ? ((R & ~31) + perm32(R & 31)) : R;
        voffA[i] = (unsigned)(R * g.lda + C) * 2u; voffB[i] = (unsigned)(Rb * K + C) * 2u; }
    const size_t kstep = (size_t)(BK * 2);
    const size_t hstepA = (size_t)HALF * g.lda * 2, hstepB = (size_t)HALF * K * 2;
    const size_t tstepA = 2 * hstepA, tstepB = 2 * hstepB;
    const unsigned ldsw = (unsigned)wid * 1024u;
    const int aoff = lds_byte(wr * 64 + fr, fq * 8), boff = lds_byte(wc * 32 + fr, fq * 8);
#define PG8_SA(b, h) (((b) * 2 + (h)) * HTB)
#define PG8_SB(b, h) ((4 + (b) * 2 + (h)) * HTB)
#define PG8_STAGE(bufoff, gbase, voff) do { _Pragma("unroll") for (int _i = 0; _i < 2; ++_i) glds16((const char*)(gbase) + (voff)[_i], lds + (bufoff) + ldsw + _i * 8192); } while (0)
#define PG8_LDA(dst, b, h) do { _Pragma("unroll") for (int m = 0; m < 4; ++m) _Pragma("unroll") for (int k = 0; k < 2; ++k) dst[m][k] = *(const LAS bf16x8*)(lds + PG8_SA(b, h) + aoff + m * 2048 + k * 1024); } while (0)
#define PG8_LDB(dst, b, h) do { _Pragma("unroll") for (int n = 0; n < 2; ++n) _Pragma("unroll") for (int k = 0; k < 2; ++k) dst[n][k] = *(const LAS bf16x8*)(lds + PG8_SB(b, h) + boff + n * 2048 + k * 1024); } while (0)
#define PG8_MMA(ai, bj, At, Bt) do { __builtin_amdgcn_s_setprio(1); _Pragma("unroll") for (int m = 0; m < 4; ++m) _Pragma("unroll") for (int n = 0; n < 2; ++n) _Pragma("unroll") for (int k = 0; k < 2; ++k) \
        acc[ai][bj][m][n] = __builtin_amdgcn_mfma_f32_16x16x32_bf16(Bt[n][k], At[m][k], acc[ai][bj][m][n], 0, 0, 0); __builtin_amdgcn_s_setprio(0); } while (0)
#define PG8_WAIT_V(n) asm volatile("s_waitcnt vmcnt(" #n ")" ::: "memory")
#define PG8_WAIT_L(n) asm volatile("s_waitcnt lgkmcnt(" #n ")" ::: "memory")
#define PG8_BAR __builtin_amdgcn_s_barrier()
#define PG8_SCHED __builtin_amdgcn_sched_barrier(0)
    Unit cur, nxt; int ui = 0;
    PG8_WAIT_V(0); PG8_BAR;
    if (!S.next(0, cur)) return;
    f32x4 acc[2][2][4][2];
#pragma unroll
    for (int a = 0; a < 2; ++a)
#pragma unroll
        for (int b = 0; b < 2; ++b)
#pragma unroll
            for (int m = 0; m < 4; ++m)
#pragma unroll
                for (int n = 0; n < 2; ++n) acc[a][b][m][n] = (f32x4){0.f, 0.f, 0.f, 0.f};
    bf16x8 At[4][2], B0[2][2], B1[2][2];
    const char* cA = (const char*)g.A + (size_t)cur.pm * tstepA; const char* cB = (const char*)g.Bt + (size_t)cur.pn * tstepB;
    PG8_STAGE(PG8_SB(0, 0), cB, voffB); PG8_STAGE(PG8_SB(0, 1), cB + hstepB, voffB); PG8_STAGE(PG8_SA(0, 0), cA, voffA); PG8_STAGE(PG8_SA(0, 1), cA + hstepA, voffA);
    if (wr == 1) PG8_BAR;
    PG8_WAIT_V(2); PG8_BAR;
    PG8_STAGE(PG8_SB(1, 0), cB + kstep, voffB); PG8_STAGE(PG8_SA(1, 0), cA + kstep, voffA); PG8_STAGE(PG8_SB(1, 1), cB + hstepB + kstep, voffB);
    PG8_WAIT_V(6); PG8_BAR;
    for (;;) {
        const bool has_next = S.next(ui + 1, nxt);
        const char* nA = has_next ? (const char*)g.A + (size_t)nxt.pm * tstepA : cA; const char* nB = has_next ? (const char*)g.Bt + (size_t)nxt.pn * tstepB : cB;
        for (int t = 0; t < nt; t += 2) {
            const bool last = (t == nt - 2);
            const char* a1 = cA + (size_t)(t + 1) * kstep;
            const char* a2 = last ? nA : cA + (size_t)(t + 2) * kstep; const char* b2 = last ? nB : cB + (size_t)(t + 2) * kstep;
            const char* a3 = a2 + kstep; const char* b3 = b2 + kstep;
            PG8_LDB(B0, 0, 0); PG8_LDB(B1, 0, 1); PG8_SCHED; PG8_LDA(At, 0, 0); PG8_STAGE(PG8_SA(1, 1), a1 + hstepA, voffA);
            PG8_WAIT_V(8); PG8_WAIT_L(0); PG8_BAR; PG8_MMA(0, 0, At, B0); PG8_MMA(0, 1, At, B1); PG8_BAR; PG8_SCHED;
            PG8_LDA(At, 0, 1); PG8_STAGE(PG8_SB(0, 0), b2, voffB); PG8_STAGE(PG8_SB(0, 1), b2 + hstepB, voffB); PG8_STAGE(PG8_SA(0, 0), a2, voffA);
            PG8_WAIT_V(8); PG8_WAIT_L(0); PG8_BAR; PG8_MMA(1, 0, At, B0); PG8_MMA(1, 1, At, B1); PG8_BAR; PG8_SCHED;
            PG8_LDB(B0, 1, 0); PG8_LDB(B1, 1, 1); PG8_SCHED; PG8_LDA(At, 1, 0); PG8_STAGE(PG8_SA(0, 1), a2 + hstepA, voffA);
            PG8_WAIT_V(8); PG8_WAIT_L(0); PG8_BAR; PG8_MMA(0, 0, At, B0); PG8_MMA(0, 1, At, B1); PG8_BAR; PG8_SCHED;
            PG8_LDA(At, 1, 1); PG8_STAGE(PG8_SB(1, 0), b3, voffB); PG8_STAGE(PG8_SB(1, 1), b3 + hstepB, voffB); PG8_STAGE(PG8_SA(1, 0), a3, voffA);
            PG8_WAIT_V(8); PG8_WAIT_L(0); PG8_BAR; PG8_MMA(1, 0, At, B0); PG8_MMA(1, 1, At, B1); PG8_BAR; PG8_SCHED;
        }
        if constexpr (ALIGN_EPI) { if (wr == 0) PG8_BAR; }
        E(acc, cur, wr, wc, fr, fq);
        if (!has_next) break;
#pragma unroll
        for (int a = 0; a < 2; ++a)
#pragma unroll
            for (int b = 0; b < 2; ++b)
#pragma unroll
                for (int m = 0; m < 4; ++m)
#pragma unroll
                    for (int n = 0; n < 2; ++n) acc[a][b][m][n] = (f32x4){0.f, 0.f, 0.f, 0.f};
        cur = nxt; cA = nA; cB = nB; ++ui;
        if constexpr (ALIGN_EPI) { if (wr == 1) PG8_BAR; }
    }
    PG8_WAIT_V(0);
    if constexpr (!ALIGN_EPI) { if (wr == 0) PG8_BAR; }
    PG8_BAR;
#undef PG8_SA
#undef PG8_SB
#undef PG8_STAGE
#undef PG8_LDA
#undef PG8_LDB
#undef PG8_MMA
#undef PG8_WAIT_V
#undef PG8_WAIT_L
#undef PG8_BAR
#undef PG8_SCHED
}
struct EpiBf16 {
    static constexpr bool PERM = true;
    bf16_t* O; size_t ldc;
    __device__ __forceinline__ void operator()(const f32x4 (&acc)[2][2][4][2], const Unit& u, int wr, int wc, int fr, int fq) const {
        const int row0 = u.pm * BM + wr * 64 + fr, col0 = u.pn * BM + wc * 32 + 8 * fq;
#pragma unroll
        for (int ai = 0; ai < 2; ++ai)
#pragma unroll
            for (int m = 0; m < 4; ++m) { bf16_t* rowp = O + (size_t)(row0 + ai * HALF + m * 16) * ldc + col0;
#pragma unroll
                for (int bj = 0; bj < 2; ++bj) { const f32x4 v0 = acc[ai][bj][m][0], v1 = acc[ai][bj][m][1];
                    u32x4 w; w.x = pk2(v0[0], v0[1]); w.y = pk2(v0[2], v0[3]); w.z = pk2(v1[0], v1[1]); w.w = pk2(v1[2], v1[3]);
                    *(u32x4*)(rowp + bj * HALF) = w; } }
    }
};
struct EpiQKV {
    static constexpr bool PERM = true;
    bf16_t* O; size_t ldc;
    __device__ __forceinline__ void operator()(const f32x4 (&acc)[2][2][4][2], const Unit& u, int wr, int wc, int fr, int fq) const {
        const int row0 = u.pm * BM + wr * 64 + fr, col0 = u.pn * BM + wc * 32 + 8 * fq;
        const float sc = (u.pn * BM < 1024) ? 0.125f * LOG2E : 1.f;
#pragma unroll
        for (int ai = 0; ai < 2; ++ai)
#pragma unroll
            for (int m = 0; m < 4; ++m) { bf16_t* rowp = O + (size_t)(row0 + ai * HALF + m * 16) * ldc + col0;
#pragma unroll
                for (int bj = 0; bj < 2; ++bj) { const f32x4 v0 = acc[ai][bj][m][0] * sc, v1 = acc[ai][bj][m][1] * sc;
                    u32x4 w; w.x = pk2(v0[0], v0[1]); w.y = pk2(v0[2], v0[3]); w.z = pk2(v1[0], v1[1]); w.w = pk2(v1[2], v1[3]);
                    *(u32x4*)(rowp + bj * HALF) = w; } }
    }
};
struct EpiRet {
    static constexpr bool PERM = true;
    bf16_t* O;
    __device__ __forceinline__ void operator()(const f32x4 (&acc)[2][2][4][2], const Unit& u, int wr, int wc, int fr, int fq) const {
        const int row0 = u.pm * BM + wr * 64 + fr, colt = u.pn * BM, col0 = colt + wc * 32 + 8 * fq;
        float l2g = 0.f, pre = 1.f;
        if (colt < 2048) { const int h = (colt & 1023) >> 8; l2g = __log2f(1.f - exp2f(-5.f - (float)h)); if (colt >= 1024) { l2g = -l2g; pre = 0.0625f; } }
#pragma unroll
        for (int ai = 0; ai < 2; ++ai)
#pragma unroll
            for (int m = 0; m < 4; ++m) { const int row = row0 + ai * HALF + m * 16; const float sc = pre * exp2f(l2g * (float)(row & 127)); bf16_t* rowp = O + (size_t)row * 6144 + col0;
#pragma unroll
                for (int bj = 0; bj < 2; ++bj) { const f32x4 v0 = acc[ai][bj][m][0] * sc, v1 = acc[ai][bj][m][1] * sc;
                    u32x4 w; w.x = pk2(v0[0], v0[1]); w.y = pk2(v0[2], v0[3]); w.z = pk2(v1[0], v1[1]); w.w = pk2(v1[2], v1[3]);
                    *(u32x4*)(rowp + bj * HALF) = w; } }
    }
};
template <bool SRC_F32> struct EpiRes {
    static constexpr bool PERM = true;
    const void* Xin; bf16_t* Xout; const float* gate;
    __device__ __forceinline__ void operator()(const f32x4 (&acc)[2][2][4][2], const Unit& u, int wr, int wc, int fr, int fq) const {
        const int row0 = u.pm * BM + wr * 64 + fr, col0 = u.pn * BM + wc * 32 + 8 * fq;
        const float* g = gate + (size_t)(row0 >> 11) * 6144 + col0;
        f32x4 gv[2][2];
#pragma unroll
        for (int bj = 0; bj < 2; ++bj)
#pragma unroll
            for (int n = 0; n < 2; ++n) gv[bj][n] = *(const f32x4*)(g + bj * HALF + n * 4);
#pragma unroll
        for (int ai = 0; ai < 2; ++ai)
#pragma unroll
            for (int m = 0; m < 4; ++m) { const int row = row0 + ai * HALF + m * 16;
#pragma unroll
                for (int bj = 0; bj < 2; ++bj) { f32x4 x0, x1;
                    if constexpr (SRC_F32) { const float* xp = (const float*)Xin + (size_t)row * D + col0 + bj * HALF; x0 = *(const f32x4*)xp; x1 = *(const f32x4*)(xp + 4); }
                    else { const u32x4 xb = *(const u32x4*)((const bf16_t*)Xin + (size_t)row * XRB_LD + XRB_OFF + col0 + bj * HALF);
                        x0 = (f32x4){bf_lo(xb.x), bf_hi(xb.x), bf_lo(xb.y), bf_hi(xb.y)}; x1 = (f32x4){bf_lo(xb.z), bf_hi(xb.z), bf_lo(xb.w), bf_hi(xb.w)}; }
                    const f32x4 v0 = x0 + gv[bj][0] * acc[ai][bj][m][0], v1 = x1 + gv[bj][1] * acc[ai][bj][m][1];
                    u32x4 w; w.x = pk2(v0[0], v0[1]); w.y = pk2(v0[2], v0[3]); w.z = pk2(v1[0], v1[1]); w.w = pk2(v1[2], v1[3]);
                    *(u32x4*)(Xout + (size_t)row * XRB_LD + XRB_OFF + col0 + bj * HALF) = w; }
                if (m & 1) asm volatile("" ::: "memory"); }
    }
};
template <class Epi>
__device__ __forceinline__ void dense(ldsp lds, const bf16_t* A, int lda, const bf16_t* Bt, int M, int N, int K, const Epi& E) {
    Gemm g{A, Bt, M, N, K, lda}; StaticOrder S; S.init(M, N, GRID, (int)blockIdx.x);
    gemm_phase<Epi, true>(lds, g, S, E);
}
struct UnitX { int pm, pn; const char* aBase; const char* bBase; const int* list; int cnt, r0, dummy; };
template <class Src, class Epi>
__device__ __forceinline__ void gemm_phase_x(ldsp lds, const Src& S, const Epi& E) {
    const int tid = fresh_tid(), wid = __builtin_amdgcn_readfirstlane(tid >> 6), lane = tid & 63, wr = wid >> 2, wc = wid & 3, fr = lane & 15, fq = lane >> 4;
    constexpr int K = Src::K, nt = K / BK, LDA = Src::LDA;
    int RA[2], CA[2]; unsigned voffB[2];
#pragma unroll
    for (int i = 0; i < 2; ++i) { int R, C; stage_rc(tid * 16 + i * 8192, R, C); RA[i] = R; CA[i] = C * 2; const int Rb = Epi::PERM ? ((R & ~31) + perm32(R & 31)) : R; voffB[i] = (unsigned)(Rb * K + C) * 2u; }
    const size_t kstep = (size_t)(BK * 2), hstepB = (size_t)HALF * K * 2;
    const unsigned ldsw = (unsigned)wid * 1024u;
    const int aoff = lds_byte(wr * 64 + fr, fq * 8), boff = lds_byte(wc * 32 + fr, fq * 8);
    auto rows_of = [&](const UnitX& u, unsigned (&v)[2][2]) {
#pragma unroll
        for (int h = 0; h < 2; ++h)
#pragma unroll
            for (int i = 0; i < 2; ++i) { const int r = h * HALF + RA[i];
                if constexpr (Src::GATHER) { const int gidx = u.r0 + r; const int tok = u.list ? (gidx < u.cnt ? u.list[gidx] : u.dummy) : u.dummy + gidx; v[h][i] = (unsigned)tok * (unsigned)(LDA * 2) + (unsigned)CA[i]; }
                else v[h][i] = (unsigned)(r * LDA * 2 + CA[i]); }
    };
#define PGX_SA(b, h) (((b) * 2 + (h)) * HTB)
#define PGX_SB(b, h) ((4 + (b) * 2 + (h)) * HTB)
#define PGX_STAGEB(bufoff, gbase) do { _Pragma("unroll") for (int _i = 0; _i < 2; ++_i) glds16((const char*)(gbase) + voffB[_i], lds + (bufoff) + ldsw + _i * 8192); } while (0)
#define PGX_STAGEA(bufoff, gbase, h, nx) do { _Pragma("unroll") for (int _i = 0; _i < 2; ++_i) glds16((const char*)(gbase) + ((nx) ? nv[h][_i] : cv[h][_i]), lds + (bufoff) + ldsw + _i * 8192); } while (0)
#define PGX_LDA(dst, b, h) do { _Pragma("unroll") for (int m = 0; m < 4; ++m) _Pragma("unroll") for (int k = 0; k < 2; ++k) dst[m][k] = *(const LAS bf16x8*)(lds + PGX_SA(b, h) + aoff + m * 2048 + k * 1024); } while (0)
#define PGX_LDB(dst, b, h) do { _Pragma("unroll") for (int n = 0; n < 2; ++n) _Pragma("unroll") for (int k = 0; k < 2; ++k) dst[n][k] = *(const LAS bf16x8*)(lds + PGX_SB(b, h) + boff + n * 2048 + k * 1024); } while (0)
#define PGX_MMA(ai, bj, At, Bt) do { __builtin_amdgcn_s_setprio(1); _Pragma("unroll") for (int m = 0; m < 4; ++m) _Pragma("unroll") for (int n = 0; n < 2; ++n) _Pragma("unroll") for (int k = 0; k < 2; ++k) \
        acc[ai][bj][m][n] = __builtin_amdgcn_mfma_f32_16x16x32_bf16(Bt[n][k], At[m][k], acc[ai][bj][m][n], 0, 0, 0); __builtin_amdgcn_s_setprio(0); } while (0)
#define PGX_WAIT_V(n) asm volatile("s_waitcnt vmcnt(" #n ")" ::: "memory")
#define PGX_WAIT_L(n) asm volatile("s_waitcnt lgkmcnt(" #n ")" ::: "memory")
#define PGX_BAR __builtin_amdgcn_s_barrier()
#define PGX_SCHED __builtin_amdgcn_sched_barrier(0)
    UnitX cur, nxt; int ui = 0;
    PGX_WAIT_V(0); PGX_BAR;
    if (!S.next(0, cur)) return;
    unsigned cv[2][2], nv[2][2];
    rows_of(cur, cv);
    asm volatile("" :: "v"(cv[0][0]), "v"(cv[0][1]), "v"(cv[1][0]), "v"(cv[1][1]));
    f32x4 acc[2][2][4][2];
#pragma unroll
    for (int a = 0; a < 2; ++a)
#pragma unroll
        for (int b = 0; b < 2; ++b)
#pragma unroll
            for (int m = 0; m < 4; ++m)
#pragma unroll
                for (int n = 0; n < 2; ++n) acc[a][b][m][n] = (f32x4){0.f, 0.f, 0.f, 0.f};
    bf16x8 At[4][2], B0[2][2], B1[2][2];
    const char* cA = cur.aBase; const char* cB = cur.bBase;
    PGX_STAGEB(PGX_SB(0, 0), cB); PGX_STAGEB(PGX_SB(0, 1), cB + hstepB); PGX_STAGEA(PGX_SA(0, 0), cA, 0, false); PGX_STAGEA(PGX_SA(0, 1), cA, 1, false);
    if (wr == 1) PGX_BAR;
    PGX_WAIT_V(2); PGX_BAR;
    PGX_STAGEB(PGX_SB(1, 0), cB + kstep); PGX_STAGEA(PGX_SA(1, 0), cA + kstep, 0, false); PGX_STAGEB(PGX_SB(1, 1), cB + hstepB + kstep);
    PGX_WAIT_V(6); PGX_BAR;
    LAS int* lbuf = (LAS int*)(lds + LDS_MISC + 2048);
    for (;;) {
        const bool has_next = S.next(ui + 1, nxt);
        if constexpr (Src::GATHER) {
            if (has_next && nxt.list && wid == 0) glds16((const char*)(nxt.list + nxt.r0) + lane * 16, (ldsp)(lbuf + ((ui + 1) & 1) * 256));
        } else {
            if (has_next) rows_of(nxt, nv); else {
#pragma unroll
                for (int h = 0; h < 2; ++h)
#pragma unroll
                    for (int i = 0; i < 2; ++i) nv[h][i] = cv[h][i]; }
        }
        const char* nA = has_next ? nxt.aBase : cA; const char* nB = has_next ? nxt.bBase : cB;
#pragma unroll 1
        for (int t = 0; t < nt; t += 2) {
            const bool last = (t == nt - 2);
            if constexpr (Src::GATHER) { if (last) {
#pragma unroll
                for (int h = 0; h < 2; ++h)
#pragma unroll
                    for (int i = 0; i < 2; ++i) { const int r = h * HALF + RA[i], gidx = nxt.r0 + r; unsigned v = cv[h][i];
                        if (has_next) { int tok;
                            if (nxt.list) { const int tl = lbuf[((ui + 1) & 1) * 256 + r]; tok = gidx < nxt.cnt ? tl : nxt.dummy; } else tok = nxt.dummy + gidx;
                            v = (unsigned)tok * (unsigned)(LDA * 2) + (unsigned)CA[i]; }
                        nv[h][i] = v; } } }
            const char* a1 = cA + (size_t)(t + 1) * kstep;
            const char* a2 = last ? nA : cA + (size_t)(t + 2) * kstep; const char* b2 = last ? nB : cB + (size_t)(t + 2) * kstep;
            const char* a3 = a2 + kstep; const char* b3 = b2 + kstep;
            PGX_LDB(B0, 0, 0); PGX_LDB(B1, 0, 1); PGX_SCHED; PGX_LDA(At, 0, 0); PGX_STAGEA(PGX_SA(1, 1), a1, 1, false);
            PGX_WAIT_V(8); PGX_WAIT_L(0); PGX_BAR; PGX_MMA(0, 0, At, B0); PGX_MMA(0, 1, At, B1); PGX_BAR; PGX_SCHED;
            PGX_LDA(At, 0, 1); PGX_STAGEB(PGX_SB(0, 0), b2); PGX_STAGEB(PGX_SB(0, 1), b2 + hstepB); PGX_STAGEA(PGX_SA(0, 0), a2, 0, last);
            PGX_WAIT_V(8); PGX_WAIT_L(0); PGX_BAR; PGX_MMA(1, 0, At, B0); PGX_MMA(1, 1, At, B1); PGX_BAR; PGX_SCHED;
            PGX_LDB(B0, 1, 0); PGX_LDB(B1, 1, 1); PGX_SCHED; PGX_LDA(At, 1, 0); PGX_STAGEA(PGX_SA(0, 1), a2, 1, last);
            PGX_WAIT_V(8); PGX_WAIT_L(0); PGX_BAR; PGX_MMA(0, 0, At, B0); PGX_MMA(0, 1, At, B1); PGX_BAR; PGX_SCHED;
            PGX_LDA(At, 1, 1); PGX_STAGEB(PGX_SB(1, 0), b3); PGX_STAGEB(PGX_SB(1, 1), b3 + hstepB); PGX_STAGEA(PGX_SA(1, 0), a3, 0, last);
            PGX_WAIT_V(8); PGX_WAIT_L(0); PGX_BAR; PGX_MMA(1, 0, At, B0); PGX_MMA(1, 1, At, B1); PGX_BAR; PGX_SCHED;
        }
        if (wr == 0) PGX_BAR;
        E(acc, cur, wr, wc, fr, fq);
        if (!has_next) break;
#pragma unroll
        for (int a = 0; a < 2; ++a)
#pragma unroll
            for (int b = 0; b < 2; ++b)
#pragma unroll
                for (int m = 0; m < 4; ++m)
#pragma unroll
                    for (int n = 0; n < 2; ++n) acc[a][b][m][n] = (f32x4){0.f, 0.f, 0.f, 0.f};
        cur = nxt; cA = nA; cB = nB; ++ui;
#pragma unroll
        for (int h = 0; h < 2; ++h)
#pragma unroll
            for (int i = 0; i < 2; ++i) cv[h][i] = nv[h][i];
        if (wr == 1) PGX_BAR;
    }
    PGX_WAIT_V(0);
    PGX_BAR;
#undef PGX_SA
#undef PGX_SB
#undef PGX_STAGEA
#undef PGX_STAGEB
#undef PGX_LDA
#undef PGX_LDB
#undef PGX_MMA
#undef PGX_WAIT_V
#undef PGX_WAIT_L
#undef PGX_BAR
#undef PGX_SCHED
}
struct EpiSwiGLUx {
    static constexpr bool PERM = false;
    bf16_t* O;
    __device__ __forceinline__ void operator()(const f32x4 (&acc)[2][2][4][2], const UnitX& u, int wr, int wc, int fr, int fq) const {
        const int row0 = u.pm * BM + wr * 64 + fr, c0 = (u.pn * BM + wc * 32) / 2 + 4 * fq;
#pragma unroll
        for (int ai = 0; ai < 2; ++ai)
#pragma unroll
            for (int m = 0; m < 4; ++m) { bf16_t* rowp = O + (size_t)(row0 + ai * HALF + m * 16) * 256 + c0;
#pragma unroll
                for (int bj = 0; bj < 2; ++bj) { const f32x4 x = acc[ai][bj][m][0], y = acc[ai][bj][m][1]; u32x2 w;
                    w.x = pk2(silu_f(x[0]) * y[0], silu_f(x[1]) * y[1]); w.y = pk2(silu_f(x[2]) * y[2], silu_f(x[3]) * y[3]); *(u32x2*)(rowp + bj * (HALF / 2)) = w; } }
    }
};
struct EpiYx {
    static constexpr bool PERM = true;
    unsigned char* O;
    __device__ __forceinline__ void operator()(const f32x4 (&acc)[2][2][4][2], const UnitX& u, int wr, int wc, int fr, int fq) const {
        const int row0 = u.pm * BM + wr * 64 + fr, col0 = u.pn * BM + wc * 32 + 8 * fq;
#pragma unroll
        for (int ai = 0; ai < 2; ++ai)
#pragma unroll
            for (int m = 0; m < 4; ++m) { unsigned char* rowp = O + (size_t)(row0 + ai * HALF + m * 16) * D + col0;
#pragma unroll
                for (int bj = 0; bj < 2; ++bj) { f32x4 v0 = acc[ai][bj][m][0], v1 = acc[ai][bj][m][1];
#pragma unroll
                    for (int e = 0; e < 4; ++e) { v0[e] = __builtin_amdgcn_fmed3f(v0[e], -448.f, 448.f); v1[e] = __builtin_amdgcn_fmed3f(v1[e], -448.f, 448.f); }
                    int w0 = __builtin_amdgcn_cvt_pk_fp8_f32(v0[0], v0[1], 0, false); w0 = __builtin_amdgcn_cvt_pk_fp8_f32(v0[2], v0[3], w0, true);
                    int w1 = __builtin_amdgcn_cvt_pk_fp8_f32(v1[0], v1[1], 0, false); w1 = __builtin_amdgcn_cvt_pk_fp8_f32(v1[2], v1[3], w1, true);
                    u32x2 w; w.x = (unsigned)w0; w.y = (unsigned)w1; *(u32x2*)(rowp + bj * HALF) = w; } }
    }
};
}

__device__ __forceinline__ void transpose_item(const float* W, int K, int N, bf16_t* WT, int mode, LAS float* scr, int item, int lane) {
    const int nblk = N / 32, kb = item / nblk, nb = item % nblk, k0 = 64 * kb, n0 = 32 * nb;
    f32x4 v[8];
#pragma unroll
    for (int i = 0; i < 8; ++i) v[i] = *(const f32x4*)(W + (size_t)(k0 + 8 * i + (lane >> 3)) * N + n0 + (lane & 7) * 4);
#pragma unroll
    for (int i = 0; i < 8; ++i) { LAS float* d = scr + (8 * i + (lane >> 3)) * 33 + (lane & 7) * 4; d[0] = v[i][0]; d[1] = v[i][1]; d[2] = v[i][2]; d[3] = v[i][3]; }
    LDS_WAIT();
    const int c = lane & 7;
#pragma unroll
    for (int j = 0; j < 4; ++j) { const int n = (lane >> 3) + 8 * j; const LAS float* s = scr + (8 * c) * 33 + n;
        u32x4 o; o.x = pk2(s[0 * 33], s[1 * 33]); o.y = pk2(s[2 * 33], s[3 * 33]); o.z = pk2(s[4 * 33], s[5 * 33]); o.w = pk2(s[6 * 33], s[7 * 33]);
        const int nn = n0 + n; const int row = mode == 0 ? nn : ((nn >> 4) * 32 + (mode == 2 ? 16 : 0) + (nn & 15));
        *(u32x4*)(WT + (size_t)row * K + k0 + 8 * c) = o; }
    LDS_WAIT();
}
__device__ __forceinline__ void convert_expert_weights(const Args& a, int layer, ldsp lds, int gw, int ngw, int wave, int lane) {
    LAS float* scr = (LAS float*)(lds + wave * 16384);
    unsigned char* ws = a.ws;
    constexpr int I13 = (D / 64) * (256 / 32), I2 = (256 / 64) * (D / 32);
    constexpr int NE = 64 * I13;
    constexpr int TOTAL = 3 * NE + 3 * 128;
    for (int it = gw; it < TOTAL; it += ngw) {
        int r = it;
        if (r < NE) { const int e = r / I13; transpose_item(a.in[I_EW1] + ((size_t)layer * 64 + e) * D * 256, D, 256, (bf16_t*)(ws + WS_W13) + (size_t)e * 512 * D, 1, scr, r % I13, lane); continue; } r -= NE;
        if (r < NE) { const int e = r / I13; transpose_item(a.in[I_EW3] + ((size_t)layer * 64 + e) * D * 256, D, 256, (bf16_t*)(ws + WS_W13) + (size_t)e * 512 * D, 2, scr, r % I13, lane); continue; } r -= NE;
        if (r < NE) { const int e = r / I2; transpose_item(a.in[I_EW2] + ((size_t)layer * 64 + e) * 256 * D, 256, D, (bf16_t*)(ws + WS_W2) + (size_t)e * D * 256, 0, scr, r % I2, lane); continue; } r -= NE;
        if (r < 128) { transpose_item(a.in[I_SW1] + (size_t)layer * D * 256, D, 256, (bf16_t*)(ws + WS_WS13), 1, scr, r, lane); continue; } r -= 128;
        if (r < 128) { transpose_item(a.in[I_SW3] + (size_t)layer * D * 256, D, 256, (bf16_t*)(ws + WS_WS13), 2, scr, r, lane); continue; } r -= 128;
        transpose_item(a.in[I_SW2] + (size_t)layer * 256 * D, 256, D, (bf16_t*)(ws + WS_WS2), 0, scr, r, lane);
    }
}
__device__ __forceinline__ void convert_dense_weights(const Args& a, ldsp lds, int gw, int ngw, int wave, int lane) {
    LAS float* scr = (LAS float*)(lds + wave * 16384);
    unsigned char* ws = a.ws;
    constexpr int IQ = 16 * 96, IO = 16 * 32, IRI = 16 * 192, IRO = 32 * 32;
    for (int it = gw; it < IQ + IO + IRI + IRO; it += ngw) {
        int r = it;
        if (r < IQ) { transpose_item(a.in[I_DAWIN], D, 3072, (bf16_t*)(ws + WS_WQKV), 0, scr, r, lane); continue; } r -= IQ;
        if (r < IO) { transpose_item(a.in[I_DAWOUT], D, D, (bf16_t*)(ws + WS_WO), 0, scr, r, lane); continue; } r -= IO;
        if (r < IRI) { transpose_item(a.in[I_RWIN], D, 6144, (bf16_t*)(ws + WS_WRI), 0, scr, r, lane); continue; } r -= IRI;
        transpose_item(a.in[I_RWOUT], 2048, D, (bf16_t*)(ws + WS_WRO), 0, scr, r, lane);
    }
}
__device__ __forceinline__ void mod_items(const Args& a, ldsp lds) {
    const int tid = threadIdx.x;
    LAS float* sl = (LAS float*)lds;
    LAS float* red = (LAS float*)(lds + 65536);
    const float* c = a.in[I_C];
    for (int i = tid; i < 16 * 1024; i += NTHR) sl[i] = silu_f(c[i]);
    __syncthreads();
    float* mod = (float*)(a.ws + WS_MOD);
    for (int item = blockIdx.x; item < 384; item += GRID) {
        const int layer = item / 192, j0 = (item % 192) * 32, kq = tid >> 5, col = tid & 31;
        const float* w = a.in[I_ADAW] + (size_t)layer * D * 6144 + j0 + col;
        float acc[16];
#pragma unroll
        for (int b = 0; b < 16; ++b) acc[b] = 0.f;
        for (int k0 = kq * 64; k0 < kq * 64 + 64; k0 += 8) {
            float wv[8];
#pragma unroll
            for (int u = 0; u < 8; ++u) wv[u] = w[(size_t)(k0 + u) * 6144];
#pragma unroll
            for (int u = 0; u < 8; ++u)
#pragma unroll
                for (int b = 0; b < 16; ++b) acc[b] += sl[b * 1024 + k0 + u] * wv[u];
        }
#pragma unroll
        for (int b = 0; b < 16; ++b) red[(kq * 16 + b) * 32 + col] = acc[b];
        __syncthreads();
        { const int b = tid >> 5, cc = tid & 31; const int j = j0 + cc; float s = a.in[I_ADAB][(size_t)layer * 6144 + j];
#pragma unroll
          for (int q = 0; q < 16; ++q) s += red[(q * 16 + b) * 32 + cc];
          if (j >= 1024 && j < 2048) s = a.in[I_NMIX][layer * D + j - 1024] * (1.f + s);
          if (j >= 4096 && j < 5120) s = a.in[I_NFFN][layer * D + j - 4096] * (1.f + s);
          mod[((size_t)layer * 16 + b) * 6144 + j] = s; }
        __syncthreads();
    }
}

__device__ __forceinline__ void adaln_store(const f32x4 (&v)[4], float rstd, const float* G, const float* sh, bf16_t* hrow, int lane) {
#pragma unroll
    for (int j = 0; j < 4; ++j) { const int col = 4 * lane + 256 * j; const f32x4 g = *(const f32x4*)(G + col), s0 = *(const f32x4*)(sh + col);
        const f32x4 h = v[j] * rstd * g + s0; u32x2 w; w.x = pk2(h[0], h[1]); w.y = pk2(h[2], h[3]); *(u32x2*)(hrow + col) = w; }
}
__device__ __forceinline__ void adaln_phase(const float* X, const float* mod_sh  , const float* mod_G, bf16_t* H, int gw, int ngw, int lane) {
    for (int row0 = gw * 2; row0 < T; row0 += ngw * 2) {
        f32x4 v[2][4]; float ss[2] = {0.f, 0.f};
#pragma unroll
        for (int r = 0; r < 2; ++r)
#pragma unroll
            for (int j = 0; j < 4; ++j) v[r][j] = *(const f32x4*)(X + (size_t)(row0 + r) * D + 4 * lane + 256 * j);
#pragma unroll
        for (int r = 0; r < 2; ++r) {
#pragma unroll
            for (int j = 0; j < 4; ++j) ss[r] += v[r][j][0] * v[r][j][0] + v[r][j][1] * v[r][j][1] + v[r][j][2] * v[r][j][2] + v[r][j][3] * v[r][j][3];
            const float rstd = rsqrtf(wave_sum(ss[r]) * (1.f / D) + 1e-6f); const int b = (row0 + r) >> 11;
            adaln_store(v[r], rstd, mod_G + (size_t)b * 6144, mod_sh + (size_t)b * 6144, H + (size_t)(row0 + r) * D, lane); }
    }
}

#define ATIC(cat) do { if (TIME_SEL >= 30 && blockIdx.x == 0 && threadIdx.x == 0) { const unsigned long long now_ = __builtin_amdgcn_s_memrealtime(); LAS unsigned long long* tb_ = (LAS unsigned long long*)(lds + LDS_MISC + 1024); if ((cat) == TIME_SEL) tb_[1] += now_ - tb_[0]; tb_[0] = now_; } } while (0)
typedef float f32x16 __attribute__((ext_vector_type(16)));
__device__ __forceinline__ float half_swap_max(float m) { auto rr = __builtin_amdgcn_permlane32_swap(__float_as_uint(m), __float_as_uint(m), false, false);
    return fmaxf(__uint_as_float(rr[0]), __uint_as_float(rr[1])); }
__device__ __forceinline__ float half_swap_sum(float m) { auto rr = __builtin_amdgcn_permlane32_swap(__float_as_uint(m), __float_as_uint(m), false, false);
    return __uint_as_float(rr[0]) + __uint_as_float(rr[1]); }
#define MX3(a, b, c) __builtin_fmaxf(__builtin_fmaxf((a), (b)), (c))
__device__ __forceinline__ void attn_phase(ldsp lds, const bf16_t* qkv, bf16_t* ao, float lam, const float* subln_g) {
    const int tid = fresh_tid(), lane = tid & 63, wid = __builtin_amdgcn_readfirstlane(tid >> 6), map = wid & 1, qg = wid >> 1, half = 0, r32 = lane & 31, hi = lane >> 5;
    constexpr int STAGE = 32768;
    constexpr float THR = 8.f;
    const int kb0 = map * 8192 + r32 * 128 + ((hi ^ ((r32 >> 1) & 7)) << 4);
    const int vb0 = 16384 + (4 * hi + ((lane & 15) >> 2)) * 256 + (((lane >> 2) & 3) << 6) + ((2 * ((lane >> 4) & 1) + ((lane & 3) >> 1)) << 4) + (lane & 1) * 8;
    for (int round = 0; round < 8; ++round) {
        const int i = blockIdx.x, xcd = i & 7, li = i >> 3, bh = xcd * 16 + 4 * (round >> 1) + (li >> 3), j8 = li & 7;
        const int qb = (round & 1) ? j8 : 15 - j8;
        const int b = bh >> 3, h = bh & 7;
        const size_t tok0 = (size_t)b * SEQ;
        const float slope2 = exp2f(-(float)(h + 1)) * LOG2E, d32 = 32.f * slope2, d64 = 64.f * slope2;
        const int qrow = qb * 128 + qg * 32 + r32;
        bf16x8 qr[4];
#pragma unroll
        for (int d0 = 0; d0 < 4; ++d0) qr[d0] = *(const bf16x8*)(qkv + (tok0 + qrow) * 3072 + (2 * h + map) * 64 + d0 * 16 + hi * 8);
        asm volatile("" :: "v"(qr[0]), "v"(qr[1]), "v"(qr[2]), "v"(qr[3]));
        f32x16 bt0;
#pragma unroll
        for (int r = 0; r < 16; ++r) bt0[r] = slope2 * (float)((r & 3) + 8 * (r >> 2) + 4 * hi);
        const char* srcK0; const char* srcV0;
        { const int row = 8 * wid + (lane >> 3), ch = (lane & 7) ^ ((row >> 1) & 7);
          srcK0 = (const char*)(qkv + (tok0 + row) * 3072 + 1024 + (2 * h) * 64) + ch * 16; }
        { const int row = 4 * wid + (lane >> 4), ch = (lane & 15) ^ ((row & 3) << 2); srcV0 = (const char*)(qkv + (tok0 + row) * 3072 + 2048 + h * 128) + ch * 16; }
        auto issue = [&](int s, int t) {
            ldsp st = lds + s * STAGE; const size_t adv = (size_t)t * 64 * 3072 * 2;
            glds16(srcK0 + adv, st + wid * 1024); glds16(srcK0 + adv + 128, st + 8192 + wid * 1024);
            glds16(srcV0 + adv, st + 16384 + wid * 1024); glds16(srcV0 + adv + (size_t)32 * 6144, st + 16384 + (wid + 8) * 1024);
        };
        f32x16 o[4];
#pragma unroll
        for (int dvt = 0; dvt < 4; ++dvt)
#pragma unroll
            for (int r = 0; r < 16; ++r) o[dvt][r] = 0.f;
        bf16x8 pw[4];
#pragma unroll
        for (int g = 0; g < 4; ++g) pw[g] = (bf16x8){0, 0, 0, 0, 0, 0, 0, 0};
        float mrel = -__builtin_inff(), lsum = 0.f;
        const int ntile = 2 * qb + 2;
        const int qfirst = qb * 128 + qg * 32;
        f32x16 pS0, pS1;
        auto pv = [&](ldsp stv) {
            int vb = vb0; asm volatile("" : "+v"(vb));
            bf16x8 vq[3];
            vq[0] = tr2(stv + vb, stv + vb + 2048);
            vq[1] = tr2(stv + (vb ^ 64), stv + (vb ^ 64) + 2048);
#pragma unroll
            for (int i = 0; i < 16; ++i) {
                const int g = i >> 2, dvt = i & 3;
                if (i + 2 < 16) { const int i2 = i + 2, vo = (vb ^ ((i2 & 3) << 6)) + (i2 >> 2) * 4096; vq[i2 % 3] = tr2(stv + vo, stv + vo + 2048); }
                o[dvt] = __builtin_amdgcn_mfma_f32_32x32x16_bf16(vq[i % 3], pw[g], o[dvt], 0, 0, 0);
                __builtin_amdgcn_sched_barrier(0);
            }
        };
        auto mslot = [&](int t) {
            pv(lds + ((t > 0 ? t - 1 : 0) & 3) * STAGE);
            ldsp stk = lds + (t & 3) * STAGE;
            int kb = kb0; asm volatile("" : "+v"(kb));
            bf16x8 kf[4];
            kf[0] = *(LAS bf16x8*)(stk + kb); kf[1] = *(LAS bf16x8*)(stk + kb + 4096);
            kf[2] = *(LAS bf16x8*)(stk + (kb ^ 32)); kf[3] = *(LAS bf16x8*)(stk + (kb ^ 32) + 4096);
            pS0 = __builtin_amdgcn_mfma_f32_32x32x16_bf16(kf[0], qr[0], bt0, 0, 0, 0);
            pS1 = __builtin_amdgcn_mfma_f32_32x32x16_bf16(kf[1], qr[0], bt0, 0, 0, 0);
            __builtin_amdgcn_sched_barrier(0);
            kf[0] = *(LAS bf16x8*)(stk + (kb ^ 64)); kf[1] = *(LAS bf16x8*)(stk + (kb ^ 64) + 4096);
            pS0 = __builtin_amdgcn_mfma_f32_32x32x16_bf16(kf[2], qr[1], pS0, 0, 0, 0);
            pS1 = __builtin_amdgcn_mfma_f32_32x32x16_bf16(kf[3], qr[1], pS1, 0, 0, 0);
            __builtin_amdgcn_sched_barrier(0);
            kf[2] = *(LAS bf16x8*)(stk + (kb ^ 96)); kf[3] = *(LAS bf16x8*)(stk + (kb ^ 96) + 4096);
            pS0 = __builtin_amdgcn_mfma_f32_32x32x16_bf16(kf[0], qr[2], pS0, 0, 0, 0);
            pS1 = __builtin_amdgcn_mfma_f32_32x32x16_bf16(kf[1], qr[2], pS1, 0, 0, 0);
            __builtin_amdgcn_sched_barrier(0);
            pS0 = __builtin_amdgcn_mfma_f32_32x32x16_bf16(kf[2], qr[3], pS0, 0, 0, 0);
            pS1 = __builtin_amdgcn_mfma_f32_32x32x16_bf16(kf[3], qr[3], pS1, 0, 0, 0);
        };
        auto sslot = [&](int t) {
            const int key0 = 64 * t;
            if (key0 + 63 > qfirst) {
                const int kq = qrow - key0 - 4 * hi;
#pragma unroll
                for (int r = 0; r < 16; ++r) { const int kr = (r & 3) + 8 * (r >> 2); if (kr > kq) pS0[r] = -__builtin_inff(); if (kr + 32 > kq) pS1[r] = -__builtin_inff(); }
            }
            float ma = MX3(pS0[0], pS0[1], pS0[2]), mb = MX3(pS1[0], pS1[1], pS1[2]);
            ma = MX3(ma, pS0[3], pS0[4]); mb = MX3(mb, pS1[3], pS1[4]);
#pragma unroll
            for (int r = 5; r < 15; r += 2) { ma = MX3(ma, pS0[r], pS0[r + 1]); mb = MX3(mb, pS1[r], pS1[r + 1]); }
            ma = fmaxf(ma, pS0[15]); mb = fmaxf(mb, pS1[15]);
            const float mx = half_swap_max(fmaxf(ma, mb + d32));
            if (__any(mx - mrel > THR)) {
                const float mnew = fmaxf(mrel, mx); float alpha = fast_exp2(mrel - mnew);
                asm volatile("s_nop 1" : "+v"(alpha));
                mrel = mnew; lsum *= alpha;
#pragma unroll
                for (int dvt = 0; dvt < 4; ++dvt)
#pragma unroll
                    for (int r = 0; r < 16; ++r) asm volatile("v_mul_f32 %0, %0, %1" : "+v"(o[dvt][r]) : "v"(alpha));
            }
            const float e0 = mrel, e1 = mrel - d32;
            float s0 = 0.f, s1 = 0.f;
#pragma unroll
            for (int r = 0; r < 16; ++r) { pS0[r] = fast_exp2(pS0[r] - e0); pS1[r] = fast_exp2(pS1[r] - e1); s0 += pS0[r]; asm volatile("" : "+v"(s0)); s1 += pS1[r]; asm volatile("" : "+v"(s1)); }
            lsum += s0 + s1;
#pragma unroll
            for (int g = 0; g < 2; ++g) { u32x4 w0, w1;
                w0.x = pk2(pS0[8 * g + 0], pS0[8 * g + 1]); w0.y = pk2(pS0[8 * g + 2], pS0[8 * g + 3]); w0.z = pk2(pS0[8 * g + 4], pS0[8 * g + 5]); w0.w = pk2(pS0[8 * g + 6], pS0[8 * g + 7]);
                w1.x = pk2(pS1[8 * g + 0], pS1[8 * g + 1]); w1.y = pk2(pS1[8 * g + 2], pS1[8 * g + 3]); w1.z = pk2(pS1[8 * g + 4], pS1[8 * g + 5]); w1.w = pk2(pS1[8 * g + 6], pS1[8 * g + 7]);
                pw[g] = __builtin_bit_cast(bf16x8, w0); pw[2 + g] = __builtin_bit_cast(bf16x8, w1); }
            mrel -= d64;
        };
        BAR();
        issue(0, 0); issue(1, 1);
        auto barseq = [&](int k) {
            if (k < ntile) { if (k + 1 < ntile) wait_vm<4>(); else wait_vm<0>(); }
            BAR();
            if (k + 2 < ntile) issue((k + 2) & 3, k + 2);
        };
        if (half) barseq(0);
#pragma unroll 1
        for (int t = 0; t < ntile; ++t) {
            if (!half) barseq(t);
            mslot(t);
            if (half) barseq(t + 1);
            sslot(t);
        }
        if (!half) barseq(ntile);
        pv(lds + ((ntile - 1) & 3) * STAGE);
        const float inv = __builtin_amdgcn_rcpf(half_swap_sum(lsum));
        BAR();
        LAS float* xb = (LAS float*)lds + qg * 4096;
        if (map == 1) {
#pragma unroll
            for (int dvt = 0; dvt < 4; ++dvt)
#pragma unroll
                for (int r = 0; r < 16; ++r) xb[(dvt * 16 + r) * 64 + lane] = o[dvt][r] * inv;
        }
        LDS_WAIT(); BAR();
        if (map == 0) {
            const float* sg = subln_g; asm volatile("" : "+s"(sg));
            float ss = 0.f;
#pragma unroll
            for (int dvt = 0; dvt < 4; ++dvt) {
#pragma unroll
                for (int r = 0; r < 16; ++r) { const float v = o[dvt][r] * inv - lam * xb[(dvt * 16 + r) * 64 + lane]; o[dvt][r] = v; ss += v * v; }
                __builtin_amdgcn_sched_barrier(0);
            }
            ss = half_swap_sum(ss);
            const float rstd = rsqrtf(ss * (1.f / 128.f) + 1e-6f) * 0.8f;
            bf16_t* orow = ao + (tok0 + qrow) * D + h * 128 + 4 * hi;
#pragma unroll
            for (int dvt = 0; dvt < 4; ++dvt) {
#pragma unroll
                for (int j = 0; j < 4; ++j) { const f32x4 g = *(const f32x4*)(sg + dvt * 32 + 8 * j + 4 * hi);
                    u32x2 w; w.x = pk2(o[dvt][4 * j] * rstd * g[0], o[dvt][4 * j + 1] * rstd * g[1]); w.y = pk2(o[dvt][4 * j + 2] * rstd * g[2], o[dvt][4 * j + 3] * rstd * g[3]);
                    *(u32x2*)(orow + dvt * 32 + 8 * j) = w; }
                __builtin_amdgcn_sched_barrier(0);
            }
        }
        LDS_WAIT(); BAR();
    }
}

__device__ __forceinline__ void chain_phase(ldsp lds, bf16_t* rp, const bf16_t* P, bool dry) {
    const int tid = fresh_tid(), lane = tid & 63, wid = __builtin_amdgcn_readfirstlane(tid >> 6), fr = lane & 15, fq = lane >> 4;
    constexpr int STAGE = 32768, NSTG = 4;
    const int chain = vcu_of_block(), b = chain >> 4, h = (chain >> 2) & 3, sl = chain & 3;
    const size_t tok0 = (size_t)b * SEQ;
    const float lg = __log2f(1.f - exp2f(-5.f - (float)h));
    const float gamma = exp2f(lg), g127 = exp2f(lg * 127.f), g128 = exp2f(lg * 128.f);
    const bf16_t* vbase = rp + tok0 * 6144 + 2048 + h * 512 + sl * 128;
    const bf16_t* qbase = rp + tok0 * 6144 + h * 256;
    const bf16_t* kbase = rp + tok0 * 6144 + 1024 + h * 256;
    const bf16_t* pbase = P + (size_t)((b * 4 + h) * 16) * 16384;
    unsigned vsrc0, psrc0, qsrc0, ksrc0;
    { const int row = 4 * wid + (lane >> 4); vsrc0 = (unsigned)(row * 6144 * 2 + (((lane & 15) ^ ((row & 7) << 1)) << 4)); psrc0 = (unsigned)(row * 256 + (((lane & 15) ^ (row & 15)) << 4)); }
    { const int row = 8 * wid + (lane >> 3); qsrc0 = (unsigned)(row * 6144 * 2 + (((lane & 7) ^ ((row >> 1) & 7)) << 4)); ksrc0 = (unsigned)(row * 6144 * 2 + (((lane & 7) ^ (((row >> 1) & 3) << 1)) << 4)); }
    auto issue = [&](int s, int g) {
        ldsp st = lds + s * STAGE; const int c = g / 6, kind = g - c * 6; const size_t coff = (size_t)c * 128 * 6144 * 2;
        if (kind == 0) {
            const char* bp = (const char*)vbase + coff;
#pragma unroll
            for (int jj = 0; jj < 4; ++jj) glds16(bp + (size_t)jj * 32 * 12288 + vsrc0, st + (wid + 8 * jj) * 1024);
        } else if (kind == 5) {
            const char* bp = (const char*)pbase + (size_t)c * 32768;
#pragma unroll
            for (int jj = 0; jj < 4; ++jj) glds16(bp + (size_t)jj * 32 * 256 + psrc0, st + (wid + 8 * jj) * 1024);
        } else { const int p = kind - 1;
            const char* bq = (const char*)qbase + coff + p * 128; const char* bk = (const char*)kbase + coff + p * 128;
#pragma unroll
            for (int jj = 0; jj < 2; ++jj) glds16(bq + (size_t)jj * 64 * 12288 + qsrc0, st + (wid + 8 * jj) * 1024);
#pragma unroll
            for (int jj = 0; jj < 2; ++jj) glds16(bk + (size_t)jj * 64 * 12288 + ksrc0, st + 16384 + (wid + 8 * jj) * 1024);
        }
    };
    const int tq = fr >> 2, tp = fr & 3;
    const int vrow = 4 * fq + tq;
    const int vfo = vrow * 256 + ((((2 * wid + (tp >> 1)) ^ ((vrow & 7) << 1)) & 15) << 4) + (tp & 1) * 8;
    const int ksw = ((vrow >> 1) & 3) << 1;
    const int kfo0 = 16384 + vrow * 128 + ((((tp >> 1) ^ ksw) & 7) << 4) + (tp & 1) * 8;
    const int qsw = fr >> 1;
    const int qfo0 = fr * 128 + ((((fq >> 1) ^ qsw) & 7) << 4) + (fq & 1) * 8;
    const int pfo0 = fr * 256 + ((((fq >> 1) ^ fr) & 15) << 4) + (fq & 1) * 8;

    f32x4 R[16];
#pragma unroll
    for (int i = 0; i < 16; ++i) R[i] = (f32x4){0.f, 0.f, 0.f, 0.f};
    f32x4 o[8];
#pragma unroll
    for (int it = 0; it < 8; ++it) o[it] = (f32x4){0.f, 0.f, 0.f, 0.f};
    bf16x8 vf[4];
#pragma unroll
    for (int s4 = 0; s4 < 4; ++s4) vf[s4] = (bf16x8){0, 0, 0, 0, 0, 0, 0, 0};
    constexpr int NG = 16 * 6;
    BAR();
    issue(0, 0); issue(1, 1); issue(2, 2);
    for (int c = 0; c < 16; ++c) {
        auto step = [&](auto KC) {
            constexpr int kind = decltype(KC)::value;
            const int g = c * 6 + kind;
            if (g + 2 < NG) wait_vm<8>(); else if (g + 1 < NG) wait_vm<4>(); else wait_vm<0>();
            BAR();
            if (g + 3 < NG) issue((g + 3) & 3, g + 3);
            ldsp st = lds + (g & 3) * STAGE;
            if constexpr (kind == 0) {
#pragma unroll
                for (int s4 = 0; s4 < 4; ++s4) vf[s4] = tr2(st + vfo + s4 * 8192, st + vfo + s4 * 8192 + 4096);
#pragma unroll
                for (int it = 0; it < 8; ++it) o[it] = (f32x4){0.f, 0.f, 0.f, 0.f};
            } else if constexpr (kind == 5) {
#pragma unroll
                for (int it = 0; it < 8; ++it) o[it] = o[it] * gamma;
                int pb = pfo0; asm volatile("" : "+v"(pb));
                bf16x8 fa[4], fb[4];
                auto loadp = [&](bf16x8 (&d)[4], int grp) { const int s4 = grp >> 1, hb = (grp & 1) * 4; const int p0 = pb ^ ((4 * s4) << 4), p1 = pb ^ ((4 * s4 + 2) << 4);
#pragma unroll
                    for (int i = 0; i < 4; ++i) d[i] = rd2x64(st + p0 + (hb + i) * 4096, st + p1 + (hb + i) * 4096); };
                auto mmap = [&](const bf16x8 (&f)[4], int grp) { const int s4 = grp >> 1, hb = (grp & 1) * 4;
#pragma unroll
                    for (int i = 0; i < 4; ++i) o[hb + i] = __builtin_amdgcn_mfma_f32_16x16x32_bf16(vf[s4], f[i], o[hb + i], 0, 0, 0); };
                loadp(fa, 0);
#pragma unroll
                for (int grp = 0; grp < 8; grp += 2) {
                    loadp(fb, grp + 1); mmap(fa, grp); __builtin_amdgcn_sched_barrier(0);
                    if (grp + 2 < 8) loadp(fa, grp + 2);
                    mmap(fb, grp + 1); __builtin_amdgcn_sched_barrier(0);
                }
                bf16_t* ob = rp + (tok0 + (size_t)c * 128) * 6144 + 2048 + h * 512 + sl * 128 + 16 * wid + 4 * fq;
#pragma unroll
                for (int it = 0; it < 8; ++it) { u32x2 w; w.x = pk2(o[it][0], o[it][1]); w.y = pk2(o[it][2], o[it][3]); if (!dry) *(u32x2*)(ob + (size_t)(16 * it + fr) * 6144) = w; else asm volatile("" :: "v"(w)); }
            } else {
                constexpr int p = kind - 1;
                bf16x8 rf[2];
#pragma unroll
                for (int s2 = 0; s2 < 2; ++s2) { u32x4 w; const f32x4 r0 = R[4 * p + 2 * s2], r1 = R[4 * p + 2 * s2 + 1];
                    w.x = pk2(r0[0], r0[1]); w.y = pk2(r0[2], r0[3]); w.z = pk2(r1[0], r1[1]); w.w = pk2(r1[2], r1[3]); rf[s2] = __builtin_bit_cast(bf16x8, w); }
                int qb = qfo0; asm volatile("" : "+v"(qb));
                int kb = kfo0; asm volatile("" : "+v"(kb));
                bf16x8 fa[4], fb[4];
                auto loadq = [&](bf16x8 (&d)[4], int grp) { const int s2 = grp >> 1, hb = (grp & 1) * 4; const int q0 = qb ^ ((4 * s2) << 4), q1 = qb ^ ((4 * s2 + 2) << 4);
#pragma unroll
                    for (int i = 0; i < 4; ++i) d[i] = rd2x64(st + q0 + (hb + i) * 2048, st + q1 + (hb + i) * 2048); };
                auto mmaq = [&](const bf16x8 (&f)[4], int grp) { const int s2 = grp >> 1, hb = (grp & 1) * 4;
#pragma unroll
                    for (int i = 0; i < 4; ++i) o[hb + i] = __builtin_amdgcn_mfma_f32_16x16x32_bf16(rf[s2], f[i], o[hb + i], 0, 0, 0); };
                auto loadk = [&](bf16x8 (&d)[4], int s4) {
#pragma unroll
                    for (int dkt = 0; dkt < 4; ++dkt) { const int ko = kb ^ (dkt << 5); d[dkt] = tr2(st + ko + s4 * 4096, st + ko + s4 * 4096 + 2048); } };
                f32x4 au[4];
#pragma unroll
                for (int dkt = 0; dkt < 4; ++dkt) au[dkt] = (f32x4){0.f, 0.f, 0.f, 0.f};
                auto mmak = [&](const bf16x8 (&f)[4], int s4) {
#pragma unroll
                    for (int dkt = 0; dkt < 4; ++dkt) au[dkt] = __builtin_amdgcn_mfma_f32_16x16x32_bf16(f[dkt], vf[s4], au[dkt], 0, 0, 0); };
                loadq(fa, 0);
                loadq(fb, 1); mmaq(fa, 0); __builtin_amdgcn_sched_barrier(0);
                loadq(fa, 2); mmaq(fb, 1); __builtin_amdgcn_sched_barrier(0);
                loadq(fb, 3); mmaq(fa, 2); __builtin_amdgcn_sched_barrier(0);
                loadk(fa, 0); mmaq(fb, 3); __builtin_amdgcn_sched_barrier(0);
                loadk(fb, 1); mmak(fa, 0); __builtin_amdgcn_sched_barrier(0);
                loadk(fa, 2); mmak(fb, 1); __builtin_amdgcn_sched_barrier(0);
                loadk(fb, 3); mmak(fa, 2); __builtin_amdgcn_sched_barrier(0);
                mmak(fb, 3);
#pragma unroll
                for (int dkt = 0; dkt < 4; ++dkt) R[4 * p + dkt] = R[4 * p + dkt] * g128 + au[dkt] * g127;
                __builtin_amdgcn_sched_barrier(0);
            }
        };
        step(std::integral_constant<int, 0>{}); step(std::integral_constant<int, 1>{}); step(std::integral_constant<int, 2>{});
        step(std::integral_constant<int, 3>{}); step(std::integral_constant<int, 4>{}); step(std::integral_constant<int, 5>{});
    }
}

__device__ __forceinline__ void gnorm_phase(bf16_t* rp, const float* gn, int gw, int ngw, int lane, bool dry) {
    f32x4 w0[4], w1[4];
#pragma unroll
    for (int hh = 0; hh < 4; ++hh) { w0[hh] = *(const f32x4*)(gn + hh * 512 + 8 * lane); w1[hh] = *(const f32x4*)(gn + hh * 512 + 8 * lane + 4); }
    for (int row = gw; row < T; row += ngw) {
        bf16_t* orow = rp + (size_t)row * 6144 + 2048; const bf16_t* grow = rp + (size_t)row * 6144 + 4096;
        u32x4 ov[4], gv[4];
#pragma unroll
        for (int hh = 0; hh < 4; ++hh) { ov[hh] = *(const u32x4*)(orow + hh * 512 + 8 * lane); gv[hh] = *(const u32x4*)(grow + hh * 512 + 8 * lane); }
#pragma unroll
        for (int hh = 0; hh < 4; ++hh) {
            float of[8] = {bf_lo(ov[hh].x), bf_hi(ov[hh].x), bf_lo(ov[hh].y), bf_hi(ov[hh].y), bf_lo(ov[hh].z), bf_hi(ov[hh].z), bf_lo(ov[hh].w), bf_hi(ov[hh].w)};
            float gf[8] = {bf_lo(gv[hh].x), bf_hi(gv[hh].x), bf_lo(gv[hh].y), bf_hi(gv[hh].y), bf_lo(gv[hh].z), bf_hi(gv[hh].z), bf_lo(gv[hh].w), bf_hi(gv[hh].w)};
            float ss = 0.f;
#pragma unroll
            for (int e = 0; e < 8; ++e) ss += of[e] * of[e];
            const float rstd = rsqrtf(wave_sum(ss) * (1.f / 512.f) + 1e-6f);
            float y[8];
#pragma unroll
            for (int e = 0; e < 8; ++e) y[e] = silu_f(gf[e]) * of[e] * rstd * (e < 4 ? w0[hh][e] : w1[hh][e - 4]);
            u32x4 w; w.x = pk2(y[0], y[1]); w.y = pk2(y[2], y[3]); w.z = pk2(y[4], y[5]); w.w = pk2(y[6], y[7]);
            if (!dry) *(u32x4*)(orow + hh * 512 + 8 * lane) = w; else asm volatile("" :: "v"(w));
        }
    }
}

__device__ __forceinline__ void router_phase(ldsp lds, const bf16_t* XRBp, const float* mod_sh, const float* mod_G, const bf16_t* rwt  , const float* rbias,
                                             bf16_t* H, int* sel_e, float* sel_w, int* sel_p, int* tokl, unsigned* cnt, int tile0, int tile_end, int tstep, int wave, int lane, bool dry) {
    LAS float* lg = (LAS float*)(lds + wave * 8192);
    LAS int* st2 = (LAS int*)(lds + wave * 8192 + 4096);
    LAS float* Gl = (LAS float*)(lds + 131072); LAS float* SHl = Gl + 1024;
    const float rb = rbias[lane];
    const int fr = lane & 15, fq = lane >> 4;
    for (int tile = tile0; tile < tile_end; tile += tstep) {
        const int row = tile * 16 + fr, b = row >> 11;
        const bf16_t* xr = XRBp + (size_t)row * XRB_LD + XRB_OFF + 8 * fq;
        bf16_t* hrow = H + (size_t)row * D + 8 * fq;
        { const int t4 = (wave * 64 + lane) * 4; const float* src = (t4 < 1024 ? mod_G : mod_sh - 1024) + (size_t)b * 6144 + t4; *(LAS f32x4*)(Gl + t4) = *(const f32x4*)src; }
        auto issue_chunk = [&](int ch) {
            ldsp buf = lds + (ch & 1) * 65536;
#pragma unroll
            for (int j = 0; j < 8; ++j) { const int i = wave + 8 * j, r2 = 2 * i + (lane >> 5), lc = (lane & 31) ^ (r2 & 15);
                glds16((const char*)rwt + (size_t)r2 * 2048 + (size_t)ch * 512 + lc * 16, buf + i * 1024); }
        };
        issue_chunk(0);
        float ss = 0.f;
#pragma unroll 8
        for (int s = 0; s < 32; ++s) { const u32x4 xb = *(const u32x4*)(xr + 32 * s);
            const float e0 = bf_lo(xb.x), e1 = bf_hi(xb.x), e2 = bf_lo(xb.y), e3 = bf_hi(xb.y), e4 = bf_lo(xb.z), e5 = bf_hi(xb.z), e6 = bf_lo(xb.w), e7 = bf_hi(xb.w);
            ss += e0 * e0 + e1 * e1 + e2 * e2 + e3 * e3 + e4 * e4 + e5 * e5 + e6 * e6 + e7 * e7; }
        ss += lane_xor<16>(ss);
        { auto rr = __builtin_amdgcn_permlane32_swap(__float_as_uint(ss), __float_as_uint(ss), false, false); ss = __uint_as_float(rr[0]) + __uint_as_float(rr[1]); }
        const float rstd = rsqrtf(ss * (1.f / D) + 1e-6f);
        f32x4 acc[4];
#pragma unroll
        for (int et = 0; et < 4; ++et) acc[et] = (f32x4){0.f, 0.f, 0.f, 0.f};
        u32x4 xc[8], xn[8];
#pragma unroll
        for (int i = 0; i < 8; ++i) xc[i] = *(const u32x4*)(xr + 32 * i);
        for (int ch = 0; ch < 4; ++ch) {
            if (ch == 0) wait_vm<0>(); else wait_vm<8>();
            LDS_WAIT();
            BAR();
            if (ch + 1 < 4) issue_chunk(ch + 1);
#pragma unroll
            for (int i = 0; i < 8; ++i) xn[i] = *(const u32x4*)(xr + 256 * ((ch + 1) & 3) + 32 * i);
            ldsp buf = lds + (ch & 1) * 65536;
#pragma unroll
            for (int sl = 0; sl < 8; ++sl) {
                const int s = 8 * ch + sl;
                const u32x4 xb = xc[sl];
                const f32x4 x0 = {bf_lo(xb.x), bf_hi(xb.x), bf_lo(xb.y), bf_hi(xb.y)}, x1 = {bf_lo(xb.z), bf_hi(xb.z), bf_lo(xb.w), bf_hi(xb.w)};
                const f32x4 g0 = *(LAS f32x4*)(Gl + 32 * s + 8 * fq), g1 = *(LAS f32x4*)(Gl + 32 * s + 8 * fq + 4), s0 = *(LAS f32x4*)(SHl + 32 * s + 8 * fq), s1 = *(LAS f32x4*)(SHl + 32 * s + 8 * fq + 4);
                const f32x4 h0 = x0 * rstd * g0 + s0, h1 = x1 * rstd * g1 + s1;
                u32x4 hi; hi.x = pk2(h0[0], h0[1]); hi.y = pk2(h0[2], h0[3]); hi.z = pk2(h1[0], h1[1]); hi.w = pk2(h1[2], h1[3]);
                *(u32x4*)(hrow + 32 * s) = hi;
                u32x4 lo; lo.x = pk2(h0[0] - bf_lo(hi.x), h0[1] - bf_hi(hi.x)); lo.y = pk2(h0[2] - bf_lo(hi.y), h0[3] - bf_hi(hi.y));
                lo.z = pk2(h1[0] - bf_lo(hi.z), h1[1] - bf_hi(hi.z)); lo.w = pk2(h1[2] - bf_lo(hi.w), h1[3] - bf_hi(hi.w));
                const bf16x8 ahi = __builtin_bit_cast(bf16x8, hi), alo = __builtin_bit_cast(bf16x8, lo);
                const int pc = (((4 * sl + fq) ^ fr) & 31) << 4;
#pragma unroll
                for (int et = 0; et < 4; ++et) {
                    const bf16x8 bh = *(LAS bf16x8*)(buf + (16 * et + fr) * 512 + pc), bl = *(LAS bf16x8*)(buf + (64 + 16 * et + fr) * 512 + pc);
                    acc[et] = __builtin_amdgcn_mfma_f32_16x16x32_bf16(ahi, bh, acc[et], 0, 0, 0);
                    acc[et] = __builtin_amdgcn_mfma_f32_16x16x32_bf16(ahi, bl, acc[et], 0, 0, 0);
                    acc[et] = __builtin_amdgcn_mfma_f32_16x16x32_bf16(alo, bh, acc[et], 0, 0, 0); }
            }
#pragma unroll
            for (int i = 0; i < 8; ++i) xc[i] = xn[i];
        }
        LDS_WAIT(); BAR();
#pragma unroll
        for (int et = 0; et < 4; ++et)
#pragma unroll
            for (int r = 0; r < 4; ++r) lg[(4 * fq + r) * 64 + 16 * et + fr] = acc[et][r];
        LDS_WAIT();
        int myc = 0;
        for (int tt = 0; tt < 16; ++tt) {
            const float logit = lg[tt * 64 + lane];
            const float score = 1.f / (1.f + __expf(-logit)), choice = score + rb;
            int rk = 0;
#pragma unroll
            for (int d = 1; d < 8; ++d) { const int oi = (lane + d) & 7; const float other = __int_as_float(__builtin_amdgcn_ds_bpermute(((lane & ~7) | oi) << 2, __float_as_int(choice))); rk += (other > choice || (other == choice && oi < (lane & 7))) ? 1 : 0; }
            float gs = rk < 2 ? choice : 0.f;
            gs += lane_xor<1>(gs); gs += lane_xor<2>(gs); gs += lane_xor<4>(gs);
            int rg = 0;
#pragma unroll
            for (int j = 0; j < 8; ++j) { const float gj = __int_as_float(__builtin_amdgcn_readlane(__float_as_int(gs), 8 * j)); rg += (gj > gs || (gj == gs && j < (lane >> 3))) ? 1 : 0; }
            const float c2 = rg < 4 ? choice : -__builtin_inff();
            const unsigned ub = __float_as_uint(c2); unsigned key = (ub & 0x80000000u) ? ~ub : (ub | 0x80000000u); key = (key & ~63u) | (unsigned)(63 - lane);
            unsigned thr = 0u;
#pragma unroll
            for (int bit = 31; bit >= 0; --bit) { const unsigned cand = thr | (1u << bit); if (__popcll(__ballot(key >= cand)) >= 8) thr = cand; }
            const bool chosen = key >= thr;
            const unsigned long long cm = __ballot(chosen);
            const int r8 = __popcll(cm & ((1ull << lane) - 1ull));
            const float wsum = wave_sum(chosen ? score : 0.f);
            lg[tt * 64 + lane] = score / wsum * 2.5f;
            st2[tt * 64 + lane] = chosen ? ((myc << 8) | r8) : -1;
            myc += chosen ? 1 : 0;
        }
        const int chunk = (tile * 16) / CH_TOK;
        unsigned base = 0;
        if (!dry && myc > 0) base = atomicAdd(&cnt[chunk * 64 + lane], (unsigned)myc);
        if (dry) asm volatile("" :: "v"(myc));
        LDS_WAIT();
        for (int tt = 0; tt < 16; ++tt) {
            const int code = st2[tt * 64 + lane];
            if (!dry && code >= 0) { const int tok = tile * 16 + tt, r8 = code & 255; const unsigned pos = base + (unsigned)(code >> 8);
                sel_e[tok * 8 + r8] = lane; sel_w[tok * 8 + r8] = lg[tt * 64 + lane]; sel_p[tok * 8 + r8] = (int)pos;
                tokl[(size_t)(chunk * 64 + lane) * CH_TOK + pos] = tok; }
        }
        LDS_WAIT();
    }
}

__device__ __forceinline__ void build_tstart(const unsigned* cnt, int c, LAS int* ts) {
    const int l = fresh_tid();
    if (l < 64) {
        const int n = ((int)cnt[c * 64 + l] + MTILE - 1) / MTILE; int incl = n;
#pragma unroll
        for (int o = 1; o < 64; o <<= 1) { const int v = __builtin_amdgcn_ds_bpermute((l >= o ? l - o : l) << 2, incl); if (l >= o) incl += v; }
        ts[l] = incl - n; if (l == 63) { ts[64] = incl; ts[65] = incl + CH_TOK / MTILE; }
    }
}
struct MoeUpSrc {
    using Epi = EpiSwiGLU;
    const unsigned char* ws; const unsigned* cnt; int c; const LAS int* ts; int total, vcu;
    template <int LA> __device__ __forceinline__ bool setup(int i, const char*& bA, unsigned (&oA)[LA], const char*& bB, Epi& e, int& n0, int wid, int lane) const {
        const int Lt = vcu + GRID * i; if (Lt >= total) return false;
        const int mt = Lt >> 1, nt = Lt & 1;
        int ex = 0;
#pragma unroll
        for (int stp = 64; stp >= 1; stp >>= 1) if (ex + stp <= 64 && ts[ex + stp] <= mt) ex += stp;
        const int ml = mt - ts[ex];
        const bf16_t* Bt = ex < 64 ? (const bf16_t*)(ws + WS_W13) + (size_t)ex * 512 * D : (const bf16_t*)(ws + WS_WS13);
        const int* list = (const int*)(ws + WS_TOKL) + (size_t)(c * 64 + (ex & 63)) * CH_TOK; const int n = ex < 64 ? (int)cnt[c * 64 + ex] : 0;
#pragma unroll
        for (int j = 0; j < LA; ++j) { const int row = stage_row(wid, j, lane), g = ml * MTILE + row;
            const int tok = ex < 64 ? (g < n ? list[g] : c * CH_TOK) : c * CH_TOK + g;
            oA[j] = (unsigned)tok * (unsigned)(D * 2) + (unsigned)stage_chunk(row, lane); }
        bA = (const char*)(ws + WS_H); bB = (const char*)(Bt + (size_t)(nt * 256) * D);
        e = EpiSwiGLU{(bf16_t*)(ws + WS_ACT), mt * MTILE}; n0 = nt * 256; return true;
    }
    static constexpr size_t ldb = D;
};
struct MoeUpX {
    static constexpr int K = D, LDA = D; static constexpr bool GATHER = true;
    const unsigned char* ws; const unsigned* cnt; int c; const LAS int* ts; int total, vcu;
    __device__ __forceinline__ bool next(int i, pg8::UnitX& u) const {
        const int Lt = vcu + GRID * i; if (Lt >= total) return false;
        const int mt = Lt >> 1, nt = Lt & 1;
        int ex = 0;
#pragma unroll
        for (int stp = 64; stp >= 1; stp >>= 1) if (ex + stp <= 64 && ts[ex + stp] <= mt) ex += stp;
        const bf16_t* Bt = ex < 64 ? (const bf16_t*)(ws + WS_W13) + (size_t)ex * 512 * D : (const bf16_t*)(ws + WS_WS13);
        u.pm = mt; u.pn = nt; u.aBase = (const char*)(ws + WS_H); u.bBase = (const char*)(Bt + (size_t)(nt * 256) * D);
        u.list = ex < 64 ? (const int*)(ws + WS_TOKL) + (size_t)(c * 64 + ex) * CH_TOK : nullptr; u.cnt = ex < 64 ? (int)cnt[c * 64 + ex] : 0;
        u.r0 = (mt - ts[ex]) * MTILE; u.dummy = c * CH_TOK; return true;
    }
};
__device__ __forceinline__ void moe_up_phase(ldsp lds, const unsigned char* ws, const unsigned* cnt, int c, const LAS int* ts) {
    MoeUpX src{ws, cnt, c, ts, ts[65] * 2, vcu_of_block()};
    pg8::gemm_phase_x(lds, src, pg8::EpiSwiGLUx{(bf16_t*)(ws + WS_ACT)});
}
struct MoeDownSrc {
    using Epi = EpiStoreBf16;
    const unsigned char* ws; const LAS int* ts; int total, vcu;
    template <int LA> __device__ __forceinline__ bool setup(int i, const char*& bA, unsigned (&oA)[LA], const char*& bB, Epi& e, int& n0, int wid, int lane) const {
        const int Lt = vcu + GRID * i; if (Lt >= total) return false;
        const int mt = Lt >> 2, nt = Lt & 3;
        int ex = 0;
#pragma unroll
        for (int stp = 64; stp >= 1; stp >>= 1) if (ex + stp <= 64 && ts[ex + stp] <= mt) ex += stp;
        const bf16_t* act = (const bf16_t*)(ws + WS_ACT);
        const bf16_t* w2 = ex < 64 ? (const bf16_t*)(ws + WS_W2) + (size_t)ex * D * 256 : (const bf16_t*)(ws + WS_WS2);
#pragma unroll
        for (int j = 0; j < LA; ++j) { const int row = stage_row(wid, j, lane); oA[j] = (unsigned)(row * 512 + stage_chunk(row, lane)); }
        bA = (const char*)(act + (size_t)(mt * MTILE) * 256); bB = (const char*)(w2 + (size_t)(nt * 256) * 256);
        e = EpiStoreBf16{(bf16_t*)(ws + WS_YS), (size_t)D, mt * MTILE}; n0 = nt * 256; return true;
    }
    static constexpr size_t ldb = 256;
};
struct MoeDownX {
    static constexpr int K = 256, LDA = 256; static constexpr bool GATHER = false;
    const unsigned char* ws; const LAS int* ts; int total, vcu;
    __device__ __forceinline__ bool next(int i, pg8::UnitX& u) const {
        const int Lt = vcu + GRID * i; if (Lt >= total) return false;
        const int mt = Lt >> 2, nt = Lt & 3;
        int ex = 0;
#pragma unroll
        for (int stp = 64; stp >= 1; stp >>= 1) if (ex + stp <= 64 && ts[ex + stp] <= mt) ex += stp;
        const bf16_t* w2 = ex < 64 ? (const bf16_t*)(ws + WS_W2) + (size_t)ex * D * 256 : (const bf16_t*)(ws + WS_WS2);
        u.pm = mt; u.pn = nt; u.aBase = (const char*)((const bf16_t*)(ws + WS_ACT) + (size_t)(mt * MTILE) * 256); u.bBase = (const char*)(w2 + (size_t)(nt * 256) * 256);
        u.list = nullptr; u.cnt = 0; u.r0 = 0; u.dummy = 0; return true;
    }
};
__device__ __forceinline__ void moe_down_phase(ldsp lds, const unsigned char* ws, const LAS int* ts) {
    MoeDownX src{ws, ts, ts[65] * 4, vcu_of_block()};
    pg8::gemm_phase_x(lds, src, pg8::EpiYx{(unsigned char*)(ws + WS_YS)});
}
__device__ __forceinline__ void moe_combine_phase(const unsigned char* ws, float* OUT, bf16_t* XRBp, int c, const LAS int* ts, const float* gate_f  , bool last_layer,
                                                  const float* mod_sh_next, const float* mod_G_next, bf16_t* H, const float* fnorm, int gw, int ngw, int lane, bool dry) {
    const unsigned char* ys = ws + WS_YS; const int* sel_e = (const int*)(ws + WS_SELE); const float* sel_w = (const float*)(ws + WS_SELW); const int* sel_p = (const int*)(ws + WS_SELP);
    int slot[9]; float wk[9];
    auto selload = [&](int tl, int (&sl)[9], float (&ww)[9]) { const int tok = c * CH_TOK + tl;
#pragma unroll
        for (int k = 0; k < 8; ++k) { const int e = sel_e[tok * 8 + k]; sl[k] = ts[e] * MTILE + sel_p[tok * 8 + k]; ww[k] = sel_w[tok * 8 + k]; }
        sl[8] = ts[64] * MTILE + tl; ww[8] = 1.f; };
    if (gw < CH_TOK) selload(gw, slot, wk);
    for (int tl = gw; tl < CH_TOK; tl += ngw) {
        const int tok = c * CH_TOK + tl; const int b = tok >> 11;
        u32x2 yv[9][2];
#pragma unroll
        for (int k = 0; k < 9; ++k) { const unsigned char* yr = ys + (size_t)slot[k] * D; yv[k][0] = *(const u32x2*)(yr + 8 * lane); yv[k][1] = *(const u32x2*)(yr + 8 * lane + 512); }
        int nslot[9]; float nwk[9];
        if (tl + ngw < CH_TOK) selload(tl + ngw, nslot, nwk);
        else {
#pragma unroll
            for (int k = 0; k < 9; ++k) { nslot[k] = 0; nwk[k] = 0.f; } }
        float acc[16];
#pragma unroll
        for (int i = 0; i < 16; ++i) acc[i] = 0.f;
#pragma unroll
        for (int k = 0; k < 9; ++k) { const float w = wk[k];
#pragma unroll
            for (int j = 0; j < 2; ++j) { const u32x2 v = yv[k][j];
                const f32x2 p0 = __builtin_amdgcn_cvt_pk_f32_fp8((int)v.x, false), p1 = __builtin_amdgcn_cvt_pk_f32_fp8((int)v.x, true);
                const f32x2 p2 = __builtin_amdgcn_cvt_pk_f32_fp8((int)v.y, false), p3 = __builtin_amdgcn_cvt_pk_f32_fp8((int)v.y, true);
                acc[8 * j + 0] += w * p0[0]; acc[8 * j + 1] += w * p0[1]; acc[8 * j + 2] += w * p1[0]; acc[8 * j + 3] += w * p1[1];
                acc[8 * j + 4] += w * p2[0]; acc[8 * j + 5] += w * p2[1]; acc[8 * j + 6] += w * p3[0]; acc[8 * j + 7] += w * p3[1]; } }
#pragma unroll
        for (int k = 0; k < 9; ++k) { slot[k] = nslot[k]; wk[k] = nwk[k]; }
        float* xr = OUT + (size_t)tok * D; bf16_t* xb = XRBp + (size_t)tok * XRB_LD + XRB_OFF; const float* gf = gate_f + (size_t)b * 6144; float ss = 0.f; float xn[16];
#pragma unroll
        for (int j = 0; j < 2; ++j) { const u32x4 xw = *(const u32x4*)(xb + 8 * lane + 512 * j);
            const float xf[8] = {bf_lo(xw.x), bf_hi(xw.x), bf_lo(xw.y), bf_hi(xw.y), bf_lo(xw.z), bf_hi(xw.z), bf_lo(xw.w), bf_hi(xw.w)};
#pragma unroll
            for (int q = 0; q < 2; ++q) { const int col = 8 * lane + 512 * j + 4 * q; const f32x4 gv = *(const f32x4*)(gf + col);
#pragma unroll
                for (int e = 0; e < 4; ++e) { const float v = xf[4 * q + e] + gv[e] * acc[8 * j + 4 * q + e]; xn[8 * j + 4 * q + e] = v; ss += v * v; } } }
        const float rstd = rsqrtf(wave_sum(ss) * (1.f / D) + 1e-6f);
        if (last_layer) {
#pragma unroll
            for (int j = 0; j < 2; ++j)
#pragma unroll
                for (int q = 0; q < 2; ++q) { const int col = 8 * lane + 512 * j + 4 * q; const f32x4 g = *(const f32x4*)(fnorm + col); f32x4 ov;
#pragma unroll
                    for (int e = 0; e < 4; ++e) ov[e] = xn[8 * j + 4 * q + e] * rstd * g[e];
                    if (!dry) *(f32x4*)(xr + col) = ov; else asm volatile("" :: "v"(ov)); }
        } else {
            const float* sh = mod_sh_next + (size_t)b * 6144; const float* Gn = mod_G_next + (size_t)b * 6144; bf16_t* hrow = H + (size_t)tok * D;
#pragma unroll
            for (int j = 0; j < 2; ++j) { u32x4 hw, xw2;
#pragma unroll
                for (int q = 0; q < 2; ++q) { const int col = 8 * lane + 512 * j + 4 * q; const f32x4 g = *(const f32x4*)(Gn + col), s0 = *(const f32x4*)(sh + col); f32x4 xv, hv;
#pragma unroll
                    for (int e = 0; e < 4; ++e) { xv[e] = xn[8 * j + 4 * q + e]; hv[e] = xv[e] * rstd * g[e] + s0[e]; }
                    if (q == 0) { hw.x = pk2(hv[0], hv[1]); hw.y = pk2(hv[2], hv[3]); xw2.x = pk2(xv[0], xv[1]); xw2.y = pk2(xv[2], xv[3]); }
                    else { hw.z = pk2(hv[0], hv[1]); hw.w = pk2(hv[2], hv[3]); xw2.z = pk2(xv[0], xv[1]); xw2.w = pk2(xv[2], xv[3]); } }
                if (!dry) { *(u32x4*)(hrow + 8 * lane + 512 * j) = hw; *(u32x4*)(xb + 8 * lane + 512 * j) = xw2; } else asm volatile("" :: "v"(hw), "v"(xw2)); }
        }
    }
}

struct PSrc {
    using Epi = EpiCausalP;
    const bf16_t* rp; bf16_t* P;
    template <int LA> __device__ __forceinline__ bool setup(int i, const char*& bA, unsigned (&oA)[LA], const char*& bB, Epi& e, int& n0, int wid, int lane) const {
        const int u = blockIdx.x + GRID * i; if (u >= 1024) return false;
        const int bh = u >> 4, c = u & 15, b = bh >> 2, h = bh & 3;
        const bf16_t* qa = rp + ((size_t)b * SEQ + c * 128) * 6144 + h * 256;
#pragma unroll
        for (int j = 0; j < LA; ++j) { const int row = stage_row(wid, j, lane); oA[j] = (unsigned)(row * 6144 * 2 + stage_chunk(row, lane)); }
        bA = (const char*)qa; bB = (const char*)(qa + 1024);
        e = EpiCausalP{P + (size_t)u * 16384}; n0 = 0; return true;
    }
    static constexpr size_t ldb = 6144;
};
#define TIC(cat) do { if (TIME_SEL >= 0 && blockIdx.x == 0 && threadIdx.x == 0) { const unsigned long long now_ = __builtin_amdgcn_s_memrealtime(); LAS unsigned long long* tb_ = (LAS unsigned long long*)(lds + LDS_MISC + 1024); if ((cat) == TIME_SEL) tb_[1] += now_ - tb_[0]; tb_[0] = now_; } } while (0)
#define FRESH_IDS() const int t_ = fresh_tid(); const int lane = t_ & 63, wave = __builtin_amdgcn_readfirstlane(t_ >> 6); const int gw = blockIdx.x * NWAVE + wave, ngw = GRID * NWAVE; (void)lane; (void)gw; (void)ngw
#define SEAM(cat) do { xcd_barrier(bar); TIC(cat); } while (0)
#define OUTPROJ_ROUTER(layer_, A_, lda_, Bt_, ldb_, K_, mk_, cat_) do { \
    pg8::dense(lds, A_, (int)(lda_), Bt_, T, D, K_, mk_); \
    SEAM(cat_); \
    { const float* modl_ = (const float*)(ws + WS_MOD) + (size_t)(layer_) * 16 * 6144; const int m0_ = vcu_of_block() * 128; FRESH_IDS(); \
      router_phase(lds, XRB, modl_ + 3072, modl_ + 4096, (const bf16_t*)(ws + WS_RWT) + (size_t)(layer_) * 2 * 64 * 1024, a.in[I_ROUTB] + (layer_) * 64, \
                   (bf16_t*)(ws + WS_H), (int*)(ws + WS_SELE), (float*)(ws + WS_SELW), (int*)(ws + WS_SELP), (int*)(ws + WS_TOKL), (unsigned*)(ws + WS_CNT) + (layer_) * 256, \
                   m0_ / 16 + wave, m0_ / 16 + wave + 1, 1, wave, lane, false); } \
  } while (0)
__device__ __forceinline__ void moe_layer(const Args& a, ldsp lds, const XcdBarrier& bar, int layer) {
    unsigned char* ws = a.ws;
    float* mod = (float*)(ws + WS_MOD); float* XR = a.out; bf16_t* XRB = (bf16_t*)a.out; bf16_t* H = (bf16_t*)(ws + WS_H);
    const float* modl = mod + (size_t)layer * 16 * 6144;
    const float* modn = mod + (size_t)16 * 6144;
    unsigned* cl = (unsigned*)(ws + WS_CNT) + layer * 256;
    LAS int* ts0 = (LAS int*)(lds + LDS_MISC); LAS int* ts1 = ts0 + 80;
    for (int c = 0; c <= NCHUNK; ++c) {
        __syncthreads();
        if (c < NCHUNK) build_tstart(cl, c, ts0);
        if (c > 0) build_tstart(cl, c - 1, ts1);
        __syncthreads();
        const bool comb_first = (blockIdx.x & 8) != 0;
        if (c > 0 && comb_first) { FRESH_IDS(); moe_combine_phase(ws, XR, XRB, c - 1, ts1, modl + 5120, layer == 1, modn, modn + 1024, H, a.in[I_FNORM], gw, ngw, lane, false); }
        if (c < NCHUNK) moe_up_phase(lds, ws, cl, c, ts0);
        if (c > 0 && !comb_first) { FRESH_IDS(); moe_combine_phase(ws, XR, XRB, c - 1, ts1, modl + 5120, layer == 1, modn, modn + 1024, H, a.in[I_FNORM], gw, ngw, lane, false); }
        if (c == NCHUNK) break;
        SEAM(6);
        moe_down_phase(lds, ws, ts0);
        SEAM(7);
    }
}
__global__ void __launch_bounds__(NTHR, 2) fwd_kernel(Args a) {
    extern __shared__ __attribute__((aligned(16))) unsigned char lds_raw[];
    ldsp lds = (ldsp)lds_raw;
    unsigned char* ws = a.ws;
    volatile LAS unsigned* st = (volatile LAS unsigned*)(lds + LDS_BYTES - 16);
    if (threadIdx.x < 4) st[threadIdx.x] = 0u;
    if (TIME_SEL >= 0 && threadIdx.x == 0) { LAS unsigned long long* tb_ = (LAS unsigned long long*)(lds + LDS_MISC + 1024); tb_[0] = __builtin_amdgcn_s_memrealtime(); tb_[1] = 0ull; }
    __syncthreads();
    XcdBarrier bar = xcd_barrier_post((unsigned*)(ws + WS_BAR), st);
    float* mod = (float*)(ws + WS_MOD);
    float* XR = a.out; bf16_t* XRB = (bf16_t*)a.out;
    bf16_t* H = (bf16_t*)(ws + WS_H);

    mod_items(a, lds);
    __syncthreads();
    { FRESH_IDS(); convert_dense_weights(a, lds, gw, ngw, wave, lane); }
    SEAM(0);
    { FRESH_IDS(); adaln_phase(a.in[I_X], mod, mod + 1024, H, gw, ngw, lane); }
    { FRESH_IDS();
      bf16_t* rwt = (bf16_t*)(ws + WS_RWT);
      for (int idx = blockIdx.x * NTHR + t_; idx < 2 * D * 64; idx += GRID * NTHR) { const int l2 = idx >> 16, k = (idx >> 6) & 1023, e = idx & 63;
          const float w = a.in[I_ROUTW][idx]; const unsigned hi = pk2(w, 0.f) & 0xffffu; const unsigned lo = pk2(w - bf_lo(hi), 0.f) & 0xffffu;
          rwt[((size_t)(l2 * 2 + 0) * 64 + e) * 1024 + k] = (bf16_t)hi; rwt[((size_t)(l2 * 2 + 1) * 64 + e) * 1024 + k] = (bf16_t)lo; } }
    SEAM(1);

    { const bool conv_first = (blockIdx.x & 8) != 0;
      if (conv_first) { FRESH_IDS(); convert_expert_weights(a, 0, lds, gw, ngw, wave, lane); __syncthreads(); }
      pg8::dense(lds, H, D, (const bf16_t*)(ws + WS_WQKV), T, 3072, D, pg8::EpiQKV{(bf16_t*)(ws + WS_QKV), (size_t)3072});
      if (!conv_first) { __syncthreads(); FRESH_IDS(); convert_expert_weights(a, 0, lds, gw, ngw, wave, lane); } }
    SEAM(2);
    { float d1 = 0.f, d2 = 0.f;
      for (int i = 0; i < 64; ++i) { d1 += a.in[I_LQ1][i] * a.in[I_LK1][i]; d2 += a.in[I_LQ2][i] * a.in[I_LK2][i]; }
      const float lam = __expf(d1) - __expf(d2) + 0.2f;
      attn_phase(lds, (const bf16_t*)(ws + WS_QKV), (bf16_t*)(ws + WS_AO), lam, a.in[I_SUBLN]); }
    SEAM(3);
    { const pg8::EpiRes<true> mk{a.in[I_X], XRB, mod + 2048};
      OUTPROJ_ROUTER(0, (const bf16_t*)(ws + WS_AO), D, (const bf16_t*)(ws + WS_WO), D, D, mk, 4); }
    SEAM(5);
    moe_layer(a, lds, bar, 0);
    SEAM(6);

    const float* mod1 = mod + (size_t)16 * 6144;
    { const bool conv_first = (blockIdx.x & 8) != 0;
      if (conv_first) { FRESH_IDS(); convert_expert_weights(a, 1, lds, gw, ngw, wave, lane); __syncthreads(); }
      pg8::dense(lds, H, D, (const bf16_t*)(ws + WS_WRI), T, 6144, D, pg8::EpiRet{(bf16_t*)(ws + WS_RP)});
      if (!conv_first) { __syncthreads(); FRESH_IDS(); convert_expert_weights(a, 1, lds, gw, ngw, wave, lane); } }
    SEAM(8);
    { PSrc src{(const bf16_t*)(ws + WS_RP), (bf16_t*)(ws + WS_P)};
      gemm_stream<2, 4, 4, 2, 3>(lds, 256, src); }
    SEAM(9);
    chain_phase(lds, (bf16_t*)(ws + WS_RP), (const bf16_t*)(ws + WS_P), false);
    SEAM(10);
    { FRESH_IDS(); gnorm_phase((bf16_t*)(ws + WS_RP), a.in[I_RGN], gw, ngw, lane, false); }
    SEAM(11);
    { const pg8::EpiRes<false> mk{XRB, XRB, mod1 + 2048};
      OUTPROJ_ROUTER(1, (const bf16_t*)(ws + WS_RP) + 2048, 6144, (const bf16_t*)(ws + WS_WRO), 2048, 2048, mk, 12); }
    SEAM(5);
    moe_layer(a, lds, bar, 1);
    if (TIME_SEL >= 0) {
        __syncthreads(); TIC(6);
        if (blockIdx.x == 0 && threadIdx.x == 0) { LAS unsigned long long* tb_ = (LAS unsigned long long*)(lds + LDS_MISC + 1024); const unsigned long long t0 = __builtin_amdgcn_s_memrealtime();
            while (__builtin_amdgcn_s_memrealtime() - t0 < tb_[1]) __builtin_amdgcn_s_sleep(8); }
    }
}

extern "C" void kernel_launch(void* const* d_in, const int* in_sizes, int n_in, void* d_out, int out_size, void* d_ws, size_t ws_size, hipStream_t stream) {
    static int ready = 0;
    if (ready == 0) {
        if (n_in != 25 || out_size != T * D || ws_size < WS_END) { fprintf(stderr, "kernel_launch: unexpected shapes (n_in %d out %d ws %zu need %zu)\n", n_in, out_size, ws_size, (size_t)WS_END); ready = -1; return; }
        (void)hipFuncSetAttribute((const void*)fwd_kernel, hipFuncAttributeMaxDynamicSharedMemorySize, LDS_BYTES);
        ready = 1;
    }
    if (ready < 0) return;
    (void)hipMemsetAsync(d_ws, 0, 65536, stream);
    Args a{};
    for (int i = 0; i < 25; ++i) a.in[i] = (const float*)d_in[i];
    a.out = (float*)d_out; a.ws = (unsigned char*)d_ws;
    hipLaunchKernelGGL(fwd_kernel, dim3(GRID), dim3(NTHR), LDS_BYTES, stream, a);
}
```

```cpp
#include <hip/hip_runtime.h>
#include <cstdio>
#include <cstdint>
#include <type_traits>

typedef unsigned short bf16_t;
typedef short bf16x8 __attribute__((ext_vector_type(8)));
typedef short bf16x4 __attribute__((ext_vector_type(4)));
typedef float f32x4 __attribute__((ext_vector_type(4)));
typedef float f32x2 __attribute__((ext_vector_type(2)));
typedef unsigned u32x4 __attribute__((ext_vector_type(4)));
typedef unsigned u32x2 __attribute__((ext_vector_type(2)));
#define LAS __attribute__((address_space(3)))
typedef LAS unsigned char* ldsp;

constexpr int T = 32768, D = 1024, NB = 16, SEQ = 2048;
constexpr int NTHR = 512, NWAVE = 8, GRID = 256;
constexpr int CH_TOK = 16384, NCHUNK = 2, MTILE = 256;
constexpr int SLOT_CAP = 163840;
constexpr float LOG2E = 1.4426950408889634f;
constexpr int XRB_LD = 2048, XRB_OFF = 1024;
#define TIME_MUL 8ull
#define TIME_SEL -1


constexpr size_t MiB = 1u << 20;
constexpr size_t WS_BAR = 0, WS_CNT = 16384, WS_RWT = 256 * 1024  , WS_MOD = 1 * MiB;
constexpr size_t WS_WQKV = 2 * MiB, WS_WO = 8 * MiB, WS_WRI = 10 * MiB, WS_WRO = 22 * MiB;
constexpr size_t WS_W13 = 26 * MiB, WS_W2 = 90 * MiB, WS_WS13 = 122 * MiB, WS_WS2 = 123 * MiB;
constexpr size_t WS_H = 124 * MiB, WS_P = WS_H;
constexpr size_t WS_BIG = 188 * MiB;
constexpr size_t WS_QKV = WS_BIG, WS_AO = WS_BIG + 192 * MiB;
constexpr size_t WS_RP = WS_BIG;
constexpr size_t WS_SELE = WS_BIG, WS_SELW = WS_BIG + 1 * MiB, WS_SELP = WS_BIG + 2 * MiB, WS_TOKL = WS_BIG + 4 * MiB;
constexpr size_t WS_ACT = WS_BIG + 12 * MiB  , WS_YS = WS_BIG + 92 * MiB  ;
constexpr size_t WS_END = WS_BIG + 412 * MiB;
constexpr int LDS_BYTES = 152 * 1024, LDS_MISC = 144 * 1024;

#define XB_TMO      128
#define XB_XCNT(j)  (256  + 64 * (j))
#define XB_XSUB(j)  (1280 + 64 * (j))
#define XB_XGEN(j)  (2304 + 64 * (j))
#define XB_TOP      3328
#define XB_TOPGEN   3392
#define XCD_BAR_WORDS 3456
#define XB_SPIN_CAP (1u << 20)
__device__ __forceinline__ unsigned xb_ld(unsigned* p)              { return __hip_atomic_load(p, __ATOMIC_RELAXED, __HIP_MEMORY_SCOPE_AGENT); }
__device__ __forceinline__ unsigned xb_add(unsigned* p, unsigned v) { return __hip_atomic_fetch_add(p, v, __ATOMIC_RELAXED, __HIP_MEMORY_SCOPE_AGENT); }
__device__ __forceinline__ unsigned xb_xcc_id() { return (unsigned)__builtin_amdgcn_s_getreg((3 << 11) | 20) & 0xFu; }
#define XB_SPIN(cond, bar) do { unsigned _sp = 0; while (cond) { __builtin_amdgcn_s_sleep(1); \
    if ((++_sp & 255u) == 0u) { if (xb_ld(&(bar)[XB_TMO])) break; if (_sp > XB_SPIN_CAP) { atomicAdd(&(bar)[XB_TMO], 1u); break; } } } } while (0)
struct XcdBarrier { unsigned* bar; unsigned x; volatile LAS unsigned* st; };
__device__ __forceinline__ XcdBarrier xcd_barrier_post(unsigned* bar, volatile LAS unsigned* st) {
    XcdBarrier b; b.bar = bar; b.x = xb_xcc_id(); b.st = st;
    if (threadIdx.x == 0) (void)xb_add(&bar[XB_XCNT(b.x)], 1u);
    return b;
}
__device__ __forceinline__ void xcd_barrier_complete(unsigned* bar, unsigned x, unsigned& nloc, unsigned& nx) {
    const unsigned G = gridDim.x * gridDim.y * gridDim.z;
    unsigned sum, cnt, mine, sp = 0u;
    for (;;) {
        sum = 0u; cnt = 0u; mine = 0u;
#pragma unroll
        for (unsigned j = 0; j < 16; ++j) { const unsigned c = xb_ld(&bar[XB_XCNT(j)]); sum += c; cnt += (c > 0u) ? 1u : 0u; mine = (j == x) ? c : mine; }
        if (sum == G) break;
        __builtin_amdgcn_s_sleep(1);
        if ((++sp & 255u) == 0u) { if (xb_ld(&bar[XB_TMO])) break; if (sp > XB_SPIN_CAP) { atomicAdd(&bar[XB_TMO], 1u); break; } }
    }
    nloc = mine > 0u ? mine : 1u; nx = cnt > 0u ? cnt : 1u;
}
__device__ __forceinline__ void xcd_barrier(const XcdBarrier& b) {
    asm volatile("s_waitcnt vmcnt(0)" ::: "memory");
    __syncthreads();
    if (threadIdx.x == 0) {
        unsigned* bar = b.bar; unsigned bx = b.x;
        asm volatile("" : "+s"(bar), "+s"(bx));
        __builtin_amdgcn_s_waitcnt(0);
        unsigned nloc = b.st[0], nx = b.st[1];
        if (nloc == 0u) { xcd_barrier_complete(bar, bx, nloc, nx); b.st[0] = nloc; b.st[1] = nx; }
        const unsigned old = xb_add(&bar[XB_XSUB(bx)], 1u);
        const unsigned gen = old / nloc;
        if (old + 1u == (gen + 1u) * nloc) {
            __builtin_amdgcn_fence(__ATOMIC_RELEASE, "agent");
            asm volatile("s_waitcnt vmcnt(0)" ::: "memory");
            const unsigned og = xb_add(&bar[XB_TOP], 1u);
            const unsigned tg = og / nx;
            if (og + 1u == (tg + 1u) * nx) xb_add(&bar[XB_TOPGEN], 1u);
            else XB_SPIN(xb_ld(&bar[XB_TOPGEN]) == tg, bar);
            __builtin_amdgcn_fence(__ATOMIC_ACQUIRE, "agent");
            xb_add(&bar[XB_XGEN(bx)], 1u);
            asm volatile("s_waitcnt vmcnt(0)" ::: "memory");
        } else {
            XB_SPIN(xb_ld(&bar[XB_XGEN(bx)]) == gen, bar);
            __builtin_amdgcn_fence(__ATOMIC_ACQUIRE, "agent");
            asm volatile("s_waitcnt vmcnt(0)" ::: "memory");
        }
    }
    __syncthreads();
}

template <class F> __device__ __forceinline__ void xcd_barrier_work(const XcdBarrier& b, F&& work) {
    asm volatile("s_waitcnt vmcnt(0)" ::: "memory");
    __syncthreads();
    if (threadIdx.x >= 64) work();
    else if (threadIdx.x == 0) {
        unsigned* bar = b.bar; unsigned bx = b.x;
        asm volatile("" : "+s"(bar), "+s"(bx));
        __builtin_amdgcn_s_waitcnt(0);
        unsigned nloc = b.st[0], nx = b.st[1];
        if (nloc == 0u) { xcd_barrier_complete(bar, bx, nloc, nx); b.st[0] = nloc; b.st[1] = nx; }
        const unsigned old = xb_add(&bar[XB_XSUB(bx)], 1u);
        const unsigned gen = old / nloc;
        if (old + 1u == (gen + 1u) * nloc) {
            __builtin_amdgcn_fence(__ATOMIC_RELEASE, "agent");
            asm volatile("s_waitcnt vmcnt(0)" ::: "memory");
            const unsigned og = xb_add(&bar[XB_TOP], 1u);
            const unsigned tg = og / nx;
            if (og + 1u == (tg + 1u) * nx) xb_add(&bar[XB_TOPGEN], 1u);
            else XB_SPIN(xb_ld(&bar[XB_TOPGEN]) == tg, bar);
            __builtin_amdgcn_fence(__ATOMIC_ACQUIRE, "agent");
            xb_add(&bar[XB_XGEN(bx)], 1u);
            asm volatile("s_waitcnt vmcnt(0)" ::: "memory");
        } else {
            XB_SPIN(xb_ld(&bar[XB_XGEN(bx)]) == gen, bar);
            __builtin_amdgcn_fence(__ATOMIC_ACQUIRE, "agent");
            asm volatile("s_waitcnt vmcnt(0)" ::: "memory");
        }
    }
    __syncthreads();
}

#define ATIC(cat) do { if (TIME_SEL >= 30 && blockIdx.x == 0 && threadIdx.x == 0) { const unsigned long long now_ = __builtin_amdgcn_s_memrealtime(); LAS unsigned long long* tb_ = (LAS unsigned long long*)(lds + LDS_MISC + 1024); if ((cat) == TIME_SEL) tb_[1] += now_ - tb_[0]; tb_[0] = now_; } } while (0)
template <int N> __device__ __forceinline__ void wait_vm() { asm volatile("s_waitcnt vmcnt(%0)" :: "n"(N) : "memory"); }
#define BAR() __builtin_amdgcn_s_barrier()
#define LDS_WAIT() asm volatile("s_waitcnt lgkmcnt(0)" ::: "memory")
__device__ __forceinline__ unsigned pk2(float a, float b) {
    typedef __bf16 bf2 __attribute__((ext_vector_type(2)));
    f32x2 v = {a, b}; bf2 r = __builtin_convertvector(v, bf2); return __builtin_bit_cast(unsigned, r);
}
__device__ __forceinline__ float bf_lo(unsigned u) { return __uint_as_float(u << 16); }
__device__ __forceinline__ float bf_hi(unsigned u) { return __uint_as_float(u & 0xffff0000u); }
template <int K> __device__ __forceinline__ float lane_xor(float v) {
    if constexpr (K == 32) { auto rr = __builtin_amdgcn_permlane32_swap(__float_as_uint(v), __float_as_uint(v), false, false); return __uint_as_float(rr[0]) == v ? __uint_as_float(rr[1]) : __uint_as_float(rr[0]); }
    else return __int_as_float(__builtin_amdgcn_ds_swizzle(__float_as_int(v), (K << 10) | 0x1f));
}
template <int CTRL> __device__ __forceinline__ float dpp_f(float v) { return __int_as_float(__builtin_amdgcn_mov_dpp(__float_as_int(v), CTRL, 0xF, 0xF, true)); }
__device__ __forceinline__ float wave_sum_dpp(float v) {
    v += dpp_f<0xB1>(v); v += dpp_f<0x4E>(v); v += dpp_f<0x141>(v); v += dpp_f<0x140>(v);
    { auto rr = __builtin_amdgcn_permlane16_swap(__float_as_uint(v), __float_as_uint(v), false, false); v = __uint_as_float(rr[0]) + __uint_as_float(rr[1]); }
    { auto rr = __builtin_amdgcn_permlane32_swap(__float_as_uint(v), __float_as_uint(v), false, false); v = __uint_as_float(rr[0]) + __uint_as_float(rr[1]); }
    return v;
}
__device__ __forceinline__ float wave_sum(float v) { return wave_sum_dpp(v); }
__device__ __forceinline__ float fast_exp2(float x) { return __builtin_amdgcn_exp2f(x); }
__device__ __forceinline__ float silu_f(float v) { return v * __builtin_amdgcn_rcpf(1.f + __builtin_amdgcn_exp2f(v * -LOG2E)); }
__device__ __forceinline__ void glds16(const void* src, ldsp dst) {
    unsigned keep; const unsigned d = (unsigned)(__SIZE_TYPE__)dst;
    asm volatile("s_mov_b32 %0, m0\n\ts_mov_b32 m0, %2\n\ts_nop 0\n\tglobal_load_lds_dwordx4 %1, off\n\ts_mov_b32 m0, %0" : "=&s"(keep) : "v"(src), "s"(d) : "memory");
}
__device__ __forceinline__ bf16x8 tr2(ldsp a0, ldsp a1) {
    const bf16x4 t0 = __builtin_amdgcn_ds_read_tr16_b64_v4i16((LAS bf16x4*)a0);
    const bf16x4 t1 = __builtin_amdgcn_ds_read_tr16_b64_v4i16((LAS bf16x4*)a1);
    return __builtin_shufflevector(t0, t1, 0, 1, 2, 3, 4, 5, 6, 7);
}
__device__ __forceinline__ bf16x8 rd2x64(ldsp a0, ldsp a1) {
    const bf16x4 t0 = *(LAS bf16x4*)a0; const bf16x4 t1 = *(LAS bf16x4*)a1;
    return __builtin_shufflevector(t0, t1, 0, 1, 2, 3, 4, 5, 6, 7);
}
__device__ __forceinline__ int fresh_tid() { int t = threadIdx.x; asm volatile("" : "+v"(t)); return t; }
__device__ __forceinline__ int vcu_of_block() { const int bx = blockIdx.x; return (bx & 7) * (GRID / 8) + (bx >> 3); }

struct Args {
    const float* in[25];
    float* out; unsigned char* ws;
};
enum { I_X = 0, I_C, I_NMIX, I_NFFN, I_ADAW, I_ADAB, I_DAWIN, I_DAWOUT, I_LQ1, I_LK1, I_LQ2, I_LK2, I_SUBLN, I_RWIN, I_RWOUT, I_RGN,
       I_ROUTW, I_ROUTB, I_EW1, I_EW3, I_EW2, I_SW1, I_SW3, I_SW2, I_FNORM };

template <int WM, int WN, int MT, int NT, int NSTAGE, class Src>
__device__ __forceinline__ void gemm_stream(ldsp lds, int K, const Src& src) {
    constexpr int BM = WM * MT * 16, BN = WN * NT * 16, STAGE = (BM + BN) * 128, LA = BM / 64, LB = BN / 64, L = LA + LB, PD = NSTAGE - 1;
    static_assert(WM * WN == NWAVE && NSTAGE * STAGE <= LDS_MISC, "8 waves; ring fits");
    const int tid = fresh_tid(), lane = tid & 63, wid = __builtin_amdgcn_readfirstlane(tid >> 6);
    const int wr = wid / WN, wc = wid % WN, fr = lane & 15, fq = lane >> 4;
    const char* cbA; const char* cbB; const char* nbA; const char* nbB; unsigned cA[LA], nA[LA], oB[LB];
    typename Src::Epi ce, ne; int cn0 = 0, nn0 = 0;
    if (!src.template setup<LA>(0, cbA, cA, cbB, ce, cn0, wid, lane)) return;
#pragma unroll
    for (int j = 0; j < LB; ++j) { const int row = 8 * (wid + 8 * j) + (lane >> 3); oB[j] = (unsigned)(row * (int)src.ldb * 2 + (((lane & 7) ^ ((row >> 1) & 7)) << 4)); }
    const int swz = fr >> 1;
    const int aoff = (wr * MT * 16 + fr) * 128, boff = BM * 128 + (wc * NT * 16 + fr) * 128;
    const int ok0 = ((fq ^ swz) << 4), ok1 = (((4 + fq) ^ swz) << 4);
    auto issue = [&](int s, const char* bA, const unsigned (&oA)[LA], const char* bB, int t) {
        ldsp st = lds + s * STAGE;
#pragma unroll
        for (int j = 0; j < LA; ++j) glds16(bA + (size_t)t * 128 + oA[j], st + (wid + 8 * j) * 1024);
#pragma unroll
        for (int j = 0; j < LB; ++j) glds16(bB + (size_t)t * 128 + oB[j], st + BM * 128 + (wid + 8 * j) * 1024);
    };
    const int nt = K / 64;
    BAR();
#pragma unroll
    for (int d = 0; d < PD; ++d) issue(d, cbA, cA, cbB, d);
    int s = 0;
    for (int i = 0;; ++i) {
        const bool hasn = src.template setup<LA>(i + 1, nbA, nA, nbB, ne, nn0, wid, lane);
        f32x4 acc[MT][NT];
#pragma unroll
        for (int m = 0; m < MT; ++m)
#pragma unroll
            for (int n = 0; n < NT; ++n) acc[m][n] = (f32x4){0.f, 0.f, 0.f, 0.f};
        for (int t = 0; t < nt; ++t) {
            if (PD >= 2 && (hasn || t + 1 < nt)) wait_vm<(PD - 1) * L>(); else wait_vm<0>();
            BAR();
            { int s2 = s + PD; if (s2 >= NSTAGE) s2 -= NSTAGE;
              if (t + PD < nt) issue(s2, cbA, cA, cbB, t + PD); else if (hasn) issue(s2, nbA, nA, nbB, t + PD - nt); }
            ldsp st = lds + s * STAGE;
#pragma unroll
            for (int kk = 0; kk < 2; ++kk) {
                bf16x8 b[NT];
                const int ok = kk ? ok1 : ok0;
#pragma unroll
                for (int n = 0; n < NT; ++n) b[n] = *(LAS bf16x8*)(st + boff + n * 2048 + ok);
#pragma unroll
                for (int mh = 0; mh < MT; mh += 4) {
                    bf16x8 a[4];
#pragma unroll
                    for (int m = 0; m < 4; ++m) a[m] = *(LAS bf16x8*)(st + aoff + (mh + m) * 2048 + ok);
                    __builtin_amdgcn_s_setprio(1);
#pragma unroll
                    for (int m = 0; m < 4; ++m)
#pragma unroll
                        for (int n = 0; n < NT; ++n) acc[mh + m][n] = __builtin_amdgcn_mfma_f32_16x16x32_bf16(b[n], a[m], acc[mh + m][n], 0, 0, 0);
                    __builtin_amdgcn_s_setprio(0);
                    if (MT > 4) __builtin_amdgcn_sched_barrier(0);
                }
            }
            s = (s == NSTAGE - 1) ? 0 : s + 1;
        }
        ce(acc, wr * MT * 16, cn0 + wc * NT * 16, fr, fq);
        if (!hasn) break;
#pragma unroll
        for (int j = 0; j < LA; ++j) cA[j] = nA[j];
        cbA = nbA; cbB = nbB; ce = ne; cn0 = nn0;
    }
}
__device__ __forceinline__ int stage_row(int wid, int j, int lane) { return 8 * (wid + 8 * j) + (lane >> 3); }
__device__ __forceinline__ int stage_chunk(int row, int lane) { return ((lane & 7) ^ ((row >> 1) & 7)) * 16; }
__device__ __forceinline__ const char* uniform_ptr(const void* p) { unsigned long long v = (unsigned long long)p; const unsigned lo = __builtin_amdgcn_readfirstlane((unsigned)v), hi = __builtin_amdgcn_readfirstlane((unsigned)(v >> 32)); return (const char*)(((unsigned long long)hi << 32) | lo); }

template <int BM, int BN, class Mk> struct DenseSrc {
    using Epi = decltype(((Mk*)nullptr)->operator()(0));
    const bf16_t* A; size_t lda; const bf16_t* Bt; size_t ldb; int nN, per_x, xcd, local; const Mk& mk;
    __device__ __forceinline__ DenseSrc(const bf16_t* A_, size_t lda_, const bf16_t* Bt_, size_t ldb_, int M, int N, const Mk& mk_) : A(A_), lda(lda_), Bt(Bt_), ldb(ldb_), mk(mk_) {
        const int vcu = vcu_of_block(); nN = N / BN; per_x = (M / BM) / 8; xcd = vcu >> 5; local = vcu & 31; }
    template <int LA> __device__ __forceinline__ bool setup(int i, const char*& bA, unsigned (&oA)[LA], const char*& bB, Epi& e, int& n0, int wid, int lane) const {
        constexpr int GM = 4;
        const int q = local + 32 * i; if (q >= per_x * nN) return false;
        const int grp = q / (GM * nN), r = q % (GM * nN), m = xcd * per_x + grp * GM + (r % GM), n = r / GM;
#pragma unroll
        for (int j = 0; j < LA; ++j) { const int row = stage_row(wid, j, lane); oA[j] = (unsigned)(row * (int)lda * 2 + stage_chunk(row, lane)); }
        bA = (const char*)(A + (size_t)(m * BM) * lda); bB = (const char*)(Bt + (size_t)(n * BN) * ldb);
        e = mk(m * BM); n0 = n * BN; return true;
    }
};
template <int WM, int WN, int MT, int NT, int NSTAGE, class Mk>
__device__ __forceinline__ void gemm_dense_phase(ldsp lds, const bf16_t* A, size_t lda, const bf16_t* Bt, size_t ldb, int M, int N, int K, const Mk& mk) {
    DenseSrc<WM * MT * 16, WN * NT * 16, Mk> src(A, lda, Bt, ldb, M, N, mk);
    gemm_stream<WM, WN, MT, NT, NSTAGE>(lds, K, src);
}

struct EpiStoreBf16 {
    bf16_t* O; size_t ldc; int m0;
    template <int MT, int NT> __device__ __forceinline__ void operator()(const f32x4 (&acc)[MT][NT], int rb, int cb, int fr, int fq) const {
#pragma unroll
        for (int m = 0; m < MT; ++m) { bf16_t* rp = O + (size_t)(m0 + rb + m * 16 + fr) * ldc + cb + 4 * fq;
#pragma unroll
            for (int n = 0; n < NT; ++n) { u32x2 w; w.x = pk2(acc[m][n][0], acc[m][n][1]); w.y = pk2(acc[m][n][2], acc[m][n][3]); *(u32x2*)(rp + n * 16) = w; } }
    }
};
struct EpiResidual {
    const float* Xin; float* Xout; const float* gate; int m0;
    template <int MT, int NT> __device__ __forceinline__ void operator()(const f32x4 (&acc)[MT][NT], int rb, int cb, int fr, int fq) const {
#pragma unroll
        for (int m = 0; m < MT; ++m) { const int row = m0 + rb + m * 16 + fr; const float* g = gate + (size_t)(row >> 11) * 6144;
#pragma unroll
            for (int n = 0; n < NT; ++n) { const int col = cb + n * 16 + 4 * fq; const f32x4 xv = *(const f32x4*)(Xin + (size_t)row * D + col); const f32x4 gv = *(const f32x4*)(g + col);
                *(f32x4*)(Xout + (size_t)row * D + col) = xv + gv * acc[m][n]; } }
    }
};
struct EpiRetProj {
    bf16_t* O; int m0;
    template <int MT, int NT> __device__ __forceinline__ void operator()(const f32x4 (&acc)[MT][NT], int rb, int cb, int fr, int fq) const {
        float l2g = 0.f, pre = 1.f;
        if (cb < 2048) { const int h = (cb & 1023) >> 8; l2g = __log2f(1.f - exp2f(-5.f - (float)h)); if (cb >= 1024) { l2g = -l2g; pre = 0.0625f; } }
#pragma unroll
        for (int m = 0; m < MT; ++m) { const int row = m0 + rb + m * 16 + fr; const float sc = pre * exp2f(l2g * (float)(row & 127)); bf16_t* rp = O + (size_t)row * 6144 + cb + 4 * fq;
#pragma unroll
            for (int n = 0; n < NT; ++n) { u32x2 w; w.x = pk2(acc[m][n][0] * sc, acc[m][n][1] * sc); w.y = pk2(acc[m][n][2] * sc, acc[m][n][3] * sc); *(u32x2*)(rp + n * 16) = w; } }
    }
};
struct EpiCausalP {
    bf16_t* O;
    template <int MT, int NT> __device__ __forceinline__ void operator()(const f32x4 (&acc)[MT][NT], int rb, int cb, int fr, int fq) const {
#pragma unroll
        for (int m = 0; m < MT; ++m) { const int i = rb + m * 16 + fr; bf16_t* rp = O + (size_t)i * 128 + cb + 4 * fq;
#pragma unroll
            for (int n = 0; n < NT; ++n) { const int j = cb + n * 16 + 4 * fq; f32x4 v = acc[m][n];
                v[0] = (i >= j) ? v[0] : 0.f; v[1] = (i >= j + 1) ? v[1] : 0.f; v[2] = (i >= j + 2) ? v[2] : 0.f; v[3] = (i >= j + 3) ? v[3] : 0.f;
                u32x2 w; w.x = pk2(v[0], v[1]); w.y = pk2(v[2], v[3]); *(u32x2*)(rp + n * 16) = w; } }
    }
};
struct EpiSwiGLU {
    bf16_t* O; int slot0;
    template <int MT, int NT> __device__ __forceinline__ void operator()(const f32x4 (&acc)[MT][NT], int rb, int cb, int fr, int fq) const {
        static_assert(NT == 4, "NT");
#pragma unroll
        for (int m = 0; m < MT; ++m) { bf16_t* rp = O + (size_t)(slot0 + rb + m * 16 + fr) * 256 + (cb >> 1) + 4 * fq;
#pragma unroll
            for (int p = 0; p < 2; ++p) { const f32x4 a = acc[m][2 * p], b = acc[m][2 * p + 1]; u32x2 w;
                w.x = pk2(silu_f(a[0]) * b[0], silu_f(a[1]) * b[1]); w.y = pk2(silu_f(a[2]) * b[2], silu_f(a[3]) * b[3]); *(u32x2*)(rp + p * 16) = w; } }
    }
};

namespace pg8 {
constexpr int BM = 256, BK = 64, HALF = 128, HTB = HALF * BK * 2  , STAGE_BYTES = 8 * HTB, NXCD = 8, WGM = 8;
__device__ __forceinline__ int lds_byte(int r, int c) { const int st = (r >> 4) * 2 + (c >> 5), rr = r & 15, cc = c & 31, ob = rr * 64 + cc * 2; return st * 1024 + (ob ^ (((ob >> 9) & 1) << 5)); }
__device__ __forceinline__ void stage_rc(int b, int& R, int& C) { const int st = b / 1024, sb = b % 1024, swz = sb ^ (((sb >> 9) & 1) << 5); R = (st >> 1) * 16 + swz / 64; C = (st & 1) * 32 + (swz % 64) / 2; }
__device__ __forceinline__ int perm32(int rho) { const int n = rho >> 4, i = rho & 15; return 8 * (i >> 2) + 4 * n + (i & 3); }
struct Unit { int pm, pn; };
struct Gemm { const bf16_t* A; const bf16_t* Bt; int M, N, K, lda; };
struct StaticOrder {
    int nM, nN, nwg, G, c;
    __device__ void init(int M, int N, int G_, int c_) { nM = M / BM; nN = N / BM; nwg = nM * nN; G = G_; c = c_; }
    __device__ bool next(int i, Unit& u) const {
        const long L = (long)i * G + c; if (L >= nwg) return false;
        int wgid = (int)L; { const int q = nwg / NXCD, r = nwg % NXCD, xcd = wgid % NXCD, off = wgid / NXCD; wgid = (xcd < r ? xcd * (q + 1) : r * (q + 1) + (xcd - r) * q) + off; }
        const int nig = WGM * nN, gid = wgid / nig, fm = gid * WGM, gsz = (nM - fm) < WGM ? (nM - fm) : WGM;
        u.pm = fm + ((wgid % nig) % gsz); u.pn = (wgid % nig) / gsz; return true;
    }
};
template <class Epi, bool ALIGN_EPI = true>
__device__ __forceinline__ void gemm_phase(ldsp lds, const Gemm g, const StaticOrder& S, const Epi& E) {
    const int tid = fresh_tid(), wid = __builtin_amdgcn_readfirstlane(tid >> 6), lane = tid & 63, wr = wid >> 2, wc = wid & 3, fr = lane & 15, fq = lane >> 4;
    const int K = g.K, nt = K / BK;
    unsigned voffA[2], voffB[2];
#pragma unroll
    for (int i = 0; i < 2; ++i) { int R, C; stage_rc(tid * 16 + i * 8192, R, C); const int p32 = perm32(R & 31);
        const int Rb = Epi::MERGE ? ((R >> 5) * 64 + ((p32 >> 3) << 4) + (p32 & 7)) : (Epi::PERM ? ((R & ~31) + p32) : R);
        voffA[i] = (unsigned)(R * g.lda + C) * 2u; voffB[i] = (unsigned)(Rb * K + C) * 2u; }
    const size_t kstep = (size_t)(BK * 2);
    const size_t hstepA = (size_t)HALF * g.lda * 2, hstepB = (size_t)(Epi::MERGE ? 8 : HALF) * K * 2;
    const size_t tstepA = 2 * hstepA, tstepB = (size_t)BM * K * 2;
    const unsigned ldsw = (unsigned)wid * 1024u;
    const int aoff = lds_byte(wr * 64 + fr, fq * 8), boff = lds_byte(wc * 32 + fr, fq * 8);
#define PG8_SA(b, h) (((b) * 2 + (h)) * HTB)
#define PG8_SB(b, h) ((4 + (b) * 2 + (h)) * HTB)
#define PG8_STAGE(bufoff, gbase, voff) do { _Pragma("unroll") for (int _i = 0; _i < 2; ++_i) glds16((const char*)(gbase) + (voff)[_i], lds + (bufoff) + ldsw + _i * 8192); } while (0)
#define PG8_LDA(dst, b, h) do { _Pragma("unroll") for (int m = 0; m < 4; ++m) _Pragma("unroll") for (int k = 0; k < 2; ++k) dst[m][k] = *(const LAS bf16x8*)(lds + PG8_SA(b, h) + aoff + m * 2048 + k * 1024); } while (0)
#define PG8_LDB(dst, b, h) do { _Pragma("unroll") for (int n = 0; n < 2; ++n) _Pragma("unroll") for (int k = 0; k < 2; ++k) dst[n][k] = *(const LAS bf16x8*)(lds + PG8_SB(b, h) + boff + n * 2048 + k * 1024); } while (0)
#define PG8_MMA(ai, bj, At, Bt) do { __builtin_amdgcn_s_setprio(1); _Pragma("unroll") for (int m = 0; m < 4; ++m) _Pragma("unroll") for (int n = 0; n < 2; ++n) _Pragma("unroll") for (int k = 0; k < 2; ++k) \
        acc[ai][bj][m][n] = __builtin_amdgcn_mfma_f32_16x16x32_bf16(Bt[n][k], At[m][k], acc[ai][bj][m][n], 0, 0, 0); __builtin_amdgcn_s_setprio(0); } while (0)
#define PG8_WAIT_V(n) asm volatile("s_waitcnt vmcnt(" #n ")" ::: "memory")
#define PG8_WAIT_L(n) asm volatile("s_waitcnt lgkmcnt(" #n ")" ::: "memory")
#define PG8_BAR __builtin_amdgcn_s_barrier()
#define PG8_SCHED __builtin_amdgcn_sched_barrier(0)
    Unit cur, nxt; int ui = 0;
    PG8_WAIT_V(0); PG8_BAR;
    if (!S.next(0, cur)) return;
    f32x4 acc[2][2][4][2];
#pragma unroll
    for (int a = 0; a < 2; ++a)
#pragma unroll
        for (int b = 0; b < 2; ++b)
#pragma unroll
            for (int m = 0; m < 4; ++m)
#pragma unroll
                for (int n = 0; n < 2; ++n) acc[a][b][m][n] = (f32x4){0.f, 0.f, 0.f, 0.f};
    bf16x8 At[4][2], B0[2][2], B1[2][2];
    const char* cA = (const char*)g.A + (size_t)cur.pm * tstepA; const char* cB = (const char*)g.Bt + (size_t)cur.pn * tstepB;
    PG8_STAGE(PG8_SB(0, 0), cB, voffB); PG8_STAGE(PG8_SB(0, 1), cB + hstepB, voffB); PG8_STAGE(PG8_SA(0, 0), cA, voffA); PG8_STAGE(PG8_SA(0, 1), cA + hstepA, voffA);
    if (wr == 1) PG8_BAR;
    PG8_WAIT_V(2); PG8_BAR;
    PG8_STAGE(PG8_SB(1, 0), cB + kstep, voffB); PG8_STAGE(PG8_SA(1, 0), cA + kstep, voffA); PG8_STAGE(PG8_SB(1, 1), cB + hstepB + kstep, voffB);
    PG8_WAIT_V(6); PG8_BAR;
    for (;;) {
        const bool has_next = S.next(ui + 1, nxt);
        const char* nA = has_next ? (const char*)g.A + (size_t)nxt.pm * tstepA : cA; const char* nB = has_next ? (const char*)g.Bt + (size_t)nxt.pn * tstepB : cB;
        for (int t = 0; t < nt; t += 2) {
            const bool last = (t == nt - 2);
            const char* a1 = cA + (size_t)(t + 1) * kstep;
            const char* a2 = last ? nA : cA + (size_t)(t + 2) * kstep; const char* b2 = last ? nB : cB + (size_t)(t + 2) * kstep;
            const char* a3 = a2 + kstep; const char* b3 = b2 + kstep;
            PG8_LDB(B0, 0, 0); PG8_LDB(B1, 0, 1); PG8_SCHED; PG8_LDA(At, 0, 0); PG8_STAGE(PG8_SA(1, 1), a1 + hstepA, voffA);
            PG8_WAIT_V(8); PG8_WAIT_L(0); PG8_BAR; PG8_MMA(0, 0, At, B0); PG8_MMA(0, 1, At, B1); PG8_BAR; PG8_SCHED;
            PG8_LDA(At, 0, 1); PG8_STAGE(PG8_SB(0, 0), b2, voffB); PG8_STAGE(PG8_SB(0, 1), b2 + hstepB, voffB); PG8_STAGE(PG8_SA(0, 0), a2, voffA);
            PG8_WAIT_V(8); PG8_WAIT_L(0); PG8_BAR; PG8_MMA(1, 0, At, B0); PG8_MMA(1, 1, At, B1); PG8_BAR; PG8_SCHED;
            PG8_LDB(B0, 1, 0); PG8_LDB(B1, 1, 1); PG8_SCHED; PG8_LDA(At, 1, 0); PG8_STAGE(PG8_SA(0, 1), a2 + hstepA, voffA);
            PG8_WAIT_V(8); PG8_WAIT_L(0); PG8_BAR; PG8_MMA(0, 0, At, B0); PG8_MMA(0, 1, At, B1); PG8_BAR; PG8_SCHED;
            PG8_LDA(At, 1, 1); PG8_STAGE(PG8_SB(1, 0), b3, voffB); PG8_STAGE(PG8_SB(1, 1), b3 + hstepB, voffB); PG8_STAGE(PG8_SA(1, 0), a3, voffA);
            PG8_WAIT_V(8); PG8_WAIT_L(0); PG8_BAR; PG8_MMA(1, 0, At, B0); PG8_MMA(1, 1, At, B1); PG8_BAR; PG8_SCHED;
        }
        if constexpr (ALIGN_EPI) { if (wr == 0) PG8_BAR; }
        E(acc, cur, wr, wc, fr, fq);
        if (!has_next) break;
#pragma unroll
        for (int a = 0; a < 2; ++a)
#pragma unroll
            for (int b = 0; b < 2; ++b)
#pragma unroll
                for (int m = 0; m < 4; ++m)
#pragma unroll
                    for (int n = 0; n < 2; ++n) acc[a][b][m][n] = (f32x4){0.f, 0.f, 0.f, 0.f};
        cur = nxt; cA = nA; cB = nB; ++ui;
        if constexpr (ALIGN_EPI) { if (wr == 1) PG8_BAR; }
    }
    PG8_WAIT_V(0);
    if constexpr (!ALIGN_EPI) { if (wr == 0) PG8_BAR; }
    PG8_BAR;
#undef PG8_SA
#undef PG8_SB
#undef PG8_STAGE
#undef PG8_LDA
#undef PG8_LDB
#undef PG8_MMA
#undef PG8_WAIT_V
#undef PG8_WAIT_L
#undef PG8_BAR
#undef PG8_SCHED
}
struct EpiBf16 {
    static constexpr bool PERM = true, MERGE = false;
    bf16_t* O; size_t ldc;
    __device__ __forceinline__ void operator()(const f32x4 (&acc)[2][2][4][2], const Unit& u, int wr, int wc, int fr, int fq) const {
        const int row0 = u.pm * BM + wr * 64 + fr, col0 = u.pn * BM + wc * 32 + 8 * fq;
#pragma unroll
        for (int ai = 0; ai < 2; ++ai)
#pragma unroll
            for (int m = 0; m < 4; ++m) { bf16_t* rowp = O + (size_t)(row0 + ai * HALF + m * 16) * ldc + col0;
#pragma unroll
                for (int bj = 0; bj < 2; ++bj) { const f32x4 v0 = acc[ai][bj][m][0], v1 = acc[ai][bj][m][1];
                    u32x4 w; w.x = pk2(v0[0], v0[1]); w.y = pk2(v0[2], v0[3]); w.z = pk2(v1[0], v1[1]); w.w = pk2(v1[2], v1[3]);
                    *(u32x4*)(rowp + bj * HALF) = w; } }
    }
};
struct EpiQKV {
    static constexpr bool PERM = true, MERGE = true;
    bf16_t* O; size_t ldc;
    __device__ __forceinline__ void operator()(const f32x4 (&acc)[2][2][4][2], const Unit& u, int wr, int wc, int fr, int fq) const {
        const int row0 = u.pm * BM + wr * 64 + fr, col0 = u.pn * BM + wc * 64 + 16 * fq;
        const float sc = (u.pn * BM < 1024) ? 0.125f * LOG2E : 1.f;
#pragma unroll
        for (int ai = 0; ai < 2; ++ai)
#pragma unroll
            for (int m = 0; m < 4; ++m) { bf16_t* rowp = O + (size_t)(row0 + ai * HALF + m * 16) * ldc + col0;
#pragma unroll
                for (int bj = 0; bj < 2; ++bj) { const f32x4 v0 = acc[ai][bj][m][0] * sc, v1 = acc[ai][bj][m][1] * sc;
                    u32x4 w; w.x = pk2(v0[0], v0[1]); w.y = pk2(v0[2], v0[3]); w.z = pk2(v1[0], v1[1]); w.w = pk2(v1[2], v1[3]);
                    *(u32x4*)(rowp + bj * 8) = w; } }
    }
};
struct EpiRet {
    static constexpr bool PERM = true, MERGE = true;
    bf16_t* O;
    __device__ __forceinline__ void operator()(const f32x4 (&acc)[2][2][4][2], const Unit& u, int wr, int wc, int fr, int fq) const {
        const int row0 = u.pm * BM + wr * 64 + fr, colt = u.pn * BM, col0 = colt + wc * 64 + 16 * fq;
        float l2g = 0.f, pre = 1.f;
        if (colt < 2048) { const int h = (colt & 1023) >> 8; l2g = __log2f(1.f - exp2f(-5.f - (float)h)); if (colt >= 1024) { l2g = -l2g; pre = 0.0625f; } }
#pragma unroll
        for (int ai = 0; ai < 2; ++ai)
#pragma unroll
            for (int m = 0; m < 4; ++m) { const int row = row0 + ai * HALF + m * 16; const float sc = pre * exp2f(l2g * (float)(row & 127)); bf16_t* rowp = O + (size_t)row * 6144 + col0;
#pragma unroll
                for (int bj = 0; bj < 2; ++bj) { const f32x4 v0 = acc[ai][bj][m][0] * sc, v1 = acc[ai][bj][m][1] * sc;
                    u32x4 w; w.x = pk2(v0[0], v0[1]); w.y = pk2(v0[2], v0[3]); w.z = pk2(v1[0], v1[1]); w.w = pk2(v1[2], v1[3]);
                    *(u32x4*)(rowp + bj * 8) = w; } }
    }
};
template <bool SRC_F32> struct EpiRes {
    static constexpr bool PERM = true, MERGE = true;
    const void* Xin; bf16_t* Xout; const float* gate;
    __device__ __forceinline__ void operator()(const f32x4 (&acc)[2][2][4][2], const Unit& u, int wr, int wc, int fr, int fq) const {
        const int row0 = u.pm * BM + wr * 64 + fr, col0 = u.pn * BM + wc * 64 + 16 * fq;
        const float* g = gate + (size_t)(row0 >> 11) * 6144 + col0;
        f32x4 gv[2][2];
#pragma unroll
        for (int bj = 0; bj < 2; ++bj)
#pragma unroll
            for (int n = 0; n < 2; ++n) gv[bj][n] = *(const f32x4*)(g + bj * 8 + n * 4);
#pragma unroll
        for (int ai = 0; ai < 2; ++ai)
#pragma unroll
            for (int m = 0; m < 4; ++m) { const int row = row0 + ai * HALF + m * 16;
#pragma unroll
                for (int bj = 0; bj < 2; ++bj) { f32x4 x0, x1;
                    if constexpr (SRC_F32) { const float* xp = (const float*)Xin + (size_t)row * D + col0 + bj * 8; x0 = *(const f32x4*)xp; x1 = *(const f32x4*)(xp + 4); }
                    else { const u32x4 xb = *(const u32x4*)((const bf16_t*)Xin + (size_t)row * XRB_LD + XRB_OFF + col0 + bj * 8);
                        x0 = (f32x4){bf_lo(xb.x), bf_hi(xb.x), bf_lo(xb.y), bf_hi(xb.y)}; x1 = (f32x4){bf_lo(xb.z), bf_hi(xb.z), bf_lo(xb.w), bf_hi(xb.w)}; }
                    const f32x4 v0 = x0 + gv[bj][0] * acc[ai][bj][m][0], v1 = x1 + gv[bj][1] * acc[ai][bj][m][1];
                    u32x4 w; w.x = pk2(v0[0], v0[1]); w.y = pk2(v0[2], v0[3]); w.z = pk2(v1[0], v1[1]); w.w = pk2(v1[2], v1[3]);
                    *(u32x4*)(Xout + (size_t)row * XRB_LD + XRB_OFF + col0 + bj * 8) = w; }
                if (m & 1) asm volatile("" ::: "memory"); }
    }
};
template <class Epi>
__device__ __forceinline__ void dense(ldsp lds, const bf16_t* A, int lda, const bf16_t* Bt, int M, int N, int K, const Epi& E) {
    Gemm g{A, Bt, M, N, K, lda}; StaticOrder S; S.init(M, N, GRID, (int)blockIdx.x);
    gemm_phase<Epi, true>(lds, g, S, E);
}
struct UnitX { int pm, pn; const char* aBase; const char* bBase; const int* list; int cnt, r0, dummy; };
template <class Src, class Epi>
__device__ __forceinline__ void gemm_phase_x(ldsp lds, const Src& S, const Epi& E) {
    const int tid = fresh_tid(), wid = __builtin_amdgcn_readfirstlane(tid >> 6), lane = tid & 63, wr = wid >> 2, wc = wid & 3, fr = lane & 15, fq = lane >> 4;
    constexpr int K = Src::K, nt = K / BK, LDA = Src::LDA;
    int RA[2], CA[2]; unsigned voffB[2];
#pragma unroll
    for (int i = 0; i < 2; ++i) { int R, C; stage_rc(tid * 16 + i * 8192, R, C); RA[i] = R; CA[i] = C * 2; const int p32 = perm32(R & 31);
        const int a2 = (R >> 5) * 32 + 8 * ((R >> 2) & 3) + (R & 3);
        const int Rb = Epi::MERGE == 2 ? ((a2 >> 4) * 32 + ((R >> 4) & 1) * 16 + (a2 & 15)) : Epi::MERGE == 1 ? ((R >> 5) * 64 + ((p32 >> 3) << 4) + (p32 & 7)) : (Epi::PERM ? ((R & ~31) + p32) : R);
        voffB[i] = (unsigned)(Rb * K + C) * 2u; }
    const size_t kstep = (size_t)(BK * 2), hstepB = (size_t)(Epi::MERGE == 2 ? 4 : Epi::MERGE == 1 ? 8 : HALF) * K * 2;
    const unsigned ldsw = (unsigned)wid * 1024u;
    const int aoff = lds_byte(wr * 64 + fr, fq * 8), boff = lds_byte(wc * 32 + fr, fq * 8);
    auto rows_of = [&](const UnitX& u, unsigned (&v)[2][2]) {
#pragma unroll
        for (int h = 0; h < 2; ++h)
#pragma unroll
            for (int i = 0; i < 2; ++i) { const int r = h * HALF + RA[i];
                if constexpr (Src::GATHER) { const int gidx = u.r0 + r; const int tok = u.list ? (gidx < u.cnt ? u.list[gidx] : u.dummy) : u.dummy + gidx; v[h][i] = (unsigned)tok * (unsigned)(LDA * 2) + (unsigned)CA[i]; }
                else v[h][i] = (unsigned)(r * LDA * 2 + CA[i]); }
    };
#define PGX_SA(b, h) (((b) * 2 + (h)) * HTB)
#define PGX_SB(b, h) ((4 + (b) * 2 + (h)) * HTB)
#define PGX_STAGEB(bufoff, gbase) do { _Pragma("unroll") for (int _i = 0; _i < 2; ++_i) glds16((const char*)(gbase) + voffB[_i], lds + (bufoff) + ldsw + _i * 8192); } while (0)
#define PGX_STAGEA(bufoff, gbase, h, nx) do { _Pragma("unroll") for (int _i = 0; _i < 2; ++_i) glds16((const char*)(gbase) + ((nx) ? nv[h][_i] : cv[h][_i]), lds + (bufoff) + ldsw + _i * 8192); } while (0)
#define PGX_LDA(dst, b, h) do { _Pragma("unroll") for (int m = 0; m < 4; ++m) _Pragma("unroll") for (int k = 0; k < 2; ++k) dst[m][k] = *(const LAS bf16x8*)(lds + PGX_SA(b, h) + aoff + m * 2048 + k * 1024); } while (0)
#define PGX_LDB(dst, b, h) do { _Pragma("unroll") for (int n = 0; n < 2; ++n) _Pragma("unroll") for (int k = 0; k < 2; ++k) dst[n][k] = *(const LAS bf16x8*)(lds + PGX_SB(b, h) + boff + n * 2048 + k * 1024); } while (0)
#define PGX_MMA(ai, bj, At, Bt) do { __builtin_amdgcn_s_setprio(1); _Pragma("unroll") for (int m = 0; m < 4; ++m) _Pragma("unroll") for (int n = 0; n < 2; ++n) _Pragma("unroll") for (int k = 0; k < 2; ++k) \
        acc[ai][bj][m][n] = __builtin_amdgcn_mfma_f32_16x16x32_bf16(Bt[n][k], At[m][k], acc[ai][bj][m][n], 0, 0, 0); __builtin_amdgcn_s_setprio(0); } while (0)
#define PGX_WAIT_V(n) asm volatile("s_waitcnt vmcnt(" #n ")" ::: "memory")
#define PGX_WAIT_L(n) asm volatile("s_waitcnt lgkmcnt(" #n ")" ::: "memory")
#define PGX_BAR __builtin_amdgcn_s_barrier()
#define PGX_SCHED __builtin_amdgcn_sched_barrier(0)
    UnitX cur, nxt; int ui = 0;
    PGX_WAIT_V(0); PGX_BAR;
    if (!S.next(0, cur)) return;
    unsigned cv[2][2], nv[2][2];
    rows_of(cur, cv);
    asm volatile("" :: "v"(cv[0][0]), "v"(cv[0][1]), "v"(cv[1][0]), "v"(cv[1][1]));
    f32x4 acc[2][2][4][2];
#pragma unroll
    for (int a = 0; a < 2; ++a)
#pragma unroll
        for (int b = 0; b < 2; ++b)
#pragma unroll
            for (int m = 0; m < 4; ++m)
#pragma unroll
                for (int n = 0; n < 2; ++n) acc[a][b][m][n] = (f32x4){0.f, 0.f, 0.f, 0.f};
    bf16x8 At[4][2], B0[2][2], B1[2][2];
    const char* cA = cur.aBase; const char* cB = cur.bBase;
    PGX_STAGEB(PGX_SB(0, 0), cB); PGX_STAGEB(PGX_SB(0, 1), cB + hstepB); PGX_STAGEA(PGX_SA(0, 0), cA, 0, false); PGX_STAGEA(PGX_SA(0, 1), cA, 1, false);
    if (wr == 1) PGX_BAR;
    PGX_WAIT_V(2); PGX_BAR;
    PGX_STAGEB(PGX_SB(1, 0), cB + kstep); PGX_STAGEA(PGX_SA(1, 0), cA + kstep, 0, false); PGX_STAGEB(PGX_SB(1, 1), cB + hstepB + kstep);
    PGX_WAIT_V(6); PGX_BAR;
    LAS int* lbuf = (LAS int*)(lds + LDS_MISC + 2048);
    for (;;) {
        const bool has_next = S.next(ui + 1, nxt);
        if constexpr (Src::GATHER) {
            if (has_next && nxt.list && wid == 0) glds16((const char*)(nxt.list + nxt.r0) + lane * 16, (ldsp)(lbuf + ((ui + 1) & 1) * 256));
        } else {
            if (has_next) rows_of(nxt, nv); else {
#pragma unroll
                for (int h = 0; h < 2; ++h)
#pragma unroll
                    for (int i = 0; i < 2; ++i) nv[h][i] = cv[h][i]; }
        }
        const char* nA = has_next ? nxt.aBase : cA; const char* nB = has_next ? nxt.bBase : cB;
#pragma unroll 1
        for (int t = 0; t < nt; t += 2) {
            const bool last = (t == nt - 2);
            if constexpr (Src::GATHER) { if (last) {
#pragma unroll
                for (int h = 0; h < 2; ++h)
#pragma unroll
                    for (int i = 0; i < 2; ++i) { const int r = h * HALF + RA[i], gidx = nxt.r0 + r; unsigned v = cv[h][i];
                        if (has_next) { int tok;
                            if (nxt.list) { const int tl = lbuf[((ui + 1) & 1) * 256 + r]; tok = gidx < nxt.cnt ? tl : nxt.dummy; } else tok = nxt.dummy + gidx;
                            v = (unsigned)tok * (unsigned)(LDA * 2) + (unsigned)CA[i]; }
                        nv[h][i] = v; } } }
            const char* a1 = cA + (size_t)(t + 1) * kstep;
            const char* a2 = last ? nA : cA + (size_t)(t + 2) * kstep; const char* b2 = last ? nB : cB + (size_t)(t + 2) * kstep;
            const char* a3 = a2 + kstep; const char* b3 = b2 + kstep;
            PGX_LDB(B0, 0, 0); PGX_LDB(B1, 0, 1); PGX_SCHED; PGX_LDA(At, 0, 0); PGX_STAGEA(PGX_SA(1, 1), a1, 1, false);
            PGX_WAIT_V(8); PGX_WAIT_L(0); PGX_BAR; PGX_MMA(0, 0, At, B0); PGX_MMA(0, 1, At, B1); PGX_BAR; PGX_SCHED;
            PGX_LDA(At, 0, 1); PGX_STAGEB(PGX_SB(0, 0), b2); PGX_STAGEB(PGX_SB(0, 1), b2 + hstepB); PGX_STAGEA(PGX_SA(0, 0), a2, 0, last);
            PGX_WAIT_V(8); PGX_WAIT_L(0); PGX_BAR; PGX_MMA(1, 0, At, B0); PGX_MMA(1, 1, At, B1); PGX_BAR; PGX_SCHED;
            PGX_LDB(B0, 1, 0); PGX_LDB(B1, 1, 1); PGX_SCHED; PGX_LDA(At, 1, 0); PGX_STAGEA(PGX_SA(0, 1), a2, 1, last);
            PGX_WAIT_V(8); PGX_WAIT_L(0); PGX_BAR; PGX_MMA(0, 0, At, B0); PGX_MMA(0, 1, At, B1); PGX_BAR; PGX_SCHED;
            PGX_LDA(At, 1, 1); PGX_STAGEB(PGX_SB(1, 0), b3); PGX_STAGEB(PGX_SB(1, 1), b3 + hstepB); PGX_STAGEA(PGX_SA(1, 0), a3, 0, last);
            PGX_WAIT_V(8); PGX_WAIT_L(0); PGX_BAR; PGX_MMA(1, 0, At, B0); PGX_MMA(1, 1, At, B1); PGX_BAR; PGX_SCHED;
        }
        if (wr == 0) PGX_BAR;
        E(acc, cur, wr, wc, fr, fq);
        if (!has_next) break;
#pragma unroll
        for (int a = 0; a < 2; ++a)
#pragma unroll
            for (int b = 0; b < 2; ++b)
#pragma unroll
                for (int m = 0; m < 4; ++m)
#pragma unroll
                    for (int n = 0; n < 2; ++n) acc[a][b][m][n] = (f32x4){0.f, 0.f, 0.f, 0.f};
        cur = nxt; cA = nA; cB = nB; ++ui;
#pragma unroll
        for (int h = 0; h < 2; ++h)
#pragma unroll
            for (int i = 0; i < 2; ++i) cv[h][i] = nv[h][i];
        if (wr == 1) PGX_BAR;
    }
    PGX_WAIT_V(0);
    PGX_BAR;
#undef PGX_SA
#undef PGX_SB
#undef PGX_STAGEA
#undef PGX_STAGEB
#undef PGX_LDA
#undef PGX_LDB
#undef PGX_MMA
#undef PGX_WAIT_V
#undef PGX_WAIT_L
#undef PGX_BAR
#undef PGX_SCHED
}
struct EpiSwiGLUx {
    static constexpr bool PERM = false; static constexpr int MERGE = 2;
    bf16_t* O;
    __device__ __forceinline__ void operator()(const f32x4 (&acc)[2][2][4][2], const UnitX& u, int wr, int wc, int fr, int fq) const {
        const int row0 = u.pm * BM + wr * 64 + fr, c0 = u.pn * (BM / 2) + wc * 32 + 8 * fq;
#pragma unroll
        for (int ai = 0; ai < 2; ++ai)
#pragma unroll
            for (int m = 0; m < 4; ++m) { bf16_t* rowp = O + (size_t)(row0 + ai * HALF + m * 16) * 256 + c0;
                u32x4 w;
#pragma unroll
                for (int bj = 0; bj < 2; ++bj) { const f32x4 x = acc[ai][bj][m][0], y = acc[ai][bj][m][1];
                    const unsigned lo = pk2(silu_f(x[0]) * y[0], silu_f(x[1]) * y[1]), hi = pk2(silu_f(x[2]) * y[2], silu_f(x[3]) * y[3]);
                    if (bj == 0) { w.x = lo; w.y = hi; } else { w.z = lo; w.w = hi; } }
                *(u32x4*)rowp = w; }
    }
};
struct EpiYx {
    static constexpr bool PERM = true; static constexpr int MERGE = 1;
    unsigned char* O;
    __device__ __forceinline__ void operator()(const f32x4 (&acc)[2][2][4][2], const UnitX& u, int wr, int wc, int fr, int fq) const {
        const int row0 = u.pm * BM + wr * 64 + fr, col0 = u.pn * BM + wc * 64 + 16 * fq;
#pragma unroll
        for (int ai = 0; ai < 2; ++ai)
#pragma unroll
            for (int m = 0; m < 4; ++m) { unsigned char* rowp = O + (size_t)(row0 + ai * HALF + m * 16) * D + col0;
                u32x4 w;
#pragma unroll
                for (int bj = 0; bj < 2; ++bj) { f32x4 v0 = acc[ai][bj][m][0], v1 = acc[ai][bj][m][1];
#pragma unroll
                    for (int e = 0; e < 4; ++e) { v0[e] = __builtin_amdgcn_fmed3f(v0[e], -448.f, 448.f); v1[e] = __builtin_amdgcn_fmed3f(v1[e], -448.f, 448.f); }
                    int w0 = __builtin_amdgcn_cvt_pk_fp8_f32(v0[0], v0[1], 0, false); w0 = __builtin_amdgcn_cvt_pk_fp8_f32(v0[2], v0[3], w0, true);
                    int w1 = __builtin_amdgcn_cvt_pk_fp8_f32(v1[0], v1[1], 0, false); w1 = __builtin_amdgcn_cvt_pk_fp8_f32(v1[2], v1[3], w1, true);
                    if (bj == 0) { w.x = (unsigned)w0; w.y = (unsigned)w1; } else { w.z = (unsigned)w0; w.w = (unsigned)w1; } }
                __builtin_nontemporal_store(w, (u32x4*)rowp); }
    }
};
}

__device__ __forceinline__ void transpose_item(const float* W, int K, int N, bf16_t* WT, int mode, LAS float* scr, int item, int lane) {
    const int nblk = N / 32, kb = item / nblk, nb = item % nblk, k0 = 64 * kb, n0 = 32 * nb;
    f32x4 v[8];
#pragma unroll
    for (int i = 0; i < 8; ++i) v[i] = __builtin_nontemporal_load((const f32x4*)(W + (size_t)(k0 + 8 * i + (lane >> 3)) * N + n0 + (lane & 7) * 4));
#pragma unroll
    for (int i = 0; i < 8; ++i) { LAS float* d = scr + (8 * i + (lane >> 3)) * 33 + (lane & 7) * 4; d[0] = v[i][0]; d[1] = v[i][1]; d[2] = v[i][2]; d[3] = v[i][3]; }
    LDS_WAIT();
    const int c = lane & 7;
#pragma unroll
    for (int j = 0; j < 4; ++j) { const int n = (lane >> 3) + 8 * j; const LAS float* s = scr + (8 * c) * 33 + n;
        u32x4 o; o.x = pk2(s[0 * 33], s[1 * 33]); o.y = pk2(s[2 * 33], s[3 * 33]); o.z = pk2(s[4 * 33], s[5 * 33]); o.w = pk2(s[6 * 33], s[7 * 33]);
        const int nn = n0 + n; const int row = mode == 0 ? nn : ((nn >> 4) * 32 + (mode == 2 ? 16 : 0) + (nn & 15));
        *(u32x4*)(WT + (size_t)row * K + k0 + 8 * c) = o; }
    LDS_WAIT();
}
__device__ __forceinline__ void convert_expert_weights(const Args& a, int layer, ldsp lds, int gw, int ngw, int wave, int lane, int slice = 0, int nslice = 1) {
    LAS float* scr = (LAS float*)(lds + wave * 16384);
    unsigned char* ws = a.ws;
    constexpr int I13 = (D / 64) * (256 / 32), I2 = (256 / 64) * (D / 32);
    constexpr int NE = 64 * I13;
    constexpr int TOTAL = 3 * NE + 3 * 128;
    const int lo = (int)((long long)TOTAL * slice / nslice), hi = (int)((long long)TOTAL * (slice + 1) / nslice);
    for (int it = lo + gw; it < hi; it += ngw) {
        int r = it;
        if (r < NE) { const int e = r / I13; transpose_item(a.in[I_EW1] + ((size_t)layer * 64 + e) * D * 256, D, 256, (bf16_t*)(ws + WS_W13) + (size_t)e * 512 * D, 1, scr, r % I13, lane); continue; } r -= NE;
        if (r < NE) { const int e = r / I13; transpose_item(a.in[I_EW3] + ((size_t)layer * 64 + e) * D * 256, D, 256, (bf16_t*)(ws + WS_W13) + (size_t)e * 512 * D, 2, scr, r % I13, lane); continue; } r -= NE;
        if (r < NE) { const int e = r / I2; transpose_item(a.in[I_EW2] + ((size_t)layer * 64 + e) * 256 * D, 256, D, (bf16_t*)(ws + WS_W2) + (size_t)e * D * 256, 0, scr, r % I2, lane); continue; } r -= NE;
        if (r < 128) { transpose_item(a.in[I_SW1] + (size_t)layer * D * 256, D, 256, (bf16_t*)(ws + WS_WS13), 1, scr, r, lane); continue; } r -= 128;
        if (r < 128) { transpose_item(a.in[I_SW3] + (size_t)layer * D * 256, D, 256, (bf16_t*)(ws + WS_WS13), 2, scr, r, lane); continue; } r -= 128;
        transpose_item(a.in[I_SW2] + (size_t)layer * 256 * D, 256, D, (bf16_t*)(ws + WS_WS2), 0, scr, r, lane);
    }
}
__device__ __forceinline__ void convert_dense_weights(const Args& a, ldsp lds, int gw, int ngw, int wave, int lane) {
    LAS float* scr = (LAS float*)(lds + wave * 16384);
    unsigned char* ws = a.ws;
    constexpr int IQ = 16 * 96, IO = 16 * 32, IRI = 16 * 192, IRO = 32 * 32;
    for (int it = gw; it < IQ + IO + IRI + IRO; it += ngw) {
        int r = it;
        if (r < IQ) { transpose_item(a.in[I_DAWIN], D, 3072, (bf16_t*)(ws + WS_WQKV), 0, scr, r, lane); continue; } r -= IQ;
        if (r < IO) { transpose_item(a.in[I_DAWOUT], D, D, (bf16_t*)(ws + WS_WO), 0, scr, r, lane); continue; } r -= IO;
        if (r < IRI) { transpose_item(a.in[I_RWIN], D, 6144, (bf16_t*)(ws + WS_WRI), 0, scr, r, lane); continue; } r -= IRI;
        transpose_item(a.in[I_RWOUT], 2048, D, (bf16_t*)(ws + WS_WRO), 0, scr, r, lane);
    }
}
__device__ __forceinline__ void mod_items(const Args& a, ldsp lds) {
    const int tid = threadIdx.x;
    LAS float* sl = (LAS float*)lds;
    LAS float* red = (LAS float*)(lds + 65536);
    const float* c = a.in[I_C];
    { f32x4 cv[8];
#pragma unroll
      for (int j = 0; j < 8; ++j) cv[j] = *(const f32x4*)(c + (size_t)(j * NTHR + tid) * 4);
#pragma unroll
      for (int j = 0; j < 8; ++j) { f32x4 v = cv[j]; v[0] = silu_f(v[0]); v[1] = silu_f(v[1]); v[2] = silu_f(v[2]); v[3] = silu_f(v[3]); *(LAS f32x4*)(sl + (j * NTHR + tid) * 4) = v; } }
    __syncthreads();
    float* mod = (float*)(a.ws + WS_MOD);
    for (int item = blockIdx.x; item < 192; item += GRID) {
        const int layer = item / 96, j0 = (item % 96) * 64, kq = tid >> 5, col = (tid & 31) * 2;
        const float* w = a.in[I_ADAW] + (size_t)layer * D * 6144 + j0 + col;
        float acc0[16], acc1[16];
#pragma unroll
        for (int b = 0; b < 16; ++b) { acc0[b] = 0.f; acc1[b] = 0.f; }
#pragma unroll 1
        for (int k0 = kq * 64; k0 < kq * 64 + 64; k0 += 32) {
            f32x2 wv[32];
#pragma unroll
            for (int u = 0; u < 32; ++u) wv[u] = __builtin_nontemporal_load((const f32x2*)(w + (size_t)(k0 + u) * 6144));
#pragma unroll
            for (int u = 0; u < 32; ++u)
#pragma unroll
                for (int b = 0; b < 16; ++b) { const float sv = sl[b * 1024 + k0 + u]; acc0[b] += sv * wv[u][0]; acc1[b] += sv * wv[u][1]; }
        }
#pragma unroll
        for (int b = 0; b < 16; ++b) { f32x2 t2 = {acc0[b], acc1[b]}; *(LAS f32x2*)(red + (kq * 16 + b) * 64 + col) = t2; }
        __syncthreads();
        { const int b = tid >> 5, cc = (tid & 31) * 2;
          f32x2 sv = *(const f32x2*)(a.in[I_ADAB] + (size_t)layer * 6144 + j0 + cc);
#pragma unroll
          for (int q = 0; q < 16; ++q) { const f32x2 r2 = *(LAS f32x2*)(red + (q * 16 + b) * 64 + cc); sv[0] += r2[0]; sv[1] += r2[1]; }
#pragma unroll
          for (int e = 0; e < 2; ++e) { const int j = j0 + cc + e; float sx = sv[e];
              if (j >= 1024 && j < 2048) sx = a.in[I_NMIX][layer * D + j - 1024] * (1.f + sx);
              if (j >= 4096 && j < 5120) sx = a.in[I_NFFN][layer * D + j - 4096] * (1.f + sx);
              mod[((size_t)layer * 16 + b) * 6144 + j] = sx; } }
        __syncthreads();
    }
}

__device__ __forceinline__ void adaln_store(const f32x4 (&v)[4], float rstd, const float* G, const float* sh, bf16_t* hrow, int lane) {
#pragma unroll
    for (int j = 0; j < 4; ++j) { const int col = 4 * lane + 256 * j; const f32x4 g = *(const f32x4*)(G + col), s0 = *(const f32x4*)(sh + col);
        const f32x4 h = v[j] * rstd * g + s0; u32x2 w; w.x = pk2(h[0], h[1]); w.y = pk2(h[2], h[3]); *(u32x2*)(hrow + col) = w; }
}
__device__ __forceinline__ void adaln_phase(const float* X, const float* mod_sh  , const float* mod_G, bf16_t* H, int gw, int ngw, int lane) {
    for (int row0 = gw * 8; row0 < T; row0 += ngw * 8) {
        f32x4 v[8][4]; float ss[8] = {0.f, 0.f, 0.f, 0.f, 0.f, 0.f, 0.f, 0.f};
#pragma unroll
        for (int r = 0; r < 8; ++r)
#pragma unroll
            for (int j = 0; j < 4; ++j) v[r][j] = __builtin_nontemporal_load((const f32x4*)(X + (size_t)(row0 + r) * D + 4 * lane + 256 * j));
#pragma unroll
        for (int r = 0; r < 8; ++r) {
#pragma unroll
            for (int j = 0; j < 4; ++j) ss[r] += v[r][j][0] * v[r][j][0] + v[r][j][1] * v[r][j][1] + v[r][j][2] * v[r][j][2] + v[r][j][3] * v[r][j][3];
            const float rstd = rsqrtf(wave_sum(ss[r]) * (1.f / D) + 1e-6f); const int b = (row0 + r) >> 11;
            adaln_store(v[r], rstd, mod_G + (size_t)b * 6144, mod_sh + (size_t)b * 6144, H + (size_t)(row0 + r) * D, lane); }
    }
}

typedef float f32x16 __attribute__((ext_vector_type(16)));
__device__ __forceinline__ float half_swap_max(float m) { auto rr = __builtin_amdgcn_permlane32_swap(__float_as_uint(m), __float_as_uint(m), false, false);
    return fmaxf(__uint_as_float(rr[0]), __uint_as_float(rr[1])); }
__device__ __forceinline__ float half_swap_sum(float m) { auto rr = __builtin_amdgcn_permlane32_swap(__float_as_uint(m), __float_as_uint(m), false, false);
    return __uint_as_float(rr[0]) + __uint_as_float(rr[1]); }
#define MX3(a, b, c) __builtin_fmaxf(__builtin_fmaxf((a), (b)), (c))
__device__ __forceinline__ void attn_phase(ldsp lds, const bf16_t* qkv, bf16_t* ao, float lam, const float* subln_g) {
    const int tid = fresh_tid(), lane = tid & 63, wid = __builtin_amdgcn_readfirstlane(tid >> 6), map = wid & 1, qg = wid >> 1, half = 0, r32 = lane & 31, hi = lane >> 5;
    constexpr int STAGE = 32768;
    constexpr float THR = 8.f;
    const int kb0 = map * 8192 + r32 * 128 + ((hi ^ ((r32 >> 1) & 7)) << 4);
    const int vb0 = 16384 + (4 * hi + ((lane & 15) >> 2)) * 256 + (((lane >> 2) & 3) << 6) + ((2 * ((lane >> 4) & 1) + ((lane & 3) >> 1)) << 4) + (lane & 1) * 8;
    bf16x8 qr[4];
    auto load_q = [&](int round) {
        const int i = blockIdx.x, xcd = i & 7, li = i >> 3, bh = xcd * 16 + 4 * (round >> 1) + (li >> 3), j8 = li & 7, qb = (round & 1) ? j8 : 15 - j8;
        const bf16_t* qp = qkv + ((size_t)(bh >> 3) * SEQ + qb * 128 + qg * 32 + r32) * 3072 + (2 * (bh & 7) + map) * 64 + hi * 8;
#pragma unroll
        for (int d0 = 0; d0 < 4; ++d0) qr[d0] = *(const bf16x8*)(qp + d0 * 16);
    };
    load_q(0);
    LAS float* sgl = (LAS float*)(lds + 131072);
    if (tid < 32) *(LAS f32x4*)(sgl + 4 * tid) = *(const f32x4*)(subln_g + 4 * tid);
    for (int round = 0; round < 8; ++round) {
        const int i = blockIdx.x, xcd = i & 7, li = i >> 3, bh = xcd * 16 + 4 * (round >> 1) + (li >> 3), j8 = li & 7;
        const int qb = (round & 1) ? j8 : 15 - j8;
        const int b = bh >> 3, h = bh & 7;
        const size_t tok0 = (size_t)b * SEQ;
        const float slope2 = exp2f(-(float)(h + 1)) * LOG2E, d32 = 32.f * slope2, d64 = 64.f * slope2;
        const int qrow = qb * 128 + qg * 32 + r32;
        asm volatile("" :: "v"(qr[0]), "v"(qr[1]), "v"(qr[2]), "v"(qr[3]));
        f32x16 bt0;
#pragma unroll
        for (int r = 0; r < 16; ++r) bt0[r] = slope2 * (float)((r & 3) + 8 * (r >> 2) + 4 * hi);
        const char* srcK0; const char* srcV0;
        { const int row = 8 * wid + (lane >> 3), ch = (lane & 7) ^ ((row >> 1) & 7);
          srcK0 = (const char*)(qkv + (tok0 + row) * 3072 + 1024 + (2 * h) * 64) + ch * 16; }
        { const int row = 4 * wid + (lane >> 4), ch = (lane & 15) ^ ((row & 3) << 2); srcV0 = (const char*)(qkv + (tok0 + row) * 3072 + 2048 + h * 128) + ch * 16; }
        auto issue = [&](int s, int t) {
            ldsp st = lds + s * STAGE; const size_t adv = (size_t)t * 64 * 3072 * 2;
            glds16(srcK0 + adv, st + wid * 1024); glds16(srcK0 + adv + 128, st + 8192 + wid * 1024);
            glds16(srcV0 + adv, st + 16384 + wid * 1024); glds16(srcV0 + adv + (size_t)32 * 6144, st + 16384 + (wid + 8) * 1024);
        };
        f32x16 o[4];
#pragma unroll
        for (int dvt = 0; dvt < 4; ++dvt)
#pragma unroll
            for (int r = 0; r < 16; ++r) o[dvt][r] = 0.f;
        bf16x8 pw[4];
#pragma unroll
        for (int g = 0; g < 4; ++g) pw[g] = (bf16x8){0, 0, 0, 0, 0, 0, 0, 0};
        float mrel = -__builtin_inff(), lsum = 0.f;
        const int ntile = 2 * qb + 2;
        const int qfirst = qb * 128 + qg * 32;
        f32x16 pS0, pS1, pT0, pT1;
        bf16x8 pw2[4];
        auto pv = [&](ldsp stv, const bf16x8 (&pwi)[4]) {
            int vb = vb0; asm volatile("" : "+v"(vb));
            bf16x8 vq[3];
            vq[0] = tr2(stv + vb, stv + vb + 2048);
            vq[1] = tr2(stv + (vb ^ 64), stv + (vb ^ 64) + 2048);
#pragma unroll
            for (int i = 0; i < 16; ++i) {
                const int g = i >> 2, dvt = i & 3;
                if (i + 2 < 16) { const int i2 = i + 2, vo = (vb ^ ((i2 & 3) << 6)) + (i2 >> 2) * 4096; vq[i2 % 3] = tr2(stv + vo, stv + vo + 2048); }
                o[dvt] = __builtin_amdgcn_mfma_f32_32x32x16_bf16(vq[i % 3], pwi[g], o[dvt], 0, 0, 0);
                __builtin_amdgcn_sched_barrier(0);
            }
        };
        auto qk = [&](int t, f32x16& S0, f32x16& S1) {
            ldsp stk = lds + (t & 3) * STAGE;
            int kb = kb0; asm volatile("" : "+v"(kb));
            bf16x8 kf[4];
            kf[0] = *(LAS bf16x8*)(stk + kb); kf[1] = *(LAS bf16x8*)(stk + kb + 4096);
            kf[2] = *(LAS bf16x8*)(stk + (kb ^ 32)); kf[3] = *(LAS bf16x8*)(stk + (kb ^ 32) + 4096);
            S0 = __builtin_amdgcn_mfma_f32_32x32x16_bf16(kf[0], qr[0], bt0, 0, 0, 0);
            S1 = __builtin_amdgcn_mfma_f32_32x32x16_bf16(kf[1], qr[0], bt0, 0, 0, 0);
            __builtin_amdgcn_sched_barrier(0);
            kf[0] = *(LAS bf16x8*)(stk + (kb ^ 64)); kf[1] = *(LAS bf16x8*)(stk + (kb ^ 64) + 4096);
            S0 = __builtin_amdgcn_mfma_f32_32x32x16_bf16(kf[2], qr[1], S0, 0, 0, 0);
            S1 = __builtin_amdgcn_mfma_f32_32x32x16_bf16(kf[3], qr[1], S1, 0, 0, 0);
            __builtin_amdgcn_sched_barrier(0);
            kf[2] = *(LAS bf16x8*)(stk + (kb ^ 96)); kf[3] = *(LAS bf16x8*)(stk + (kb ^ 96) + 4096);
            S0 = __builtin_amdgcn_mfma_f32_32x32x16_bf16(kf[0], qr[2], S0, 0, 0, 0);
            S1 = __builtin_amdgcn_mfma_f32_32x32x16_bf16(kf[1], qr[2], S1, 0, 0, 0);
            __builtin_amdgcn_sched_barrier(0);
            S0 = __builtin_amdgcn_mfma_f32_32x32x16_bf16(kf[2], qr[3], S0, 0, 0, 0);
            S1 = __builtin_amdgcn_mfma_f32_32x32x16_bf16(kf[3], qr[3], S1, 0, 0, 0);
        };
        float alpha_d = 1.f; bool resc_d = false;
        auto smax = [&](int t, f32x16& S0, f32x16& S1, bool defer) {
            const int key0 = 64 * t;
            if (key0 + 63 > qfirst) {
                const int kq = qrow - key0 - 4 * hi;
#pragma unroll
                for (int r = 0; r < 16; ++r) { const int kr = (r & 3) + 8 * (r >> 2); if (kr > kq) S0[r] = -__builtin_inff(); if (kr + 32 > kq) S1[r] = -__builtin_inff(); }
            }
            float ma = MX3(S0[0], S0[1], S0[2]), mb = MX3(S1[0], S1[1], S1[2]);
            ma = MX3(ma, S0[3], S0[4]); mb = MX3(mb, S1[3], S1[4]);
#pragma unroll
            for (int r = 5; r < 15; r += 2) { ma = MX3(ma, S0[r], S0[r + 1]); mb = MX3(mb, S1[r], S1[r + 1]); }
            ma = fmaxf(ma, S0[15]); mb = fmaxf(mb, S1[15]);
            const float mx = half_swap_max(fmaxf(ma, mb + d32));
            resc_d = false;
            if (__any(mx - mrel > THR)) {
                const float mnew = fmaxf(mrel, mx); float alpha = fast_exp2(mrel - mnew);
                asm volatile("s_nop 1" : "+v"(alpha));
                mrel = mnew; lsum *= alpha;
                if (defer) { alpha_d = alpha; resc_d = true; }
                else {
#pragma unroll
                    for (int dvt = 0; dvt < 4; ++dvt)
#pragma unroll
                        for (int r = 0; r < 16; ++r) asm volatile("v_mul_f32 %0, %0, %1" : "+v"(o[dvt][r]) : "v"(alpha));
                }
            }
        };
        auto sexp = [&](f32x16& S0, f32x16& S1, bf16x8 (&pwo)[4]) {
            const float e0 = mrel, e1 = mrel - d32;
            float s0 = 0.f, s1 = 0.f;
#pragma unroll
            for (int r = 0; r < 16; ++r) { S0[r] = fast_exp2(S0[r] - e0); S1[r] = fast_exp2(S1[r] - e1); s0 += S0[r]; asm volatile("" : "+v"(s0)); s1 += S1[r]; asm volatile("" : "+v"(s1)); }
            lsum += s0 + s1;
#pragma unroll
            for (int g = 0; g < 2; ++g) { u32x4 w0, w1;
                w0.x = pk2(S0[8 * g + 0], S0[8 * g + 1]); w0.y = pk2(S0[8 * g + 2], S0[8 * g + 3]); w0.z = pk2(S0[8 * g + 4], S0[8 * g + 5]); w0.w = pk2(S0[8 * g + 6], S0[8 * g + 7]);
                w1.x = pk2(S1[8 * g + 0], S1[8 * g + 1]); w1.y = pk2(S1[8 * g + 2], S1[8 * g + 3]); w1.z = pk2(S1[8 * g + 4], S1[8 * g + 5]); w1.w = pk2(S1[8 * g + 6], S1[8 * g + 7]);
                pwo[g] = __builtin_bit_cast(bf16x8, w0); pwo[2 + g] = __builtin_bit_cast(bf16x8, w1); }
            mrel -= d64;
        };
        auto pv_sexp = [&](ldsp stv, const bf16x8 (&pwi)[4], f32x16& S0, f32x16& S1, bf16x8 (&pwo)[4]) {
            const float e0 = mrel, e1 = mrel - d32;
            float s0 = 0.f, s1 = 0.f; unsigned wa[8], wb[8];
            int vb = vb0; asm volatile("" : "+v"(vb));
            bf16x8 vq[3];
            vq[0] = tr2(stv + vb, stv + vb + 2048);
            vq[1] = tr2(stv + (vb ^ 64), stv + (vb ^ 64) + 2048);
#pragma unroll
            for (int i = 0; i < 16; ++i) {
                const int g = i >> 2, dvt = i & 3;
                if (i + 2 < 16) { const int i2 = i + 2, vo = (vb ^ ((i2 & 3) << 6)) + (i2 >> 2) * 4096; vq[i2 % 3] = tr2(stv + vo, stv + vo + 2048); }
                o[dvt] = __builtin_amdgcn_mfma_f32_32x32x16_bf16(vq[i % 3], pwi[g], o[dvt], 0, 0, 0);
                S0[i] = fast_exp2(S0[i] - e0); S1[i] = fast_exp2(S1[i] - e1); s0 += S0[i]; s1 += S1[i];
                if (i & 1) { wa[i >> 1] = pk2(S0[i - 1], S0[i]); wb[i >> 1] = pk2(S1[i - 1], S1[i]); asm volatile("" : "+v"(wa[i >> 1]), "+v"(wb[i >> 1])); }
                asm volatile("" : "+v"(s0), "+v"(s1));
                __builtin_amdgcn_sched_barrier(0);
            }
            lsum += s0 + s1;
#pragma unroll
            for (int g = 0; g < 2; ++g) { u32x4 w0 = {wa[4 * g], wa[4 * g + 1], wa[4 * g + 2], wa[4 * g + 3]}, w1 = {wb[4 * g], wb[4 * g + 1], wb[4 * g + 2], wb[4 * g + 3]};
                pwo[g] = __builtin_bit_cast(bf16x8, w0); pwo[2 + g] = __builtin_bit_cast(bf16x8, w1); }
            mrel -= d64;
        };
        auto qk_sexp = [&](int t, f32x16& N0, f32x16& N1, f32x16& S0, f32x16& S1, bf16x8 (&pwo)[4]) {
            const float e0 = mrel, e1 = mrel - d32;
            float s0 = 0.f, s1 = 0.f; unsigned wa[8], wb[8];
            auto fill = [&](int q) {
#pragma unroll
                for (int r = 4 * q; r < 4 * q + 4; ++r) { S0[r] = fast_exp2(S0[r] - e0); S1[r] = fast_exp2(S1[r] - e1); s0 += S0[r]; s1 += S1[r]; }
                wa[2 * q] = pk2(S0[4 * q], S0[4 * q + 1]); wa[2 * q + 1] = pk2(S0[4 * q + 2], S0[4 * q + 3]);
                wb[2 * q] = pk2(S1[4 * q], S1[4 * q + 1]); wb[2 * q + 1] = pk2(S1[4 * q + 2], S1[4 * q + 3]);
                asm volatile("" : "+v"(wa[2 * q]), "+v"(wa[2 * q + 1]), "+v"(wb[2 * q]), "+v"(wb[2 * q + 1]), "+v"(s0), "+v"(s1));
            };
            ldsp stk = lds + (t & 3) * STAGE;
            int kb = kb0; asm volatile("" : "+v"(kb));
            bf16x8 kf[4];
            kf[0] = *(LAS bf16x8*)(stk + kb); kf[1] = *(LAS bf16x8*)(stk + kb + 4096);
            kf[2] = *(LAS bf16x8*)(stk + (kb ^ 32)); kf[3] = *(LAS bf16x8*)(stk + (kb ^ 32) + 4096);
            N0 = __builtin_amdgcn_mfma_f32_32x32x16_bf16(kf[0], qr[0], bt0, 0, 0, 0);
            N1 = __builtin_amdgcn_mfma_f32_32x32x16_bf16(kf[1], qr[0], bt0, 0, 0, 0);
            fill(0);
            __builtin_amdgcn_sched_barrier(0);
            kf[0] = *(LAS bf16x8*)(stk + (kb ^ 64)); kf[1] = *(LAS bf16x8*)(stk + (kb ^ 64) + 4096);
            N0 = __builtin_amdgcn_mfma_f32_32x32x16_bf16(kf[2], qr[1], N0, 0, 0, 0);
            N1 = __builtin_amdgcn_mfma_f32_32x32x16_bf16(kf[3], qr[1], N1, 0, 0, 0);
            fill(1);
            __builtin_amdgcn_sched_barrier(0);
            kf[2] = *(LAS bf16x8*)(stk + (kb ^ 96)); kf[3] = *(LAS bf16x8*)(stk + (kb ^ 96) + 4096);
            N0 = __builtin_amdgcn_mfma_f32_32x32x16_bf16(kf[0], qr[2], N0, 0, 0, 0);
            N1 = __builtin_amdgcn_mfma_f32_32x32x16_bf16(kf[1], qr[2], N1, 0, 0, 0);
            fill(2);
            __builtin_amdgcn_sched_barrier(0);
            N0 = __builtin_amdgcn_mfma_f32_32x32x16_bf16(kf[2], qr[3], N0, 0, 0, 0);
            N1 = __builtin_amdgcn_mfma_f32_32x32x16_bf16(kf[3], qr[3], N1, 0, 0, 0);
            fill(3);
            __builtin_amdgcn_sched_barrier(0);
            lsum += s0 + s1;
#pragma unroll
            for (int g = 0; g < 2; ++g) { u32x4 w0 = {wa[4 * g], wa[4 * g + 1], wa[4 * g + 2], wa[4 * g + 3]}, w1 = {wb[4 * g], wb[4 * g + 1], wb[4 * g + 2], wb[4 * g + 3]};
                pwo[g] = __builtin_bit_cast(bf16x8, w0); pwo[2 + g] = __builtin_bit_cast(bf16x8, w1); }
            mrel -= d64;
        };
        BAR();
        issue(0, 0); issue(1, 1);
#pragma unroll 1
        for (int pr = 0; pr < ntile; pr += 2) {
            wait_vm<0>();
            BAR();
            if (pr + 2 < ntile) { issue((pr + 2) & 3, pr + 2); issue((pr + 3) & 3, pr + 3); }
            qk(pr, pS0, pS1);
            smax(pr, pS0, pS1, false);
            qk_sexp(pr + 1, pT0, pT1, pS0, pS1, pw);
            smax(pr + 1, pT0, pT1, true);
            pv_sexp(lds + (pr & 3) * STAGE, pw, pT0, pT1, pw2);
            if (resc_d) {
#pragma unroll
                for (int dvt = 0; dvt < 4; ++dvt)
#pragma unroll
                    for (int r = 0; r < 16; ++r) asm volatile("v_mul_f32 %0, %0, %1" : "+v"(o[dvt][r]) : "v"(alpha_d));
            }
            pv(lds + ((pr + 1) & 3) * STAGE, pw2);
        }
        if (round + 1 < 8) load_q(round + 1);
        const float inv = __builtin_amdgcn_rcpf(half_swap_sum(lsum));
        BAR();
        LAS float* xb = (LAS float*)lds + qg * 4096;
        if (map == 1) {
#pragma unroll
            for (int dvt = 0; dvt < 4; ++dvt)
#pragma unroll
                for (int r = 0; r < 16; ++r) xb[(dvt * 16 + r) * 64 + lane] = o[dvt][r] * inv;
        }
        LDS_WAIT(); BAR();
        if (map == 0) {
            float ss = 0.f;
#pragma unroll
            for (int dvt = 0; dvt < 4; ++dvt) {
#pragma unroll
                for (int r = 0; r < 16; ++r) { const float v = o[dvt][r] * inv - lam * xb[(dvt * 16 + r) * 64 + lane]; o[dvt][r] = v; ss += v * v; }
                __builtin_amdgcn_sched_barrier(0);
            }
            ss = half_swap_sum(ss);
            const float rstd = rsqrtf(ss * (1.f / 128.f) + 1e-6f) * 0.8f;
            bf16_t* orow = ao + (tok0 + qrow) * D + h * 128 + 4 * hi;
#pragma unroll
            for (int dvt = 0; dvt < 4; ++dvt) {
#pragma unroll
                for (int j = 0; j < 4; ++j) { const f32x4 g = *(LAS f32x4*)(sgl + dvt * 32 + 8 * j + 4 * hi);
                    u32x2 w; w.x = pk2(o[dvt][4 * j] * rstd * g[0], o[dvt][4 * j + 1] * rstd * g[1]); w.y = pk2(o[dvt][4 * j + 2] * rstd * g[2], o[dvt][4 * j + 3] * rstd * g[3]);
                    *(u32x2*)(orow + dvt * 32 + 8 * j) = w; }
                __builtin_amdgcn_sched_barrier(0);
            }
        }
        LDS_WAIT(); BAR();
    }
}

__device__ __forceinline__ void chain_phase(ldsp lds, bf16_t* rp, const bf16_t* P, bool dry) {
    const int tid = fresh_tid(), lane = tid & 63, wid = __builtin_amdgcn_readfirstlane(tid >> 6), fr = lane & 15, fq = lane >> 4;
    constexpr int STAGE = 32768, NSTG = 4;
    const int chain = vcu_of_block(), b = chain >> 4, h = (chain >> 2) & 3, sl = chain & 3;
    const size_t tok0 = (size_t)b * SEQ;
    const float lg = __log2f(1.f - exp2f(-5.f - (float)h));
    const float gamma = exp2f(lg), g127 = exp2f(lg * 127.f), g128 = exp2f(lg * 128.f);
    const bf16_t* vbase = rp + tok0 * 6144 + 2048 + h * 512 + sl * 128;
    const bf16_t* qbase = rp + tok0 * 6144 + h * 256;
    const bf16_t* kbase = rp + tok0 * 6144 + 1024 + h * 256;
    const bf16_t* pbase = P + (size_t)((b * 4 + h) * 16) * 16384;
    unsigned vsrc0, psrc0, qsrc0, ksrc0;
    { const int row = 4 * wid + (lane >> 4); vsrc0 = (unsigned)(row * 6144 * 2 + (((lane & 15) ^ ((row & 7) << 1)) << 4)); psrc0 = (unsigned)(row * 256 + (((lane & 15) ^ (row & 15)) << 4)); }
    { const int row = 8 * wid + (lane >> 3); qsrc0 = (unsigned)(row * 6144 * 2 + (((lane & 7) ^ ((row >> 1) & 7)) << 4)); ksrc0 = (unsigned)(row * 6144 * 2 + (((lane & 7) ^ (((row >> 1) & 3) << 1)) << 4)); }
    auto issue = [&](int s, int g) {
        ldsp st = lds + s * STAGE; const int c = g / 6, kind = g - c * 6; const size_t coff = (size_t)c * 128 * 6144 * 2;
        if (kind == 0) {
            const char* bp = (const char*)vbase + coff;
#pragma unroll
            for (int jj = 0; jj < 4; ++jj) glds16(bp + (size_t)jj * 32 * 12288 + vsrc0, st + (wid + 8 * jj) * 1024);
        } else if (kind == 5) {
            const char* bp = (const char*)pbase + (size_t)c * 32768;
#pragma unroll
            for (int jj = 0; jj < 4; ++jj) glds16(bp + (size_t)jj * 32 * 256 + psrc0, st + (wid + 8 * jj) * 1024);
        } else { const int p = kind - 1;
            const char* bq = (const char*)qbase + coff + p * 128; const char* bk = (const char*)kbase + coff + p * 128;
#pragma unroll
            for (int jj = 0; jj < 2; ++jj) glds16(bq + (size_t)jj * 64 * 12288 + qsrc0, st + (wid + 8 * jj) * 1024);
#pragma unroll
            for (int jj = 0; jj < 2; ++jj) glds16(bk + (size_t)jj * 64 * 12288 + ksrc0, st + 16384 + (wid + 8 * jj) * 1024);
        }
    };
    const int tq = fr >> 2, tp = fr & 3;
    const int vrow = 4 * fq + tq;
    const int vfo = vrow * 256 + ((((2 * wid + (tp >> 1)) ^ ((vrow & 7) << 1)) & 15) << 4) + (tp & 1) * 8;
    const int ksw = ((vrow >> 1) & 3) << 1;
    const int kfo0 = 16384 + vrow * 128 + ((((tp >> 1) ^ ksw) & 7) << 4) + (tp & 1) * 8;
    const int qsw = fr >> 1;
    const int qfo0 = fr * 128 + ((((fq >> 1) ^ qsw) & 7) << 4) + (fq & 1) * 8;
    const int pfo0 = fr * 256 + ((((fq >> 1) ^ fr) & 15) << 4) + (fq & 1) * 8;

    f32x4 R[16];
#pragma unroll
    for (int i = 0; i < 16; ++i) R[i] = (f32x4){0.f, 0.f, 0.f, 0.f};
    f32x4 o[8];
#pragma unroll
    for (int it = 0; it < 8; ++it) o[it] = (f32x4){0.f, 0.f, 0.f, 0.f};
    bf16x8 vf[4];
#pragma unroll
    for (int s4 = 0; s4 < 4; ++s4) vf[s4] = (bf16x8){0, 0, 0, 0, 0, 0, 0, 0};
    constexpr int NG = 16 * 6;
    BAR();
    issue(0, 0); issue(1, 1); issue(2, 2);
    for (int c = 0; c < 16; ++c) {
        auto step = [&](auto KC) {
            constexpr int kind = decltype(KC)::value;
            const int g = c * 6 + kind;
            if (g + 2 < NG) wait_vm<8>(); else if (g + 1 < NG) wait_vm<4>(); else wait_vm<0>();
            BAR();
            if (g + 3 < NG) issue((g + 3) & 3, g + 3);
            ldsp st = lds + (g & 3) * STAGE;
            if constexpr (kind == 0) {
#pragma unroll
                for (int s4 = 0; s4 < 4; ++s4) vf[s4] = tr2(st + vfo + s4 * 8192, st + vfo + s4 * 8192 + 4096);
#pragma unroll
                for (int it = 0; it < 8; ++it) o[it] = (f32x4){0.f, 0.f, 0.f, 0.f};
            } else if constexpr (kind == 5) {
#pragma unroll
                for (int it = 0; it < 8; ++it) o[it] = o[it] * gamma;
                int pb = pfo0; asm volatile("" : "+v"(pb));
                bf16x8 fa[4], fb[4];
                auto loadp = [&](bf16x8 (&d)[4], int grp) { const int s4 = grp >> 1, hb = (grp & 1) * 4; const int p0 = pb ^ ((4 * s4) << 4), p1 = pb ^ ((4 * s4 + 2) << 4);
#pragma unroll
                    for (int i = 0; i < 4; ++i) d[i] = rd2x64(st + p0 + (hb + i) * 4096, st + p1 + (hb + i) * 4096); };
                auto mmap = [&](const bf16x8 (&f)[4], int grp) { const int s4 = grp >> 1, hb = (grp & 1) * 4;
#pragma unroll
                    for (int i = 0; i < 4; ++i) o[hb + i] = __builtin_amdgcn_mfma_f32_16x16x32_bf16(vf[s4], f[i], o[hb + i], 0, 0, 0); };
                loadp(fa, 0);
#pragma unroll
                for (int grp = 0; grp < 8; grp += 2) {
                    loadp(fb, grp + 1); mmap(fa, grp); __builtin_amdgcn_sched_barrier(0);
                    if (grp + 2 < 8) loadp(fa, grp + 2);
                    mmap(fb, grp + 1); __builtin_amdgcn_sched_barrier(0);
                }
                bf16_t* ob = rp + (tok0 + (size_t)c * 128) * 6144 + 2048 + h * 512 + sl * 128 + 16 * wid + 4 * fq;
#pragma unroll
                for (int it = 0; it < 8; ++it) { u32x2 w; w.x = pk2(o[it][0], o[it][1]); w.y = pk2(o[it][2], o[it][3]); if (!dry) *(u32x2*)(ob + (size_t)(16 * it + fr) * 6144) = w; else asm volatile("" :: "v"(w)); }
            } else {
                constexpr int p = kind - 1;
                bf16x8 rf[2];
#pragma unroll
                for (int s2 = 0; s2 < 2; ++s2) { u32x4 w; const f32x4 r0 = R[4 * p + 2 * s2], r1 = R[4 * p + 2 * s2 + 1];
                    w.x = pk2(r0[0], r0[1]); w.y = pk2(r0[2], r0[3]); w.z = pk2(r1[0], r1[1]); w.w = pk2(r1[2], r1[3]); rf[s2] = __builtin_bit_cast(bf16x8, w); }
                int qb = qfo0; asm volatile("" : "+v"(qb));
                int kb = kfo0; asm volatile("" : "+v"(kb));
                bf16x8 fa[4], fb[4];
                auto loadq = [&](bf16x8 (&d)[4], int grp) { const int s2 = grp >> 1, hb = (grp & 1) * 4; const int q0 = qb ^ ((4 * s2) << 4), q1 = qb ^ ((4 * s2 + 2) << 4);
#pragma unroll
                    for (int i = 0; i < 4; ++i) d[i] = rd2x64(st + q0 + (hb + i) * 2048, st + q1 + (hb + i) * 2048); };
                auto mmaq = [&](const bf16x8 (&f)[4], int grp) { const int s2 = grp >> 1, hb = (grp & 1) * 4;
#pragma unroll
                    for (int i = 0; i < 4; ++i) o[hb + i] = __builtin_amdgcn_mfma_f32_16x16x32_bf16(rf[s2], f[i], o[hb + i], 0, 0, 0); };
                auto loadk = [&](bf16x8 (&d)[4], int s4) {
#pragma unroll
                    for (int dkt = 0; dkt < 4; ++dkt) { const int ko = kb ^ (dkt << 5); d[dkt] = tr2(st + ko + s4 * 4096, st + ko + s4 * 4096 + 2048); } };
                f32x4 au[4];
#pragma unroll
                for (int dkt = 0; dkt < 4; ++dkt) au[dkt] = (f32x4){0.f, 0.f, 0.f, 0.f};
                auto mmak = [&](const bf16x8 (&f)[4], int s4) {
#pragma unroll
                    for (int dkt = 0; dkt < 4; ++dkt) au[dkt] = __builtin_amdgcn_mfma_f32_16x16x32_bf16(f[dkt], vf[s4], au[dkt], 0, 0, 0); };
                loadq(fa, 0);
                loadq(fb, 1); mmaq(fa, 0); __builtin_amdgcn_sched_barrier(0);
                loadq(fa, 2); mmaq(fb, 1); __builtin_amdgcn_sched_barrier(0);
                loadq(fb, 3); mmaq(fa, 2); __builtin_amdgcn_sched_barrier(0);
                loadk(fa, 0); mmaq(fb, 3); __builtin_amdgcn_sched_barrier(0);
                loadk(fb, 1); mmak(fa, 0); __builtin_amdgcn_sched_barrier(0);
                loadk(fa, 2); mmak(fb, 1); __builtin_amdgcn_sched_barrier(0);
                loadk(fb, 3); mmak(fa, 2); __builtin_amdgcn_sched_barrier(0);
                mmak(fb, 3);
#pragma unroll
                for (int dkt = 0; dkt < 4; ++dkt) R[4 * p + dkt] = R[4 * p + dkt] * g128 + au[dkt] * g127;
                __builtin_amdgcn_sched_barrier(0);
            }
        };
        step(std::integral_constant<int, 0>{}); step(std::integral_constant<int, 1>{}); step(std::integral_constant<int, 2>{});
        step(std::integral_constant<int, 3>{}); step(std::integral_constant<int, 4>{}); step(std::integral_constant<int, 5>{});
    }
}

__device__ __forceinline__ void gnorm_phase(bf16_t* rp, const float* gn, int gw, int ngw, int lane, bool dry) {
    f32x4 w0[4], w1[4];
#pragma unroll
    for (int hh = 0; hh < 4; ++hh) { w0[hh] = *(const f32x4*)(gn + hh * 512 + 8 * lane); w1[hh] = *(const f32x4*)(gn + hh * 512 + 8 * lane + 4); }
    for (int row = gw; row < T; row += ngw) {
        bf16_t* orow = rp + (size_t)row * 6144 + 2048; const bf16_t* grow = rp + (size_t)row * 6144 + 4096;
        u32x4 ov[4], gv[4];
#pragma unroll
        for (int hh = 0; hh < 4; ++hh) { ov[hh] = *(const u32x4*)(orow + hh * 512 + 8 * lane); gv[hh] = *(const u32x4*)(grow + hh * 512 + 8 * lane); }
#pragma unroll
        for (int hh = 0; hh < 4; ++hh) {
            float of[8] = {bf_lo(ov[hh].x), bf_hi(ov[hh].x), bf_lo(ov[hh].y), bf_hi(ov[hh].y), bf_lo(ov[hh].z), bf_hi(ov[hh].z), bf_lo(ov[hh].w), bf_hi(ov[hh].w)};
            float gf[8] = {bf_lo(gv[hh].x), bf_hi(gv[hh].x), bf_lo(gv[hh].y), bf_hi(gv[hh].y), bf_lo(gv[hh].z), bf_hi(gv[hh].z), bf_lo(gv[hh].w), bf_hi(gv[hh].w)};
            float ss = 0.f;
#pragma unroll
            for (int e = 0; e < 8; ++e) ss += of[e] * of[e];
            const float rstd = rsqrtf(wave_sum(ss) * (1.f / 512.f) + 1e-6f);
            float y[8];
#pragma unroll
            for (int e = 0; e < 8; ++e) y[e] = silu_f(gf[e]) * of[e] * rstd * (e < 4 ? w0[hh][e] : w1[hh][e - 4]);
            u32x4 w; w.x = pk2(y[0], y[1]); w.y = pk2(y[2], y[3]); w.z = pk2(y[4], y[5]); w.w = pk2(y[6], y[7]);
            if (!dry) *(u32x4*)(orow + hh * 512 + 8 * lane) = w; else asm volatile("" :: "v"(w));
        }
    }
}

__device__ __forceinline__ void router_phase(ldsp lds, const bf16_t* XRBp, const float* mod_sh, const float* mod_G, const bf16_t* rwt  , const float* rbias,
                                             bf16_t* H, int* sel_e, float* sel_w, int* sel_p, int* tokl, unsigned* cnt, int tile0, int tile_end, int tstep, int wave, int lane, bool dry) {
    LAS float* lg = (LAS float*)(lds + wave * 8192);
    LAS int* st2 = (LAS int*)(lds + wave * 8192 + 4096);
    LAS float* Gl = (LAS float*)(lds + 131072); LAS float* SHl = Gl + 1024;
    const float rb = rbias[lane];
    const int fr = lane & 15, fq = lane >> 4;
    for (int tile = tile0; tile < tile_end; tile += tstep) {
        const int row = tile * 16 + fr, b = row >> 11;
        const bf16_t* xr = XRBp + (size_t)row * XRB_LD + XRB_OFF + 8 * fq;
        bf16_t* hrow = H + (size_t)row * D + 8 * fq;
        { const int t4 = (wave * 64 + lane) * 4; const float* src = (t4 < 1024 ? mod_G : mod_sh - 1024) + (size_t)b * 6144 + t4; *(LAS f32x4*)(Gl + t4) = *(const f32x4*)src; }
        auto issue_chunk = [&](int ch) {
            ldsp buf = lds + (ch & 1) * 65536;
#pragma unroll
            for (int j = 0; j < 8; ++j) { const int i = wave + 8 * j, r2 = 2 * i + (lane >> 5), lc = (lane & 31) ^ (r2 & 15);
                glds16((const char*)rwt + (size_t)r2 * 2048 + (size_t)ch * 512 + lc * 16, buf + i * 1024); }
        };
        issue_chunk(0);
        float ss = 0.f;
#pragma unroll 32
        for (int s = 0; s < 32; ++s) { const u32x4 xb = *(const u32x4*)(xr + 32 * s);
            const float e0 = bf_lo(xb.x), e1 = bf_hi(xb.x), e2 = bf_lo(xb.y), e3 = bf_hi(xb.y), e4 = bf_lo(xb.z), e5 = bf_hi(xb.z), e6 = bf_lo(xb.w), e7 = bf_hi(xb.w);
            ss += e0 * e0 + e1 * e1 + e2 * e2 + e3 * e3 + e4 * e4 + e5 * e5 + e6 * e6 + e7 * e7; }
        ss += lane_xor<16>(ss);
        { auto rr = __builtin_amdgcn_permlane32_swap(__float_as_uint(ss), __float_as_uint(ss), false, false); ss = __uint_as_float(rr[0]) + __uint_as_float(rr[1]); }
        const float rstd = rsqrtf(ss * (1.f / D) + 1e-6f);
        f32x4 acc[4];
#pragma unroll
        for (int et = 0; et < 4; ++et) acc[et] = (f32x4){0.f, 0.f, 0.f, 0.f};
        u32x4 xc[8], xn[8];
#pragma unroll
        for (int i = 0; i < 8; ++i) xc[i] = *(const u32x4*)(xr + 32 * i);
        for (int ch = 0; ch < 4; ++ch) {
            if (ch == 0) wait_vm<0>(); else wait_vm<8>();
            LDS_WAIT();
            BAR();
            if (ch + 1 < 4) issue_chunk(ch + 1);
#pragma unroll
            for (int i = 0; i < 8; ++i) xn[i] = *(const u32x4*)(xr + 256 * ((ch + 1) & 3) + 32 * i);
            ldsp buf = lds + (ch & 1) * 65536;
#pragma unroll
            for (int sl = 0; sl < 8; ++sl) {
                const int s = 8 * ch + sl;
                const int pc = (((4 * sl + fq) ^ fr) & 31) << 4;
                bf16x8 bhf[4], blf[4];
#pragma unroll
                for (int et = 0; et < 4; ++et) { bhf[et] = *(LAS bf16x8*)(buf + (16 * et + fr) * 512 + pc); blf[et] = *(LAS bf16x8*)(buf + (64 + 16 * et + fr) * 512 + pc); }
                const u32x4 xb = xc[sl];
                const f32x4 x0 = {bf_lo(xb.x), bf_hi(xb.x), bf_lo(xb.y), bf_hi(xb.y)}, x1 = {bf_lo(xb.z), bf_hi(xb.z), bf_lo(xb.w), bf_hi(xb.w)};
                const f32x4 g0 = *(LAS f32x4*)(Gl + 32 * s + 8 * fq), g1 = *(LAS f32x4*)(Gl + 32 * s + 8 * fq + 4), s0 = *(LAS f32x4*)(SHl + 32 * s + 8 * fq), s1 = *(LAS f32x4*)(SHl + 32 * s + 8 * fq + 4);
                __builtin_amdgcn_sched_barrier(0);
                const f32x4 h0 = x0 * rstd * g0 + s0, h1 = x1 * rstd * g1 + s1;
                u32x4 hi; hi.x = pk2(h0[0], h0[1]); hi.y = pk2(h0[2], h0[3]); hi.z = pk2(h1[0], h1[1]); hi.w = pk2(h1[2], h1[3]);
                *(u32x4*)(hrow + 32 * s) = hi;
                u32x4 lo; lo.x = pk2(h0[0] - bf_lo(hi.x), h0[1] - bf_hi(hi.x)); lo.y = pk2(h0[2] - bf_lo(hi.y), h0[3] - bf_hi(hi.y));
                lo.z = pk2(h1[0] - bf_lo(hi.z), h1[1] - bf_hi(hi.z)); lo.w = pk2(h1[2] - bf_lo(hi.w), h1[3] - bf_hi(hi.w));
                const bf16x8 ahi = __builtin_bit_cast(bf16x8, hi), alo = __builtin_bit_cast(bf16x8, lo);
#pragma unroll
                for (int et = 0; et < 4; ++et) {
                    acc[et] = __builtin_amdgcn_mfma_f32_16x16x32_bf16(ahi, bhf[et], acc[et], 0, 0, 0);
                    acc[et] = __builtin_amdgcn_mfma_f32_16x16x32_bf16(ahi, blf[et], acc[et], 0, 0, 0);
                    acc[et] = __builtin_amdgcn_mfma_f32_16x16x32_bf16(alo, bhf[et], acc[et], 0, 0, 0); }
            }
#pragma unroll
            for (int i = 0; i < 8; ++i) xc[i] = xn[i];
        }
        LDS_WAIT(); BAR();
#pragma unroll
        for (int et = 0; et < 4; ++et)
#pragma unroll
            for (int r = 0; r < 4; ++r) lg[(4 * fq + r) * 64 + 16 * et + fr] = acc[et][r];
        LDS_WAIT();
        int myc = 0;
        const int l7 = lane & 7, g8 = lane >> 3;
        LAS unsigned* kb = (LAS unsigned*)(lds + 65536 + 4096 + wave * 1024);
#pragma unroll 1
        for (int tt0 = 0; tt0 < 16; tt0 += 4) {
            float score[4], choice[4], gs[4]; unsigned key[4];
#pragma unroll
            for (int u = 0; u < 4; ++u) { const float logit = lg[(tt0 + u) * 64 + lane]; score[u] = 1.f / (1.f + __expf(-logit)); choice[u] = score[u] + rb; }
#pragma unroll
            for (int u = 0; u < 4; ++u) {
                const float c = choice[u], m = dpp_f<0x141>(c);
                const float ot[7] = {dpp_f<0xB1>(c), dpp_f<0x4E>(c), dpp_f<0x1B>(c), dpp_f<0x1B>(m), dpp_f<0x4E>(m), dpp_f<0xB1>(m), m};
                int rk = 0;
#pragma unroll
                for (int d = 1; d < 8; ++d) rk += (ot[d - 1] > c || (ot[d - 1] == c && (l7 ^ d) < l7)) ? 1 : 0;
                float g = rk < 2 ? c : 0.f;
                g += dpp_f<0xB1>(g); g += dpp_f<0x4E>(g); g += dpp_f<0x141>(g);
                gs[u] = g;
            }
#pragma unroll
            for (int u = 0; u < 4; ++u) {
                int rg = 0;
#pragma unroll
                for (int j = 0; j < 8; ++j) { const float gj = __int_as_float(__builtin_amdgcn_readlane(__float_as_int(gs[u]), 8 * j)); rg += (gj > gs[u] || (gj == gs[u] && j < g8)) ? 1 : 0; }
                const float c2 = rg < 4 ? choice[u] : -__builtin_inff();
                const unsigned ub = __float_as_uint(c2); unsigned k = (ub & 0x80000000u) ? ~ub : (ub | 0x80000000u); key[u] = (k & ~63u) | (unsigned)(63 - lane);
                const bool elig = rg < 4; const unsigned long long em = __ballot(elig);
                if (elig) kb[u * 32 + __popcll(em & ((1ull << lane) - 1ull))] = key[u];
            }
            LDS_WAIT();
            int rank[4] = {0, 0, 0, 0};
#pragma unroll
            for (int q = 0; q < 8; ++q)
#pragma unroll
                for (int u = 0; u < 4; ++u) { const u32x4 kk = *(LAS u32x4*)(kb + u * 32 + 4 * q);
                    rank[u] += (kk.x > key[u] ? 1 : 0) + (kk.y > key[u] ? 1 : 0) + (kk.z > key[u] ? 1 : 0) + (kk.w > key[u] ? 1 : 0); }
#pragma unroll
            for (int u = 0; u < 4; ++u) {
                const bool chosen = rank[u] < 8;
                const unsigned long long cm = __ballot(chosen);
                const int r8 = __popcll(cm & ((1ull << lane) - 1ull));
                const float wsum = wave_sum_dpp(chosen ? score[u] : 0.f);
                lg[(tt0 + u) * 64 + lane] = score[u] / wsum * 2.5f;
                st2[(tt0 + u) * 64 + lane] = chosen ? ((myc << 8) | r8) : -1;
                myc += chosen ? 1 : 0;
            }
        }
        const int chunk = (tile * 16) / CH_TOK;
        LAS int* cw = (LAS int*)(lds + 65536); LAS unsigned* bs = (LAS unsigned*)(cw + 512);
        cw[wave * 64 + lane] = myc;
        LDS_WAIT(); BAR();
        int pre = 0, tot = 0;
#pragma unroll
        for (int w = 0; w < 8; ++w) { const int v = cw[w * 64 + lane]; pre += (w < wave) ? v : 0; tot += v; }
        if (wave == 0) { unsigned bb = 0; if (!dry && tot > 0) bb = atomicAdd(&cnt[chunk * 64 + lane], (unsigned)tot); bs[lane] = bb; }
        LDS_WAIT(); BAR();
        const unsigned base = bs[lane] + (unsigned)pre;
        if (dry) asm volatile("" :: "v"(myc));
        LDS_WAIT();
        for (int tt = 0; tt < 16; ++tt) {
            const int code = st2[tt * 64 + lane];
            if (!dry && code >= 0) { const int tok = tile * 16 + tt, r8 = code & 255; const unsigned pos = base + (unsigned)(code >> 8);
                sel_e[tok * 8 + r8] = lane; sel_w[tok * 8 + r8] = lg[tt * 64 + lane]; sel_p[tok * 8 + r8] = (int)pos;
                tokl[(size_t)(chunk * 64 + lane) * CH_TOK + pos] = tok; }
        }
        LDS_WAIT();
    }
}

__device__ __forceinline__ void build_tstart(const unsigned* cnt, int c, LAS int* ts) {
    const int l = fresh_tid();
    if (l < 64) {
        const int n = ((int)cnt[c * 64 + l] + MTILE - 1) / MTILE; int incl = n;
#pragma unroll
        for (int o = 1; o < 64; o <<= 1) { const int v = __builtin_amdgcn_ds_bpermute((l >= o ? l - o : l) << 2, incl); if (l >= o) incl += v; }
        ts[l] = incl - n; if (l == 63) { ts[64] = incl; ts[65] = incl + CH_TOK / MTILE; }
    }
}
struct MoeUpSrc {
    using Epi = EpiSwiGLU;
    const unsigned char* ws; const unsigned* cnt; int c; const LAS int* ts; int total, vcu;
    template <int LA> __device__ __forceinline__ bool setup(int i, const char*& bA, unsigned (&oA)[LA], const char*& bB, Epi& e, int& n0, int wid, int lane) const {
        const int Lt = vcu + GRID * i; if (Lt >= total) return false;
        const int mt = Lt >> 1, nt = Lt & 1;
        int ex = 0;
#pragma unroll
        for (int stp = 64; stp >= 1; stp >>= 1) if (ex + stp <= 64 && ts[ex + stp] <= mt) ex += stp;
        const int ml = mt - ts[ex];
        const bf16_t* Bt = ex < 64 ? (const bf16_t*)(ws + WS_W13) + (size_t)ex * 512 * D : (const bf16_t*)(ws + WS_WS13);
        const int* list = (const int*)(ws + WS_TOKL) + (size_t)(c * 64 + (ex & 63)) * CH_TOK; const int n = ex < 64 ? (int)cnt[c * 64 + ex] : 0;
#pragma unroll
        for (int j = 0; j < LA; ++j) { const int row = stage_row(wid, j, lane), g = ml * MTILE + row;
            const int tok = ex < 64 ? (g < n ? list[g] : c * CH_TOK) : c * CH_TOK + g;
            oA[j] = (unsigned)tok * (unsigned)(D * 2) + (unsigned)stage_chunk(row, lane); }
        bA = (const char*)(ws + WS_H); bB = (const char*)(Bt + (size_t)(nt * 256) * D);
        e = EpiSwiGLU{(bf16_t*)(ws + WS_ACT), mt * MTILE}; n0 = nt * 256; return true;
    }
    static constexpr size_t ldb = D;
};
struct MoeUpX {
    static constexpr int K = D, LDA = D; static constexpr bool GATHER = true;
    const unsigned char* ws; const unsigned* cnt; int c; const LAS int* ts; int total, vcu;
    __device__ __forceinline__ bool next(int i, pg8::UnitX& u) const {
        const int Lt = vcu + GRID * i; if (Lt >= total) return false;
        const int mt = Lt >> 1, nt = Lt & 1;
        int ex = 0;
#pragma unroll
        for (int stp = 64; stp >= 1; stp >>= 1) if (ex + stp <= 64 && ts[ex + stp] <= mt) ex += stp;
        const bf16_t* Bt = ex < 64 ? (const bf16_t*)(ws + WS_W13) + (size_t)ex * 512 * D : (const bf16_t*)(ws + WS_WS13);
        u.pm = mt; u.pn = nt; u.aBase = (const char*)(ws + WS_H); u.bBase = (const char*)(Bt + (size_t)(nt * 256) * D);
        u.list = ex < 64 ? (const int*)(ws + WS_TOKL) + (size_t)(c * 64 + ex) * CH_TOK : nullptr; u.cnt = ex < 64 ? (int)cnt[c * 64 + ex] : 0;
        u.r0 = (mt - ts[ex]) * MTILE; u.dummy = c * CH_TOK; return true;
    }
};
__device__ __forceinline__ void moe_up_phase(ldsp lds, const unsigned char* ws, const unsigned* cnt, int c, const LAS int* ts) {
    MoeUpX src{ws, cnt, c, ts, ts[65] * 2, vcu_of_block()};
    pg8::gemm_phase_x(lds, src, pg8::EpiSwiGLUx{(bf16_t*)(ws + WS_ACT)});
}
struct MoeDownSrc {
    using Epi = EpiStoreBf16;
    const unsigned char* ws; const LAS int* ts; int total, vcu;
    template <int LA> __device__ __forceinline__ bool setup(int i, const char*& bA, unsigned (&oA)[LA], const char*& bB, Epi& e, int& n0, int wid, int lane) const {
        const int Lt = vcu + GRID * i; if (Lt >= total) return false;
        const int mt = Lt >> 2, nt = Lt & 3;
        int ex = 0;
#pragma unroll
        for (int stp = 64; stp >= 1; stp >>= 1) if (ex + stp <= 64 && ts[ex + stp] <= mt) ex += stp;
        const bf16_t* act = (const bf16_t*)(ws + WS_ACT);
        const bf16_t* w2 = ex < 64 ? (const bf16_t*)(ws + WS_W2) + (size_t)ex * D * 256 : (const bf16_t*)(ws + WS_WS2);
#pragma unroll
        for (int j = 0; j < LA; ++j) { const int row = stage_row(wid, j, lane); oA[j] = (unsigned)(row * 512 + stage_chunk(row, lane)); }
        bA = (const char*)(act + (size_t)(mt * MTILE) * 256); bB = (const char*)(w2 + (size_t)(nt * 256) * 256);
        e = EpiStoreBf16{(bf16_t*)(ws + WS_YS), (size_t)D, mt * MTILE}; n0 = nt * 256; return true;
    }
    static constexpr size_t ldb = 256;
};
struct MoeDownX {
    static constexpr int K = 256, LDA = 256; static constexpr bool GATHER = false;
    const unsigned char* ws; const LAS int* ts; int total, vcu;
    __device__ __forceinline__ bool next(int i, pg8::UnitX& u) const {
        const int Lt = vcu + GRID * i; if (Lt >= total) return false;
        const int mt = Lt >> 2, nt = Lt & 3;
        int ex = 0;
#pragma unroll
        for (int stp = 64; stp >= 1; stp >>= 1) if (ex + stp <= 64 && ts[ex + stp] <= mt) ex += stp;
        const bf16_t* w2 = ex < 64 ? (const bf16_t*)(ws + WS_W2) + (size_t)ex * D * 256 : (const bf16_t*)(ws + WS_WS2);
        u.pm = mt; u.pn = nt; u.aBase = (const char*)((const bf16_t*)(ws + WS_ACT) + (size_t)(mt * MTILE) * 256); u.bBase = (const char*)(w2 + (size_t)(nt * 256) * 256);
        u.list = nullptr; u.cnt = 0; u.r0 = 0; u.dummy = 0; return true;
    }
};
__device__ __forceinline__ void moe_down_phase(ldsp lds, const unsigned char* ws, const LAS int* ts) {
    MoeDownX src{ws, ts, ts[65] * 4, vcu_of_block()};
    pg8::gemm_phase_x(lds, src, pg8::EpiYx{(unsigned char*)(ws + WS_YS)});
}
__device__ __forceinline__ void moe_combine_phase(const unsigned char* ws, float* OUT, bf16_t* XRBp, int c, const LAS int* ts, const float* gate_f  , bool last_layer,
                                                  const float* mod_sh_next, const float* mod_G_next, bf16_t* H, const float* fnorm, int gw, int ngw, int lane, bool dry) {
    const unsigned char* ys = ws + WS_YS; const int* sel_e = (const int*)(ws + WS_SELE); const float* sel_w = (const float*)(ws + WS_SELW); const int* sel_p = (const int*)(ws + WS_SELP);
    int slot[9]; float wk[9];
    auto selload = [&](int tl, int (&sl)[9], float (&ww)[9]) { const int tok = c * CH_TOK + tl;
#pragma unroll
        for (int k = 0; k < 8; ++k) { const int e = sel_e[tok * 8 + k]; sl[k] = ts[e] * MTILE + sel_p[tok * 8 + k]; ww[k] = sel_w[tok * 8 + k]; }
        sl[8] = ts[64] * MTILE + tl; ww[8] = 1.f; };
    if (gw < CH_TOK) selload(gw, slot, wk);
    for (int tl = gw; tl < CH_TOK; tl += ngw) {
        const int tok = c * CH_TOK + tl; const int b = tok >> 11;
        u32x2 yv[9][2];
#pragma unroll
        for (int k = 0; k < 9; ++k) { const unsigned char* yr = ys + (size_t)slot[k] * D; yv[k][0] = *(const u32x2*)(yr + 8 * lane); yv[k][1] = *(const u32x2*)(yr + 8 * lane + 512); }
        int nslot[9]; float nwk[9];
        if (tl + ngw < CH_TOK) selload(tl + ngw, nslot, nwk);
        else {
#pragma unroll
            for (int k = 0; k < 9; ++k) { nslot[k] = 0; nwk[k] = 0.f; } }
        float acc[16];
#pragma unroll
        for (int i = 0; i < 16; ++i) acc[i] = 0.f;
#pragma unroll
        for (int k = 0; k < 9; ++k) { const float w = wk[k];
#pragma unroll
            for (int j = 0; j < 2; ++j) { const u32x2 v = yv[k][j];
                const f32x2 p0 = __builtin_amdgcn_cvt_pk_f32_fp8((int)v.x, false), p1 = __builtin_amdgcn_cvt_pk_f32_fp8((int)v.x, true);
                const f32x2 p2 = __builtin_amdgcn_cvt_pk_f32_fp8((int)v.y, false), p3 = __builtin_amdgcn_cvt_pk_f32_fp8((int)v.y, true);
                acc[8 * j + 0] += w * p0[0]; acc[8 * j + 1] += w * p0[1]; acc[8 * j + 2] += w * p1[0]; acc[8 * j + 3] += w * p1[1];
                acc[8 * j + 4] += w * p2[0]; acc[8 * j + 5] += w * p2[1]; acc[8 * j + 6] += w * p3[0]; acc[8 * j + 7] += w * p3[1]; } }
#pragma unroll
        for (int k = 0; k < 9; ++k) { slot[k] = nslot[k]; wk[k] = nwk[k]; }
        float* xr = OUT + (size_t)tok * D; bf16_t* xb = XRBp + (size_t)tok * XRB_LD + XRB_OFF; const float* gf = gate_f + (size_t)b * 6144; float ss = 0.f; float xn[16];
#pragma unroll
        for (int j = 0; j < 2; ++j) { const u32x4 xw = *(const u32x4*)(xb + 8 * lane + 512 * j);
            const float xf[8] = {bf_lo(xw.x), bf_hi(xw.x), bf_lo(xw.y), bf_hi(xw.y), bf_lo(xw.z), bf_hi(xw.z), bf_lo(xw.w), bf_hi(xw.w)};
#pragma unroll
            for (int q = 0; q < 2; ++q) { const int col = 8 * lane + 512 * j + 4 * q; const f32x4 gv = *(const f32x4*)(gf + col);
#pragma unroll
                for (int e = 0; e < 4; ++e) { const float v = xf[4 * q + e] + gv[e] * acc[8 * j + 4 * q + e]; xn[8 * j + 4 * q + e] = v; ss += v * v; } } }
        const float rstd = rsqrtf(wave_sum(ss) * (1.f / D) + 1e-6f);
        if (last_layer) {
#pragma unroll
            for (int j = 0; j < 2; ++j)
#pragma unroll
                for (int q = 0; q < 2; ++q) { const int col = 8 * lane + 512 * j + 4 * q; const f32x4 g = *(const f32x4*)(fnorm + col); f32x4 ov;
#pragma unroll
                    for (int e = 0; e < 4; ++e) ov[e] = xn[8 * j + 4 * q + e] * rstd * g[e];
                    if (!dry) *(f32x4*)(xr + col) = ov; else asm volatile("" :: "v"(ov)); }
        } else {
            const float* sh = mod_sh_next + (size_t)b * 6144; const float* Gn = mod_G_next + (size_t)b * 6144; bf16_t* hrow = H + (size_t)tok * D;
#pragma unroll
            for (int j = 0; j < 2; ++j) { u32x4 hw, xw2;
#pragma unroll
                for (int q = 0; q < 2; ++q) { const int col = 8 * lane + 512 * j + 4 * q; const f32x4 g = *(const f32x4*)(Gn + col), s0 = *(const f32x4*)(sh + col); f32x4 xv, hv;
#pragma unroll
                    for (int e = 0; e < 4; ++e) { xv[e] = xn[8 * j + 4 * q + e]; hv[e] = xv[e] * rstd * g[e] + s0[e]; }
                    if (q == 0) { hw.x = pk2(hv[0], hv[1]); hw.y = pk2(hv[2], hv[3]); xw2.x = pk2(xv[0], xv[1]); xw2.y = pk2(xv[2], xv[3]); }
                    else { hw.z = pk2(hv[0], hv[1]); hw.w = pk2(hv[2], hv[3]); xw2.z = pk2(xv[0], xv[1]); xw2.w = pk2(xv[2], xv[3]); } }
                if (!dry) { *(u32x4*)(hrow + 8 * lane + 512 * j) = hw; *(u32x4*)(xb + 8 * lane + 512 * j) = xw2; } else asm volatile("" :: "v"(hw), "v"(xw2)); }
        }
    }
}

struct PSrc {
    using Epi = EpiCausalP;
    const bf16_t* rp; bf16_t* P;
    template <int LA> __device__ __forceinline__ bool setup(int i, const char*& bA, unsigned (&oA)[LA], const char*& bB, Epi& e, int& n0, int wid, int lane) const {
        const int u = blockIdx.x + GRID * i; if (u >= 1024) return false;
        const int bh = u >> 4, c = u & 15, b = bh >> 2, h = bh & 3;
        const bf16_t* qa = rp + ((size_t)b * SEQ + c * 128) * 6144 + h * 256;
#pragma unroll
        for (int j = 0; j < LA; ++j) { const int row = stage_row(wid, j, lane); oA[j] = (unsigned)(row * 6144 * 2 + stage_chunk(row, lane)); }
        bA = (const char*)qa; bB = (const char*)(qa + 1024);
        e = EpiCausalP{P + (size_t)u * 16384}; n0 = 0; return true;
    }
    static constexpr size_t ldb = 6144;
};
#define TIC(cat) do { if (TIME_SEL >= 0 && blockIdx.x == 0 && threadIdx.x == 0) { const unsigned long long now_ = __builtin_amdgcn_s_memrealtime(); LAS unsigned long long* tb_ = (LAS unsigned long long*)(lds + LDS_MISC + 1024); if ((cat) == TIME_SEL) tb_[1] += now_ - tb_[0]; tb_[0] = now_; } } while (0)
#define FRESH_IDS() const int t_ = fresh_tid(); const int lane = t_ & 63, wave = __builtin_amdgcn_readfirstlane(t_ >> 6); const int gw = blockIdx.x * NWAVE + wave, ngw = GRID * NWAVE; (void)lane; (void)gw; (void)ngw
#define SEAM(cat) do { xcd_barrier(bar); TIC(cat); } while (0)
#define SEAMW(cat, layer_, k_, n_) do { xcd_barrier_work(bar, [&]() { const int t_ = fresh_tid(); const int lane = t_ & 63, wave = __builtin_amdgcn_readfirstlane(t_ >> 6); \
        convert_expert_weights(a, (layer_), lds, blockIdx.x * 7 + wave - 1, GRID * 7, wave, lane, (k_), (n_)); }); TIC(cat); } while (0)
#define OUTPROJ_ROUTER(layer_, A_, lda_, Bt_, ldb_, K_, mk_, cat_, sk_, sn_) do { \
    pg8::dense(lds, A_, (int)(lda_), Bt_, T, D, K_, mk_); \
    SEAMW(cat_, layer_, sk_, sn_); \
    { const float* modl_ = (const float*)(ws + WS_MOD) + (size_t)(layer_) * 16 * 6144; const int m0_ = vcu_of_block() * 128; FRESH_IDS(); \
      router_phase(lds, XRB, modl_ + 3072, modl_ + 4096, (const bf16_t*)(ws + WS_RWT) + (size_t)(layer_) * 2 * 64 * 1024, a.in[I_ROUTB] + (layer_) * 64, \
                   (bf16_t*)(ws + WS_H), (int*)(ws + WS_SELE), (float*)(ws + WS_SELW), (int*)(ws + WS_SELP), (int*)(ws + WS_TOKL), (unsigned*)(ws + WS_CNT) + (layer_) * 256, \
                   m0_ / 16 + wave, m0_ / 16 + wave + 1, 1, wave, lane, false); } \
  } while (0)
__device__ __forceinline__ void moe_layer(const Args& a, ldsp lds, const XcdBarrier& bar, int layer) {
    unsigned char* ws = a.ws;
    float* mod = (float*)(ws + WS_MOD); float* XR = a.out; bf16_t* XRB = (bf16_t*)a.out; bf16_t* H = (bf16_t*)(ws + WS_H);
    const float* modl = mod + (size_t)layer * 16 * 6144;
    const float* modn = mod + (size_t)16 * 6144;
    unsigned* cl = (unsigned*)(ws + WS_CNT) + layer * 256;
    LAS int* ts0 = (LAS int*)(lds + LDS_MISC); LAS int* ts1 = ts0 + 80;
    for (int c = 0; c <= NCHUNK; ++c) {
        __syncthreads();
        if (c < NCHUNK) build_tstart(cl, c, ts0);
        if (c > 0) build_tstart(cl, c - 1, ts1);
        __syncthreads();
        const bool comb_first = (blockIdx.x & 8) != 0;
        if (c > 0 && comb_first) { FRESH_IDS(); moe_combine_phase(ws, XR, XRB, c - 1, ts1, modl + 5120, layer == 1, modn, modn + 1024, H, a.in[I_FNORM], gw, ngw, lane, false); }
        if (c < NCHUNK) moe_up_phase(lds, ws, cl, c, ts0);
        if (c > 0 && !comb_first) { FRESH_IDS(); moe_combine_phase(ws, XR, XRB, c - 1, ts1, modl + 5120, layer == 1, modn, modn + 1024, H, a.in[I_FNORM], gw, ngw, lane, false); }
        if (c == NCHUNK) break;
        SEAM(6);
        moe_down_phase(lds, ws, ts0);
        if (layer == 0 && c == NCHUNK - 1) SEAMW(7, 1, 0, 7); else SEAM(7);
    }
}
__global__ void __launch_bounds__(NTHR, 2) fwd_kernel(Args a) {
    extern __shared__ __attribute__((aligned(16))) unsigned char lds_raw[];
    ldsp lds = (ldsp)lds_raw;
    unsigned char* ws = a.ws;
    volatile LAS unsigned* st = (volatile LAS unsigned*)(lds + LDS_BYTES - 16);
    if (threadIdx.x < 4) st[threadIdx.x] = 0u;
    if (TIME_SEL >= 0 && threadIdx.x == 0) { LAS unsigned long long* tb_ = (LAS unsigned long long*)(lds + LDS_MISC + 1024); tb_[0] = __builtin_amdgcn_s_memrealtime(); tb_[1] = 0ull; }
    __syncthreads();
    XcdBarrier bar = xcd_barrier_post((unsigned*)(ws + WS_BAR), st);
    float* mod = (float*)(ws + WS_MOD);
    float* XR = a.out; bf16_t* XRB = (bf16_t*)a.out;
    bf16_t* H = (bf16_t*)(ws + WS_H);

    mod_items(a, lds);
    __syncthreads();
    { FRESH_IDS(); convert_dense_weights(a, lds, gw, ngw, wave, lane); }
    SEAMW(0, 0, 0, 5);
    { FRESH_IDS(); adaln_phase(a.in[I_X], mod, mod + 1024, H, gw, ngw, lane); }
    { FRESH_IDS();
      bf16_t* rwt = (bf16_t*)(ws + WS_RWT);
      for (int idx = blockIdx.x * NTHR + t_; idx < 2 * D * 64; idx += GRID * NTHR) { const int l2 = idx >> 16, k = (idx >> 6) & 1023, e = idx & 63;
          const float w = a.in[I_ROUTW][idx]; const unsigned hi = pk2(w, 0.f) & 0xffffu; const unsigned lo = pk2(w - bf_lo(hi), 0.f) & 0xffffu;
          rwt[((size_t)(l2 * 2 + 0) * 64 + e) * 1024 + k] = (bf16_t)hi; rwt[((size_t)(l2 * 2 + 1) * 64 + e) * 1024 + k] = (bf16_t)lo; } }
    SEAMW(1, 0, 1, 5);

    pg8::dense(lds, H, D, (const bf16_t*)(ws + WS_WQKV), T, 3072, D, pg8::EpiQKV{(bf16_t*)(ws + WS_QKV), (size_t)3072});
    SEAMW(2, 0, 2, 5);
    { float d1 = 0.f, d2 = 0.f;
      for (int i = 0; i < 64; ++i) { d1 += a.in[I_LQ1][i] * a.in[I_LK1][i]; d2 += a.in[I_LQ2][i] * a.in[I_LK2][i]; }
      const float lam = __expf(d1) - __expf(d2) + 0.2f;
      attn_phase(lds, (const bf16_t*)(ws + WS_QKV), (bf16_t*)(ws + WS_AO), lam, a.in[I_SUBLN]); }
    SEAMW(3, 0, 3, 5);
    { const pg8::EpiRes<true> mk{a.in[I_X], XRB, mod + 2048};
      OUTPROJ_ROUTER(0, (const bf16_t*)(ws + WS_AO), D, (const bf16_t*)(ws + WS_WO), D, D, mk, 4, 4, 5); }
    SEAM(5);
    moe_layer(a, lds, bar, 0);
    SEAMW(6, 1, 1, 7);

    const float* mod1 = mod + (size_t)16 * 6144;
    pg8::dense(lds, H, D, (const bf16_t*)(ws + WS_WRI), T, 6144, D, pg8::EpiRet{(bf16_t*)(ws + WS_RP)});
    SEAMW(8, 1, 2, 7);
    { PSrc src{(const bf16_t*)(ws + WS_RP), (bf16_t*)(ws + WS_P)};
      gemm_stream<2, 4, 4, 2, 3>(lds, 256, src); }
    SEAMW(9, 1, 3, 7);
    chain_phase(lds, (bf16_t*)(ws + WS_RP), (const bf16_t*)(ws + WS_P), false);
    SEAMW(10, 1, 4, 7);
    { FRESH_IDS(); gnorm_phase((bf16_t*)(ws + WS_RP), a.in[I_RGN], gw, ngw, lane, false); }
    SEAMW(11, 1, 5, 7);
    { const pg8::EpiRes<false> mk{XRB, XRB, mod1 + 2048};
      OUTPROJ_ROUTER(1, (const bf16_t*)(ws + WS_RP) + 2048, 6144, (const bf16_t*)(ws + WS_WRO), 2048, 2048, mk, 12, 6, 7); }
    SEAM(5);
    moe_layer(a, lds, bar, 1);
    if (TIME_SEL >= 0) {
        __syncthreads(); TIC(6);
        if (blockIdx.x == 0 && threadIdx.x == 0) { LAS unsigned long long* tb_ = (LAS unsigned long long*)(lds + LDS_MISC + 1024); const unsigned long long t0 = __builtin_amdgcn_s_memrealtime();
            while (__builtin_amdgcn_s_memrealtime() - t0 < TIME_MUL * tb_[1]) __builtin_amdgcn_s_sleep(8); }
    }
}

extern "C" void kernel_launch(void* const* d_in, const int* in_sizes, int n_in, void* d_out, int out_size, void* d_ws, size_t ws_size, hipStream_t stream) {
    static int ready = 0;
    if (ready == 0) {
        if (n_in != 25 || out_size != T * D || ws_size < WS_END) { fprintf(stderr, "kernel_launch: unexpected shapes (n_in %d out %d ws %zu need %zu)\n", n_in, out_size, ws_size, (size_t)WS_END); ready = -1; return; }
        (void)hipFuncSetAttribute((const void*)fwd_kernel, hipFuncAttributeMaxDynamicSharedMemorySize, LDS_BYTES);
        ready = 1;
    }
    if (ready < 0) return;
    (void)hipMemsetAsync(d_ws, 0, 65536, stream);
    Args a{};
    for (int i = 0; i < 25; ++i) a.in[i] = (const float*)d_in[i];
    a.out = (float*)d_out; a.ws = (unsigned char*)d_ws;
    hipLaunchKernelGGL(fwd_kernel, dim3(GRID), dim3(NTHR), LDS_BYTES, stream, a);
}
```
